# Optimizing an MI355X kernel written in HIP

```python
import math
import jax, jax.numpy as jnp
from jax import lax
import numpy as np

D_MODEL = 1024
BATCH = 4
SEQ = 4096
DEPTH = 4

D_FF = 2816
NSA_HEADS = 8
NSA_GROUPS = 2
NSA_HPG = NSA_HEADS // NSA_GROUPS
NSA_DH = 64
CMP_BLOCK = 32
CMP_STRIDE = 16
CMP_HIDDEN = 256
SEL_BLOCK = 64
SEL_TOPN = 16
WINDOW = 512
Q_BLOCK = 64
GLA_HEADS = 4
GLA_DK = 128
GLA_DV = 256
GLA_RANK = 16
GLA_TAU = 16.0
GLA_CHUNK = 64
REL_BUCKETS = 32
REL_MAX_DIST = 1024
EPS = 1e-6
NEG = -1e30

W_IN_SPLITS = (
    NSA_HEADS * NSA_DH,
    6 * NSA_GROUPS * NSA_DH,
    3 * NSA_HEADS,
    GLA_HEADS * GLA_DK,
    GLA_HEADS * GLA_DK,
    GLA_HEADS * GLA_DV,
    GLA_RANK,
    GLA_HEADS * GLA_DV,
    2 * D_MODEL,
)
D_IN = sum(W_IN_SPLITS)

kernel_name = "hybrid_nsa_gla_macaron_t5bias"


def rmsnorm(x, g):
    xf = x.astype(jnp.float32)
    y = xf * lax.rsqrt(jnp.mean(xf * xf, axis=-1, keepdims=True) + EPS)
    return (y * g.astype(jnp.float32)).astype(x.dtype)


def swiglu(x, w_gate, w_up, w_down):
    return (jax.nn.silu(x @ w_gate) * (x @ w_up)) @ w_down


def rel_bucket(dist):
    n = jnp.maximum(dist, 0)
    exact = REL_BUCKETS // 2
    nf = jnp.maximum(n, 1).astype(jnp.float32)
    log_b = exact + (jnp.log(nf / exact) / math.log(REL_MAX_DIST / exact)
                     * (REL_BUCKETS - exact)).astype(jnp.int32)
    return jnp.where(n < exact, n, jnp.minimum(log_b, REL_BUCKETS - 1))


def masked_softmax(logits, mask):
    p = jax.nn.softmax(jnp.where(mask, logits, NEG), axis=-1)
    return jnp.where(mask, p, 0.0)


def nsa_compress(k, pos, w1, w2):
    B, S, G, dh = k.shape
    nc = (S - CMP_BLOCK) // CMP_STRIDE + 1
    idx = jnp.arange(nc)[:, None] * CMP_STRIDE + jnp.arange(CMP_BLOCK)[None, :]
    blocks = k[:, idx] + pos[None, None, :, None, :]
    blocks = blocks.transpose(0, 1, 3, 2, 4).reshape(B, nc, G, CMP_BLOCK * dh)
    return jax.nn.silu(blocks @ w1) @ w2


def nsa_attention(q, k_cmp, v_cmp, k_slc, v_slc, k_win, v_win, gates, rel_table):
    B, S, H, dh = q.shape
    G, HPG = NSA_GROUPS, NSA_HPG
    nqb = S // Q_BLOCK
    ns = S // SEL_BLOCK
    nc = k_cmp.shape[1]
    n_sel = min(SEL_TOPN, ns)
    kw_len = WINDOW + Q_BLOCK

    c_start = jnp.arange(nc) * CMP_STRIDE
    cmp_end = c_start + CMP_BLOCK - 1
    sb_start = jnp.arange(ns) * SEL_BLOCK
    overlap = ((c_start[:, None] < sb_start[None, :] + SEL_BLOCK)
               & (c_start[:, None] + CMP_BLOCK > sb_start[None, :])).astype(jnp.float32)
    js = jnp.arange(ns)
    table_g = rel_table.reshape(REL_BUCKETS, G, HPG).transpose(1, 0, 2)

    kb = k_slc.reshape(B, ns, SEL_BLOCK, G, dh).transpose(0, 3, 1, 2, 4)
    vb = v_slc.reshape(B, ns, SEL_BLOCK, G, dh).transpose(0, 3, 1, 2, 4)
    pad = ((0, 0), (WINDOW, 0), (0, 0), (0, 0))
    kw = jnp.pad(k_win, pad)
    vw = jnp.pad(v_win, pad)

    def to_blocks(a):
        return a.reshape(B, nqb, Q_BLOCK, *a.shape[2:]).swapaxes(0, 1)

    qs = to_blocks(q * (dh ** -0.5))
    gs = to_blocks(gates)
    bi = jnp.arange(B)[:, None, None, None]
    gi = jnp.arange(G)[None, :, None, None]

    def block_fn(args):
        c, qc, gc = args
        t = c * Q_BLOCK + jnp.arange(Q_BLOCK)
        qg = qc.reshape(B, Q_BLOCK, G, HPG, dh)

        lc = jnp.einsum('bqghd,bcgd->bghqc', qg, k_cmp).astype(jnp.float32)
        bias_c = rel_table[rel_bucket(t[:, None] - cmp_end[None, :])]
        lc = lc + bias_c.reshape(Q_BLOCK, nc, G, HPG).transpose(2, 3, 0, 1)
        p_cmp = masked_softmax(lc, cmp_end[None, :] <= t[:, None])
        o_cmp = jnp.einsum('bghqc,bcgd->bqghd', p_cmp.astype(v_cmp.dtype), v_cmp)

        imp = jnp.einsum('bghqc,cs->bgqs', p_cmp, overlap)
        jcur = t // SEL_BLOCK
        forced = (js[None, :] == 0) | (js[None, :] == jcur[:, None]) | (js[None, :] == jcur[:, None] - 1)
        valid = js[None, :] <= jcur[:, None]
        score = jnp.where(forced, 1e6, jnp.where(valid, imp, -1e6))
        _, sel = lax.top_k(score, n_sel)
        ks = kb[bi, gi, sel]
        vs = vb[bi, gi, sel]
        s_pos = sel[..., None] * SEL_BLOCK + jnp.arange(SEL_BLOCK)
        ls = jnp.einsum('bqghd,bgqnrd->bghqnr', qg, ks).astype(jnp.float32)
        bias_s = table_g[gi[..., None], rel_bucket(t[:, None, None] - s_pos)]
        ls = ls + bias_s.transpose(0, 1, 5, 2, 3, 4)
        ksel = n_sel * SEL_BLOCK
        ls = ls.reshape(B, G, HPG, Q_BLOCK, ksel)
        ms = (s_pos <= t[:, None, None]).reshape(B, G, Q_BLOCK, ksel)[:, :, None]
        p_s = masked_softmax(ls, ms)
        o_slc = jnp.einsum('bghqk,bgqkd->bqghd', p_s.astype(vs.dtype),
                           vs.reshape(B, G, Q_BLOCK, ksel, dh))

        kwc = lax.dynamic_slice_in_dim(kw, c * Q_BLOCK, kw_len, axis=1)
        vwc = lax.dynamic_slice_in_dim(vw, c * Q_BLOCK, kw_len, axis=1)
        s_w = c * Q_BLOCK - WINDOW + jnp.arange(kw_len)
        dist = t[:, None] - s_w[None, :]
        mw = (s_w[None, :] >= 0) & (dist >= 0) & (dist < WINDOW)
        lw = jnp.einsum('bqghd,bkgd->bghqk', qg, kwc).astype(jnp.float32)
        lw = lw + rel_table[rel_bucket(dist)].reshape(Q_BLOCK, kw_len, G, HPG).transpose(2, 3, 0, 1)
        p_w = masked_softmax(lw, mw)
        o_win = jnp.einsum('bghqk,bkgd->bqghd', p_w.astype(vwc.dtype), vwc)

        o = jnp.stack([o_cmp, o_slc, o_win], axis=-1)
        g = gc.reshape(B, Q_BLOCK, G, HPG, 3)[..., None, :]
        return jnp.sum(o * g, axis=-1).reshape(B, Q_BLOCK, H * dh).astype(q.dtype)

    out = lax.map(block_fn, (jnp.arange(nqb), qs, gs))
    return out.swapaxes(0, 1).reshape(B, S, H * dh)


def gla_attention(q, k, v, log_a):
    B, S, Hb, dk = q.shape
    dv = v.shape[-1]
    C = GLA_CHUNK
    n = S // C

    def chunks(a):
        return a.reshape(B, n, C, *a.shape[2:])

    qc, kc, vc, la = chunks(q * (dk ** -0.5)), chunks(k), chunks(v), chunks(log_a)
    b = jnp.cumsum(la.astype(jnp.float32), axis=2)
    b_last = b[:, :, -1:]
    q_dec = qc * jnp.exp(b)
    k_intra = kc * jnp.exp(-b)
    k_state = kc * jnp.exp(b_last - b)
    causal = jnp.tril(jnp.ones((C, C), dtype=bool))
    A = jnp.where(causal, jnp.einsum('bnihd,bnjhd->bnhij', q_dec, k_intra), 0.0)
    o_intra = jnp.einsum('bnhij,bnjhv->bnihv', A, vc.astype(jnp.float32))
    decay_chunk = jnp.exp(b_last[:, :, 0])

    def step(state, inp):
        qd, ksd, vcc, dch = inp
        o = jnp.einsum('bihd,bhdv->bihv', qd, state)
        state = dch[..., None] * state + jnp.einsum('bjhd,bjhv->bhdv', ksd, vcc.astype(jnp.float32))
        return state, o

    s0 = jnp.zeros((B, Hb, dk, dv), jnp.float32)
    _, o_inter = lax.scan(step, s0, (q_dec.swapaxes(0, 1), k_state.swapaxes(0, 1),
                                     vc.swapaxes(0, 1), decay_chunk.swapaxes(0, 1)))
    o = o_intra + o_inter.swapaxes(0, 1)
    return o.reshape(B, S, Hb, dv).astype(v.dtype)


def setup_inputs(seed: int = 0) -> dict:
    key = jax.random.key(seed)
    ks = jax.random.split(key, 32)
    f32 = jnp.float32
    L, D = DEPTH, D_MODEL

    def w(k, shape, fan_in):
        return jax.random.normal(k, shape, f32) * fan_in ** -0.5

    def gain(k, shape):
        return 1.0 + 0.05 * jax.random.normal(k, shape, f32)

    return {
        "x": jax.random.normal(ks[0], (BATCH, SEQ, D), f32),
        "rel_table": 0.2 * jax.random.normal(ks[1], (REL_BUCKETS, NSA_HEADS), f32),
        "ffn1_norm": gain(ks[2], (L, D)),
        "ffn1_w_gate": w(ks[3], (L, D, D_FF), D),
        "ffn1_w_up": w(ks[4], (L, D, D_FF), D),
        "ffn1_w_down": w(ks[5], (L, D_FF, D), D_FF),
        "mix_norm": gain(ks[6], (L, D)),
        "w_in": w(ks[7], (L, D, D_IN), D),
        "cmp_pos_k": 0.5 * jax.random.normal(ks[8], (L, CMP_BLOCK, NSA_DH), f32),
        "cmp_pos_v": 0.5 * jax.random.normal(ks[9], (L, CMP_BLOCK, NSA_DH), f32),
        "cmp_k_w1": w(ks[10], (L, CMP_BLOCK * NSA_DH, CMP_HIDDEN), CMP_BLOCK * NSA_DH),
        "cmp_k_w2": w(ks[11], (L, CMP_HIDDEN, NSA_DH), CMP_HIDDEN),
        "cmp_v_w1": w(ks[12], (L, CMP_BLOCK * NSA_DH, CMP_HIDDEN), CMP_BLOCK * NSA_DH),
        "cmp_v_w2": w(ks[13], (L, CMP_HIDDEN, NSA_DH), CMP_HIDDEN),
        "gla_a_w2": w(ks[14], (L, GLA_RANK, GLA_HEADS * GLA_DK), GLA_RANK),
        "gla_a_b": 0.1 * jax.random.normal(ks[15], (L, GLA_HEADS * GLA_DK), f32),
        "gla_out_norm": gain(ks[16], (L, GLA_HEADS * GLA_DV)),
        "w_branch_nsa": w(ks[17], (L, NSA_HEADS * NSA_DH, D), NSA_HEADS * NSA_DH),
        "w_branch_gla": w(ks[18], (L, GLA_HEADS * GLA_DV, D), GLA_HEADS * GLA_DV),
        "w_out": w(ks[19], (L, D, D), D),
        "ffn2_norm": gain(ks[20], (L, D)),
        "ffn2_w_gate": w(ks[21], (L, D, D_FF), D),
        "ffn2_w_up": w(ks[22], (L, D, D_FF), D),
        "ffn2_w_down": w(ks[23], (L, D_FF, D), D_FF),
        "final_norm": gain(ks[24], (D,)),
    }


def reference(x, rel_table, ffn1_norm, ffn1_w_gate, ffn1_w_up, ffn1_w_down, mix_norm, w_in,
              cmp_pos_k, cmp_pos_v, cmp_k_w1, cmp_k_w2, cmp_v_w1, cmp_v_w2, gla_a_w2, gla_a_b,
              gla_out_norm, w_branch_nsa, w_branch_gla, w_out, ffn2_norm, ffn2_w_gate, ffn2_w_up,
              ffn2_w_down, final_norm):
    B, S, D = x.shape
    offsets = np.cumsum(W_IN_SPLITS)[:-1].tolist()
    for l in range(DEPTH):
        x = x + 0.5 * swiglu(rmsnorm(x, ffn1_norm[l]), ffn1_w_gate[l], ffn1_w_up[l], ffn1_w_down[l])

        h = rmsnorm(x, mix_norm[l])
        proj = h @ w_in[l]
        q_a, kv_a, g_a, q_b, k_b, v_b, a_lr, r_b, g_merge = jnp.split(proj, offsets, axis=-1)

        q_a = q_a.reshape(B, S, NSA_HEADS, NSA_DH)
        kv_a = kv_a.reshape(B, S, 6, NSA_GROUPS, NSA_DH)
        k_cmp = nsa_compress(kv_a[:, :, 0], cmp_pos_k[l], cmp_k_w1[l], cmp_k_w2[l])
        v_cmp = nsa_compress(kv_a[:, :, 1], cmp_pos_v[l], cmp_v_w1[l], cmp_v_w2[l])
        gates_a = jax.nn.sigmoid(g_a).reshape(B, S, NSA_HEADS, 3)
        o_a = nsa_attention(q_a, k_cmp, v_cmp, kv_a[:, :, 2], kv_a[:, :, 3],
                            kv_a[:, :, 4], kv_a[:, :, 5], gates_a, rel_table)

        log_a = jax.nn.log_sigmoid((a_lr @ gla_a_w2[l] + gla_a_b[l]).astype(jnp.float32)) / GLA_TAU
        o_b = gla_attention(q_b.reshape(B, S, GLA_HEADS, GLA_DK),
                            k_b.reshape(B, S, GLA_HEADS, GLA_DK),
                            v_b.reshape(B, S, GLA_HEADS, GLA_DV),
                            log_a.reshape(B, S, GLA_HEADS, GLA_DK))
        o_b = rmsnorm(o_b, gla_out_norm[l].reshape(GLA_HEADS, GLA_DV))
        o_b = o_b.reshape(B, S, GLA_HEADS * GLA_DV) * jax.nn.silu(r_b)

        gm = jax.nn.sigmoid(g_merge).reshape(B, S, 2, D)
        y = gm[:, :, 0] * (o_a @ w_branch_nsa[l]) + gm[:, :, 1] * (o_b @ w_branch_gla[l])
        x = x + y @ w_out[l]

        x = x + 0.5 * swiglu(rmsnorm(x, ffn2_norm[l]), ffn2_w_gate[l], ffn2_w_up[l], ffn2_w_down[l])
    return rmsnorm(x, final_norm)
```

```cpp
#include <hip/hip_runtime.h>
#include <cstdio>
#include <cstdint>

namespace pg8 {
#define PG8_LAS __attribute__((address_space(3)))
typedef unsigned short bf16_t;
typedef short bf16x8 __attribute__((ext_vector_type(8)));
typedef float f32x4 __attribute__((ext_vector_type(4)));
typedef unsigned u32x4 __attribute__((ext_vector_type(4)));
constexpr int BM = 256, BK = 64, HALF = 128, HTB = HALF * BK * 2  , STAGE_BYTES = 8 * HTB, NXCD = 8, WGM = 8;

__host__ __device__ __forceinline__ int lds_byte(int r, int c) { const int st = (r >> 4) * 2 + (c >> 5), rr = r & 15, cc = c & 31, ob = rr * 64 + cc * 2; return st * 1024 + (ob ^ (((ob >> 9) & 1) << 5)); }
__host__ __device__ __forceinline__ void stage_rc(int b, int& R, int& C) { const int st = b / 1024, sb = b % 1024, swz = sb ^ (((sb >> 9) & 1) << 5); R = (st >> 1) * 16 + swz / 64; C = (st & 1) * 32 + (swz % 64) / 2; }
__host__ __device__ __forceinline__ int perm32(int rho) { const int n = rho >> 4, i = rho & 15; return 8 * (i >> 2) + 4 * n + (i & 3); }

struct Unit { int pm, pn; };
struct Gemm { const bf16_t* A; const bf16_t* Bt; int M, N, K, lda; };

struct StaticOrder {
    int nM, nN, nwg, G, c;
    __host__ __device__ void init(int M, int N, int G_, int c_) { nM = M / BM; nN = N / BM; nwg = nM * nN; G = G_; c = c_; }
    __host__ __device__ bool next(int i, Unit& u) const {
        const long L = (long)i * G + c; if (L >= nwg) return false;
        int wgid = (int)L; { const int q = nwg / NXCD, r = nwg % NXCD, xcd = wgid % NXCD, off = wgid / NXCD; wgid = (xcd < r ? xcd * (q + 1) : r * (q + 1) + (xcd - r) * q) + off; }
        const int nig = WGM * nN, gid = wgid / nig, fm = gid * WGM, gsz = (nM - fm) < WGM ? (nM - fm) : WGM;
        u.pm = fm + ((wgid % nig) % gsz); u.pn = (wgid % nig) / gsz; return true;
    }
    __device__ __forceinline__ void a_ready(const Unit&) const {}
    __device__ __forceinline__ void done(const Unit&) const {}
};
template <class Epi, class Sched, bool ALIGN_EPI = false, bool SP2 = false>
__device__ __forceinline__ void gemm_phase(PG8_LAS unsigned char* lds, const Gemm g, const Sched& S, const Epi& E) {
    int tid_ = threadIdx.x; asm volatile("" : "+v"(tid_));
    const int tid = tid_, wid = __builtin_amdgcn_readfirstlane(tid >> 6), lane = tid & 63, wr = wid >> 2, wc = wid & 3, fr = lane & 15, fq = lane >> 4;
    const int K = g.K, nt = K / BK;
    unsigned voffA[2], voffB[2];
#pragma unroll
    for (int i = 0; i < 2; ++i) { int R, C; stage_rc(tid * 16 + i * 8192, R, C); const int Rb = Epi::PERM ? ((R & ~31) + perm32(R & 31)) : R;
        voffA[i] = (unsigned)(R * g.lda + C) * 2u; voffB[i] = (unsigned)(Rb * K + C) * 2u; }
    const size_t kstep = (size_t)(BK * 2);
    const size_t hstep = (size_t)HALF * K * 2;
    const size_t tstep = 2 * hstep;
    const size_t hstepA = (size_t)HALF * g.lda * 2, tstepA = 2 * hstepA;
    const unsigned ldsw = (unsigned)wid * 1024u;
    const int aoff = lds_byte(wr * 64 + fr, fq * 8), boff = lds_byte(wc * 32 + fr, fq * 8);
#define PG8_SA(b, h) (((b) * 2 + (h)) * HTB)
#define PG8_SB(b, h) ((4 + (b) * 2 + (h)) * HTB)
#define PG8_STAGE(bufoff, gbase, voff) do { _Pragma("unroll") for (int _i = 0; _i < 2; ++_i) \
        __builtin_amdgcn_global_load_lds((const unsigned*)((const char*)(gbase) + (voff)[_i]), (PG8_LAS unsigned*)(lds + (bufoff) + ldsw + _i * 8192), 16, 0, 0); } while (0)
#define PG8_LDA(dst, b, h) do { _Pragma("unroll") for (int m = 0; m < 4; ++m) _Pragma("unroll") for (int k = 0; k < 2; ++k) dst[m][k] = *(const PG8_LAS bf16x8*)(lds + PG8_SA(b, h) + aoff + m * 2048 + k * 1024); } while (0)
#define PG8_LDB(dst, b, h) do { _Pragma("unroll") for (int n = 0; n < 2; ++n) _Pragma("unroll") for (int k = 0; k < 2; ++k) dst[n][k] = *(const PG8_LAS bf16x8*)(lds + PG8_SB(b, h) + boff + n * 2048 + k * 1024); } while (0)
#define PG8_MMA(ai, bj, At, Bt) do { __builtin_amdgcn_s_setprio(1); _Pragma("unroll") for (int m = 0; m < 4; ++m) _Pragma("unroll") for (int n = 0; n < 2; ++n) _Pragma("unroll") for (int k = 0; k < 2; ++k) \
        acc[ai][bj][m][n] = __builtin_amdgcn_mfma_f32_16x16x32_bf16(Bt[n][k], At[m][k], acc[ai][bj][m][n], 0, 0, 0); __builtin_amdgcn_s_setprio(0); } while (0)
#define PG8_WAIT_V(n) asm volatile("s_waitcnt vmcnt(" #n ")" ::: "memory")
#define PG8_WAIT_L(n) asm volatile("s_waitcnt lgkmcnt(" #n ")" ::: "memory")
#define PG8_BAR __builtin_amdgcn_s_barrier()
#define PG8_SCHED __builtin_amdgcn_sched_barrier(0)
    Unit cur, nxt; int ui = 0;
    if (!S.next(0, cur)) return;
    f32x4 acc[2][2][4][2];
#pragma unroll
    for (int a = 0; a < 2; ++a)
#pragma unroll
        for (int b = 0; b < 2; ++b)
#pragma unroll
            for (int m = 0; m < 4; ++m)
#pragma unroll
                for (int n = 0; n < 2; ++n) acc[a][b][m][n] = (f32x4){0.f, 0.f, 0.f, 0.f};
    bf16x8 At[4][2], B0[2][2], B1[2][2];
    const char* cA = (const char*)g.A + (size_t)cur.pm * tstepA; const char* cB = (const char*)g.Bt + (size_t)cur.pn * tstep;
    S.a_ready(cur);
    if constexpr (SP2) {
        PG8_STAGE(PG8_SB(0, 0), cB, voffB); PG8_STAGE(PG8_SB(0, 1), cB + hstep, voffB); PG8_STAGE(PG8_SA(0, 0), cA, voffA); PG8_STAGE(PG8_SA(0, 1), cA + hstepA, voffA);
        if (wr == 1) PG8_BAR;
        PG8_WAIT_V(2); PG8_BAR;
        PG8_STAGE(PG8_SB(1, 0), cB + kstep, voffB); PG8_STAGE(PG8_SA(1, 0), cA + kstep, voffA); PG8_STAGE(PG8_SB(1, 1), cB + hstep + kstep, voffB);
        PG8_WAIT_V(6); PG8_BAR;
    } else {
        PG8_STAGE(PG8_SB(0, 0), cB, voffB); PG8_STAGE(PG8_SA(0, 0), cA, voffA); PG8_STAGE(PG8_SB(0, 1), cB + hstep, voffB); PG8_STAGE(PG8_SA(0, 1), cA + hstepA, voffA);
        if (wr == 1) PG8_BAR;
        PG8_WAIT_V(4); PG8_BAR;
        PG8_STAGE(PG8_SB(1, 0), cB + kstep, voffB); PG8_STAGE(PG8_SA(1, 0), cA + kstep, voffA); PG8_STAGE(PG8_SB(1, 1), cB + hstep + kstep, voffB);
        PG8_WAIT_V(6); PG8_BAR;
    }
    for (;;) {
        const bool has_next = S.next(ui + 1, nxt);
        const char* nA = has_next ? (const char*)g.A + (size_t)nxt.pm * tstepA : cA; const char* nB = has_next ? (const char*)g.Bt + (size_t)nxt.pn * tstep : cB;
        for (int t = 0; t < nt; t += 2) {
            const bool last = (t == nt - 2);
            const char* a1 = cA + (size_t)(t + 1) * kstep;
            const char* a2 = last ? nA : cA + (size_t)(t + 2) * kstep; const char* b2 = last ? nB : cB + (size_t)(t + 2) * kstep;
            const char* a3 = a2 + kstep; const char* b3 = b2 + kstep;
            if (last && has_next) S.a_ready(nxt);
            if constexpr (SP2) {
            PG8_LDB(B0, 0, 0); PG8_LDB(B1, 0, 1); PG8_SCHED; PG8_LDA(At, 0, 0); PG8_STAGE(PG8_SA(1, 1), a1 + hstepA, voffA);
            PG8_WAIT_V(8); PG8_WAIT_L(0); PG8_BAR; PG8_MMA(0, 0, At, B0); PG8_MMA(0, 1, At, B1); PG8_BAR; PG8_SCHED;
            PG8_LDA(At, 0, 1); PG8_STAGE(PG8_SB(0, 0), b2, voffB); PG8_STAGE(PG8_SB(0, 1), b2 + hstep, voffB); PG8_STAGE(PG8_SA(0, 0), a2, voffA);
            PG8_WAIT_V(8); PG8_WAIT_L(0); PG8_BAR; PG8_MMA(1, 0, At, B0); PG8_MMA(1, 1, At, B1); PG8_BAR; PG8_SCHED;
            PG8_LDB(B0, 1, 0); PG8_LDB(B1, 1, 1); PG8_SCHED; PG8_LDA(At, 1, 0); PG8_STAGE(PG8_SA(0, 1), a2 + hstepA, voffA);
            PG8_WAIT_V(8); PG8_WAIT_L(0); PG8_BAR; PG8_MMA(0, 0, At, B0); PG8_MMA(0, 1, At, B1); PG8_BAR; PG8_SCHED;
            PG8_LDA(At, 1, 1); PG8_STAGE(PG8_SB(1, 0), b3, voffB); PG8_STAGE(PG8_SB(1, 1), b3 + hstep, voffB); PG8_STAGE(PG8_SA(1, 0), a3, voffA);
            PG8_WAIT_V(8); PG8_WAIT_L(0); PG8_BAR; PG8_MMA(1, 0, At, B0); PG8_MMA(1, 1, At, B1); PG8_BAR; PG8_SCHED;
            } else {
            PG8_LDB(B0, 0, 0); PG8_SCHED; PG8_LDA(At, 0, 0); PG8_STAGE(PG8_SA(1, 1), a1 + hstepA, voffA);
            PG8_WAIT_L(8); PG8_BAR; PG8_WAIT_L(0); PG8_MMA(0, 0, At, B0); PG8_BAR; PG8_SCHED;
            PG8_LDB(B1, 0, 1); PG8_STAGE(PG8_SB(0, 0), b2, voffB);
            PG8_BAR; PG8_WAIT_L(0); PG8_MMA(0, 1, At, B1); PG8_BAR;
            PG8_LDA(At, 0, 1); PG8_STAGE(PG8_SA(0, 0), a2, voffA);
            PG8_BAR; PG8_WAIT_L(0); PG8_MMA(1, 0, At, B0); PG8_BAR; PG8_SCHED;
            PG8_STAGE(PG8_SB(0, 1), b2 + hstep, voffB);
            PG8_WAIT_V(6); PG8_BAR; PG8_MMA(1, 1, At, B1); PG8_BAR;
            PG8_LDB(B0, 1, 0); PG8_SCHED; PG8_LDA(At, 1, 0); PG8_STAGE(PG8_SA(0, 1), a2 + hstepA, voffA);
            PG8_WAIT_L(8); PG8_BAR; PG8_WAIT_L(0); PG8_MMA(0, 0, At, B0); PG8_BAR; PG8_SCHED;
            PG8_LDB(B1, 1, 1); PG8_STAGE(PG8_SB(1, 0), b3, voffB);
            PG8_BAR; PG8_WAIT_L(0); PG8_MMA(0, 1, At, B1); PG8_BAR;
            PG8_LDA(At, 1, 1); PG8_STAGE(PG8_SA(1, 0), a3, voffA);
            PG8_BAR; PG8_WAIT_L(0); PG8_MMA(1, 0, At, B0); PG8_BAR; PG8_SCHED;
            PG8_STAGE(PG8_SB(1, 1), b3 + hstep, voffB);
            PG8_WAIT_V(6); PG8_BAR; PG8_MMA(1, 1, At, B1); PG8_BAR;
            }
        }
        if constexpr (ALIGN_EPI) { if (wr == 0) PG8_BAR; }
        if constexpr (!Epi::AFTER_DRAIN) { E(acc, cur, wr, wc, fr, fq); S.done(cur); }
        if (!has_next) break;
#pragma unroll
        for (int a = 0; a < 2; ++a)
#pragma unroll
            for (int b = 0; b < 2; ++b)
#pragma unroll
                for (int m = 0; m < 4; ++m)
#pragma unroll
                    for (int n = 0; n < 2; ++n) acc[a][b][m][n] = (f32x4){0.f, 0.f, 0.f, 0.f};
        cur = nxt; cA = nA; cB = nB; ++ui;
        if constexpr (ALIGN_EPI) { if (wr == 1) PG8_BAR; }
    }
    PG8_WAIT_V(0);
    if constexpr (!ALIGN_EPI) { if (wr == 0) PG8_BAR; }
    PG8_BAR;
    if constexpr (Epi::AFTER_DRAIN) { E.fused(acc, cur, wr, wc, fr, fq, lds, wid, lane); S.done(cur); }
#undef PG8_SA
#undef PG8_SB
#undef PG8_STAGE
#undef PG8_LDA
#undef PG8_LDB
#undef PG8_MMA
#undef PG8_WAIT_V
#undef PG8_WAIT_L
#undef PG8_BAR
#undef PG8_SCHED
}
}

constexpr int NB = 4, SEQ = 4096, DM = 1024, NL = 4, FF = 2816, MTOK = NB * SEQ;
constexpr int DIN = 6440, NIN = 6656;
constexpr int NGU = 2 * FF;
constexpr float EPSN = 1e-6f;
constexpr int SRC_QA = 0, SRC_KVA = 512, SRC_GA = 1280, SRC_QB = 1304, SRC_KB = 1816, SRC_VB = 2328, SRC_ALR = 3352, SRC_RB = 3368, SRC_GM = 4392;
constexpr int T_QA = 0, T_KVA = 2, T_QB = 5, T_KB = 7, T_VB = 9, T_RB = 13, T_GM = 17, T_MISC = 25;

constexpr size_t MiB = 1u << 20;
constexpr size_t WS_CTL = 0, CTL_ZERO_BYTES = 64 * 1024;
constexpr size_t WS_LUT = 1 * MiB;
constexpr size_t WS_POSB = WS_LUT + 128 * 1024;
constexpr size_t WS_W = 2 * MiB;
constexpr size_t W_GU1 = WS_W, W_D1 = W_GU1 + 11 * MiB, W_GU2 = W_D1 + 11 * MiB / 2, W_D2 = W_GU2 + 11 * MiB;
constexpr size_t W_IN = W_D2 + 11 * MiB / 2, W_C1K = W_IN + 13 * MiB, W_C1V = W_C1K + 1 * MiB, W_N = W_C1V + 1 * MiB, W_G = W_N + 1 * MiB, W_O = W_G + 2 * MiB;
constexpr size_t WS_XB = 58 * MiB;
constexpr size_t WS_SSP = 90 * MiB;
constexpr size_t WS_R = 92 * MiB;
constexpr size_t WS_ACT = WS_R;
constexpr size_t WS_QA = WS_R, WS_KVS = WS_QA + 16 * MiB, WS_KVC = WS_KVS + 16 * MiB, WS_GA = WS_KVC + 9 * MiB, WS_ALR = WS_GA + 2 * MiB;
constexpr size_t WS_QB = WS_ALR + 1 * MiB, WS_KB = WS_QB + 16 * MiB, WS_VB = WS_KB + 16 * MiB, WS_RB = WS_VB + 32 * MiB, WS_GM = WS_RB + 32 * MiB;
constexpr size_t WS_HID = WS_GM + 64 * MiB, WS_KVCMP = WS_HID + 2 * MiB, WS_OA = WS_KVCMP + 1 * MiB, WS_ORAW = WS_OA + 16 * MiB, WS_OB = WS_ORAW + 64 * MiB;
constexpr size_t WS_Y = WS_OB + 32 * MiB, WS_END = WS_Y + 32 * MiB;
constexpr size_t WS_YPART = WS_ORAW;
static_assert(W_O + 2 * MiB <= WS_XB, "weights fit");
static_assert(WS_END <= 460 * MiB, "workspace budget");

constexpr int CW_BAR = 1024;

constexpr int RING_OFF = 0, RING_BYTES = 131072;
constexpr int LDSCTL_OFF = RING_BYTES, MISC_OFF = LDSCTL_OFF + 320;
constexpr int LDS_BYTES = 147456;
constexpr int NWAVES = 8;

#define GAS __attribute__((address_space(1)))
#define LAS __attribute__((address_space(3)))
typedef unsigned short bf16;
typedef unsigned v4u __attribute__((ext_vector_type(4)));
typedef unsigned v2u __attribute__((ext_vector_type(2)));
typedef float f32x4 __attribute__((ext_vector_type(4)));
typedef short bf16x8 __attribute__((ext_vector_type(8)));
#define LDS_WAIT() asm volatile("s_waitcnt lgkmcnt(0)" ::: "memory")
#define VM_WAIT() asm volatile("s_waitcnt vmcnt(0)" ::: "memory")
__device__ __forceinline__ unsigned f2bf(float f) { unsigned u = __builtin_bit_cast(unsigned, f); return (u + 0x7fffu + ((u >> 16) & 1u)) >> 16; }
__device__ __forceinline__ unsigned pk2(float lo, float hi) { return f2bf(lo) | (f2bf(hi) << 16); }
__device__ __forceinline__ float bf2f(unsigned short b) { return __builtin_bit_cast(float, ((unsigned)b) << 16); }
__device__ __forceinline__ float bflo(unsigned w) { return __builtin_bit_cast(float, w << 16); }
__device__ __forceinline__ float bfhi(unsigned w) { return __builtin_bit_cast(float, w & 0xffff0000u); }
__device__ __forceinline__ float wave_sum(float v) {
#pragma unroll
    for (int o = 1; o < 64; o <<= 1) v += __shfl_xor(v, o);
    return v;
}
__device__ __forceinline__ float wave_max(float v) {
#pragma unroll
    for (int o = 1; o < 64; o <<= 1) v = fmaxf(v, __shfl_xor(v, o));
    return v;
}
__device__ __forceinline__ float sigmoidf_(float x) { return 1.0f / (1.0f + __expf(-x)); }
__device__ __forceinline__ float siluf_(float x) { return x / (1.0f + __expf(-x)); }

#define XB_TMO      128
#define XB_XCNT(j)  (256  + 64 * (j))
#define XB_XSUB(j)  (1280 + 64 * (j))
#define XB_XGEN(j)  (2304 + 64 * (j))
#define XB_TOP      3328
#define XB_TOPGEN   3392
#define XCD_BAR_WORDS 3456
#define XB_SPIN_CAP (1u << 18)

__device__ __forceinline__ unsigned xb_ld(unsigned* p)              { return __hip_atomic_load(p, __ATOMIC_RELAXED, __HIP_MEMORY_SCOPE_AGENT); }
__device__ __forceinline__ unsigned xb_add(unsigned* p, unsigned v) { return __hip_atomic_fetch_add(p, v, __ATOMIC_RELAXED, __HIP_MEMORY_SCOPE_AGENT); }
__device__ __forceinline__ unsigned xb_xcc_id() { return (unsigned)__builtin_amdgcn_s_getreg((3 << 11) | 20) & 0xFu; }
#define XB_SPIN(cond, bar) do { unsigned _sp = 0; while (cond) { __builtin_amdgcn_s_sleep(1); \
    if ((++_sp & 255u) == 0u) { if (xb_ld(&(bar)[XB_TMO])) break; if (_sp > XB_SPIN_CAP) { atomicAdd(&(bar)[XB_TMO], 1u); break; } } } } while (0)

struct XcdBarrier {
    unsigned* bar; unsigned x;
    volatile LAS unsigned* st;
};
__device__ __forceinline__ XcdBarrier xcd_barrier_post(unsigned* bar, volatile LAS unsigned* st) {
    XcdBarrier b; b.bar = bar; b.x = xb_xcc_id(); b.st = st;
    if (threadIdx.x == 0) (void)xb_add(&bar[XB_XCNT(b.x)], 1u);
    return b;
}
__device__ __forceinline__ void xcd_barrier_complete(unsigned* bar, unsigned x, unsigned& nloc, unsigned& nx) {
    const unsigned G = gridDim.x * gridDim.y * gridDim.z;
    unsigned sum, cnt, mine, sp = 0u;
    for (;;) {
        sum = 0u; cnt = 0u; mine = 0u;
#pragma unroll
        for (unsigned j = 0; j < 16; ++j) { const unsigned c = xb_ld(&bar[XB_XCNT(j)]); sum += c; cnt += (c > 0u) ? 1u : 0u; mine = (j == x) ? c : mine; }
        if (sum == G) break;
        __builtin_amdgcn_s_sleep(1);
        if ((++sp & 255u) == 0u) { if (xb_ld(&bar[XB_TMO])) break; if (sp > XB_SPIN_CAP) { atomicAdd(&bar[XB_TMO], 1u); break; } }
    }
    nloc = mine > 0u ? mine : 1u; nx = cnt > 0u ? cnt : 1u;
}
__device__ __forceinline__ void xcd_barrier(const XcdBarrier& b) {
    asm volatile("s_waitcnt vmcnt(0)" ::: "memory");
    __syncthreads();
    if (threadIdx.x == 0) {
        unsigned* bar = b.bar;
        __builtin_amdgcn_s_waitcnt(0);
        unsigned nloc = b.st[0], nx = b.st[1];
        if (nloc == 0u) { xcd_barrier_complete(bar, b.x, nloc, nx); b.st[0] = nloc; b.st[1] = nx; }
        const unsigned old = xb_add(&bar[XB_XSUB(b.x)], 1u);
        const unsigned gen = old / nloc;
        if (old + 1u == (gen + 1u) * nloc) {
            __builtin_amdgcn_fence(__ATOMIC_RELEASE, "agent");
            asm volatile("s_waitcnt vmcnt(0)" ::: "memory");
            const unsigned og = xb_add(&bar[XB_TOP], 1u);
            const unsigned tg = og / nx;
            if (og + 1u == (tg + 1u) * nx) xb_add(&bar[XB_TOPGEN], 1u);
            else XB_SPIN(xb_ld(&bar[XB_TOPGEN]) == tg, bar);
            __builtin_amdgcn_fence(__ATOMIC_ACQUIRE, "agent");
            xb_add(&bar[XB_XGEN(b.x)], 1u);
            asm volatile("s_waitcnt vmcnt(0)" ::: "memory");
        } else {
            XB_SPIN(xb_ld(&bar[XB_XGEN(b.x)]) == gen, bar);
            __builtin_amdgcn_fence(__ATOMIC_ACQUIRE, "agent");
            asm volatile("s_waitcnt vmcnt(0)" ::: "memory");
        }
    }
    __syncthreads();
}

struct Args { const float* in[25]; float* out; unsigned char* ws; int ph_lo, ph_hi; };
enum { I_X = 0, I_REL, I_F1N, I_F1G, I_F1U, I_F1D, I_MIXN, I_WIN, I_POSK, I_POSV, I_CKW1, I_CKW2, I_CVW1, I_CVW2, I_AW2, I_AB, I_GON, I_WBN, I_WBG, I_WOUT, I_F2N, I_F2G, I_F2U, I_F2D, I_FIN };

struct Frame {
    LAS unsigned char* lds;
    int tid, lane, wave, G, bid;
    unsigned char* ws;
};
__device__ __forceinline__ void relaunder(Frame& F) { int t = threadIdx.x; asm volatile("" : "+v"(t)); F.tid = t; F.lane = t & 63; F.wave = __builtin_amdgcn_readfirstlane(t >> 6); }

using pg8::Unit;
__device__ __forceinline__ float row_rstd(const float* ssp, int row) {
    const f32x4* p = (const f32x4*)(ssp + (size_t)row * 16);
    const f32x4 a = p[0], b = p[1], c = p[2], d = p[3];
    const float s = ((a[0] + a[1]) + (a[2] + a[3])) + ((b[0] + b[1]) + (b[2] + b[3])) + ((c[0] + c[1]) + (c[2] + c[3])) + ((d[0] + d[1]) + (d[2] + d[3]));
    return 1.0f / sqrtf(s * (1.0f / DM) + EPSN);
}
struct EpiGU {
    static constexpr bool PERM = true, AFTER_DRAIN = false;
    bf16* act; const float* ssp;
    __device__ __forceinline__ void operator()(const f32x4 (&acc)[2][2][4][2], const Unit& u, int wr, int wc, int fr, int fq) const {
        const int row0 = u.pm * 256 + wr * 64 + fr, col0 = u.pn * 128 + wc * 32 + 8 * fq;
#pragma unroll
        for (int ai = 0; ai < 2; ++ai)
#pragma unroll
            for (int m = 0; m < 4; ++m) {
                const int row = row0 + ai * 128 + m * 16; const float r = row_rstd(ssp, row);
                float h[8];
#pragma unroll
                for (int n = 0; n < 2; ++n)
#pragma unroll
                    for (int j = 0; j < 4; ++j) { const float g = acc[ai][0][m][n][j] * r, up = acc[ai][1][m][n][j] * r; h[n * 4 + j] = siluf_(g) * up; }
                v4u w; w.x = pk2(h[0], h[1]); w.y = pk2(h[2], h[3]); w.z = pk2(h[4], h[5]); w.w = pk2(h[6], h[7]);
                *(v4u*)(act + (size_t)row * FF + col0) = w;
            }
    }
};
struct EpiResid {
    static constexpr bool PERM = true, AFTER_DRAIN = false;
    float* x; bf16* xb; float* ssp; float alpha;
    __device__ __forceinline__ void operator()(const f32x4 (&acc)[2][2][4][2], const Unit& u, int wr, int wc, int fr, int fq) const {
        const int row0 = u.pm * 256 + wr * 64 + fr, col0 = u.pn * 256 + wc * 32 + 8 * fq;
#pragma unroll
        for (int ai = 0; ai < 2; ++ai)
#pragma unroll
            for (int m = 0; m < 4; ++m) {
                const int row = row0 + ai * 128 + m * 16; float ssq = 0.f;
#pragma unroll
                for (int bj = 0; bj < 2; ++bj) {
                    float* xp = x + (size_t)row * DM + col0 + bj * 128;
                    f32x4 x0 = *(const f32x4*)xp, x1 = *(const f32x4*)(xp + 4);
                    x0 = x0 + acc[ai][bj][m][0] * alpha; x1 = x1 + acc[ai][bj][m][1] * alpha;
                    *(f32x4*)xp = x0; *(f32x4*)(xp + 4) = x1;
                    ssq += (x0[0] * x0[0] + x0[1] * x0[1]) + (x0[2] * x0[2] + x0[3] * x0[3]) + (x1[0] * x1[0] + x1[1] * x1[1]) + (x1[2] * x1[2] + x1[3] * x1[3]);
                    v4u w; w.x = pk2(x0[0], x0[1]); w.y = pk2(x0[2], x0[3]); w.z = pk2(x1[0], x1[1]); w.w = pk2(x1[2], x1[3]);
                    *(v4u*)(xb + (size_t)row * DM + col0 + bj * 128) = w;
                }
                ssq += __shfl_xor(ssq, 16); ssq += __shfl_xor(ssq, 32);
                if (fq == 0) ssp[(size_t)row * 16 + u.pn * 4 + wc] = ssq;
            }
    }
};
struct EpiWin {
    static constexpr bool PERM = true, AFTER_DRAIN = false;
    unsigned char* ws; const float* ssp;
    __device__ __forceinline__ void operator()(const f32x4 (&acc)[2][2][4][2], const Unit& u, int wr, int wc, int fr, int fq) const {
        const int row0 = u.pm * 256 + wr * 64 + fr, pn = u.pn;
        bf16* dst = nullptr; int ld = 0, coff = 0, actk = 0; float scale = 1.f;
        if (pn < T_KVA) { dst = (bf16*)(ws + WS_QA); ld = 512; coff = (pn - T_QA) * 256; scale = 0.125f; }
        else if (pn == T_KVA) { }
        else if (pn < T_QB) { dst = (bf16*)(ws + WS_KVS); ld = 512; coff = (pn - T_KVA - 1) * 256; }
        else if (pn < T_KB) { dst = (bf16*)(ws + WS_QB); ld = 512; coff = (pn - T_QB) * 256; scale = 0.08838834764831845f; }
        else if (pn < T_VB) { dst = (bf16*)(ws + WS_KB); ld = 512; coff = (pn - T_KB) * 256; }
        else if (pn < T_RB) { dst = (bf16*)(ws + WS_VB); ld = 1024; coff = (pn - T_VB) * 256; }
        else if (pn < T_GM) { dst = (bf16*)(ws + WS_RB); ld = 1024; coff = (pn - T_RB) * 256; actk = 1; }
        else if (pn < T_MISC) { dst = (bf16*)(ws + WS_GM); ld = 2048; coff = (pn - T_GM) * 256; actk = 2; }
#pragma unroll
        for (int ai = 0; ai < 2; ++ai)
#pragma unroll
            for (int m = 0; m < 4; ++m) {
                const int row = row0 + ai * 128 + m * 16; const float r = row_rstd(ssp, row);
                if (pn == T_MISC) {
                    float* ga = (float*)(ws + WS_GA); float* alr = (float*)(ws + WS_ALR);
#pragma unroll
                    for (int n = 0; n < 2; ++n)
#pragma unroll
                        for (int j = 0; j < 4; ++j) { const int c = wc * 32 + 8 * fq + 4 * n + j; const float v = acc[ai][0][m][n][j] * r;
                            if (c < 24) ga[(size_t)row * 24 + c] = sigmoidf_(v); else if (c < 40) alr[(size_t)row * 16 + (c - 24)] = v; }
                } else {
#pragma unroll
                    for (int bj = 0; bj < 2; ++bj) {
                        float h[8];
#pragma unroll
                        for (int n = 0; n < 2; ++n)
#pragma unroll
                            for (int j = 0; j < 4; ++j) { float v = acc[ai][bj][m][n][j] * r * scale; if (actk == 1) v = siluf_(v); else if (actk == 2) v = sigmoidf_(v); h[n * 4 + j] = v; }
                        v4u w; w.x = pk2(h[0], h[1]); w.y = pk2(h[2], h[3]); w.z = pk2(h[4], h[5]); w.w = pk2(h[6], h[7]);
                        if (pn == T_KVA) {
                            const int b = row >> 12, t = row & 4095, g = wc >> 1, d = (wc & 1) * 32 + 8 * fq;
                            bf16* kvc = (bf16*)(ws + WS_KVC);
                            *(v4u*)(kvc + ((size_t)((bj * 4 + b) * 2 + g) * SEQ + t) * 64 + d) = w;
                        } else {
                            *(v4u*)(dst + (size_t)row * ld + coff + bj * 128 + wc * 32 + 8 * fq) = w;
                        }
                    }
                }
            }
    }
};
struct EpiCmp1 {
    static constexpr bool PERM = true, AFTER_DRAIN = false;
    bf16* hid; const float* posb;
    __device__ __forceinline__ void operator()(const f32x4 (&acc)[2][2][4][2], const Unit& u, int wr, int wc, int fr, int fq) const {
        const int row0 = u.pm * 256 + wr * 64 + fr, col0 = wc * 32 + 8 * fq;
#pragma unroll
        for (int ai = 0; ai < 2; ++ai)
#pragma unroll
            for (int m = 0; m < 4; ++m) {
                const int row = row0 + ai * 128 + m * 16;
#pragma unroll
                for (int bj = 0; bj < 2; ++bj) {
                    const f32x4 b0 = *(const f32x4*)(posb + col0 + bj * 128), b1 = *(const f32x4*)(posb + col0 + bj * 128 + 4);
                    const f32x4 v0 = acc[ai][bj][m][0] + b0, v1 = acc[ai][bj][m][1] + b1;
                    v4u w; w.x = pk2(siluf_(v0[0]), siluf_(v0[1])); w.y = pk2(siluf_(v0[2]), siluf_(v0[3])); w.z = pk2(siluf_(v1[0]), siluf_(v1[1])); w.w = pk2(siluf_(v1[2]), siluf_(v1[3]));
                    *(v4u*)(hid + (size_t)row * 256 + col0 + bj * 128) = w;
                }
            }
    }
};
template <int STEP> struct EpiMerge {
    static constexpr bool PERM = true, AFTER_DRAIN = false;
    const bf16* gm; float* ypart; bf16* y;
    __device__ __forceinline__ void operator()(const f32x4 (&acc)[2][2][4][2], const Unit& u, int wr, int wc, int fr, int fq) const {
        const int row0 = u.pm * 256 + wr * 64 + fr, col0 = u.pn * 256 + wc * 32 + 8 * fq;
#pragma unroll
        for (int ai = 0; ai < 2; ++ai)
#pragma unroll
            for (int m = 0; m < 4; ++m) {
                const int row = row0 + ai * 128 + m * 16;
#pragma unroll
                for (int bj = 0; bj < 2; ++bj) {
                    const int col = col0 + bj * 128;
                    const v4u gw = *(const v4u*)(gm + (size_t)row * 2048 + (STEP == 1 ? 0 : 1024) + col);
                    f32x4 g0 = {bflo(gw.x), bfhi(gw.x), bflo(gw.y), bfhi(gw.y)}, g1 = {bflo(gw.z), bfhi(gw.z), bflo(gw.w), bfhi(gw.w)};
                    float* yp = ypart + (size_t)row * DM + col;
                    if (STEP == 1) { *(f32x4*)yp = g0 * acc[ai][bj][m][0]; *(f32x4*)(yp + 4) = g1 * acc[ai][bj][m][1]; }
                    else { const f32x4 v0 = *(const f32x4*)yp + g0 * acc[ai][bj][m][0], v1 = *(const f32x4*)(yp + 4) + g1 * acc[ai][bj][m][1];
                        v4u w; w.x = pk2(v0[0], v0[1]); w.y = pk2(v0[2], v0[3]); w.z = pk2(v1[0], v1[1]); w.w = pk2(v1[2], v1[3]);
                        *(v4u*)(y + (size_t)row * DM + col) = w; }
                }
            }
    }
};

struct SrcCol { const float* p; int col; };
template <class Map>
__device__ __forceinline__ void tr_item(int ldw, const float* gain, bf16* WT, int K, int nblk, int item, LAS float* scr, int lane, const Map& cm) {
    const int kb = item / nblk, nb = item % nblk, k0 = 64 * kb, n0 = 32 * nb;
    const SrcCol sc = cm(n0 + (lane & 31));
#pragma unroll 8
    for (int i = 0; i < 32; ++i) { const int kk = 2 * i + (lane >> 5); float v = 0.f;
        if (sc.col >= 0) { v = sc.p[(size_t)(k0 + kk) * ldw + sc.col]; if (gain) v *= gain[k0 + kk]; }
        scr[kk * 33 + (lane & 31)] = v; }
    LDS_WAIT();
    const int c = lane & 7;
#pragma unroll
    for (int j = 0; j < 4; ++j) { const int n = (lane >> 3) + 8 * j; const LAS float* s = scr + (8 * c) * 33 + n;
        v4u o; o.x = pk2(s[0 * 33], s[1 * 33]); o.y = pk2(s[2 * 33], s[3 * 33]); o.z = pk2(s[4 * 33], s[5 * 33]); o.w = pk2(s[6 * 33], s[7 * 33]);
        *(v4u*)(WT + (size_t)(n0 + n) * K + k0 + 8 * c) = o; }
    LDS_WAIT();
}
struct MapGU { const float* p; __device__ __forceinline__ SrcCol operator()(int n) const { return SrcCol{p, (n >> 8) * 128 + (n & 127)}; } };
struct MapId { const float* p; __device__ __forceinline__ SrcCol operator()(int n) const { return SrcCol{p, n}; } };
struct MapWin { const float* p; __device__ __forceinline__ SrcCol operator()(int n) const {
    const int t = n >> 8, r = n & 255; int c;
    if (t < T_KVA) c = SRC_QA + n; else if (t < T_QB) c = SRC_KVA + (n - T_KVA * 256); else if (t < T_KB) c = SRC_QB + (n - T_QB * 256); else if (t < T_VB) c = SRC_KB + (n - T_KB * 256);
    else if (t < T_RB) c = SRC_VB + (n - T_VB * 256); else if (t < T_GM) c = SRC_RB + (n - T_RB * 256); else if (t < T_MISC) c = SRC_GM + (n - T_GM * 256);
    else c = r < 24 ? SRC_GA + r : (r < 40 ? SRC_ALR + (r - 24) : -1);
    return SrcCol{p, c}; } };

__device__ __forceinline__ void phase_conv(Frame& F, const Args& a, int l) {
    relaunder(F);
    LAS float* scr = (LAS float*)(F.lds + RING_OFF + F.wave * 16384);
    const int gw = F.bid * NWAVES + F.wave, NGW = F.G * NWAVES;
    unsigned char* ws = F.ws;
    constexpr int I_GU = (DM / 64) * (NGU / 32), I_D = (FF / 64) * (DM / 32), I_IN = (DM / 64) * (NIN / 32), I_C1 = (2048 / 64) * (256 / 32), I_N = (512 / 64) * (DM / 32), I_SQ = (DM / 64) * (DM / 32);
    constexpr int NITEMS = 2 * I_GU + 2 * I_D + I_IN + 2 * I_C1 + I_N + 2 * I_SQ;
    const size_t oG = (size_t)l * DM * FF, oD = (size_t)l * FF * DM;
    for (int it = gw; it < NITEMS; it += NGW) {
        int r = it;
        if (r < I_GU) { const bool up = (((r % (NGU / 32)) * 32) & 255) >= 128;
            if (up) tr_item(FF, a.in[I_F1N] + l * DM, (bf16*)(ws + W_GU1), DM, NGU / 32, r, scr, F.lane, MapGU{a.in[I_F1U] + oG});
            else tr_item(FF, a.in[I_F1N] + l * DM, (bf16*)(ws + W_GU1), DM, NGU / 32, r, scr, F.lane, MapGU{a.in[I_F1G] + oG});
            continue; } r -= I_GU;
        if (r < I_GU) { const bool up = (((r % (NGU / 32)) * 32) & 255) >= 128;
            if (up) tr_item(FF, a.in[I_F2N] + l * DM, (bf16*)(ws + W_GU2), DM, NGU / 32, r, scr, F.lane, MapGU{a.in[I_F2U] + oG});
            else tr_item(FF, a.in[I_F2N] + l * DM, (bf16*)(ws + W_GU2), DM, NGU / 32, r, scr, F.lane, MapGU{a.in[I_F2G] + oG});
            continue; } r -= I_GU;
        if (r < I_D) { tr_item(DM, nullptr, (bf16*)(ws + W_D1), FF, DM / 32, r, scr, F.lane, MapId{a.in[I_F1D] + oD}); continue; } r -= I_D;
        if (r < I_D) { tr_item(DM, nullptr, (bf16*)(ws + W_D2), FF, DM / 32, r, scr, F.lane, MapId{a.in[I_F2D] + oD}); continue; } r -= I_D;
        if (r < I_IN) { tr_item(DIN, a.in[I_MIXN] + l * DM, (bf16*)(ws + W_IN), DM, NIN / 32, r, scr, F.lane, MapWin{a.in[I_WIN] + (size_t)l * DM * DIN}); continue; } r -= I_IN;
        if (r < I_C1) { tr_item(256, nullptr, (bf16*)(ws + W_C1K), 2048, 256 / 32, r, scr, F.lane, MapId{a.in[I_CKW1] + (size_t)l * 2048 * 256}); continue; } r -= I_C1;
        if (r < I_C1) { tr_item(256, nullptr, (bf16*)(ws + W_C1V), 2048, 256 / 32, r, scr, F.lane, MapId{a.in[I_CVW1] + (size_t)l * 2048 * 256}); continue; } r -= I_C1;
        if (r < I_N) { tr_item(DM, nullptr, (bf16*)(ws + W_N), 512, DM / 32, r, scr, F.lane, MapId{a.in[I_WBN] + (size_t)l * 512 * DM}); continue; } r -= I_N;
        if (r < I_SQ) { tr_item(DM, a.in[I_GON] + l * DM, (bf16*)(ws + W_G), DM, DM / 32, r, scr, F.lane, MapId{a.in[I_WBG] + (size_t)l * DM * DM}); continue; } r -= I_SQ;
        tr_item(DM, nullptr, (bf16*)(ws + W_O), DM, DM / 32, r, scr, F.lane, MapId{a.in[I_WOUT] + (size_t)l * DM * DM});
    }
    __syncthreads();
    if (F.bid < 32) {
        const int kv = F.bid >> 4, nb = (F.bid & 15) * 16, c = F.tid & 15, ks = F.tid >> 4;
        const float* pos = a.in[kv ? I_POSV : I_POSK] + (size_t)l * 2048; const float* w1 = a.in[kv ? I_CVW1 : I_CKW1] + (size_t)l * 2048 * 256;
        float s = 0.f;
        for (int k = ks * 64; k < ks * 64 + 64; ++k) s += pos[k] * w1[(size_t)k * 256 + nb + c];
        LAS float* red = (LAS float*)(F.lds + RING_OFF);
        red[F.tid] = s; __syncthreads();
        if (F.tid < 16) { float t = 0.f; for (int i = 0; i < 32; ++i) t += red[i * 16 + F.tid]; ((float*)(ws + WS_POSB))[kv * 256 + nb + F.tid] = t; }
        __syncthreads();
    }
}
__device__ __forceinline__ void phase_lut(Frame& F, const Args& a) {
    relaunder(F);
    float* lut = (float*)(F.ws + WS_LUT); const float* tab = a.in[I_REL];
    for (int i = F.bid * 512 + F.tid; i < 8 * 4096; i += F.G * 512) {
        const int h = i >> 12, n = i & 4095; int bk;
        if (n < 16) bk = n; else { const float nf = (float)n; int lb = 16 + (int)(logf(nf / 16.0f) / 4.1588830833596715f * 16.0f); bk = lb < 31 ? lb : 31; }
        lut[i] = tab[bk * 8 + h];
    }
}
__device__ __forceinline__ void phase_x0(Frame& F, const Args& a) {
    relaunder(F);
    const int gw = F.bid * NWAVES + F.wave, NGW = F.G * NWAVES;
    bf16* xb = (bf16*)(F.ws + WS_XB); float* ssp = (float*)(F.ws + WS_SSP);
    for (int m = gw; m < MTOK; m += NGW) {
        const f32x4* xr = (const f32x4*)(a.in[I_X] + (size_t)m * DM) + F.lane; f32x4* orow = (f32x4*)(a.out + (size_t)m * DM) + F.lane;
        v2u* o8 = (v2u*)(xb + (size_t)m * DM) + F.lane; float s = 0.f;
#pragma unroll
        for (int j = 0; j < 4; ++j) { const f32x4 v = xr[64 * j]; orow[64 * j] = v; s += (v[0] * v[0] + v[1] * v[1]) + (v[2] * v[2] + v[3] * v[3]); v2u w; w.x = pk2(v[0], v[1]); w.y = pk2(v[2], v[3]); o8[64 * j] = w; }
        s = wave_sum(s);
        if (F.lane < 16) ssp[(size_t)m * 16 + F.lane] = F.lane == 0 ? s : 0.f;
    }
}
__device__ __forceinline__ void phase_final(Frame& F, const Args& a) {
    relaunder(F);
    const int gw = F.bid * NWAVES + F.wave, NGW = F.G * NWAVES; const f32x4* gn = (const f32x4*)a.in[I_FIN] + F.lane;
    for (int m = gw; m < MTOK; m += NGW) {
        f32x4* xr = (f32x4*)(a.out + (size_t)m * DM) + F.lane; f32x4 v[4]; float s = 0.f;
#pragma unroll
        for (int j = 0; j < 4; ++j) { v[j] = xr[64 * j]; s += (v[j][0] * v[j][0] + v[j][1] * v[j][1]) + (v[j][2] * v[j][2] + v[j][3] * v[j][3]); }
        const float r = 1.0f / sqrtf(wave_sum(s) * (1.0f / DM) + EPSN);
#pragma unroll
        for (int j = 0; j < 4; ++j) xr[64 * j] = v[j] * r * gn[64 * j];
    }
}
__device__ __forceinline__ void phase_cmp2(Frame& F, const Args& a, int l) {
    relaunder(F);
    const int gw = F.bid * NWAVES + F.wave, NGW = F.G * NWAVES;
    const bf16* hid = (const bf16*)(F.ws + WS_HID); float* out = (float*)(F.ws + WS_KVCMP);
    for (int row = gw; row < 4096; row += NGW) {
        const int kv = row >> 11; const float* w2 = a.in[kv ? I_CVW2 : I_CKW2] + (size_t)l * 256 * 64;
        const bf16* hr = hid + (size_t)row * 256; float s = 0.f;
        for (int k = 0; k < 256; k += 8) { const v4u hw = *(const v4u*)(hr + k);
            s += bflo(hw.x) * w2[(k + 0) * 64 + F.lane] + bfhi(hw.x) * w2[(k + 1) * 64 + F.lane] + bflo(hw.y) * w2[(k + 2) * 64 + F.lane] + bfhi(hw.y) * w2[(k + 3) * 64 + F.lane]
               + bflo(hw.z) * w2[(k + 4) * 64 + F.lane] + bfhi(hw.z) * w2[(k + 5) * 64 + F.lane] + bflo(hw.w) * w2[(k + 6) * 64 + F.lane] + bfhi(hw.w) * w2[(k + 7) * 64 + F.lane]; }
        out[(size_t)row * 64 + F.lane] = s;
    }
}

__device__ __forceinline__ void dot4_bf16(const bf16* kp, const LAS float* qs, float (&s)[4]) {
    s[0] = s[1] = s[2] = s[3] = 0.f;
#pragma unroll 2
    for (int c = 0; c < 8; ++c) { const v4u kw = *(const v4u*)(kp + c * 8);
        const float kf[8] = {bflo(kw.x), bfhi(kw.x), bflo(kw.y), bfhi(kw.y), bflo(kw.z), bfhi(kw.z), bflo(kw.w), bfhi(kw.w)};
#pragma unroll
        for (int h = 0; h < 4; ++h) { const f32x4 q0 = *(const LAS f32x4*)(qs + h * 64 + c * 8), q1 = *(const LAS f32x4*)(qs + h * 64 + c * 8 + 4);
            s[h] += (kf[0] * q0[0] + kf[1] * q0[1]) + (kf[2] * q0[2] + kf[3] * q0[3]) + (kf[4] * q1[0] + kf[5] * q1[1]) + (kf[6] * q1[2] + kf[7] * q1[3]); } }
}
__device__ __forceinline__ void dot4_f32(const float* kp, const LAS float* qs, float (&s)[4]) {
    s[0] = s[1] = s[2] = s[3] = 0.f;
#pragma unroll 4
    for (int c = 0; c < 16; ++c) { const f32x4 kf = *(const f32x4*)(kp + c * 4);
#pragma unroll
        for (int h = 0; h < 4; ++h) { const f32x4 q0 = *(const LAS f32x4*)(qs + h * 64 + c * 4); s[h] += (kf[0] * q0[0] + kf[1] * q0[1]) + (kf[2] * q0[2] + kf[3] * q0[3]); } }
}
__device__ __forceinline__ void online_block(const float (&s)[4], bool kvalid, const bf16* vp, int vld, LAS float* ps, int lane, float (&m)[4], float (&lsum)[4], float (&o)[4]) {
    float p[4];
#pragma unroll
    for (int h = 0; h < 4; ++h) {
        const float sm = wave_max(kvalid ? s[h] : -INFINITY), mn = fmaxf(m[h], sm);
        const float sc = (m[h] == -INFINITY) ? 0.f : __expf(m[h] - mn);
        p[h] = (kvalid && mn > -INFINITY) ? __expf(s[h] - mn) : 0.f;
        lsum[h] = lsum[h] * sc + wave_sum(p[h]); o[h] *= sc; m[h] = mn;
    }
    *(LAS f32x4*)(ps + lane * 4) = (f32x4){p[0], p[1], p[2], p[3]};
    LDS_WAIT();
#pragma unroll 8
    for (int k = 0; k < 64; ++k) { const f32x4 pv = *(const LAS f32x4*)(ps + k * 4); const float v = bf2f(vp[(size_t)k * vld + lane]);
        o[0] += pv[0] * v; o[1] += pv[1] * v; o[2] += pv[2] * v; o[3] += pv[3] * v; }
    LDS_WAIT();
}
__device__ __forceinline__ void phase_nsa_naive(Frame& F) {
    relaunder(F);
    LAS float* wl = (LAS float*)(F.lds + RING_OFF + F.wave * 16384);
    LAS float* qs = wl; LAS float* ps = wl + 256; LAS float* psum = wl + 512; LAS float* scl = wl + 1024;
    const bf16* qa = (const bf16*)(F.ws + WS_QA); const bf16* kvs = (const bf16*)(F.ws + WS_KVS); const float* ga = (const float*)(F.ws + WS_GA);
    const float* kvcmp = (const float*)(F.ws + WS_KVCMP); const float* lut = (const float*)(F.ws + WS_LUT); bf16* oa = (bf16*)(F.ws + WS_OA);
    const int lane = F.lane;
    for (int wt = F.bid; wt < 4096; wt += F.G) {
        const int bg = wt & 7, tb = wt >> 3, b = bg >> 1, g = bg & 1, t = tb * 8 + F.wave, row = b * SEQ + t, jcur = t >> 6;
        const float* lutg = lut + (size_t)(g * 4) * 4096;
#pragma unroll
        for (int h = 0; h < 4; ++h) qs[h * 64 + lane] = bf2f(qa[(size_t)row * 512 + (g * 4 + h) * 64 + lane]);
        LDS_WAIT();
        float gate[4][3];
#pragma unroll
        for (int h = 0; h < 4; ++h)
#pragma unroll
            for (int br = 0; br < 3; ++br) gate[h][br] = ga[(size_t)row * 24 + (g * 4 + h) * 3 + br];
        float oacc[4] = {0.f, 0.f, 0.f, 0.f};
        const int ncv = t >= 31 ? ((t - 31) >> 4) + 1 : 0;
        float imp = 0.f;
        if (ncv > 0) {
            const float* kc = kvcmp + (size_t)(0 * 8 + bg) * 256 * 64; const float* vc = kvcmp + (size_t)(1 * 8 + bg) * 256 * 64;
            float mx[4] = {-INFINITY, -INFINITY, -INFINITY, -INFINITY};
            const int nblk = (ncv + 63) >> 6;
#pragma unroll 1
            for (int blk = 0; blk < nblk; ++blk) {
                const int c = blk * 64 + lane; const bool valid = c < ncv;
                float s[4]; dot4_f32(kc + (size_t)(c < 255 ? c : 255) * 64, qs, s);
                const int dist = valid ? t - (16 * c + 31) : 0;
#pragma unroll
                for (int h = 0; h < 4; ++h) { const float v = valid ? s[h] + lutg[h * 4096 + dist] : -INFINITY; scl[h * 256 + c] = v; mx[h] = fmaxf(mx[h], v); }
            }
            float ls[4] = {0.f, 0.f, 0.f, 0.f};
#pragma unroll
            for (int h = 0; h < 4; ++h) mx[h] = wave_max(mx[h]);
            LDS_WAIT();
#pragma unroll 1
            for (int blk = 0; blk < nblk; ++blk) {
                const int c = blk * 64 + lane;
#pragma unroll
                for (int h = 0; h < 4; ++h) { const float v = scl[h * 256 + c]; const float p = v > -INFINITY ? __expf(v - mx[h]) : 0.f; scl[h * 256 + c] = p; ls[h] += p; }
            }
#pragma unroll
            for (int h = 0; h < 4; ++h) ls[h] = 1.0f / wave_sum(ls[h]);
            LDS_WAIT();
            float oc[4] = {0.f, 0.f, 0.f, 0.f};
#pragma unroll 1
            for (int blk = 0; blk < 4; ++blk) {
                const int c = blk * 64 + lane; float pt = 0.f;
                if (blk < nblk) {
#pragma unroll
                    for (int h = 0; h < 4; ++h) { const float p = scl[h * 256 + c] * ls[h]; scl[h * 256 + c] = p; pt += p; }
                }
                psum[c] = pt;
            }
            LDS_WAIT();
#pragma unroll 2
            for (int k = 0; k < ncv; ++k) { const float v = vc[(size_t)k * 64 + lane];
                oc[0] += scl[k] * v; oc[1] += scl[256 + k] * v; oc[2] += scl[512 + k] * v; oc[3] += scl[768 + k] * v; }
#pragma unroll
            for (int i = -1; i <= 3; ++i) { const int c = 4 * lane + i; if (c >= 0 && c < 255) imp += psum[c]; }
#pragma unroll
            for (int h = 0; h < 4; ++h) oacc[h] += gate[h][0] * oc[h];
            LDS_WAIT();
        }
        const bool forced = (lane == 0) || (lane == jcur) || (lane == jcur - 1);
        const float score = forced ? 1e6f : (lane <= jcur ? imp : -1e6f);
        int rank = 0;
#pragma unroll 4
        for (int s2 = 0; s2 < 64; ++s2) { const float v2 = __shfl(score, s2); rank += (v2 > score || (v2 == score && s2 < lane)) ? 1 : 0; }
        unsigned long long selmask = __ballot(rank < 16);
        selmask &= (jcur == 63) ? ~0ull : ((1ull << (jcur + 1)) - 1ull);
        {
            float m[4] = {-INFINITY, -INFINITY, -INFINITY, -INFINITY}, lsum[4] = {0.f, 0.f, 0.f, 0.f}, o[4] = {0.f, 0.f, 0.f, 0.f};
#pragma unroll 1
            while (selmask) {
                const int j = __builtin_ctzll(selmask); selmask &= selmask - 1ull;
                const int pos = j * 64 + lane; const bool kvalid = pos <= t;
                float s[4]; dot4_bf16(kvs + (size_t)(b * SEQ + pos) * 512 + 0 * 128 + g * 64, qs, s);
                if (kvalid) {
#pragma unroll
                    for (int h = 0; h < 4; ++h) s[h] += lutg[h * 4096 + (t - pos)];
                }
                online_block(s, kvalid, kvs + (size_t)(b * SEQ + j * 64) * 512 + 1 * 128 + g * 64, 512, ps, lane, m, lsum, o);
            }
#pragma unroll
            for (int h = 0; h < 4; ++h) oacc[h] += gate[h][1] * o[h] / lsum[h];
        }
        {
            float m[4] = {-INFINITY, -INFINITY, -INFINITY, -INFINITY}, lsum[4] = {0.f, 0.f, 0.f, 0.f}, o[4] = {0.f, 0.f, 0.f, 0.f};
            const int lo = t - 511 > 0 ? t - 511 : 0;
#pragma unroll 1
            for (int j = lo >> 6; j <= jcur; ++j) {
                const int pos = j * 64 + lane; const bool kvalid = pos <= t && pos >= lo;
                float s[4]; dot4_bf16(kvs + (size_t)(b * SEQ + pos) * 512 + 2 * 128 + g * 64, qs, s);
                if (kvalid) {
#pragma unroll
                    for (int h = 0; h < 4; ++h) s[h] += lutg[h * 4096 + (t - pos)];
                }
                online_block(s, kvalid, kvs + (size_t)(b * SEQ + j * 64) * 512 + 3 * 128 + g * 64, 512, ps, lane, m, lsum, o);
            }
#pragma unroll
            for (int h = 0; h < 4; ++h) oacc[h] += gate[h][2] * o[h] / lsum[h];
        }
#pragma unroll
        for (int h = 0; h < 4; ++h) oa[(size_t)row * 512 + (g * 4 + h) * 64 + lane] = (bf16)f2bf(oacc[h]);
        LDS_WAIT();
    }
}

__device__ __forceinline__ void phase_gla_naive(Frame& F, const Args& a, int l) {
    relaunder(F);
    if (F.bid >= 64) return;
    const int bh = F.bid >> 2, cb = F.bid & 3, b = bh >> 2, h = bh & 3;
    LAS float* qL = (LAS float*)(F.lds + RING_OFF); LAS float* kL = qL + 32 * 128; LAS float* aL = kL + 32 * 128; LAS float* vL = aL + 32 * 128;
    const bf16* qb = (const bf16*)(F.ws + WS_QB); const bf16* kb = (const bf16*)(F.ws + WS_KB); const bf16* vb = (const bf16*)(F.ws + WS_VB);
    const float* alr = (const float*)(F.ws + WS_ALR); float* oraw = (float*)(F.ws + WS_ORAW);
    const int tid = F.tid, split = tid & 7, ci = tid >> 3, d_st = tid & 127;
    float w2r[16];
#pragma unroll
    for (int r = 0; r < 16; ++r) w2r[r] = a.in[I_AW2][(size_t)l * 16 * 512 + r * 512 + h * 128 + d_st];
    const float ab = a.in[I_AB][l * 512 + h * 128 + d_st];
    float S[16];
#pragma unroll
    for (int i = 0; i < 16; ++i) S[i] = 0.f;
    for (int tc = 0; tc < SEQ / 32; ++tc) {
        const int t0 = tc * 32;
        __syncthreads();
#pragma unroll
        for (int i = 0; i < 8; ++i) { const int idx = tid + 512 * i, tt = idx >> 7; const size_t row = (size_t)b * SEQ + t0 + tt;
            qL[idx] = bf2f(qb[row * 512 + h * 128 + d_st]); kL[idx] = bf2f(kb[row * 512 + h * 128 + d_st]);
            const f32x4* ar = (const f32x4*)(alr + row * 16); float z = ab;
#pragma unroll
            for (int q = 0; q < 4; ++q) { const f32x4 av = ar[q]; z += av[0] * w2r[4 * q] + av[1] * w2r[4 * q + 1] + av[2] * w2r[4 * q + 2] + av[3] * w2r[4 * q + 3]; }
            const float ls = fminf(z, 0.f) - log1pf(__expf(-fabsf(z)));
            aL[idx] = __expf(ls * (1.0f / 16.0f)); }
#pragma unroll
        for (int i = 0; i < 4; ++i) { const int idx = tid + 512 * i, tt = idx >> 6, c = idx & 63; vL[idx] = bf2f(vb[((size_t)b * SEQ + t0 + tt) * 1024 + h * 256 + cb * 64 + c]); }
        __syncthreads();
        for (int tt = 0; tt < 32; ++tt) {
            const float vt = vL[tt * 64 + ci]; float o = 0.f;
#pragma unroll
            for (int q = 0; q < 4; ++q) { const f32x4 av = *(const LAS f32x4*)(aL + tt * 128 + split * 16 + 4 * q), kv = *(const LAS f32x4*)(kL + tt * 128 + split * 16 + 4 * q), qv = *(const LAS f32x4*)(qL + tt * 128 + split * 16 + 4 * q);
#pragma unroll
                for (int j = 0; j < 4; ++j) { S[4 * q + j] = av[j] * S[4 * q + j] + kv[j] * vt; o += qv[j] * S[4 * q + j]; } }
            o += __shfl_xor(o, 1); o += __shfl_xor(o, 2); o += __shfl_xor(o, 4);
            if (split == 0) oraw[((size_t)b * SEQ + t0 + tt) * 1024 + h * 256 + cb * 64 + ci] = o;
        }
    }
    __syncthreads();
}
__device__ __forceinline__ void phase_gla_norm(Frame& F) {
    relaunder(F);
    const int gw = F.bid * NWAVES + F.wave, NGW = F.G * NWAVES;
    const float* oraw = (const float*)(F.ws + WS_ORAW); const bf16* rb = (const bf16*)(F.ws + WS_RB); bf16* ob = (bf16*)(F.ws + WS_OB);
    for (int i = gw; i < MTOK * 4; i += NGW) {
        const f32x4 v = *((const f32x4*)(oraw + (size_t)i * 256) + F.lane);
        const float s = wave_sum((v[0] * v[0] + v[1] * v[1]) + (v[2] * v[2] + v[3] * v[3]));
        const float r = 1.0f / sqrtf(s * (1.0f / 256.0f) + EPSN);
        const v2u rw = *((const v2u*)(rb + (size_t)i * 256) + F.lane);
        v2u w; w.x = pk2(v[0] * r * bflo(rw.x), v[1] * r * bfhi(rw.x)); w.y = pk2(v[2] * r * bflo(rw.y), v[3] * r * bfhi(rw.y));
        *((v2u*)(ob + (size_t)i * 256) + F.lane) = w;
    }
}

#ifndef MK_PER_PHASE
#define MK_PER_PHASE 0
#endif
#ifndef PG8_SP2
#define PG8_SP2 true
#endif
constexpr int NPH_L = 12, NPHASES = NL * NPH_L + 1;

__global__ void __launch_bounds__(NWAVES * 64, 2) fwd(Args args) {
    extern __shared__ __attribute__((aligned(16))) unsigned char lds[];
    Frame F;
    F.lds = (LAS unsigned char*)lds;
    F.tid = threadIdx.x; F.lane = F.tid & 63; F.wave = __builtin_amdgcn_readfirstlane(F.tid >> 6);
    F.G = gridDim.x; F.bid = blockIdx.x; F.ws = args.ws;
    unsigned char* ws = args.ws;
    for (int u = F.tid; u < (LDS_BYTES - LDSCTL_OFF) / 4; u += NWAVES * 64) ((LAS unsigned*)(F.lds + LDSCTL_OFF))[u] = 0u;
    __syncthreads();
    XcdBarrier bar; bar.bar = (unsigned*)(ws + WS_CTL) + CW_BAR; bar.x = 0; bar.st = nullptr;
    if (!MK_PER_PHASE) bar = xcd_barrier_post((unsigned*)(ws + WS_CTL) + CW_BAR, (volatile LAS unsigned*)(F.lds + MISC_OFF) + 8);
    const int lo = args.ph_lo, hi = args.ph_hi;
#ifndef PH_MASK
#define PH_MASK 0xFFFF
#endif
#define INL(j) (((PH_MASK >> (j)) & 1) && lo <= (pb + (j)) && (pb + (j)) < hi)
#define IN(k) (lo <= (k) && (k) < hi)
#define SEAM(k) do { if (IN((k) + 1)) { if (MK_PER_PHASE) { } else xcd_barrier(bar); } } while (0)
    bf16* xb = (bf16*)(ws + WS_XB); float* ssp = (float*)(ws + WS_SSP); bf16* act = (bf16*)(ws + WS_ACT);

    for (int l = 0; l < NL; ++l) {
        const int pb = l * NPH_L;
        if (INL(0)) { phase_conv(F, args, l); if (l == 0) { phase_lut(F, args); phase_x0(F, args); } SEAM(pb + 0); }
        if (INL(1)) {
            pg8::Gemm g{xb, (const bf16*)(ws + W_GU1), MTOK, NGU, DM, DM}; pg8::StaticOrder S; S.init(MTOK, NGU, F.G, F.bid);
            EpiGU E{act, ssp};
            pg8::gemm_phase<EpiGU, pg8::StaticOrder, true, PG8_SP2>(F.lds + RING_OFF, g, S, E);
            SEAM(pb + 1);
        }
        if (INL(2)) {
            pg8::Gemm g{act, (const bf16*)(ws + W_D1), MTOK, DM, FF, FF}; pg8::StaticOrder S; S.init(MTOK, DM, F.G, F.bid);
            EpiResid E{args.out, xb, ssp, 0.5f};
            pg8::gemm_phase<EpiResid, pg8::StaticOrder, true, PG8_SP2>(F.lds + RING_OFF, g, S, E);
            SEAM(pb + 2);
        }
        if (INL(3)) {
            pg8::Gemm g{xb, (const bf16*)(ws + W_IN), MTOK, NIN, DM, DM}; pg8::StaticOrder S; S.init(MTOK, NIN, F.G, F.bid);
            EpiWin E{ws, ssp};
            pg8::gemm_phase<EpiWin, pg8::StaticOrder, true, PG8_SP2>(F.lds + RING_OFF, g, S, E);
            SEAM(pb + 3);
        }
        if (INL(4)) {
            const bf16* kvc = (const bf16*)(ws + WS_KVC); bf16* hid = (bf16*)(ws + WS_HID); const float* posb = (const float*)(ws + WS_POSB);
            { pg8::Gemm g{kvc, (const bf16*)(ws + W_C1K), 2048, 256, 2048, 1024}; pg8::StaticOrder S; S.init(2048, 256, F.G, F.bid);
              EpiCmp1 E{hid, posb};
              pg8::gemm_phase<EpiCmp1, pg8::StaticOrder, true, PG8_SP2>(F.lds + RING_OFF, g, S, E); }
            { pg8::Gemm g{kvc + (size_t)8 * SEQ * 64, (const bf16*)(ws + W_C1V), 2048, 256, 2048, 1024}; pg8::StaticOrder S; S.init(2048, 256, F.G, (F.bid + F.G - 8) % F.G);
              EpiCmp1 E{hid + (size_t)2048 * 256, posb + 256};
              pg8::gemm_phase<EpiCmp1, pg8::StaticOrder, true, PG8_SP2>(F.lds + RING_OFF, g, S, E); }
            SEAM(pb + 4);
        }
        if (INL(5)) { phase_cmp2(F, args, l); SEAM(pb + 5); }
        if (INL(6)) { phase_gla_naive(F, args, l); phase_nsa_naive(F); SEAM(pb + 6); }
        if (INL(7)) { phase_gla_norm(F); SEAM(pb + 7); }
        if (INL(8)) {
            const bf16* gm = (const bf16*)(ws + WS_GM); float* yp = (float*)(ws + WS_YPART); bf16* y = (bf16*)(ws + WS_Y);
            { pg8::Gemm g{(const bf16*)(ws + WS_OA), (const bf16*)(ws + W_N), MTOK, DM, 512, 512}; pg8::StaticOrder S; S.init(MTOK, DM, F.G, F.bid);
              EpiMerge<1> E{gm, yp, y};
              pg8::gemm_phase<EpiMerge<1>, pg8::StaticOrder, true, PG8_SP2>(F.lds + RING_OFF, g, S, E); }
            { pg8::Gemm g{(const bf16*)(ws + WS_OB), (const bf16*)(ws + W_G), MTOK, DM, DM, DM}; pg8::StaticOrder S; S.init(MTOK, DM, F.G, F.bid);
              EpiMerge<2> E{gm, yp, y};
              pg8::gemm_phase<EpiMerge<2>, pg8::StaticOrder, true, PG8_SP2>(F.lds + RING_OFF, g, S, E); }
            SEAM(pb + 8);
        }
        if (INL(9)) {
            pg8::Gemm g{(const bf16*)(ws + WS_Y), (const bf16*)(ws + W_O), MTOK, DM, DM, DM}; pg8::StaticOrder S; S.init(MTOK, DM, F.G, F.bid);
            EpiResid E{args.out, xb, ssp, 1.0f};
            pg8::gemm_phase<EpiResid, pg8::StaticOrder, true, PG8_SP2>(F.lds + RING_OFF, g, S, E);
            SEAM(pb + 9);
        }
        if (INL(10)) {
            pg8::Gemm g{xb, (const bf16*)(ws + W_GU2), MTOK, NGU, DM, DM}; pg8::StaticOrder S; S.init(MTOK, NGU, F.G, F.bid);
            EpiGU E{act, ssp};
            pg8::gemm_phase<EpiGU, pg8::StaticOrder, true, PG8_SP2>(F.lds + RING_OFF, g, S, E);
            SEAM(pb + 10);
        }
        if (INL(11)) {
            pg8::Gemm g{act, (const bf16*)(ws + W_D2), MTOK, DM, FF, FF}; pg8::StaticOrder S; S.init(MTOK, DM, F.G, F.bid);
            EpiResid E{args.out, xb, ssp, 0.5f};
            pg8::gemm_phase<EpiResid, pg8::StaticOrder, true, PG8_SP2>(F.lds + RING_OFF, g, S, E);
            SEAM(pb + 11);
        }
    }
    if (IN(NL * NPH_L)) phase_final(F, args);
#undef IN
#undef SEAM
}

extern "C" void kernel_launch(void* const* d_in, const int* in_sizes, int n_in, void* d_out, int out_size, void* d_ws, size_t ws_size, hipStream_t stream) {
    static int grid = 0;
    if (grid == 0) {
        if (n_in != 25 || out_size != MTOK * DM || ws_size < WS_END) { fprintf(stderr, "kernel_launch: unexpected shapes (n_in %d, out %d, ws %zu, need %zu)\n", n_in, out_size, ws_size, (size_t)WS_END); grid = -1; return; }
        int dev = 0, cus = 0, per_cu = 0;
        if (hipGetDevice(&dev) != hipSuccess || hipDeviceGetAttribute(&cus, hipDeviceAttributeMultiprocessorCount, dev) != hipSuccess) { grid = -1; return; }
        if (hipFuncSetAttribute((const void*)fwd, hipFuncAttributeMaxDynamicSharedMemorySize, LDS_BYTES) != hipSuccess) { fprintf(stderr, "kernel_launch: hipFuncSetAttribute failed\n"); grid = -1; return; }
        if (hipOccupancyMaxActiveBlocksPerMultiprocessor(&per_cu, (const void*)fwd, NWAVES * 64, LDS_BYTES) != hipSuccess || per_cu < 1) { fprintf(stderr, "kernel_launch: occupancy query reports %d\n", per_cu); }
        (void)hipGetLastError();
        grid = cus;
    }
    if (grid < 0) return;
    (void)hipMemsetAsync((char*)d_ws + WS_CTL, 0, CTL_ZERO_BYTES, stream);
    Args a{};
    for (int i = 0; i < 25; ++i) a.in[i] = (const float*)d_in[i];
    a.out = (float*)d_out; a.ws = (unsigned char*)d_ws;
#if MK_PER_PHASE
    for (int p = 0; p < NPHASES; ++p) { a.ph_lo = p; a.ph_hi = p + 1; hipLaunchKernelGGL(fwd, dim3(grid), dim3(NWAVES * 64), LDS_BYTES, stream, a); }
#else
    a.ph_lo = 0; a.ph_hi = NPHASES;
    hipLaunchKernelGGL(fwd, dim3(grid), dim3(NWAVES * 64), LDS_BYTES, stream, a);
#endif
    const hipError_t le = hipPeekAtLastError();
    if (le != hipSuccess) fprintf(stderr, "kernel_launch: launch failed: %s\n", hipGetErrorName(le));
}
```

```cpp
#include <hip/hip_runtime.h>
#include <cstdio>
#include <cstdint>

namespace pg8 {
#define PG8_LAS __attribute__((address_space(3)))
typedef unsigned short bf16_t;
typedef short bf16x8 __attribute__((ext_vector_type(8)));
typedef float f32x4 __attribute__((ext_vector_type(4)));
typedef unsigned u32x4 __attribute__((ext_vector_type(4)));
constexpr int BM = 256, BK = 64, HALF = 128, HTB = HALF * BK * 2  , STAGE_BYTES = 8 * HTB, NXCD = 8, WGM = 8;

__host__ __device__ __forceinline__ int lds_byte(int r, int c) { const int st = (r >> 4) * 2 + (c >> 5), rr = r & 15, cc = c & 31, ob = rr * 64 + cc * 2; return st * 1024 + (ob ^ (((ob >> 9) & 1) << 5)); }
__host__ __device__ __forceinline__ void stage_rc(int b, int& R, int& C) { const int st = b / 1024, sb = b % 1024, swz = sb ^ (((sb >> 9) & 1) << 5); R = (st >> 1) * 16 + swz / 64; C = (st & 1) * 32 + (swz % 64) / 2; }
__host__ __device__ __forceinline__ int perm32(int rho) { const int n = rho >> 4, i = rho & 15; return 8 * (i >> 2) + 4 * n + (i & 3); }

struct Unit { int pm, pn; };
struct Gemm { const bf16_t* A; const bf16_t* Bt; int M, N, K, lda; };

struct StaticOrder {
    int nM, nN, nwg, G, c;
    __host__ __device__ void init(int M, int N, int G_, int c_) { nM = M / BM; nN = N / BM; nwg = nM * nN; G = G_; c = c_; }
    __host__ __device__ bool next(int i, Unit& u) const {
        const long L = (long)i * G + c; if (L >= nwg) return false;
        int wgid = (int)L; { const int q = nwg / NXCD, r = nwg % NXCD, xcd = wgid % NXCD, off = wgid / NXCD; wgid = (xcd < r ? xcd * (q + 1) : r * (q + 1) + (xcd - r) * q) + off; }
        const int nig = WGM * nN, gid = wgid / nig, fm = gid * WGM, gsz = (nM - fm) < WGM ? (nM - fm) : WGM;
        u.pm = fm + ((wgid % nig) % gsz); u.pn = (wgid % nig) / gsz; return true;
    }
    __device__ __forceinline__ void a_ready(const Unit&) const {}
    __device__ __forceinline__ void done(const Unit&) const {}
};
template <class Epi, class Sched, bool ALIGN_EPI = false, bool SP2 = false>
__device__ __forceinline__ void gemm_phase(PG8_LAS unsigned char* lds, const Gemm g, const Sched& S, const Epi& E) {
    int tid_ = threadIdx.x; asm volatile("" : "+v"(tid_));
    const int tid = tid_, wid = __builtin_amdgcn_readfirstlane(tid >> 6), lane = tid & 63, wr = wid >> 2, wc = wid & 3, fr = lane & 15, fq = lane >> 4;
    const int K = g.K, nt = K / BK;
    unsigned voffA[2], voffB[2];
#pragma unroll
    for (int i = 0; i < 2; ++i) { int R, C; stage_rc(tid * 16 + i * 8192, R, C); const int Rb = Epi::PERM ? ((R & ~31) + perm32(R & 31)) : R;
        voffA[i] = (unsigned)(R * g.lda + C) * 2u; voffB[i] = (unsigned)(Rb * K + C) * 2u; }
    const size_t kstep = (size_t)(BK * 2);
    const size_t hstep = (size_t)HALF * K * 2;
    const size_t tstep = 2 * hstep;
    const size_t hstepA = (size_t)HALF * g.lda * 2, tstepA = 2 * hstepA;
    const unsigned ldsw = (unsigned)wid * 1024u;
    const int aoff = lds_byte(wr * 64 + fr, fq * 8), boff = lds_byte(wc * 32 + fr, fq * 8);
#define PG8_SA(b, h) (((b) * 2 + (h)) * HTB)
#define PG8_SB(b, h) ((4 + (b) * 2 + (h)) * HTB)
#define PG8_STAGE(bufoff, gbase, voff) do { _Pragma("unroll") for (int _i = 0; _i < 2; ++_i) \
        __builtin_amdgcn_global_load_lds((const unsigned*)((const char*)(gbase) + (voff)[_i]), (PG8_LAS unsigned*)(lds + (bufoff) + ldsw + _i * 8192), 16, 0, 0); } while (0)
#define PG8_LDA(dst, b, h) do { _Pragma("unroll") for (int m = 0; m < 4; ++m) _Pragma("unroll") for (int k = 0; k < 2; ++k) dst[m][k] = *(const PG8_LAS bf16x8*)(lds + PG8_SA(b, h) + aoff + m * 2048 + k * 1024); } while (0)
#define PG8_LDB(dst, b, h) do { _Pragma("unroll") for (int n = 0; n < 2; ++n) _Pragma("unroll") for (int k = 0; k < 2; ++k) dst[n][k] = *(const PG8_LAS bf16x8*)(lds + PG8_SB(b, h) + boff + n * 2048 + k * 1024); } while (0)
#define PG8_MMA(ai, bj, At, Bt) do { __builtin_amdgcn_s_setprio(1); _Pragma("unroll") for (int m = 0; m < 4; ++m) _Pragma("unroll") for (int n = 0; n < 2; ++n) _Pragma("unroll") for (int k = 0; k < 2; ++k) \
        acc[ai][bj][m][n] = __builtin_amdgcn_mfma_f32_16x16x32_bf16(Bt[n][k], At[m][k], acc[ai][bj][m][n], 0, 0, 0); __builtin_amdgcn_s_setprio(0); } while (0)
#define PG8_WAIT_V(n) asm volatile("s_waitcnt vmcnt(" #n ")" ::: "memory")
#define PG8_WAIT_L(n) asm volatile("s_waitcnt lgkmcnt(" #n ")" ::: "memory")
#define PG8_BAR __builtin_amdgcn_s_barrier()
#define PG8_SCHED __builtin_amdgcn_sched_barrier(0)
    Unit cur, nxt; int ui = 0;
    if (!S.next(0, cur)) return;
    f32x4 acc[2][2][4][2];
#pragma unroll
    for (int a = 0; a < 2; ++a)
#pragma unroll
        for (int b = 0; b < 2; ++b)
#pragma unroll
            for (int m = 0; m < 4; ++m)
#pragma unroll
                for (int n = 0; n < 2; ++n) acc[a][b][m][n] = (f32x4){0.f, 0.f, 0.f, 0.f};
    bf16x8 At[4][2], B0[2][2], B1[2][2];
    const char* cA = (const char*)g.A + (size_t)cur.pm * tstepA; const char* cB = (const char*)g.Bt + (size_t)cur.pn * tstep;
    S.a_ready(cur);
    if constexpr (SP2) {
        PG8_STAGE(PG8_SB(0, 0), cB, voffB); PG8_STAGE(PG8_SB(0, 1), cB + hstep, voffB); PG8_STAGE(PG8_SA(0, 0), cA, voffA); PG8_STAGE(PG8_SA(0, 1), cA + hstepA, voffA);
        if (wr == 1) PG8_BAR;
        PG8_WAIT_V(2); PG8_BAR;
        PG8_STAGE(PG8_SB(1, 0), cB + kstep, voffB); PG8_STAGE(PG8_SA(1, 0), cA + kstep, voffA); PG8_STAGE(PG8_SB(1, 1), cB + hstep + kstep, voffB);
        PG8_WAIT_V(6); PG8_BAR;
    } else {
        PG8_STAGE(PG8_SB(0, 0), cB, voffB); PG8_STAGE(PG8_SA(0, 0), cA, voffA); PG8_STAGE(PG8_SB(0, 1), cB + hstep, voffB); PG8_STAGE(PG8_SA(0, 1), cA + hstepA, voffA);
        if (wr == 1) PG8_BAR;
        PG8_WAIT_V(4); PG8_BAR;
        PG8_STAGE(PG8_SB(1, 0), cB + kstep, voffB); PG8_STAGE(PG8_SA(1, 0), cA + kstep, voffA); PG8_STAGE(PG8_SB(1, 1), cB + hstep + kstep, voffB);
        PG8_WAIT_V(6); PG8_BAR;
    }
    for (;;) {
        const bool has_next = S.next(ui + 1, nxt);
        const char* nA = has_next ? (const char*)g.A + (size_t)nxt.pm * tstepA : cA; const char* nB = has_next ? (const char*)g.Bt + (size_t)nxt.pn * tstep : cB;
        for (int t = 0; t < nt; t += 2) {
            const bool last = (t == nt - 2);
            const char* a1 = cA + (size_t)(t + 1) * kstep;
            const char* a2 = last ? nA : cA + (size_t)(t + 2) * kstep; const char* b2 = last ? nB : cB + (size_t)(t + 2) * kstep;
            const char* a3 = a2 + kstep; const char* b3 = b2 + kstep;
            if (last && has_next) S.a_ready(nxt);
            if constexpr (SP2) {
            PG8_LDB(B0, 0, 0); PG8_LDB(B1, 0, 1); PG8_SCHED; PG8_LDA(At, 0, 0); PG8_STAGE(PG8_SA(1, 1), a1 + hstepA, voffA);
            PG8_WAIT_V(8); PG8_WAIT_L(0); PG8_BAR; PG8_MMA(0, 0, At, B0); PG8_MMA(0, 1, At, B1); PG8_BAR; PG8_SCHED;
            PG8_LDA(At, 0, 1); PG8_STAGE(PG8_SB(0, 0), b2, voffB); PG8_STAGE(PG8_SB(0, 1), b2 + hstep, voffB); PG8_STAGE(PG8_SA(0, 0), a2, voffA);
            PG8_WAIT_V(8); PG8_WAIT_L(0); PG8_BAR; PG8_MMA(1, 0, At, B0); PG8_MMA(1, 1, At, B1); PG8_BAR; PG8_SCHED;
            PG8_LDB(B0, 1, 0); PG8_LDB(B1, 1, 1); PG8_SCHED; PG8_LDA(At, 1, 0); PG8_STAGE(PG8_SA(0, 1), a2 + hstepA, voffA);
            PG8_WAIT_V(8); PG8_WAIT_L(0); PG8_BAR; PG8_MMA(0, 0, At, B0); PG8_MMA(0, 1, At, B1); PG8_BAR; PG8_SCHED;
            PG8_LDA(At, 1, 1); PG8_STAGE(PG8_SB(1, 0), b3, voffB); PG8_STAGE(PG8_SB(1, 1), b3 + hstep, voffB); PG8_STAGE(PG8_SA(1, 0), a3, voffA);
            PG8_WAIT_V(8); PG8_WAIT_L(0); PG8_BAR; PG8_MMA(1, 0, At, B0); PG8_MMA(1, 1, At, B1); PG8_BAR; PG8_SCHED;
            } else {
            PG8_LDB(B0, 0, 0); PG8_SCHED; PG8_LDA(At, 0, 0); PG8_STAGE(PG8_SA(1, 1), a1 + hstepA, voffA);
            PG8_WAIT_L(8); PG8_BAR; PG8_WAIT_L(0); PG8_MMA(0, 0, At, B0); PG8_BAR; PG8_SCHED;
            PG8_LDB(B1, 0, 1); PG8_STAGE(PG8_SB(0, 0), b2, voffB);
            PG8_BAR; PG8_WAIT_L(0); PG8_MMA(0, 1, At, B1); PG8_BAR;
            PG8_LDA(At, 0, 1); PG8_STAGE(PG8_SA(0, 0), a2, voffA);
            PG8_BAR; PG8_WAIT_L(0); PG8_MMA(1, 0, At, B0); PG8_BAR; PG8_SCHED;
            PG8_STAGE(PG8_SB(0, 1), b2 + hstep, voffB);
            PG8_WAIT_V(6); PG8_BAR; PG8_MMA(1, 1, At, B1); PG8_BAR;
            PG8_LDB(B0, 1, 0); PG8_SCHED; PG8_LDA(At, 1, 0); PG8_STAGE(PG8_SA(0, 1), a2 + hstepA, voffA);
            PG8_WAIT_L(8); PG8_BAR; PG8_WAIT_L(0); PG8_MMA(0, 0, At, B0); PG8_BAR; PG8_SCHED;
            PG8_LDB(B1, 1, 1); PG8_STAGE(PG8_SB(1, 0), b3, voffB);
            PG8_BAR; PG8_WAIT_L(0); PG8_MMA(0, 1, At, B1); PG8_BAR;
            PG8_LDA(At, 1, 1); PG8_STAGE(PG8_SA(1, 0), a3, voffA);
            PG8_BAR; PG8_WAIT_L(0); PG8_MMA(1, 0, At, B0); PG8_BAR; PG8_SCHED;
            PG8_STAGE(PG8_SB(1, 1), b3 + hstep, voffB);
            PG8_WAIT_V(6); PG8_BAR; PG8_MMA(1, 1, At, B1); PG8_BAR;
            }
        }
        if constexpr (ALIGN_EPI) { if (wr == 0) PG8_BAR; }
        if constexpr (!Epi::AFTER_DRAIN) { E(acc, cur, wr, wc, fr, fq); S.done(cur); }
        if (!has_next) break;
#pragma unroll
        for (int a = 0; a < 2; ++a)
#pragma unroll
            for (int b = 0; b < 2; ++b)
#pragma unroll
                for (int m = 0; m < 4; ++m)
#pragma unroll
                    for (int n = 0; n < 2; ++n) acc[a][b][m][n] = (f32x4){0.f, 0.f, 0.f, 0.f};
        cur = nxt; cA = nA; cB = nB; ++ui;
        if constexpr (ALIGN_EPI) { if (wr == 1) PG8_BAR; }
    }
    PG8_WAIT_V(0);
    if constexpr (!ALIGN_EPI) { if (wr == 0) PG8_BAR; }
    PG8_BAR;
    if constexpr (Epi::AFTER_DRAIN) { E.fused(acc, cur, wr, wc, fr, fq, lds, wid, lane); S.done(cur); }
#undef PG8_SA
#undef PG8_SB
#undef PG8_STAGE
#undef PG8_LDA
#undef PG8_LDB
#undef PG8_MMA
#undef PG8_WAIT_V
#undef PG8_WAIT_L
#undef PG8_BAR
#undef PG8_SCHED
}
}

constexpr int NB = 4, SEQ = 4096, DM = 1024, NL = 4, FF = 2816, MTOK = NB * SEQ;
constexpr int DIN = 6440, NIN = 6656;
constexpr int NGU = 2 * FF;
constexpr float EPSN = 1e-6f;
constexpr int SRC_QA = 0, SRC_KVA = 512, SRC_GA = 1280, SRC_QB = 1304, SRC_KB = 1816, SRC_VB = 2328, SRC_ALR = 3352, SRC_RB = 3368, SRC_GM = 4392;
constexpr int T_QA = 0, T_KVA = 2, T_QB = 5, T_KB = 7, T_VB = 9, T_RB = 13, T_GM = 17, T_MISC = 25;

constexpr size_t MiB = 1u << 20;
constexpr size_t WS_CTL = 0, CTL_ZERO_BYTES = 64 * 1024;
constexpr size_t WS_LUT = 1 * MiB;
constexpr size_t WS_POSB = WS_LUT + 128 * 1024;
constexpr size_t WS_W = 2 * MiB;
constexpr size_t W_GU1 = WS_W, W_D1 = W_GU1 + 11 * MiB, W_GU2 = W_D1 + 11 * MiB / 2, W_D2 = W_GU2 + 11 * MiB;
constexpr size_t W_IN = W_D2 + 11 * MiB / 2, W_C1K = W_IN + 13 * MiB, W_C1V = W_C1K + 1 * MiB, W_N = W_C1V + 1 * MiB, W_G = W_N + 1 * MiB, W_O = W_G + 2 * MiB;
constexpr size_t WS_XB = 58 * MiB;
constexpr size_t WS_SSP = 90 * MiB;
constexpr size_t WS_R = 92 * MiB;
constexpr size_t WS_ACT = WS_R;
constexpr size_t WS_QA = WS_R, WS_KVS = WS_QA + 16 * MiB, WS_KVC = WS_KVS + 16 * MiB, WS_GA = WS_KVC + 9 * MiB, WS_ALR = WS_GA + 2 * MiB;
constexpr size_t WS_QB = WS_ALR + 1 * MiB, WS_KB = WS_QB + 16 * MiB, WS_VB = WS_KB + 16 * MiB, WS_RB = WS_VB + 32 * MiB, WS_GM = WS_RB + 32 * MiB;
constexpr size_t WS_HID = WS_GM + 64 * MiB, WS_KVCMP = WS_HID + 2 * MiB, WS_OA = WS_KVCMP + 1 * MiB, WS_ORAW = WS_OA + 16 * MiB, WS_OB = WS_ORAW + 64 * MiB;
constexpr size_t WS_Y = WS_OB + 32 * MiB, WS_END = WS_Y + 32 * MiB;
constexpr size_t WS_YPART = WS_ORAW;
constexpr size_t WS_KVCMPB = WS_KVC + 8 * MiB + 64 * 1024;
static_assert(W_O + 2 * MiB <= WS_XB, "weights fit");
static_assert(WS_END <= 460 * MiB, "workspace budget");

constexpr int CW_BAR = 1024;

constexpr int RING_OFF = 0, RING_BYTES = 131072;
constexpr int LDSCTL_OFF = RING_BYTES, MISC_OFF = LDSCTL_OFF + 320;
constexpr int LDS_BYTES = 147456;
constexpr int NWAVES = 8;

#define GAS __attribute__((address_space(1)))
#define LAS __attribute__((address_space(3)))
typedef unsigned short bf16;
typedef unsigned v4u __attribute__((ext_vector_type(4)));
typedef unsigned v2u __attribute__((ext_vector_type(2)));
typedef float f32x4 __attribute__((ext_vector_type(4)));
typedef short bf16x8 __attribute__((ext_vector_type(8)));
#define LDS_WAIT() asm volatile("s_waitcnt lgkmcnt(0)" ::: "memory")
#define VM_WAIT() asm volatile("s_waitcnt vmcnt(0)" ::: "memory")
__device__ __forceinline__ unsigned f2bf(float f) { unsigned u = __builtin_bit_cast(unsigned, f); return (u + 0x7fffu + ((u >> 16) & 1u)) >> 16; }
__device__ __forceinline__ unsigned pk2(float lo, float hi) { return f2bf(lo) | (f2bf(hi) << 16); }
__device__ __forceinline__ float bf2f(unsigned short b) { return __builtin_bit_cast(float, ((unsigned)b) << 16); }
__device__ __forceinline__ float bflo(unsigned w) { return __builtin_bit_cast(float, w << 16); }
__device__ __forceinline__ float bfhi(unsigned w) { return __builtin_bit_cast(float, w & 0xffff0000u); }
__device__ __forceinline__ float wave_sum(float v) {
#pragma unroll
    for (int o = 1; o < 64; o <<= 1) v += __shfl_xor(v, o);
    return v;
}
__device__ __forceinline__ float wave_max(float v) {
#pragma unroll
    for (int o = 1; o < 64; o <<= 1) v = fmaxf(v, __shfl_xor(v, o));
    return v;
}
__device__ __forceinline__ float sigmoidf_(float x) { return 1.0f / (1.0f + __expf(-x)); }
__device__ __forceinline__ float siluf_(float x) { return x / (1.0f + __expf(-x)); }

#define XB_TMO      128
#define XB_XCNT(j)  (256  + 64 * (j))
#define XB_XSUB(j)  (1280 + 64 * (j))
#define XB_XGEN(j)  (2304 + 64 * (j))
#define XB_TOP      3328
#define XB_TOPGEN   3392
#define XCD_BAR_WORDS 3456
#define XB_SPIN_CAP (1u << 18)

__device__ __forceinline__ unsigned xb_ld(unsigned* p)              { return __hip_atomic_load(p, __ATOMIC_RELAXED, __HIP_MEMORY_SCOPE_AGENT); }
__device__ __forceinline__ unsigned xb_add(unsigned* p, unsigned v) { return __hip_atomic_fetch_add(p, v, __ATOMIC_RELAXED, __HIP_MEMORY_SCOPE_AGENT); }
__device__ __forceinline__ unsigned xb_xcc_id() { return (unsigned)__builtin_amdgcn_s_getreg((3 << 11) | 20) & 0xFu; }
#define XB_SPIN(cond, bar) do { unsigned _sp = 0; while (cond) { __builtin_amdgcn_s_sleep(1); \
    if ((++_sp & 255u) == 0u) { if (xb_ld(&(bar)[XB_TMO])) break; if (_sp > XB_SPIN_CAP) { atomicAdd(&(bar)[XB_TMO], 1u); break; } } } } while (0)

struct XcdBarrier {
    unsigned* bar; unsigned x;
    volatile LAS unsigned* st;
};
__device__ __forceinline__ XcdBarrier xcd_barrier_post(unsigned* bar, volatile LAS unsigned* st) {
    XcdBarrier b; b.bar = bar; b.x = xb_xcc_id(); b.st = st;
    if (threadIdx.x == 0) (void)xb_add(&bar[XB_XCNT(b.x)], 1u);
    return b;
}
__device__ __forceinline__ void xcd_barrier_complete(unsigned* bar, unsigned x, unsigned& nloc, unsigned& nx) {
    const unsigned G = gridDim.x * gridDim.y * gridDim.z;
    unsigned sum, cnt, mine, sp = 0u;
    for (;;) {
        sum = 0u; cnt = 0u; mine = 0u;
#pragma unroll
        for (unsigned j = 0; j < 16; ++j) { const unsigned c = xb_ld(&bar[XB_XCNT(j)]); sum += c; cnt += (c > 0u) ? 1u : 0u; mine = (j == x) ? c : mine; }
        if (sum == G) break;
        __builtin_amdgcn_s_sleep(1);
        if ((++sp & 255u) == 0u) { if (xb_ld(&bar[XB_TMO])) break; if (sp > XB_SPIN_CAP) { atomicAdd(&bar[XB_TMO], 1u); break; } }
    }
    nloc = mine > 0u ? mine : 1u; nx = cnt > 0u ? cnt : 1u;
}
__device__ __forceinline__ void xcd_barrier(const XcdBarrier& b) {
    asm volatile("s_waitcnt vmcnt(0)" ::: "memory");
    __syncthreads();
    if (threadIdx.x == 0) {
        unsigned* bar = b.bar;
        __builtin_amdgcn_s_waitcnt(0);
        unsigned nloc = b.st[0], nx = b.st[1];
        if (nloc == 0u) { xcd_barrier_complete(bar, b.x, nloc, nx); b.st[0] = nloc; b.st[1] = nx; }
        const unsigned old = xb_add(&bar[XB_XSUB(b.x)], 1u);
        const unsigned gen = old / nloc;
        if (old + 1u == (gen + 1u) * nloc) {
            __builtin_amdgcn_fence(__ATOMIC_RELEASE, "agent");
            asm volatile("s_waitcnt vmcnt(0)" ::: "memory");
            const unsigned og = xb_add(&bar[XB_TOP], 1u);
            const unsigned tg = og / nx;
            if (og + 1u == (tg + 1u) * nx) xb_add(&bar[XB_TOPGEN], 1u);
            else XB_SPIN(xb_ld(&bar[XB_TOPGEN]) == tg, bar);
            __builtin_amdgcn_fence(__ATOMIC_ACQUIRE, "agent");
            xb_add(&bar[XB_XGEN(b.x)], 1u);
            asm volatile("s_waitcnt vmcnt(0)" ::: "memory");
        } else {
            XB_SPIN(xb_ld(&bar[XB_XGEN(b.x)]) == gen, bar);
            __builtin_amdgcn_fence(__ATOMIC_ACQUIRE, "agent");
            asm volatile("s_waitcnt vmcnt(0)" ::: "memory");
        }
    }
    __syncthreads();
}

struct Args { const float* in[25]; float* out; unsigned char* ws; int ph_lo, ph_hi; };
enum { I_X = 0, I_REL, I_F1N, I_F1G, I_F1U, I_F1D, I_MIXN, I_WIN, I_POSK, I_POSV, I_CKW1, I_CKW2, I_CVW1, I_CVW2, I_AW2, I_AB, I_GON, I_WBN, I_WBG, I_WOUT, I_F2N, I_F2G, I_F2U, I_F2D, I_FIN };

struct Frame {
    LAS unsigned char* lds;
    int tid, lane, wave, G, bid;
    unsigned char* ws;
};
__device__ __forceinline__ const float* inp(const Frame& F, int i) {
    const LAS unsigned* t = (const LAS unsigned*)(F.lds + LDSCTL_OFF);
    const unsigned lo = __builtin_amdgcn_readfirstlane(t[2 * i]), hi = __builtin_amdgcn_readfirstlane(t[2 * i + 1]);
    return (const float*)(((unsigned long long)hi << 32) | lo);
}
__device__ __forceinline__ void relaunder(Frame& F) { int t = threadIdx.x; asm volatile("" : "+v"(t)); F.tid = t; F.lane = t & 63; F.wave = __builtin_amdgcn_readfirstlane(t >> 6); }

using pg8::Unit;
__device__ __forceinline__ float row_rstd(const float* ssp, int row) {
    const f32x4* p = (const f32x4*)(ssp + (size_t)row * 16);
    const f32x4 a = p[0], b = p[1], c = p[2], d = p[3];
    const float s = ((a[0] + a[1]) + (a[2] + a[3])) + ((b[0] + b[1]) + (b[2] + b[3])) + ((c[0] + c[1]) + (c[2] + c[3])) + ((d[0] + d[1]) + (d[2] + d[3]));
    return 1.0f / sqrtf(s * (1.0f / DM) + EPSN);
}
struct EpiGU {
    static constexpr bool PERM = true, AFTER_DRAIN = false;
    bf16* act; const float* ssp;
    __device__ __forceinline__ void operator()(const f32x4 (&acc)[2][2][4][2], const Unit& u, int wr, int wc, int fr, int fq) const {
        const int row0 = u.pm * 256 + wr * 64 + fr, col0 = u.pn * 128 + wc * 32 + 8 * fq;
#pragma unroll
        for (int ai = 0; ai < 2; ++ai)
#pragma unroll
            for (int m = 0; m < 4; ++m) {
                const int row = row0 + ai * 128 + m * 16; const float r = row_rstd(ssp, row);
                float h[8];
#pragma unroll
                for (int n = 0; n < 2; ++n)
#pragma unroll
                    for (int j = 0; j < 4; ++j) { const float g = acc[ai][0][m][n][j] * r, up = acc[ai][1][m][n][j] * r; h[n * 4 + j] = siluf_(g) * up; }
                v4u w; w.x = pk2(h[0], h[1]); w.y = pk2(h[2], h[3]); w.z = pk2(h[4], h[5]); w.w = pk2(h[6], h[7]);
                *(v4u*)(act + (size_t)row * FF + col0) = w;
            }
    }
};
struct EpiResid {
    static constexpr bool PERM = true, AFTER_DRAIN = false;
    float* x; bf16* xb; float* ssp; float alpha;
    __device__ __forceinline__ void operator()(const f32x4 (&acc)[2][2][4][2], const Unit& u, int wr, int wc, int fr, int fq) const {
        const int row0 = u.pm * 256 + wr * 64 + fr, col0 = u.pn * 256 + wc * 32 + 8 * fq;
#pragma unroll
        for (int ai = 0; ai < 2; ++ai)
#pragma unroll
            for (int m = 0; m < 4; ++m) {
                const int row = row0 + ai * 128 + m * 16; float ssq = 0.f;
#pragma unroll
                for (int bj = 0; bj < 2; ++bj) {
                    float* xp = x + (size_t)row * DM + col0 + bj * 128;
                    f32x4 x0 = *(const f32x4*)xp, x1 = *(const f32x4*)(xp + 4);
                    x0 = x0 + acc[ai][bj][m][0] * alpha; x1 = x1 + acc[ai][bj][m][1] * alpha;
                    *(f32x4*)xp = x0; *(f32x4*)(xp + 4) = x1;
                    ssq += (x0[0] * x0[0] + x0[1] * x0[1]) + (x0[2] * x0[2] + x0[3] * x0[3]) + (x1[0] * x1[0] + x1[1] * x1[1]) + (x1[2] * x1[2] + x1[3] * x1[3]);
                    v4u w; w.x = pk2(x0[0], x0[1]); w.y = pk2(x0[2], x0[3]); w.z = pk2(x1[0], x1[1]); w.w = pk2(x1[2], x1[3]);
                    *(v4u*)(xb + (size_t)row * DM + col0 + bj * 128) = w;
                }
                ssq += __shfl_xor(ssq, 16); ssq += __shfl_xor(ssq, 32);
                if (fq == 0) ssp[(size_t)row * 16 + u.pn * 4 + wc] = ssq;
            }
    }
};
struct EpiWin {
    static constexpr bool PERM = true, AFTER_DRAIN = false;
    unsigned char* ws; const float* ssp;
    __device__ __forceinline__ void operator()(const f32x4 (&acc)[2][2][4][2], const Unit& u, int wr, int wc, int fr, int fq) const {
        const int row0 = u.pm * 256 + wr * 64 + fr, pn = u.pn;
        bf16* dst = nullptr; int ld = 0, coff = 0, actk = 0; float scale = 1.f;
        if (pn < T_KVA) { dst = (bf16*)(ws + WS_QA); ld = 512; coff = (pn - T_QA) * 256; scale = 0.125f; }
        else if (pn == T_KVA) { }
        else if (pn < T_QB) { dst = (bf16*)(ws + WS_KVS); ld = 512; coff = (pn - T_KVA - 1) * 256; }
        else if (pn < T_KB) { dst = (bf16*)(ws + WS_QB); ld = 512; coff = (pn - T_QB) * 256; scale = 0.08838834764831845f; }
        else if (pn < T_VB) { dst = (bf16*)(ws + WS_KB); ld = 512; coff = (pn - T_KB) * 256; }
        else if (pn < T_RB) { dst = (bf16*)(ws + WS_VB); ld = 1024; coff = (pn - T_VB) * 256; }
        else if (pn < T_GM) { dst = (bf16*)(ws + WS_RB); ld = 1024; coff = (pn - T_RB) * 256; actk = 1; }
        else if (pn < T_MISC) { dst = (bf16*)(ws + WS_GM); ld = 2048; coff = (pn - T_GM) * 256; actk = 2; }
#pragma unroll
        for (int ai = 0; ai < 2; ++ai)
#pragma unroll
            for (int m = 0; m < 4; ++m) {
                const int row = row0 + ai * 128 + m * 16; const float r = row_rstd(ssp, row);
                if (pn == T_MISC) {
                    float* ga = (float*)(ws + WS_GA); float* alr = (float*)(ws + WS_ALR);
#pragma unroll
                    for (int n = 0; n < 2; ++n)
#pragma unroll
                        for (int j = 0; j < 4; ++j) { const int c = wc * 32 + 8 * fq + 4 * n + j; const float v = acc[ai][0][m][n][j] * r;
                            if (c < 24) ga[(size_t)row * 24 + c] = sigmoidf_(v); else if (c < 40) alr[(size_t)row * 16 + (c - 24)] = v; }
                } else {
#pragma unroll
                    for (int bj = 0; bj < 2; ++bj) {
                        float h[8];
#pragma unroll
                        for (int n = 0; n < 2; ++n)
#pragma unroll
                            for (int j = 0; j < 4; ++j) { float v = acc[ai][bj][m][n][j] * r * scale; if (actk == 1) v = siluf_(v); else if (actk == 2) v = sigmoidf_(v); h[n * 4 + j] = v; }
                        v4u w; w.x = pk2(h[0], h[1]); w.y = pk2(h[2], h[3]); w.z = pk2(h[4], h[5]); w.w = pk2(h[6], h[7]);
                        if (pn == T_KVA) {
                            const int b = row >> 12, t = row & 4095, g = wc >> 1, d = (wc & 1) * 32 + 8 * fq;
                            bf16* kvc = (bf16*)(ws + WS_KVC);
                            *(v4u*)(kvc + ((size_t)((bj * 4 + b) * 2 + g) * SEQ + t) * 64 + d) = w;
                        } else {
                            *(v4u*)(dst + (size_t)row * ld + coff + bj * 128 + wc * 32 + 8 * fq) = w;
                        }
                    }
                }
            }
    }
};
struct EpiCmp1 {
    static constexpr bool PERM = true, AFTER_DRAIN = false;
    bf16* hid; const float* posb;
    __device__ __forceinline__ void operator()(const f32x4 (&acc)[2][2][4][2], const Unit& u, int wr, int wc, int fr, int fq) const {
        const int row0 = u.pm * 256 + wr * 64 + fr, col0 = wc * 32 + 8 * fq;
#pragma unroll
        for (int ai = 0; ai < 2; ++ai)
#pragma unroll
            for (int m = 0; m < 4; ++m) {
                const int row = row0 + ai * 128 + m * 16;
#pragma unroll
                for (int bj = 0; bj < 2; ++bj) {
                    const f32x4 b0 = *(const f32x4*)(posb + col0 + bj * 128), b1 = *(const f32x4*)(posb + col0 + bj * 128 + 4);
                    const f32x4 v0 = acc[ai][bj][m][0] + b0, v1 = acc[ai][bj][m][1] + b1;
                    v4u w; w.x = pk2(siluf_(v0[0]), siluf_(v0[1])); w.y = pk2(siluf_(v0[2]), siluf_(v0[3])); w.z = pk2(siluf_(v1[0]), siluf_(v1[1])); w.w = pk2(siluf_(v1[2]), siluf_(v1[3]));
                    *(v4u*)(hid + (size_t)row * 256 + col0 + bj * 128) = w;
                }
            }
    }
};
template <int STEP> struct EpiMerge {
    static constexpr bool PERM = true, AFTER_DRAIN = false;
    const bf16* gm; float* ypart; bf16* y;
    __device__ __forceinline__ void operator()(const f32x4 (&acc)[2][2][4][2], const Unit& u, int wr, int wc, int fr, int fq) const {
        const int row0 = u.pm * 256 + wr * 64 + fr, col0 = u.pn * 256 + wc * 32 + 8 * fq;
#pragma unroll
        for (int ai = 0; ai < 2; ++ai)
#pragma unroll
            for (int m = 0; m < 4; ++m) {
                const int row = row0 + ai * 128 + m * 16;
#pragma unroll
                for (int bj = 0; bj < 2; ++bj) {
                    const int col = col0 + bj * 128;
                    const v4u gw = *(const v4u*)(gm + (size_t)row * 2048 + (STEP == 1 ? 0 : 1024) + col);
                    f32x4 g0 = {bflo(gw.x), bfhi(gw.x), bflo(gw.y), bfhi(gw.y)}, g1 = {bflo(gw.z), bfhi(gw.z), bflo(gw.w), bfhi(gw.w)};
                    float* yp = ypart + (size_t)row * DM + col;
                    if (STEP == 1) { *(f32x4*)yp = g0 * acc[ai][bj][m][0]; *(f32x4*)(yp + 4) = g1 * acc[ai][bj][m][1]; }
                    else { const f32x4 v0 = *(const f32x4*)yp + g0 * acc[ai][bj][m][0], v1 = *(const f32x4*)(yp + 4) + g1 * acc[ai][bj][m][1];
                        v4u w; w.x = pk2(v0[0], v0[1]); w.y = pk2(v0[2], v0[3]); w.z = pk2(v1[0], v1[1]); w.w = pk2(v1[2], v1[3]);
                        *(v4u*)(y + (size_t)row * DM + col) = w; }
                }
            }
    }
};

struct SrcCol { const float* p; int col; };
template <class Map>
__device__ __forceinline__ void tr_item(int ldw, const float* gain, bf16* WT, int K, int nblk, int item, LAS float* scr, int lane, const Map& cm) {
    const int kb = item / nblk, nb = item % nblk, k0 = 64 * kb, n0 = 32 * nb;
    const SrcCol sc = cm(n0 + (lane & 31));
#pragma unroll 8
    for (int i = 0; i < 32; ++i) { const int kk = 2 * i + (lane >> 5); float v = 0.f;
        if (sc.col >= 0) { v = sc.p[(size_t)(k0 + kk) * ldw + sc.col]; if (gain) v *= gain[k0 + kk]; }
        scr[kk * 33 + (lane & 31)] = v; }
    LDS_WAIT();
    const int c = lane & 7;
#pragma unroll
    for (int j = 0; j < 4; ++j) { const int n = (lane >> 3) + 8 * j; const LAS float* s = scr + (8 * c) * 33 + n;
        v4u o; o.x = pk2(s[0 * 33], s[1 * 33]); o.y = pk2(s[2 * 33], s[3 * 33]); o.z = pk2(s[4 * 33], s[5 * 33]); o.w = pk2(s[6 * 33], s[7 * 33]);
        *(v4u*)(WT + (size_t)(n0 + n) * K + k0 + 8 * c) = o; }
    LDS_WAIT();
}
struct MapGU { const float* p; __device__ __forceinline__ SrcCol operator()(int n) const { return SrcCol{p, (n >> 8) * 128 + (n & 127)}; } };
struct MapId { const float* p; __device__ __forceinline__ SrcCol operator()(int n) const { return SrcCol{p, n}; } };
struct MapWin { const float* p; __device__ __forceinline__ SrcCol operator()(int n) const {
    const int t = n >> 8, r = n & 255; int c;
    if (t < T_KVA) c = SRC_QA + n; else if (t < T_QB) c = SRC_KVA + (n - T_KVA * 256); else if (t < T_KB) c = SRC_QB + (n - T_QB * 256); else if (t < T_VB) c = SRC_KB + (n - T_KB * 256);
    else if (t < T_RB) c = SRC_VB + (n - T_VB * 256); else if (t < T_GM) c = SRC_RB + (n - T_RB * 256); else if (t < T_MISC) c = SRC_GM + (n - T_GM * 256);
    else c = r < 24 ? SRC_GA + r : (r < 40 ? SRC_ALR + (r - 24) : -1);
    return SrcCol{p, c}; } };

__device__ __forceinline__ void phase_conv(Frame& F, const Args& a, int l) {
    relaunder(F);
    LAS float* scr = (LAS float*)(F.lds + RING_OFF + F.wave * 16384);
    const int gw = F.bid * NWAVES + F.wave, NGW = F.G * NWAVES;
    unsigned char* ws = F.ws;
    constexpr int I_GU = (DM / 64) * (NGU / 32), I_D = (FF / 64) * (DM / 32), I_IN = (DM / 64) * (NIN / 32), I_C1 = (2048 / 64) * (256 / 32), I_N = (512 / 64) * (DM / 32), I_SQ = (DM / 64) * (DM / 32);
    constexpr int NITEMS = 2 * I_GU + 2 * I_D + I_IN + 2 * I_C1 + I_N + 2 * I_SQ;
    const size_t oG = (size_t)l * DM * FF, oD = (size_t)l * FF * DM;
    for (int it = gw; it < NITEMS; it += NGW) {
        int r = it;
        if (r < I_GU) { const bool up = (((r % (NGU / 32)) * 32) & 255) >= 128;
            if (up) tr_item(FF, inp(F, I_F1N) + l * DM, (bf16*)(ws + W_GU1), DM, NGU / 32, r, scr, F.lane, MapGU{inp(F, I_F1U) + oG});
            else tr_item(FF, inp(F, I_F1N) + l * DM, (bf16*)(ws + W_GU1), DM, NGU / 32, r, scr, F.lane, MapGU{inp(F, I_F1G) + oG});
            continue; } r -= I_GU;
        if (r < I_GU) { const bool up = (((r % (NGU / 32)) * 32) & 255) >= 128;
            if (up) tr_item(FF, inp(F, I_F2N) + l * DM, (bf16*)(ws + W_GU2), DM, NGU / 32, r, scr, F.lane, MapGU{inp(F, I_F2U) + oG});
            else tr_item(FF, inp(F, I_F2N) + l * DM, (bf16*)(ws + W_GU2), DM, NGU / 32, r, scr, F.lane, MapGU{inp(F, I_F2G) + oG});
            continue; } r -= I_GU;
        if (r < I_D) { tr_item(DM, nullptr, (bf16*)(ws + W_D1), FF, DM / 32, r, scr, F.lane, MapId{inp(F, I_F1D) + oD}); continue; } r -= I_D;
        if (r < I_D) { tr_item(DM, nullptr, (bf16*)(ws + W_D2), FF, DM / 32, r, scr, F.lane, MapId{inp(F, I_F2D) + oD}); continue; } r -= I_D;
        if (r < I_IN) { tr_item(DIN, inp(F, I_MIXN) + l * DM, (bf16*)(ws + W_IN), DM, NIN / 32, r, scr, F.lane, MapWin{inp(F, I_WIN) + (size_t)l * DM * DIN}); continue; } r -= I_IN;
        if (r < I_C1) { tr_item(256, nullptr, (bf16*)(ws + W_C1K), 2048, 256 / 32, r, scr, F.lane, MapId{inp(F, I_CKW1) + (size_t)l * 2048 * 256}); continue; } r -= I_C1;
        if (r < I_C1) { tr_item(256, nullptr, (bf16*)(ws + W_C1V), 2048, 256 / 32, r, scr, F.lane, MapId{inp(F, I_CVW1) + (size_t)l * 2048 * 256}); continue; } r -= I_C1;
        if (r < I_N) { tr_item(DM, nullptr, (bf16*)(ws + W_N), 512, DM / 32, r, scr, F.lane, MapId{inp(F, I_WBN) + (size_t)l * 512 * DM}); continue; } r -= I_N;
        if (r < I_SQ) { tr_item(DM, inp(F, I_GON) + l * DM, (bf16*)(ws + W_G), DM, DM / 32, r, scr, F.lane, MapId{inp(F, I_WBG) + (size_t)l * DM * DM}); continue; } r -= I_SQ;
        tr_item(DM, nullptr, (bf16*)(ws + W_O), DM, DM / 32, r, scr, F.lane, MapId{inp(F, I_WOUT) + (size_t)l * DM * DM});
    }
    __syncthreads();
    if (F.bid < 32) {
        const int kv = F.bid >> 4, nb = (F.bid & 15) * 16, c = F.tid & 15, ks = F.tid >> 4;
        const float* pos = inp(F, kv ? I_POSV : I_POSK) + (size_t)l * 2048; const float* w1 = inp(F, kv ? I_CVW1 : I_CKW1) + (size_t)l * 2048 * 256;
        float s = 0.f;
        for (int k = ks * 64; k < ks * 64 + 64; ++k) s += pos[k] * w1[(size_t)k * 256 + nb + c];
        LAS float* red = (LAS float*)(F.lds + RING_OFF);
        red[F.tid] = s; __syncthreads();
        if (F.tid < 16) { float t = 0.f; for (int i = 0; i < 32; ++i) t += red[i * 16 + F.tid]; ((float*)(ws + WS_POSB))[kv * 256 + nb + F.tid] = t; }
        __syncthreads();
    }
}
__device__ __forceinline__ void phase_lut(Frame& F, const Args& a) {
    relaunder(F);
    float* lut = (float*)(F.ws + WS_LUT); const float* tab = inp(F, I_REL);
    for (int i = F.bid * 512 + F.tid; i < 8 * 4096; i += F.G * 512) {
        const int h = i >> 12, n = i & 4095; int bk;
        if (n < 16) bk = n; else { const float nf = (float)n; int lb = 16 + (int)(logf(nf / 16.0f) / 4.1588830833596715f * 16.0f); bk = lb < 31 ? lb : 31; }
        lut[i] = tab[bk * 8 + h];
    }
}
__device__ __forceinline__ void phase_x0(Frame& F, const Args& a) {
    relaunder(F);
    const int gw = F.bid * NWAVES + F.wave, NGW = F.G * NWAVES;
    bf16* xb = (bf16*)(F.ws + WS_XB); float* ssp = (float*)(F.ws + WS_SSP);
    for (int m = gw; m < MTOK; m += NGW) {
        const f32x4* xr = (const f32x4*)(inp(F, I_X) + (size_t)m * DM) + F.lane; f32x4* orow = (f32x4*)(a.out + (size_t)m * DM) + F.lane;
        v2u* o8 = (v2u*)(xb + (size_t)m * DM) + F.lane; float s = 0.f;
#pragma unroll
        for (int j = 0; j < 4; ++j) { const f32x4 v = xr[64 * j]; orow[64 * j] = v; s += (v[0] * v[0] + v[1] * v[1]) + (v[2] * v[2] + v[3] * v[3]); v2u w; w.x = pk2(v[0], v[1]); w.y = pk2(v[2], v[3]); o8[64 * j] = w; }
        s = wave_sum(s);
        if (F.lane < 16) ssp[(size_t)m * 16 + F.lane] = F.lane == 0 ? s : 0.f;
    }
}
__device__ __forceinline__ void phase_final(Frame& F, const Args& a) {
    relaunder(F);
    const int gw = F.bid * NWAVES + F.wave, NGW = F.G * NWAVES; const f32x4* gn = (const f32x4*)inp(F, I_FIN) + F.lane;
    for (int m = gw; m < MTOK; m += NGW) {
        f32x4* xr = (f32x4*)(a.out + (size_t)m * DM) + F.lane; f32x4 v[4]; float s = 0.f;
#pragma unroll
        for (int j = 0; j < 4; ++j) { v[j] = xr[64 * j]; s += (v[j][0] * v[j][0] + v[j][1] * v[j][1]) + (v[j][2] * v[j][2] + v[j][3] * v[j][3]); }
        const float r = 1.0f / sqrtf(wave_sum(s) * (1.0f / DM) + EPSN);
#pragma unroll
        for (int j = 0; j < 4; ++j) xr[64 * j] = v[j] * r * gn[64 * j];
    }
}
__device__ __forceinline__ void phase_cmp2(Frame& F, const Args& a, int l) {
    relaunder(F);
    const int gw = F.bid * NWAVES + F.wave, NGW = F.G * NWAVES;
    const bf16* hid = (const bf16*)(F.ws + WS_HID); float* out = (float*)(F.ws + WS_KVCMP);
    for (int row = gw; row < 4096; row += NGW) {
        const int kv = row >> 11; const float* w2 = inp(F, kv ? I_CVW2 : I_CKW2) + (size_t)l * 256 * 64;
        const bf16* hr = hid + (size_t)row * 256; float s = 0.f;
        for (int k = 0; k < 256; k += 8) { const v4u hw = *(const v4u*)(hr + k);
            s += bflo(hw.x) * w2[(k + 0) * 64 + F.lane] + bfhi(hw.x) * w2[(k + 1) * 64 + F.lane] + bflo(hw.y) * w2[(k + 2) * 64 + F.lane] + bfhi(hw.y) * w2[(k + 3) * 64 + F.lane]
               + bflo(hw.z) * w2[(k + 4) * 64 + F.lane] + bfhi(hw.z) * w2[(k + 5) * 64 + F.lane] + bflo(hw.w) * w2[(k + 6) * 64 + F.lane] + bfhi(hw.w) * w2[(k + 7) * 64 + F.lane]; }
        out[(size_t)row * 64 + F.lane] = s; ((bf16*)(F.ws + WS_KVCMPB))[(size_t)row * 64 + F.lane] = (bf16)f2bf(s);
    }
}

__device__ __forceinline__ void dot4_bf16(const bf16* kp, const LAS float* qs, float (&s)[4]) {
    s[0] = s[1] = s[2] = s[3] = 0.f;
#pragma unroll 2
    for (int c = 0; c < 8; ++c) { const v4u kw = *(const v4u*)(kp + c * 8);
        const float kf[8] = {bflo(kw.x), bfhi(kw.x), bflo(kw.y), bfhi(kw.y), bflo(kw.z), bfhi(kw.z), bflo(kw.w), bfhi(kw.w)};
#pragma unroll
        for (int h = 0; h < 4; ++h) { const f32x4 q0 = *(const LAS f32x4*)(qs + h * 64 + c * 8), q1 = *(const LAS f32x4*)(qs + h * 64 + c * 8 + 4);
            s[h] += (kf[0] * q0[0] + kf[1] * q0[1]) + (kf[2] * q0[2] + kf[3] * q0[3]) + (kf[4] * q1[0] + kf[5] * q1[1]) + (kf[6] * q1[2] + kf[7] * q1[3]); } }
}
__device__ __forceinline__ void dot4_f32(const float* kp, const LAS float* qs, float (&s)[4]) {
    s[0] = s[1] = s[2] = s[3] = 0.f;
#pragma unroll 4
    for (int c = 0; c < 16; ++c) { const f32x4 kf = *(const f32x4*)(kp + c * 4);
#pragma unroll
        for (int h = 0; h < 4; ++h) { const f32x4 q0 = *(const LAS f32x4*)(qs + h * 64 + c * 4); s[h] += (kf[0] * q0[0] + kf[1] * q0[1]) + (kf[2] * q0[2] + kf[3] * q0[3]); } }
}
__device__ __forceinline__ void online_block(const float (&s)[4], bool kvalid, const bf16* vp, int vld, LAS float* ps, int lane, float (&m)[4], float (&lsum)[4], float (&o)[4]) {
    float p[4];
#pragma unroll
    for (int h = 0; h < 4; ++h) {
        const float sm = wave_max(kvalid ? s[h] : -INFINITY), mn = fmaxf(m[h], sm);
        const float sc = (m[h] == -INFINITY) ? 0.f : __expf(m[h] - mn);
        p[h] = (kvalid && mn > -INFINITY) ? __expf(s[h] - mn) : 0.f;
        lsum[h] = lsum[h] * sc + wave_sum(p[h]); o[h] *= sc; m[h] = mn;
    }
    *(LAS f32x4*)(ps + lane * 4) = (f32x4){p[0], p[1], p[2], p[3]};
    LDS_WAIT();
#pragma unroll 8
    for (int k = 0; k < 64; ++k) { const f32x4 pv = *(const LAS f32x4*)(ps + k * 4); const float v = bf2f(vp[(size_t)k * vld + lane]);
        o[0] += pv[0] * v; o[1] += pv[1] * v; o[2] += pv[2] * v; o[3] += pv[3] * v; }
    LDS_WAIT();
}
__device__ __forceinline__ void phase_nsa_naive(Frame& F) {
    relaunder(F);
    LAS float* wl = (LAS float*)(F.lds + RING_OFF + F.wave * 16384);
    LAS float* qs = wl; LAS float* ps = wl + 256; LAS float* psum = wl + 512; LAS float* scl = wl + 1024;
    const bf16* qa = (const bf16*)(F.ws + WS_QA); const bf16* kvs = (const bf16*)(F.ws + WS_KVS); const float* ga = (const float*)(F.ws + WS_GA);
    const float* kvcmp = (const float*)(F.ws + WS_KVCMP); const float* lut = (const float*)(F.ws + WS_LUT); bf16* oa = (bf16*)(F.ws + WS_OA);
    const int lane = F.lane;
    for (int wt = F.bid; wt < 4096; wt += F.G) {
        const int bg = wt & 7, tb = wt >> 3, b = bg >> 1, g = bg & 1, t = tb * 8 + F.wave, row = b * SEQ + t, jcur = t >> 6;
        const float* lutg = lut + (size_t)(g * 4) * 4096;
#pragma unroll
        for (int h = 0; h < 4; ++h) qs[h * 64 + lane] = bf2f(qa[(size_t)row * 512 + (g * 4 + h) * 64 + lane]);
        LDS_WAIT();
        float gate[4][3];
#pragma unroll
        for (int h = 0; h < 4; ++h)
#pragma unroll
            for (int br = 0; br < 3; ++br) gate[h][br] = ga[(size_t)row * 24 + (g * 4 + h) * 3 + br];
        float oacc[4] = {0.f, 0.f, 0.f, 0.f};
        const int ncv = t >= 31 ? ((t - 31) >> 4) + 1 : 0;
        float imp = 0.f;
        if (ncv > 0) {
            const float* kc = kvcmp + (size_t)(0 * 8 + bg) * 256 * 64; const float* vc = kvcmp + (size_t)(1 * 8 + bg) * 256 * 64;
            float mx[4] = {-INFINITY, -INFINITY, -INFINITY, -INFINITY};
            const int nblk = (ncv + 63) >> 6;
#pragma unroll 1
            for (int blk = 0; blk < nblk; ++blk) {
                const int c = blk * 64 + lane; const bool valid = c < ncv;
                float s[4]; dot4_f32(kc + (size_t)(c < 255 ? c : 255) * 64, qs, s);
                const int dist = valid ? t - (16 * c + 31) : 0;
#pragma unroll
                for (int h = 0; h < 4; ++h) { const float v = valid ? s[h] + lutg[h * 4096 + dist] : -INFINITY; scl[h * 256 + c] = v; mx[h] = fmaxf(mx[h], v); }
            }
            float ls[4] = {0.f, 0.f, 0.f, 0.f};
#pragma unroll
            for (int h = 0; h < 4; ++h) mx[h] = wave_max(mx[h]);
            LDS_WAIT();
#pragma unroll 1
            for (int blk = 0; blk < nblk; ++blk) {
                const int c = blk * 64 + lane;
#pragma unroll
                for (int h = 0; h < 4; ++h) { const float v = scl[h * 256 + c]; const float p = v > -INFINITY ? __expf(v - mx[h]) : 0.f; scl[h * 256 + c] = p; ls[h] += p; }
            }
#pragma unroll
            for (int h = 0; h < 4; ++h) ls[h] = 1.0f / wave_sum(ls[h]);
            LDS_WAIT();
            float oc[4] = {0.f, 0.f, 0.f, 0.f};
#pragma unroll 1
            for (int blk = 0; blk < 4; ++blk) {
                const int c = blk * 64 + lane; float pt = 0.f;
                if (blk < nblk) {
#pragma unroll
                    for (int h = 0; h < 4; ++h) { const float p = scl[h * 256 + c] * ls[h]; scl[h * 256 + c] = p; pt += p; }
                }
                psum[c] = pt;
            }
            LDS_WAIT();
#pragma unroll 2
            for (int k = 0; k < ncv; ++k) { const float v = vc[(size_t)k * 64 + lane];
                oc[0] += scl[k] * v; oc[1] += scl[256 + k] * v; oc[2] += scl[512 + k] * v; oc[3] += scl[768 + k] * v; }
#pragma unroll
            for (int i = -1; i <= 3; ++i) { const int c = 4 * lane + i; if (c >= 0 && c < 255) imp += psum[c]; }
#pragma unroll
            for (int h = 0; h < 4; ++h) oacc[h] += gate[h][0] * oc[h];
            LDS_WAIT();
        }
        const bool forced = (lane == 0) || (lane == jcur) || (lane == jcur - 1);
        const float score = forced ? 1e6f : (lane <= jcur ? imp : -1e6f);
        int rank = 0;
#pragma unroll 4
        for (int s2 = 0; s2 < 64; ++s2) { const float v2 = __shfl(score, s2); rank += (v2 > score || (v2 == score && s2 < lane)) ? 1 : 0; }
        unsigned long long selmask = __ballot(rank < 16);
        selmask &= (jcur == 63) ? ~0ull : ((1ull << (jcur + 1)) - 1ull);
        {
            float m[4] = {-INFINITY, -INFINITY, -INFINITY, -INFINITY}, lsum[4] = {0.f, 0.f, 0.f, 0.f}, o[4] = {0.f, 0.f, 0.f, 0.f};
#pragma unroll 1
            while (selmask) {
                const int j = __builtin_ctzll(selmask); selmask &= selmask - 1ull;
                const int pos = j * 64 + lane; const bool kvalid = pos <= t;
                float s[4]; dot4_bf16(kvs + (size_t)(b * SEQ + pos) * 512 + 0 * 128 + g * 64, qs, s);
                if (kvalid) {
#pragma unroll
                    for (int h = 0; h < 4; ++h) s[h] += lutg[h * 4096 + (t - pos)];
                }
                online_block(s, kvalid, kvs + (size_t)(b * SEQ + j * 64) * 512 + 1 * 128 + g * 64, 512, ps, lane, m, lsum, o);
            }
#pragma unroll
            for (int h = 0; h < 4; ++h) oacc[h] += gate[h][1] * o[h] / lsum[h];
        }
        {
            float m[4] = {-INFINITY, -INFINITY, -INFINITY, -INFINITY}, lsum[4] = {0.f, 0.f, 0.f, 0.f}, o[4] = {0.f, 0.f, 0.f, 0.f};
            const int lo = t - 511 > 0 ? t - 511 : 0;
#pragma unroll 1
            for (int j = lo >> 6; j <= jcur; ++j) {
                const int pos = j * 64 + lane; const bool kvalid = pos <= t && pos >= lo;
                float s[4]; dot4_bf16(kvs + (size_t)(b * SEQ + pos) * 512 + 2 * 128 + g * 64, qs, s);
                if (kvalid) {
#pragma unroll
                    for (int h = 0; h < 4; ++h) s[h] += lutg[h * 4096 + (t - pos)];
                }
                online_block(s, kvalid, kvs + (size_t)(b * SEQ + j * 64) * 512 + 3 * 128 + g * 64, 512, ps, lane, m, lsum, o);
            }
#pragma unroll
            for (int h = 0; h < 4; ++h) oacc[h] += gate[h][2] * o[h] / lsum[h];
        }
#pragma unroll
        for (int h = 0; h < 4; ++h) oa[(size_t)row * 512 + (g * 4 + h) * 64 + lane] = (bf16)f2bf(oacc[h]);
        LDS_WAIT();
    }
}


typedef float f32x16 __attribute__((ext_vector_type(16)));
typedef short v4i16_t __attribute__((ext_vector_type(4)));
constexpr int NSA_TS = 144;
constexpr int NL_K = 0, NL_V = 9216, NL_LUT = 18432, NL_IMP = NL_LUT + 32768, NL_SEL = NL_IMP + 4 * 64 * 65 * 4, NL_END = NL_SEL + 512;
static_assert(NL_END <= RING_BYTES, "nsa lds");
#define KLOC(i) (((i) & 3) + 8 * ((i) >> 2) + 4 * hf)

__device__ __forceinline__ void nsa_qk(const LAS unsigned char* Kt, const bf16x8 (&qf)[4], int r32, int hf, f32x16& p0, f32x16& p1) {
#pragma unroll
    for (int i = 0; i < 16; ++i) { p0[i] = 0.f; p1[i] = 0.f; }
#pragma unroll
    for (int ks = 0; ks < 4; ++ks) {
        const bf16x8 a0 = *(const LAS bf16x8*)(Kt + r32 * NSA_TS + ks * 32 + hf * 16);
        const bf16x8 a1 = *(const LAS bf16x8*)(Kt + (32 + r32) * NSA_TS + ks * 32 + hf * 16);
        p0 = __builtin_amdgcn_mfma_f32_32x32x16_bf16(a0, qf[ks], p0, 0, 0, 0);
        p1 = __builtin_amdgcn_mfma_f32_32x32x16_bf16(a1, qf[ks], p1, 0, 0, 0);
    }
}
__device__ __forceinline__ bf16x8 nsa_pack(const f32x16& p, const int s) {
    v4u w; w.x = pk2(p[8 * s + 0], p[8 * s + 1]); w.y = pk2(p[8 * s + 2], p[8 * s + 3]); w.z = pk2(p[8 * s + 4], p[8 * s + 5]); w.w = pk2(p[8 * s + 6], p[8 * s + 7]);
    return __builtin_bit_cast(bf16x8, w);
}
__device__ __forceinline__ void nsa_pv(const LAS unsigned char* Vt, const f32x16& p0, const f32x16& p1, int lane, int hf, f32x16 (&o)[2]) {
    bf16x8 pb[4]; pb[0] = nsa_pack(p0, 0); pb[1] = nsa_pack(p0, 1); pb[2] = nsa_pack(p1, 0); pb[3] = nsa_pack(p1, 1);
    const LAS unsigned char* base = Vt + (4 * hf + ((lane & 15) >> 2)) * NSA_TS + (16 * ((lane >> 4) & 1) + 4 * (lane & 3)) * 2;
#pragma unroll
    for (int dt = 0; dt < 2; ++dt)
#pragma unroll
        for (int ks = 0; ks < 4; ++ks) {
            const LAS unsigned char* ap = base + (16 * ks) * NSA_TS + dt * 64;
            const v4i16_t lo = __builtin_amdgcn_ds_read_tr16_b64_v4i16((LAS v4i16_t*)ap);
            const v4i16_t hi = __builtin_amdgcn_ds_read_tr16_b64_v4i16((LAS v4i16_t*)(ap + 8 * NSA_TS));
            const bf16x8 a = {lo[0], lo[1], lo[2], lo[3], hi[0], hi[1], hi[2], hi[3]};
            o[dt] = __builtin_amdgcn_mfma_f32_32x32x16_bf16(a, pb[ks], o[dt], 0, 0, 0);
        }
}
__device__ __forceinline__ void nsa_online(f32x16& p0, f32x16& p1, float& m, float& l, f32x16 (&o)[2]) {
    float bm = -INFINITY;
#pragma unroll
    for (int i = 0; i < 16; ++i) bm = fmaxf(bm, fmaxf(p0[i], p1[i]));
    bm = fmaxf(bm, __shfl_xor(bm, 32));
    const float mn = fmaxf(m, bm), mref = (mn == -INFINITY) ? 0.f : mn, sc = __expf(m - mref);
    float ps = 0.f;
#pragma unroll
    for (int i = 0; i < 16; ++i) { p0[i] = __expf(p0[i] - mref); p1[i] = __expf(p1[i] - mref); ps += p0[i] + p1[i]; }
    l = l * sc + ps; m = mn;
#pragma unroll
    for (int i = 0; i < 16; ++i) { o[0][i] *= sc; o[1][i] *= sc; }
}
__device__ __forceinline__ v4u nsa_ld16(const bf16* p) { return *(const v4u*)p; }

__device__ __forceinline__ void phase_nsa(Frame& F) {
    relaunder(F);
    LAS unsigned char* L = F.lds + RING_OFF;
    LAS unsigned char* Kt = L + NL_K; LAS unsigned char* Vt = L + NL_V;
    LAS float* lutL = (LAS float*)(L + NL_LUT); LAS float* impL = (LAS float*)(L + NL_IMP); LAS unsigned long long* selL = (LAS unsigned long long*)(L + NL_SEL);
    const bf16* qa = (const bf16*)(F.ws + WS_QA); const bf16* kvs = (const bf16*)(F.ws + WS_KVS); const float* ga = (const float*)(F.ws + WS_GA);
    const bf16* kvcb = (const bf16*)(F.ws + WS_KVCMPB); const float* lut = (const float*)(F.ws + WS_LUT); bf16* oa = (bf16*)(F.ws + WS_OA);
    const int tid = F.tid, lane = F.lane, wave = F.wave, r32 = lane & 31, hf = lane >> 5, hh = wave >> 1, qh = wave & 1;
    const int srow = tid >> 3, schunk = tid & 7;
    const int soff = srow * NSA_TS + schunk * 16;
    for (int i = tid; i < 8 * 1024; i += 512) lutL[i] = lut[(i >> 10) * 4096 + (i & 1023)];
    __syncthreads();
    for (int ui = 0; ui < 2; ++ui) {
        const int w = F.bid, bg = w & 7, a_ = (w >> 3) & 31, cq = ui == 0 ? 63 - a_ : a_;
        if (w >= 256) break;
        const int b = bg >> 1, g = bg & 1, head = g * 4 + hh, tq = cq * 64 + qh * 32 + r32;
        const size_t qrow = (size_t)b * SEQ + tq;
        const LAS float* lutH = lutL + head * 1024;
        bf16x8 qf[4];
#pragma unroll
        for (int ks = 0; ks < 4; ++ks) qf[ks] = *(const bf16x8*)(qa + qrow * 512 + head * 64 + ks * 16 + hf * 8);
        const float g_cmp = ga[qrow * 24 + head * 3 + 0], g_slc = ga[qrow * 24 + head * 3 + 1], g_win = ga[qrow * 24 + head * 3 + 2];
        f32x16 oc[2];
#pragma unroll
        for (int i = 0; i < 16; ++i) { oc[0][i] = 0.f; oc[1][i] = 0.f; }
        for (int i = tid; i < 4 * 64 * 65; i += 512) impL[i] = 0.f;
        const bf16* kc = kvcb + (size_t)(0 * 8 + bg) * 256 * 64; const bf16* vc = kvcb + (size_t)(1 * 8 + bg) * 256 * 64;
        const int ncb = (4 * cq + 2) / 64 + 1;
        float m = -INFINITY, l = 0.f;
        f32x16 p0, p1, o[2];
        for (int cb = 0; cb < ncb; ++cb) {
            __syncthreads();
            *(LAS v4u*)(Kt + soff) = nsa_ld16(kc + (size_t)(cb * 64 + srow) * 64 + schunk * 8);
            __syncthreads();
            nsa_qk(Kt, qf, r32, hf, p0, p1);
#pragma unroll
            for (int i = 0; i < 16; ++i) {
                const int d0 = tq - 31 - 16 * (cb * 64 + KLOC(i)), d1 = d0 - 512;
                p0[i] = d0 >= 0 ? p0[i] + lutH[d0 > 1023 ? 1023 : (d0 < 0 ? 0 : d0)] : -INFINITY;
                p1[i] = d1 >= 0 ? p1[i] + lutH[d1 > 1023 ? 1023 : (d1 < 0 ? 0 : d1)] : -INFINITY;
            }
            float bm = -INFINITY;
#pragma unroll
            for (int i = 0; i < 16; ++i) bm = fmaxf(bm, fmaxf(p0[i], p1[i]));
            bm = fmaxf(bm, __shfl_xor(bm, 32));
            const float mn = fmaxf(m, bm), mref = (mn == -INFINITY) ? 0.f : mn;
            float ps = 0.f;
#pragma unroll
            for (int i = 0; i < 16; ++i) ps += __expf(p0[i] - mref) + __expf(p1[i] - mref);
            l = l * __expf(m - mref) + ps; m = mn;
        }
        {
            const float lt = l + __shfl_xor(l, 32), invl = lt > 0.f ? 1.0f / lt : 0.f, mref = (m == -INFINITY) ? 0.f : m;
#pragma unroll
            for (int i = 0; i < 16; ++i) { o[0][i] = 0.f; o[1][i] = 0.f; }
            LAS float* impH = impL + hh * (64 * 65) + (qh * 32 + r32) * 65;
            for (int cb = 0; cb < ncb; ++cb) {
                __syncthreads();
                *(LAS v4u*)(Kt + soff) = nsa_ld16(kc + (size_t)(cb * 64 + srow) * 64 + schunk * 8);
                *(LAS v4u*)(Vt + soff) = nsa_ld16(vc + (size_t)(cb * 64 + srow) * 64 + schunk * 8);
                __syncthreads();
                nsa_qk(Kt, qf, r32, hf, p0, p1);
#pragma unroll
                for (int i = 0; i < 16; ++i) {
                    const int d0 = tq - 31 - 16 * (cb * 64 + KLOC(i)), d1 = d0 - 512;
                    p0[i] = d0 >= 0 ? __expf(p0[i] + lutH[d0 > 1023 ? 1023 : (d0 < 0 ? 0 : d0)] - mref) * invl : 0.f;
                    p1[i] = d1 >= 0 ? __expf(p1[i] + lutH[d1 > 1023 ? 1023 : (d1 < 0 ? 0 : d1)] - mref) * invl : 0.f;
                }
#pragma unroll
                for (int g4 = 0; g4 < 4; ++g4) {
                    const int u0 = cb * 16 + 2 * g4 + hf, u1 = u0 + 8;
                    impH[u0] += (p0[4 * g4] + p0[4 * g4 + 1]) + (p0[4 * g4 + 2] + p0[4 * g4 + 3]);
                    impH[u1] += (p1[4 * g4] + p1[4 * g4 + 1]) + (p1[4 * g4 + 2] + p1[4 * g4 + 3]);
                }
                LDS_WAIT();
#pragma unroll
                for (int g4 = 0; g4 < 4; ++g4) {
                    const int u0 = cb * 16 + 2 * g4 + hf + 1, u1 = u0 + 8;
                    if (u0 < 64) impH[u0] += p0[4 * g4 + 3];
                    if (u1 < 64) impH[u1] += p1[4 * g4 + 3];
                }
                nsa_pv(Vt, p0, p1, lane, hf, o);
            }
#pragma unroll
            for (int i = 0; i < 16; ++i) { oc[0][i] += g_cmp * o[0][i]; oc[1][i] += g_cmp * o[1][i]; }
        }
        __syncthreads();
        {
            const int q = tid >> 3, sub = tid & 7; float v[8];
#pragma unroll
            for (int k = 0; k < 8; ++k) { const int s = sub * 8 + k; const int idx = q * 65 + s;
                const float im = ((impL[idx] + impL[64 * 65 + idx]) + impL[2 * 64 * 65 + idx]) + impL[3 * 64 * 65 + idx];
                v[k] = (s == 0 || s == cq || s == cq - 1) ? 1e6f : (s <= cq ? im : -1e6f); }
            __syncthreads();
#pragma unroll
            for (int k = 0; k < 8; ++k) impL[q * 65 + sub * 8 + k] = v[k];
            __syncthreads();
            int cnt[8];
#pragma unroll
            for (int k = 0; k < 8; ++k) cnt[k] = 0;
#pragma unroll 4
            for (int s2 = 0; s2 < 64; ++s2) { const float x = impL[q * 65 + s2];
#pragma unroll
                for (int k = 0; k < 8; ++k) cnt[k] += (x > v[k] || (x == v[k] && s2 < sub * 8 + k)) ? 1 : 0; }
            unsigned byte = 0;
#pragma unroll
            for (int k = 0; k < 8; ++k) byte |= (cnt[k] < 16 ? 1u : 0u) << k;
            ((LAS unsigned char*)selL)[q * 8 + sub] = (unsigned char)byte;
        }
        __syncthreads();
        const unsigned long long vmask = (cq == 63) ? ~0ull : ((1ull << (cq + 1)) - 1ull);
        const unsigned long long mysel = selL[qh * 32 + r32] & vmask;
        unsigned long long U = selL[lane] & vmask;
#pragma unroll
        for (int off = 1; off < 64; off <<= 1) { const unsigned lo_ = __shfl_xor((unsigned)U, off), hi_ = __shfl_xor((unsigned)(U >> 32), off); U |= ((unsigned long long)hi_ << 32) | lo_; }
        U = ((unsigned long long)(unsigned)__builtin_amdgcn_readfirstlane((unsigned)(U >> 32)) << 32) | (unsigned)__builtin_amdgcn_readfirstlane((unsigned)U);
        {
            m = -INFINITY; l = 0.f;
#pragma unroll
            for (int i = 0; i < 16; ++i) { o[0][i] = 0.f; o[1][i] = 0.f; }
            unsigned long long rem = U;
            int j = __builtin_ctzll(rem); rem &= rem - 1ull;
            v4u kreg = nsa_ld16(kvs + ((size_t)b * SEQ + j * 64 + srow) * 512 + 0 * 128 + g * 64 + schunk * 8);
            v4u vreg = nsa_ld16(kvs + ((size_t)b * SEQ + j * 64 + srow) * 512 + 1 * 128 + g * 64 + schunk * 8);
            for (;;) {
                __syncthreads();
                *(LAS v4u*)(Kt + soff) = kreg; *(LAS v4u*)(Vt + soff) = vreg;
                __syncthreads();
                const int jc = j; const bool more = rem != 0ull;
                if (more) { j = __builtin_ctzll(rem); rem &= rem - 1ull;
                    kreg = nsa_ld16(kvs + ((size_t)b * SEQ + j * 64 + srow) * 512 + 0 * 128 + g * 64 + schunk * 8);
                    vreg = nsa_ld16(kvs + ((size_t)b * SEQ + j * 64 + srow) * 512 + 1 * 128 + g * 64 + schunk * 8); }
                nsa_qk(Kt, qf, r32, hf, p0, p1);
                const bool sel = (mysel >> jc) & 1ull;
                if (cq - jc >= 14) {
                    const float bias = lutH[1023];
#pragma unroll
                    for (int i = 0; i < 16; ++i) { p0[i] = sel ? p0[i] + bias : -INFINITY; p1[i] = sel ? p1[i] + bias : -INFINITY; }
                } else {
                    const int dbase = tq - jc * 64;
#pragma unroll
                    for (int i = 0; i < 16; ++i) { const int d0 = dbase - KLOC(i), d1 = d0 - 32;
                        p0[i] = (sel && d0 >= 0) ? p0[i] + lutH[d0 < 0 ? 0 : d0] : -INFINITY;
                        p1[i] = (sel && d1 >= 0) ? p1[i] + lutH[d1 < 0 ? 0 : d1] : -INFINITY; }
                }
                nsa_online(p0, p1, m, l, o);
                nsa_pv(Vt, p0, p1, lane, hf, o);
                if (!more) break;
            }
            const float lt = l + __shfl_xor(l, 32), sc = g_slc / lt;
#pragma unroll
            for (int i = 0; i < 16; ++i) { oc[0][i] += sc * o[0][i]; oc[1][i] += sc * o[1][i]; }
        }
        {
            m = -INFINITY; l = 0.f;
#pragma unroll
            for (int i = 0; i < 16; ++i) { o[0][i] = 0.f; o[1][i] = 0.f; }
            int j = cq - 8 > 0 ? cq - 8 : 0;
            v4u kreg = nsa_ld16(kvs + ((size_t)b * SEQ + j * 64 + srow) * 512 + 2 * 128 + g * 64 + schunk * 8);
            v4u vreg = nsa_ld16(kvs + ((size_t)b * SEQ + j * 64 + srow) * 512 + 3 * 128 + g * 64 + schunk * 8);
            for (;;) {
                __syncthreads();
                *(LAS v4u*)(Kt + soff) = kreg; *(LAS v4u*)(Vt + soff) = vreg;
                __syncthreads();
                const int jc = j; const bool more = jc < cq;
                if (more) { j = jc + 1;
                    kreg = nsa_ld16(kvs + ((size_t)b * SEQ + j * 64 + srow) * 512 + 2 * 128 + g * 64 + schunk * 8);
                    vreg = nsa_ld16(kvs + ((size_t)b * SEQ + j * 64 + srow) * 512 + 3 * 128 + g * 64 + schunk * 8); }
                nsa_qk(Kt, qf, r32, hf, p0, p1);
                const int dbase = tq - jc * 64;
#pragma unroll
                for (int i = 0; i < 16; ++i) { const int d0 = dbase - KLOC(i), d1 = d0 - 32;
                    p0[i] = (d0 >= 0 && d0 < 512) ? p0[i] + lutH[d0 < 0 ? 0 : d0] : -INFINITY;
                    p1[i] = (d1 >= 0 && d1 < 512) ? p1[i] + lutH[d1 < 0 ? 0 : d1] : -INFINITY; }
                nsa_online(p0, p1, m, l, o);
                nsa_pv(Vt, p0, p1, lane, hf, o);
                if (!more) break;
            }
            const float lt = l + __shfl_xor(l, 32), sc = g_win / lt;
#pragma unroll
            for (int i = 0; i < 16; ++i) { oc[0][i] += sc * o[0][i]; oc[1][i] += sc * o[1][i]; }
        }
#pragma unroll
        for (int dt = 0; dt < 2; ++dt)
#pragma unroll
            for (int g4 = 0; g4 < 4; ++g4) { v2u wv; wv.x = pk2(oc[dt][4 * g4], oc[dt][4 * g4 + 1]); wv.y = pk2(oc[dt][4 * g4 + 2], oc[dt][4 * g4 + 3]);
                *(v2u*)(oa + qrow * 512 + head * 64 + dt * 32 + 8 * g4 + 4 * hf) = wv; }
        __syncthreads();
    }
}
#undef KLOC

__device__ __forceinline__ void phase_gla_naive(Frame& F, const Args& a, int l) {
    relaunder(F);
    if (F.bid >= 64) return;
    const int bh = F.bid >> 2, cb = F.bid & 3, b = bh >> 2, h = bh & 3;
    LAS float* qL = (LAS float*)(F.lds + RING_OFF); LAS float* kL = qL + 32 * 128; LAS float* aL = kL + 32 * 128; LAS float* vL = aL + 32 * 128;
    const bf16* qb = (const bf16*)(F.ws + WS_QB); const bf16* kb = (const bf16*)(F.ws + WS_KB); const bf16* vb = (const bf16*)(F.ws + WS_VB);
    const float* alr = (const float*)(F.ws + WS_ALR); float* oraw = (float*)(F.ws + WS_ORAW);
    const int tid = F.tid, split = tid & 7, ci = tid >> 3, d_st = tid & 127;
    float w2r[16];
#pragma unroll
    for (int r = 0; r < 16; ++r) w2r[r] = inp(F, I_AW2)[(size_t)l * 16 * 512 + r * 512 + h * 128 + d_st];
    const float ab = inp(F, I_AB)[l * 512 + h * 128 + d_st];
    float S[16];
#pragma unroll
    for (int i = 0; i < 16; ++i) S[i] = 0.f;
    for (int tc = 0; tc < SEQ / 32; ++tc) {
        const int t0 = tc * 32;
        __syncthreads();
#pragma unroll
        for (int i = 0; i < 8; ++i) { const int idx = tid + 512 * i, tt = idx >> 7; const size_t row = (size_t)b * SEQ + t0 + tt;
            qL[idx] = bf2f(qb[row * 512 + h * 128 + d_st]); kL[idx] = bf2f(kb[row * 512 + h * 128 + d_st]);
            const f32x4* ar = (const f32x4*)(alr + row * 16); float z = ab;
#pragma unroll
            for (int q = 0; q < 4; ++q) { const f32x4 av = ar[q]; z += av[0] * w2r[4 * q] + av[1] * w2r[4 * q + 1] + av[2] * w2r[4 * q + 2] + av[3] * w2r[4 * q + 3]; }
            const float ls = fminf(z, 0.f) - log1pf(__expf(-fabsf(z)));
            aL[idx] = __expf(ls * (1.0f / 16.0f)); }
#pragma unroll
        for (int i = 0; i < 4; ++i) { const int idx = tid + 512 * i, tt = idx >> 6, c = idx & 63; vL[idx] = bf2f(vb[((size_t)b * SEQ + t0 + tt) * 1024 + h * 256 + cb * 64 + c]); }
        __syncthreads();
        for (int tt = 0; tt < 32; ++tt) {
            const float vt = vL[tt * 64 + ci]; float o = 0.f;
#pragma unroll
            for (int q = 0; q < 4; ++q) { const f32x4 av = *(const LAS f32x4*)(aL + tt * 128 + split * 16 + 4 * q), kv = *(const LAS f32x4*)(kL + tt * 128 + split * 16 + 4 * q), qv = *(const LAS f32x4*)(qL + tt * 128 + split * 16 + 4 * q);
#pragma unroll
                for (int j = 0; j < 4; ++j) { S[4 * q + j] = av[j] * S[4 * q + j] + kv[j] * vt; o += qv[j] * S[4 * q + j]; } }
            o += __shfl_xor(o, 1); o += __shfl_xor(o, 2); o += __shfl_xor(o, 4);
            if (split == 0) oraw[((size_t)b * SEQ + t0 + tt) * 1024 + h * 256 + cb * 64 + ci] = o;
        }
    }
    __syncthreads();
}
__device__ __forceinline__ void phase_gla_norm(Frame& F) {
    relaunder(F);
    const int gw = F.bid * NWAVES + F.wave, NGW = F.G * NWAVES;
    const float* oraw = (const float*)(F.ws + WS_ORAW); const bf16* rb = (const bf16*)(F.ws + WS_RB); bf16* ob = (bf16*)(F.ws + WS_OB);
    for (int i = gw; i < MTOK * 4; i += NGW) {
        const f32x4 v = *((const f32x4*)(oraw + (size_t)i * 256) + F.lane);
        const float s = wave_sum((v[0] * v[0] + v[1] * v[1]) + (v[2] * v[2] + v[3] * v[3]));
        const float r = 1.0f / sqrtf(s * (1.0f / 256.0f) + EPSN);
        const v2u rw = *((const v2u*)(rb + (size_t)i * 256) + F.lane);
        v2u w; w.x = pk2(v[0] * r * bflo(rw.x), v[1] * r * bfhi(rw.x)); w.y = pk2(v[2] * r * bflo(rw.y), v[3] * r * bfhi(rw.y));
        *((v2u*)(ob + (size_t)i * 256) + F.lane) = w;
    }
}

#ifndef NSA_NAIVE
#define NSA_NAIVE 0
#endif
#ifndef MK_PER_PHASE
#define MK_PER_PHASE 0
#endif
#ifndef PG8_SP2
#define PG8_SP2 true
#endif
constexpr int NPH_L = 12, NPHASES = NL * NPH_L + 1;

__global__ void __launch_bounds__(NWAVES * 64, 2) fwd(Args args) {
    extern __shared__ __attribute__((aligned(16))) unsigned char lds[];
    Frame F;
    F.lds = (LAS unsigned char*)lds;
    F.tid = threadIdx.x; F.lane = F.tid & 63; F.wave = __builtin_amdgcn_readfirstlane(F.tid >> 6);
    F.G = gridDim.x; F.bid = blockIdx.x; F.ws = args.ws;
    unsigned char* ws = args.ws;
    for (int u = F.tid; u < (LDS_BYTES - LDSCTL_OFF) / 4; u += NWAVES * 64) ((LAS unsigned*)(F.lds + LDSCTL_OFF))[u] = 0u;
    if (F.tid < 50) ((LAS unsigned*)(F.lds + LDSCTL_OFF))[F.tid] = ((const __attribute__((address_space(4))) unsigned*)__builtin_amdgcn_kernarg_segment_ptr())[F.tid];
    __syncthreads();
    XcdBarrier bar; bar.bar = (unsigned*)(ws + WS_CTL) + CW_BAR; bar.x = 0; bar.st = nullptr;
    if (!MK_PER_PHASE) bar = xcd_barrier_post((unsigned*)(ws + WS_CTL) + CW_BAR, (volatile LAS unsigned*)(F.lds + MISC_OFF) + 8);
    const int lo = args.ph_lo, hi = args.ph_hi;
#ifndef PH_MASK
#define PH_MASK 0xFFFF
#endif
#define INL(j) (((PH_MASK >> (j)) & 1) && lo <= (pb + (j)) && (pb + (j)) < hi)
#define IN(k) (lo <= (k) && (k) < hi)
#define SEAM(k) do { if (IN((k) + 1)) { if (MK_PER_PHASE) { } else xcd_barrier(bar); } } while (0)
    bf16* xb = (bf16*)(ws + WS_XB); float* ssp = (float*)(ws + WS_SSP); bf16* act = (bf16*)(ws + WS_ACT);

    for (int l = 0; l < NL; ++l) {
        const int pb = l * NPH_L;
        if (INL(0)) { phase_conv(F, args, l); if (l == 0) { phase_lut(F, args); phase_x0(F, args); } SEAM(pb + 0); }
        if (INL(1)) {
            pg8::Gemm g{xb, (const bf16*)(ws + W_GU1), MTOK, NGU, DM, DM}; pg8::StaticOrder S; S.init(MTOK, NGU, F.G, F.bid);
            EpiGU E{act, ssp};
            pg8::gemm_phase<EpiGU, pg8::StaticOrder, true, PG8_SP2>(F.lds + RING_OFF, g, S, E);
            SEAM(pb + 1);
        }
        if (INL(2)) {
            pg8::Gemm g{act, (const bf16*)(ws + W_D1), MTOK, DM, FF, FF}; pg8::StaticOrder S; S.init(MTOK, DM, F.G, F.bid);
            EpiResid E{args.out, xb, ssp, 0.5f};
            pg8::gemm_phase<EpiResid, pg8::StaticOrder, true, PG8_SP2>(F.lds + RING_OFF, g, S, E);
            SEAM(pb + 2);
        }
        if (INL(3)) {
            pg8::Gemm g{xb, (const bf16*)(ws + W_IN), MTOK, NIN, DM, DM}; pg8::StaticOrder S; S.init(MTOK, NIN, F.G, F.bid);
            EpiWin E{ws, ssp};
            pg8::gemm_phase<EpiWin, pg8::StaticOrder, true, PG8_SP2>(F.lds + RING_OFF, g, S, E);
            SEAM(pb + 3);
        }
        if (INL(4)) {
            const bf16* kvc = (const bf16*)(ws + WS_KVC); bf16* hid = (bf16*)(ws + WS_HID); const float* posb = (const float*)(ws + WS_POSB);
            { pg8::Gemm g{kvc, (const bf16*)(ws + W_C1K), 2048, 256, 2048, 1024}; pg8::StaticOrder S; S.init(2048, 256, F.G, F.bid);
              EpiCmp1 E{hid, posb};
              pg8::gemm_phase<EpiCmp1, pg8::StaticOrder, true, PG8_SP2>(F.lds + RING_OFF, g, S, E); }
            { pg8::Gemm g{kvc + (size_t)8 * SEQ * 64, (const bf16*)(ws + W_C1V), 2048, 256, 2048, 1024}; pg8::StaticOrder S; S.init(2048, 256, F.G, (F.bid + F.G - 8) % F.G);
              EpiCmp1 E{hid + (size_t)2048 * 256, posb + 256};
              pg8::gemm_phase<EpiCmp1, pg8::StaticOrder, true, PG8_SP2>(F.lds + RING_OFF, g, S, E); }
            SEAM(pb + 4);
        }
        if (INL(5)) { phase_cmp2(F, args, l); SEAM(pb + 5); }
        if (INL(6)) { phase_gla_naive(F, args, l);
#if NSA_NAIVE
            phase_nsa_naive(F);
#else
            phase_nsa(F);
#endif
            SEAM(pb + 6); }
        if (INL(7)) { phase_gla_norm(F); SEAM(pb + 7); }
        if (INL(8)) {
            const bf16* gm = (const bf16*)(ws + WS_GM); float* yp = (float*)(ws + WS_YPART); bf16* y = (bf16*)(ws + WS_Y);
            { pg8::Gemm g{(const bf16*)(ws + WS_OA), (const bf16*)(ws + W_N), MTOK, DM, 512, 512}; pg8::StaticOrder S; S.init(MTOK, DM, F.G, F.bid);
              EpiMerge<1> E{gm, yp, y};
              pg8::gemm_phase<EpiMerge<1>, pg8::StaticOrder, true, PG8_SP2>(F.lds + RING_OFF, g, S, E); }
            { pg8::Gemm g{(const bf16*)(ws + WS_OB), (const bf16*)(ws + W_G), MTOK, DM, DM, DM}; pg8::StaticOrder S; S.init(MTOK, DM, F.G, F.bid);
              EpiMerge<2> E{gm, yp, y};
              pg8::gemm_phase<EpiMerge<2>, pg8::StaticOrder, true, PG8_SP2>(F.lds + RING_OFF, g, S, E); }
            SEAM(pb + 8);
        }
        if (INL(9)) {
            pg8::Gemm g{(const bf16*)(ws + WS_Y), (const bf16*)(ws + W_O), MTOK, DM, DM, DM}; pg8::StaticOrder S; S.init(MTOK, DM, F.G, F.bid);
            EpiResid E{args.out, xb, ssp, 1.0f};
            pg8::gemm_phase<EpiResid, pg8::StaticOrder, true, PG8_SP2>(F.lds + RING_OFF, g, S, E);
            SEAM(pb + 9);
        }
        if (INL(10)) {
            pg8::Gemm g{xb, (const bf16*)(ws + W_GU2), MTOK, NGU, DM, DM}; pg8::StaticOrder S; S.init(MTOK, NGU, F.G, F.bid);
            EpiGU E{act, ssp};
            pg8::gemm_phase<EpiGU, pg8::StaticOrder, true, PG8_SP2>(F.lds + RING_OFF, g, S, E);
            SEAM(pb + 10);
        }
        if (INL(11)) {
            pg8::Gemm g{act, (const bf16*)(ws + W_D2), MTOK, DM, FF, FF}; pg8::StaticOrder S; S.init(MTOK, DM, F.G, F.bid);
            EpiResid E{args.out, xb, ssp, 0.5f};
            pg8::gemm_phase<EpiResid, pg8::StaticOrder, true, PG8_SP2>(F.lds + RING_OFF, g, S, E);
            SEAM(pb + 11);
        }
    }
    if (IN(NL * NPH_L)) phase_final(F, args);
#undef IN
#undef SEAM
}

extern "C" void kernel_launch(void* const* d_in, const int* in_sizes, int n_in, void* d_out, int out_size, void* d_ws, size_t ws_size, hipStream_t stream) {
    static int grid = 0;
    if (grid == 0) {
        if (n_in != 25 || out_size != MTOK * DM || ws_size < WS_END) { fprintf(stderr, "kernel_launch: unexpected shapes (n_in %d, out %d, ws %zu, need %zu)\n", n_in, out_size, ws_size, (size_t)WS_END); grid = -1; return; }
        int dev = 0, cus = 0, per_cu = 0;
        if (hipGetDevice(&dev) != hipSuccess || hipDeviceGetAttribute(&cus, hipDeviceAttributeMultiprocessorCount, dev) != hipSuccess) { grid = -1; return; }
        if (hipFuncSetAttribute((const void*)fwd, hipFuncAttributeMaxDynamicSharedMemorySize, LDS_BYTES) != hipSuccess) { fprintf(stderr, "kernel_launch: hipFuncSetAttribute failed\n"); grid = -1; return; }
        if (hipOccupancyMaxActiveBlocksPerMultiprocessor(&per_cu, (const void*)fwd, NWAVES * 64, LDS_BYTES) != hipSuccess || per_cu < 1) { fprintf(stderr, "kernel_launch: occupancy query reports %d\n", per_cu); }
        (void)hipGetLastError();
        grid = cus;
    }
    if (grid < 0) return;
    (void)hipMemsetAsync((char*)d_ws + WS_CTL, 0, CTL_ZERO_BYTES, stream);
    Args a{};
    for (int i = 0; i < 25; ++i) a.in[i] = (const float*)d_in[i];
    a.out = (float*)d_out; a.ws = (unsigned char*)d_ws;
#if MK_PER_PHASE
    for (int p = 0; p < NPHASES; ++p) { a.ph_lo = p; a.ph_hi = p + 1; hipLaunchKernelGGL(fwd, dim3(grid), dim3(NWAVES * 64), LDS_BYTES, stream, a); }
#else
    a.ph_lo = 0; a.ph_hi = NPHASES;
    hipLaunchKernelGGL(fwd, dim3(grid), dim3(NWAVES * 64), LDS_BYTES, stream, a);
#endif
    const hipError_t le = hipPeekAtLastError();
    if (le != hipSuccess) fprintf(stderr, "kernel_launch: launch failed: %s\n", hipGetErrorName(le));
}
```

```cpp
#include <hip/hip_runtime.h>
#include <cstdio>
#include <cstdint>

namespace pg8 {
#define PG8_LAS __attribute__((address_space(3)))
typedef unsigned short bf16_t;
typedef short bf16x8 __attribute__((ext_vector_type(8)));
typedef float f32x4 __attribute__((ext_vector_type(4)));
typedef unsigned u32x4 __attribute__((ext_vector_type(4)));
constexpr int BM = 256, BK = 64, HALF = 128, HTB = HALF * BK * 2  , STAGE_BYTES = 8 * HTB, NXCD = 8, WGM = 8;

__host__ __device__ __forceinline__ int lds_byte(int r, int c) { const int st = (r >> 4) * 2 + (c >> 5), rr = r & 15, cc = c & 31, ob = rr * 64 + cc * 2; return st * 1024 + (ob ^ (((ob >> 9) & 1) << 5)); }
__host__ __device__ __forceinline__ void stage_rc(int b, int& R, int& C) { const int st = b / 1024, sb = b % 1024, swz = sb ^ (((sb >> 9) & 1) << 5); R = (st >> 1) * 16 + swz / 64; C = (st & 1) * 32 + (swz % 64) / 2; }
__host__ __device__ __forceinline__ int perm32(int rho) { const int n = rho >> 4, i = rho & 15; return 8 * (i >> 2) + 4 * n + (i & 3); }

struct Unit { int pm, pn; };
struct Gemm { const bf16_t* A; const bf16_t* Bt; int M, N, K, lda; };

struct StaticOrder {
    int nM, nN, nwg, G, c;
    __host__ __device__ void init(int M, int N, int G_, int c_) { nM = M / BM; nN = N / BM; nwg = nM * nN; G = G_; c = c_; }
    __host__ __device__ bool next(int i, Unit& u) const {
        const long L = (long)i * G + c; if (L >= nwg) return false;
        int wgid = (int)L; { const int q = nwg / NXCD, r = nwg % NXCD, xcd = wgid % NXCD, off = wgid / NXCD; wgid = (xcd < r ? xcd * (q + 1) : r * (q + 1) + (xcd - r) * q) + off; }
        const int nig = WGM * nN, gid = wgid / nig, fm = gid * WGM, gsz = (nM - fm) < WGM ? (nM - fm) : WGM;
        u.pm = fm + ((wgid % nig) % gsz); u.pn = (wgid % nig) / gsz; return true;
    }
    __device__ __forceinline__ void a_ready(const Unit&) const {}
    __device__ __forceinline__ void done(const Unit&) const {}
};
template <class Epi, class Sched, bool ALIGN_EPI = false, bool SP2 = false>
__device__ __forceinline__ void gemm_phase(PG8_LAS unsigned char* lds, const Gemm g, const Sched& S, const Epi& E) {
    int tid_ = threadIdx.x; asm volatile("" : "+v"(tid_));
    const int tid = tid_, wid = __builtin_amdgcn_readfirstlane(tid >> 6), lane = tid & 63, wr = wid >> 2, wc = wid & 3, fr = lane & 15, fq = lane >> 4;
    const int K = g.K, nt = K / BK;
    unsigned voffA[2], voffB[2];
#pragma unroll
    for (int i = 0; i < 2; ++i) { int R, C; stage_rc(tid * 16 + i * 8192, R, C); const int Rb = Epi::PERM ? ((R & ~31) + perm32(R & 31)) : R;
        voffA[i] = (unsigned)(R * g.lda + C) * 2u; voffB[i] = (unsigned)(Rb * K + C) * 2u; }
    const size_t kstep = (size_t)(BK * 2);
    const size_t hstep = (size_t)HALF * K * 2;
    const size_t tstep = 2 * hstep;
    const size_t hstepA = (size_t)HALF * g.lda * 2, tstepA = 2 * hstepA;
    const unsigned ldsw = (unsigned)wid * 1024u;
    const int aoff = lds_byte(wr * 64 + fr, fq * 8), boff = lds_byte(wc * 32 + fr, fq * 8);
#define PG8_SA(b, h) (((b) * 2 + (h)) * HTB)
#define PG8_SB(b, h) ((4 + (b) * 2 + (h)) * HTB)
#define PG8_STAGE(bufoff, gbase, voff) do { _Pragma("unroll") for (int _i = 0; _i < 2; ++_i) \
        __builtin_amdgcn_global_load_lds((const unsigned*)((const char*)(gbase) + (voff)[_i]), (PG8_LAS unsigned*)(lds + (bufoff) + ldsw + _i * 8192), 16, 0, 0); } while (0)
#define PG8_LDA(dst, b, h) do { _Pragma("unroll") for (int m = 0; m < 4; ++m) _Pragma("unroll") for (int k = 0; k < 2; ++k) dst[m][k] = *(const PG8_LAS bf16x8*)(lds + PG8_SA(b, h) + aoff + m * 2048 + k * 1024); } while (0)
#define PG8_LDB(dst, b, h) do { _Pragma("unroll") for (int n = 0; n < 2; ++n) _Pragma("unroll") for (int k = 0; k < 2; ++k) dst[n][k] = *(const PG8_LAS bf16x8*)(lds + PG8_SB(b, h) + boff + n * 2048 + k * 1024); } while (0)
#define PG8_MMA(ai, bj, At, Bt) do { __builtin_amdgcn_s_setprio(1); _Pragma("unroll") for (int m = 0; m < 4; ++m) _Pragma("unroll") for (int n = 0; n < 2; ++n) _Pragma("unroll") for (int k = 0; k < 2; ++k) \
        acc[ai][bj][m][n] = __builtin_amdgcn_mfma_f32_16x16x32_bf16(Bt[n][k], At[m][k], acc[ai][bj][m][n], 0, 0, 0); __builtin_amdgcn_s_setprio(0); } while (0)
#define PG8_WAIT_V(n) asm volatile("s_waitcnt vmcnt(" #n ")" ::: "memory")
#define PG8_WAIT_L(n) asm volatile("s_waitcnt lgkmcnt(" #n ")" ::: "memory")
#define PG8_BAR __builtin_amdgcn_s_barrier()
#define PG8_SCHED __builtin_amdgcn_sched_barrier(0)
    Unit cur, nxt; int ui = 0;
    if (!S.next(0, cur)) return;
    f32x4 acc[2][2][4][2];
#pragma unroll
    for (int a = 0; a < 2; ++a)
#pragma unroll
        for (int b = 0; b < 2; ++b)
#pragma unroll
            for (int m = 0; m < 4; ++m)
#pragma unroll
                for (int n = 0; n < 2; ++n) acc[a][b][m][n] = (f32x4){0.f, 0.f, 0.f, 0.f};
    bf16x8 At[4][2], B0[2][2], B1[2][2];
    const char* cA = (const char*)g.A + (size_t)cur.pm * tstepA; const char* cB = (const char*)g.Bt + (size_t)cur.pn * tstep;
    S.a_ready(cur);
    if constexpr (SP2) {
        PG8_STAGE(PG8_SB(0, 0), cB, voffB); PG8_STAGE(PG8_SB(0, 1), cB + hstep, voffB); PG8_STAGE(PG8_SA(0, 0), cA, voffA); PG8_STAGE(PG8_SA(0, 1), cA + hstepA, voffA);
        if (wr == 1) PG8_BAR;
        PG8_WAIT_V(2); PG8_BAR;
        PG8_STAGE(PG8_SB(1, 0), cB + kstep, voffB); PG8_STAGE(PG8_SA(1, 0), cA + kstep, voffA); PG8_STAGE(PG8_SB(1, 1), cB + hstep + kstep, voffB);
        PG8_WAIT_V(6); PG8_BAR;
    } else {
        PG8_STAGE(PG8_SB(0, 0), cB, voffB); PG8_STAGE(PG8_SA(0, 0), cA, voffA); PG8_STAGE(PG8_SB(0, 1), cB + hstep, voffB); PG8_STAGE(PG8_SA(0, 1), cA + hstepA, voffA);
        if (wr == 1) PG8_BAR;
        PG8_WAIT_V(4); PG8_BAR;
        PG8_STAGE(PG8_SB(1, 0), cB + kstep, voffB); PG8_STAGE(PG8_SA(1, 0), cA + kstep, voffA); PG8_STAGE(PG8_SB(1, 1), cB + hstep + kstep, voffB);
        PG8_WAIT_V(6); PG8_BAR;
    }
    for (;;) {
        const bool has_next = S.next(ui + 1, nxt);
        const char* nA = has_next ? (const char*)g.A + (size_t)nxt.pm * tstepA : cA; const char* nB = has_next ? (const char*)g.Bt + (size_t)nxt.pn * tstep : cB;
        for (int t = 0; t < nt; t += 2) {
            const bool last = (t == nt - 2);
            const char* a1 = cA + (size_t)(t + 1) * kstep;
            const char* a2 = last ? nA : cA + (size_t)(t + 2) * kstep; const char* b2 = last ? nB : cB + (size_t)(t + 2) * kstep;
            const char* a3 = a2 + kstep; const char* b3 = b2 + kstep;
            if (last && has_next) S.a_ready(nxt);
            if constexpr (SP2) {
            PG8_LDB(B0, 0, 0); PG8_LDB(B1, 0, 1); PG8_SCHED; PG8_LDA(At, 0, 0); PG8_STAGE(PG8_SA(1, 1), a1 + hstepA, voffA);
            PG8_WAIT_V(8); PG8_WAIT_L(0); PG8_BAR; PG8_MMA(0, 0, At, B0); PG8_MMA(0, 1, At, B1); PG8_BAR; PG8_SCHED;
            PG8_LDA(At, 0, 1); PG8_STAGE(PG8_SB(0, 0), b2, voffB); PG8_STAGE(PG8_SB(0, 1), b2 + hstep, voffB); PG8_STAGE(PG8_SA(0, 0), a2, voffA);
            PG8_WAIT_V(8); PG8_WAIT_L(0); PG8_BAR; PG8_MMA(1, 0, At, B0); PG8_MMA(1, 1, At, B1); PG8_BAR; PG8_SCHED;
            PG8_LDB(B0, 1, 0); PG8_LDB(B1, 1, 1); PG8_SCHED; PG8_LDA(At, 1, 0); PG8_STAGE(PG8_SA(0, 1), a2 + hstepA, voffA);
            PG8_WAIT_V(8); PG8_WAIT_L(0); PG8_BAR; PG8_MMA(0, 0, At, B0); PG8_MMA(0, 1, At, B1); PG8_BAR; PG8_SCHED;
            PG8_LDA(At, 1, 1); PG8_STAGE(PG8_SB(1, 0), b3, voffB); PG8_STAGE(PG8_SB(1, 1), b3 + hstep, voffB); PG8_STAGE(PG8_SA(1, 0), a3, voffA);
            PG8_WAIT_V(8); PG8_WAIT_L(0); PG8_BAR; PG8_MMA(1, 0, At, B0); PG8_MMA(1, 1, At, B1); PG8_BAR; PG8_SCHED;
            } else {
            PG8_LDB(B0, 0, 0); PG8_SCHED; PG8_LDA(At, 0, 0); PG8_STAGE(PG8_SA(1, 1), a1 + hstepA, voffA);
            PG8_WAIT_L(8); PG8_BAR; PG8_WAIT_L(0); PG8_MMA(0, 0, At, B0); PG8_BAR; PG8_SCHED;
            PG8_LDB(B1, 0, 1); PG8_STAGE(PG8_SB(0, 0), b2, voffB);
            PG8_BAR; PG8_WAIT_L(0); PG8_MMA(0, 1, At, B1); PG8_BAR;
            PG8_LDA(At, 0, 1); PG8_STAGE(PG8_SA(0, 0), a2, voffA);
            PG8_BAR; PG8_WAIT_L(0); PG8_MMA(1, 0, At, B0); PG8_BAR; PG8_SCHED;
            PG8_STAGE(PG8_SB(0, 1), b2 + hstep, voffB);
            PG8_WAIT_V(6); PG8_BAR; PG8_MMA(1, 1, At, B1); PG8_BAR;
            PG8_LDB(B0, 1, 0); PG8_SCHED; PG8_LDA(At, 1, 0); PG8_STAGE(PG8_SA(0, 1), a2 + hstepA, voffA);
            PG8_WAIT_L(8); PG8_BAR; PG8_WAIT_L(0); PG8_MMA(0, 0, At, B0); PG8_BAR; PG8_SCHED;
            PG8_LDB(B1, 1, 1); PG8_STAGE(PG8_SB(1, 0), b3, voffB);
            PG8_BAR; PG8_WAIT_L(0); PG8_MMA(0, 1, At, B1); PG8_BAR;
            PG8_LDA(At, 1, 1); PG8_STAGE(PG8_SA(1, 0), a3, voffA);
            PG8_BAR; PG8_WAIT_L(0); PG8_MMA(1, 0, At, B0); PG8_BAR; PG8_SCHED;
            PG8_STAGE(PG8_SB(1, 1), b3 + hstep, voffB);
            PG8_WAIT_V(6); PG8_BAR; PG8_MMA(1, 1, At, B1); PG8_BAR;
            }
        }
        if constexpr (ALIGN_EPI) { if (wr == 0) PG8_BAR; }
        if constexpr (!Epi::AFTER_DRAIN) { E(acc, cur, wr, wc, fr, fq); S.done(cur); }
        if (!has_next) break;
#pragma unroll
        for (int a = 0; a < 2; ++a)
#pragma unroll
            for (int b = 0; b < 2; ++b)
#pragma unroll
                for (int m = 0; m < 4; ++m)
#pragma unroll
                    for (int n = 0; n < 2; ++n) acc[a][b][m][n] = (f32x4){0.f, 0.f, 0.f, 0.f};
        cur = nxt; cA = nA; cB = nB; ++ui;
        if constexpr (ALIGN_EPI) { if (wr == 1) PG8_BAR; }
    }
    PG8_WAIT_V(0);
    if constexpr (!ALIGN_EPI) { if (wr == 0) PG8_BAR; }
    PG8_BAR;
    if constexpr (Epi::AFTER_DRAIN) { E.fused(acc, cur, wr, wc, fr, fq, lds, wid, lane); S.done(cur); }
#undef PG8_SA
#undef PG8_SB
#undef PG8_STAGE
#undef PG8_LDA
#undef PG8_LDB
#undef PG8_MMA
#undef PG8_WAIT_V
#undef PG8_WAIT_L
#undef PG8_BAR
#undef PG8_SCHED
}
}

constexpr int NB = 4, SEQ = 4096, DM = 1024, NL = 4, FF = 2816, MTOK = NB * SEQ;
constexpr int DIN = 6440, NIN = 6656;
constexpr int NGU = 2 * FF;
constexpr float EPSN = 1e-6f;
constexpr int SRC_QA = 0, SRC_KVA = 512, SRC_GA = 1280, SRC_QB = 1304, SRC_KB = 1816, SRC_VB = 2328, SRC_ALR = 3352, SRC_RB = 3368, SRC_GM = 4392;
constexpr int T_QA = 0, T_KVA = 2, T_QB = 5, T_KB = 7, T_VB = 9, T_RB = 13, T_GM = 17, T_MISC = 25;

constexpr size_t MiB = 1u << 20;
constexpr size_t WS_CTL = 0, CTL_ZERO_BYTES = 64 * 1024;
constexpr size_t WS_LUT = 1 * MiB;
constexpr size_t WS_POSB = WS_LUT + 128 * 1024;
constexpr size_t WS_W = 2 * MiB;
constexpr size_t W_GU1 = WS_W, W_D1 = W_GU1 + 11 * MiB, W_GU2 = W_D1 + 11 * MiB / 2, W_D2 = W_GU2 + 11 * MiB;
constexpr size_t W_IN = W_D2 + 11 * MiB / 2, W_C1K = W_IN + 13 * MiB, W_C1V = W_C1K + 1 * MiB, W_N = W_C1V + 1 * MiB, W_G = W_N + 1 * MiB, W_O = W_G + 2 * MiB;
constexpr size_t WS_XB = 58 * MiB;
constexpr size_t WS_SSP = 90 * MiB;
constexpr size_t WS_R = 92 * MiB;
constexpr size_t WS_ACT = WS_R;
constexpr size_t WS_QA = WS_R, WS_KVS = WS_QA + 16 * MiB, WS_KVC = WS_KVS + 16 * MiB, WS_GA = WS_KVC + 9 * MiB, WS_ALR = WS_GA + 2 * MiB;
constexpr size_t WS_QB = WS_ALR + 1 * MiB, WS_KB = WS_QB + 16 * MiB, WS_VB = WS_KB + 16 * MiB, WS_RB = WS_VB + 32 * MiB, WS_GM = WS_RB + 32 * MiB;
constexpr size_t WS_HID = WS_GM + 64 * MiB, WS_KVCMP = WS_HID + 2 * MiB, WS_OA = WS_KVCMP + 1 * MiB, WS_ORAW = WS_OA + 16 * MiB, WS_OB = WS_ORAW + 64 * MiB;
constexpr size_t WS_Y = WS_OB + 32 * MiB, WS_END = WS_Y + 32 * MiB;
constexpr size_t WS_YPART = WS_ORAW;
constexpr size_t WS_GST = WS_ORAW;
constexpr size_t WS_DECAY = WS_GA + 1536 * 1024;
constexpr size_t WS_KVCMPB = WS_KVC + 8 * MiB + 64 * 1024;
static_assert(W_O + 2 * MiB <= WS_XB, "weights fit");
static_assert(WS_END <= 460 * MiB, "workspace budget");

constexpr int CW_BAR = 1024;

constexpr int RING_OFF = 0, RING_BYTES = 131072;
constexpr int LDSCTL_OFF = RING_BYTES, MISC_OFF = LDSCTL_OFF + 320;
constexpr int LDS_BYTES = 147456;
constexpr int NWAVES = 8;

#define GAS __attribute__((address_space(1)))
#define LAS __attribute__((address_space(3)))
typedef unsigned short bf16;
typedef unsigned v4u __attribute__((ext_vector_type(4)));
typedef unsigned v2u __attribute__((ext_vector_type(2)));
typedef float f32x4 __attribute__((ext_vector_type(4)));
typedef short bf16x8 __attribute__((ext_vector_type(8)));
#define LDS_WAIT() asm volatile("s_waitcnt lgkmcnt(0)" ::: "memory")
#define VM_WAIT() asm volatile("s_waitcnt vmcnt(0)" ::: "memory")
__device__ __forceinline__ unsigned f2bf(float f) { unsigned u = __builtin_bit_cast(unsigned, f); return (u + 0x7fffu + ((u >> 16) & 1u)) >> 16; }
__device__ __forceinline__ unsigned pk2(float lo, float hi) { return f2bf(lo) | (f2bf(hi) << 16); }
__device__ __forceinline__ float bf2f(unsigned short b) { return __builtin_bit_cast(float, ((unsigned)b) << 16); }
__device__ __forceinline__ float bflo(unsigned w) { return __builtin_bit_cast(float, w << 16); }
__device__ __forceinline__ float bfhi(unsigned w) { return __builtin_bit_cast(float, w & 0xffff0000u); }
__device__ __forceinline__ float wave_sum(float v) {
#pragma unroll
    for (int o = 1; o < 64; o <<= 1) v += __shfl_xor(v, o);
    return v;
}
__device__ __forceinline__ float wave_max(float v) {
#pragma unroll
    for (int o = 1; o < 64; o <<= 1) v = fmaxf(v, __shfl_xor(v, o));
    return v;
}
__device__ __forceinline__ float sigmoidf_(float x) { return 1.0f / (1.0f + __expf(-x)); }
__device__ __forceinline__ float siluf_(float x) { return x / (1.0f + __expf(-x)); }

#define XB_TMO      128
#define XB_XCNT(j)  (256  + 64 * (j))
#define XB_XSUB(j)  (1280 + 64 * (j))
#define XB_XGEN(j)  (2304 + 64 * (j))
#define XB_TOP      3328
#define XB_TOPGEN   3392
#define XCD_BAR_WORDS 3456
#define XB_SPIN_CAP (1u << 18)

__device__ __forceinline__ unsigned xb_ld(unsigned* p)              { return __hip_atomic_load(p, __ATOMIC_RELAXED, __HIP_MEMORY_SCOPE_AGENT); }
__device__ __forceinline__ unsigned xb_add(unsigned* p, unsigned v) { return __hip_atomic_fetch_add(p, v, __ATOMIC_RELAXED, __HIP_MEMORY_SCOPE_AGENT); }
__device__ __forceinline__ unsigned xb_xcc_id() { return (unsigned)__builtin_amdgcn_s_getreg((3 << 11) | 20) & 0xFu; }
#define XB_SPIN(cond, bar) do { unsigned _sp = 0; while (cond) { __builtin_amdgcn_s_sleep(1); \
    if ((++_sp & 255u) == 0u) { if (xb_ld(&(bar)[XB_TMO])) break; if (_sp > XB_SPIN_CAP) { atomicAdd(&(bar)[XB_TMO], 1u); break; } } } } while (0)

struct XcdBarrier {
    unsigned* bar; unsigned x;
    volatile LAS unsigned* st;
};
__device__ __forceinline__ XcdBarrier xcd_barrier_post(unsigned* bar, volatile LAS unsigned* st) {
    XcdBarrier b; b.bar = bar; b.x = xb_xcc_id(); b.st = st;
    if (threadIdx.x == 0) (void)xb_add(&bar[XB_XCNT(b.x)], 1u);
    return b;
}
__device__ __forceinline__ void xcd_barrier_complete(unsigned* bar, unsigned x, unsigned& nloc, unsigned& nx) {
    const unsigned G = gridDim.x * gridDim.y * gridDim.z;
    unsigned sum, cnt, mine, sp = 0u;
    for (;;) {
        sum = 0u; cnt = 0u; mine = 0u;
#pragma unroll
        for (unsigned j = 0; j < 16; ++j) { const unsigned c = xb_ld(&bar[XB_XCNT(j)]); sum += c; cnt += (c > 0u) ? 1u : 0u; mine = (j == x) ? c : mine; }
        if (sum == G) break;
        __builtin_amdgcn_s_sleep(1);
        if ((++sp & 255u) == 0u) { if (xb_ld(&bar[XB_TMO])) break; if (sp > XB_SPIN_CAP) { atomicAdd(&bar[XB_TMO], 1u); break; } }
    }
    nloc = mine > 0u ? mine : 1u; nx = cnt > 0u ? cnt : 1u;
}
__device__ __forceinline__ void xcd_barrier(const XcdBarrier& b) {
    asm volatile("s_waitcnt vmcnt(0)" ::: "memory");
    __syncthreads();
    if (threadIdx.x == 0) {
        unsigned* bar = b.bar;
        __builtin_amdgcn_s_waitcnt(0);
        unsigned nloc = b.st[0], nx = b.st[1];
        if (nloc == 0u) { xcd_barrier_complete(bar, b.x, nloc, nx); b.st[0] = nloc; b.st[1] = nx; }
        const unsigned old = xb_add(&bar[XB_XSUB(b.x)], 1u);
        const unsigned gen = old / nloc;
        if (old + 1u == (gen + 1u) * nloc) {
            __builtin_amdgcn_fence(__ATOMIC_RELEASE, "agent");
            asm volatile("s_waitcnt vmcnt(0)" ::: "memory");
            const unsigned og = xb_add(&bar[XB_TOP], 1u);
            const unsigned tg = og / nx;
            if (og + 1u == (tg + 1u) * nx) xb_add(&bar[XB_TOPGEN], 1u);
            else XB_SPIN(xb_ld(&bar[XB_TOPGEN]) == tg, bar);
            __builtin_amdgcn_fence(__ATOMIC_ACQUIRE, "agent");
            xb_add(&bar[XB_XGEN(b.x)], 1u);
            asm volatile("s_waitcnt vmcnt(0)" ::: "memory");
        } else {
            XB_SPIN(xb_ld(&bar[XB_XGEN(b.x)]) == gen, bar);
            __builtin_amdgcn_fence(__ATOMIC_ACQUIRE, "agent");
            asm volatile("s_waitcnt vmcnt(0)" ::: "memory");
        }
    }
    __syncthreads();
}

struct Args { const float* in[25]; float* out; unsigned char* ws; int ph_lo, ph_hi; };
enum { I_X = 0, I_REL, I_F1N, I_F1G, I_F1U, I_F1D, I_MIXN, I_WIN, I_POSK, I_POSV, I_CKW1, I_CKW2, I_CVW1, I_CVW2, I_AW2, I_AB, I_GON, I_WBN, I_WBG, I_WOUT, I_F2N, I_F2G, I_F2U, I_F2D, I_FIN };

struct Frame {
    LAS unsigned char* lds;
    int tid, lane, wave, G, bid;
    unsigned char* ws;
};
__device__ __forceinline__ const float* inp(const Frame& F, int i) {
    const LAS unsigned* t = (const LAS unsigned*)(F.lds + LDSCTL_OFF);
    const unsigned lo = __builtin_amdgcn_readfirstlane(t[2 * i]), hi = __builtin_amdgcn_readfirstlane(t[2 * i + 1]);
    return (const float*)(((unsigned long long)hi << 32) | lo);
}
__device__ __forceinline__ void relaunder(Frame& F) { int t = threadIdx.x; asm volatile("" : "+v"(t)); F.tid = t; F.lane = t & 63; F.wave = __builtin_amdgcn_readfirstlane(t >> 6); }

using pg8::Unit;
__device__ __forceinline__ float row_rstd(const float* ssp, int row) {
    const f32x4* p = (const f32x4*)(ssp + (size_t)row * 16);
    const f32x4 a = p[0], b = p[1], c = p[2], d = p[3];
    const float s = ((a[0] + a[1]) + (a[2] + a[3])) + ((b[0] + b[1]) + (b[2] + b[3])) + ((c[0] + c[1]) + (c[2] + c[3])) + ((d[0] + d[1]) + (d[2] + d[3]));
    return 1.0f / sqrtf(s * (1.0f / DM) + EPSN);
}
struct EpiGU {
    static constexpr bool PERM = true, AFTER_DRAIN = false;
    bf16* act; const float* ssp;
    __device__ __forceinline__ void operator()(const f32x4 (&acc)[2][2][4][2], const Unit& u, int wr, int wc, int fr, int fq) const {
        const int row0 = u.pm * 256 + wr * 64 + fr, col0 = u.pn * 128 + wc * 32 + 8 * fq;
#pragma unroll
        for (int ai = 0; ai < 2; ++ai)
#pragma unroll
            for (int m = 0; m < 4; ++m) {
                const int row = row0 + ai * 128 + m * 16; const float r = row_rstd(ssp, row);
                float h[8];
#pragma unroll
                for (int n = 0; n < 2; ++n)
#pragma unroll
                    for (int j = 0; j < 4; ++j) { const float g = acc[ai][0][m][n][j] * r, up = acc[ai][1][m][n][j] * r; h[n * 4 + j] = siluf_(g) * up; }
                v4u w; w.x = pk2(h[0], h[1]); w.y = pk2(h[2], h[3]); w.z = pk2(h[4], h[5]); w.w = pk2(h[6], h[7]);
                *(v4u*)(act + (size_t)row * FF + col0) = w;
            }
    }
};
struct EpiResid {
    static constexpr bool PERM = true, AFTER_DRAIN = false;
    float* x; bf16* xb; float* ssp; float alpha;
    __device__ __forceinline__ void operator()(const f32x4 (&acc)[2][2][4][2], const Unit& u, int wr, int wc, int fr, int fq) const {
        const int row0 = u.pm * 256 + wr * 64 + fr, col0 = u.pn * 256 + wc * 32 + 8 * fq;
#pragma unroll
        for (int ai = 0; ai < 2; ++ai)
#pragma unroll
            for (int m = 0; m < 4; ++m) {
                const int row = row0 + ai * 128 + m * 16; float ssq = 0.f;
#pragma unroll
                for (int bj = 0; bj < 2; ++bj) {
                    float* xp = x + (size_t)row * DM + col0 + bj * 128;
                    f32x4 x0 = *(const f32x4*)xp, x1 = *(const f32x4*)(xp + 4);
                    x0 = x0 + acc[ai][bj][m][0] * alpha; x1 = x1 + acc[ai][bj][m][1] * alpha;
                    *(f32x4*)xp = x0; *(f32x4*)(xp + 4) = x1;
                    ssq += (x0[0] * x0[0] + x0[1] * x0[1]) + (x0[2] * x0[2] + x0[3] * x0[3]) + (x1[0] * x1[0] + x1[1] * x1[1]) + (x1[2] * x1[2] + x1[3] * x1[3]);
                    v4u w; w.x = pk2(x0[0], x0[1]); w.y = pk2(x0[2], x0[3]); w.z = pk2(x1[0], x1[1]); w.w = pk2(x1[2], x1[3]);
                    *(v4u*)(xb + (size_t)row * DM + col0 + bj * 128) = w;
                }
                ssq += __shfl_xor(ssq, 16); ssq += __shfl_xor(ssq, 32);
                if (fq == 0) ssp[(size_t)row * 16 + u.pn * 4 + wc] = ssq;
            }
    }
};
struct EpiWin {
    static constexpr bool PERM = true, AFTER_DRAIN = false;
    unsigned char* ws; const float* ssp;
    __device__ __forceinline__ void operator()(const f32x4 (&acc)[2][2][4][2], const Unit& u, int wr, int wc, int fr, int fq) const {
        const int row0 = u.pm * 256 + wr * 64 + fr, pn = u.pn;
        bf16* dst = nullptr; int ld = 0, coff = 0, actk = 0; float scale = 1.f;
        if (pn < T_KVA) { dst = (bf16*)(ws + WS_QA); ld = 512; coff = (pn - T_QA) * 256; scale = 0.125f; }
        else if (pn == T_KVA) { }
        else if (pn < T_QB) { dst = (bf16*)(ws + WS_KVS); ld = 512; coff = (pn - T_KVA - 1) * 256; }
        else if (pn < T_KB) { dst = (bf16*)(ws + WS_QB); ld = 512; coff = (pn - T_QB) * 256; scale = 0.08838834764831845f; }
        else if (pn < T_VB) { dst = (bf16*)(ws + WS_KB); ld = 512; coff = (pn - T_KB) * 256; }
        else if (pn < T_RB) { dst = (bf16*)(ws + WS_VB); ld = 1024; coff = (pn - T_VB) * 256; }
        else if (pn < T_GM) { dst = (bf16*)(ws + WS_RB); ld = 1024; coff = (pn - T_RB) * 256; actk = 1; }
        else if (pn < T_MISC) { dst = (bf16*)(ws + WS_GM); ld = 2048; coff = (pn - T_GM) * 256; actk = 2; }
#pragma unroll
        for (int ai = 0; ai < 2; ++ai)
#pragma unroll
            for (int m = 0; m < 4; ++m) {
                const int row = row0 + ai * 128 + m * 16; const float r = row_rstd(ssp, row);
                if (pn == T_MISC) {
                    float* ga = (float*)(ws + WS_GA); float* alr = (float*)(ws + WS_ALR);
#pragma unroll
                    for (int n = 0; n < 2; ++n)
#pragma unroll
                        for (int j = 0; j < 4; ++j) { const int c = wc * 32 + 8 * fq + 4 * n + j; const float v = acc[ai][0][m][n][j] * r;
                            if (c < 24) ga[(size_t)row * 24 + c] = sigmoidf_(v); else if (c < 40) alr[(size_t)row * 16 + (c - 24)] = v; }
                } else {
#pragma unroll
                    for (int bj = 0; bj < 2; ++bj) {
                        float h[8];
#pragma unroll
                        for (int n = 0; n < 2; ++n)
#pragma unroll
                            for (int j = 0; j < 4; ++j) { float v = acc[ai][bj][m][n][j] * r * scale; if (actk == 1) v = siluf_(v); else if (actk == 2) v = sigmoidf_(v); h[n * 4 + j] = v; }
                        v4u w; w.x = pk2(h[0], h[1]); w.y = pk2(h[2], h[3]); w.z = pk2(h[4], h[5]); w.w = pk2(h[6], h[7]);
                        if (pn == T_KVA) {
                            const int b = row >> 12, t = row & 4095, g = wc >> 1, d = (wc & 1) * 32 + 8 * fq;
                            bf16* kvc = (bf16*)(ws + WS_KVC);
                            *(v4u*)(kvc + ((size_t)((bj * 4 + b) * 2 + g) * SEQ + t) * 64 + d) = w;
                        } else {
                            *(v4u*)(dst + (size_t)row * ld + coff + bj * 128 + wc * 32 + 8 * fq) = w;
                        }
                    }
                }
            }
    }
};
struct EpiCmp1 {
    static constexpr bool PERM = true, AFTER_DRAIN = false;
    bf16* hid; const float* posb;
    __device__ __forceinline__ void operator()(const f32x4 (&acc)[2][2][4][2], const Unit& u, int wr, int wc, int fr, int fq) const {
        const int row0 = u.pm * 256 + wr * 64 + fr, col0 = wc * 32 + 8 * fq;
#pragma unroll
        for (int ai = 0; ai < 2; ++ai)
#pragma unroll
            for (int m = 0; m < 4; ++m) {
                const int row = row0 + ai * 128 + m * 16;
#pragma unroll
                for (int bj = 0; bj < 2; ++bj) {
                    const f32x4 b0 = *(const f32x4*)(posb + col0 + bj * 128), b1 = *(const f32x4*)(posb + col0 + bj * 128 + 4);
                    const f32x4 v0 = acc[ai][bj][m][0] + b0, v1 = acc[ai][bj][m][1] + b1;
                    v4u w; w.x = pk2(siluf_(v0[0]), siluf_(v0[1])); w.y = pk2(siluf_(v0[2]), siluf_(v0[3])); w.z = pk2(siluf_(v1[0]), siluf_(v1[1])); w.w = pk2(siluf_(v1[2]), siluf_(v1[3]));
                    *(v4u*)(hid + (size_t)row * 256 + col0 + bj * 128) = w;
                }
            }
    }
};
template <int STEP> struct EpiMerge {
    static constexpr bool PERM = true, AFTER_DRAIN = false;
    const bf16* gm; float* ypart; bf16* y;
    __device__ __forceinline__ void operator()(const f32x4 (&acc)[2][2][4][2], const Unit& u, int wr, int wc, int fr, int fq) const {
        const int row0 = u.pm * 256 + wr * 64 + fr, col0 = u.pn * 256 + wc * 32 + 8 * fq;
#pragma unroll
        for (int ai = 0; ai < 2; ++ai)
#pragma unroll
            for (int m = 0; m < 4; ++m) {
                const int row = row0 + ai * 128 + m * 16;
#pragma unroll
                for (int bj = 0; bj < 2; ++bj) {
                    const int col = col0 + bj * 128;
                    const v4u gw = *(const v4u*)(gm + (size_t)row * 2048 + (STEP == 1 ? 0 : 1024) + col);
                    f32x4 g0 = {bflo(gw.x), bfhi(gw.x), bflo(gw.y), bfhi(gw.y)}, g1 = {bflo(gw.z), bfhi(gw.z), bflo(gw.w), bfhi(gw.w)};
                    float* yp = ypart + (size_t)row * DM + col;
                    if (STEP == 1) { *(f32x4*)yp = g0 * acc[ai][bj][m][0]; *(f32x4*)(yp + 4) = g1 * acc[ai][bj][m][1]; }
                    else { const f32x4 v0 = *(const f32x4*)yp + g0 * acc[ai][bj][m][0], v1 = *(const f32x4*)(yp + 4) + g1 * acc[ai][bj][m][1];
                        v4u w; w.x = pk2(v0[0], v0[1]); w.y = pk2(v0[2], v0[3]); w.z = pk2(v1[0], v1[1]); w.w = pk2(v1[2], v1[3]);
                        *(v4u*)(y + (size_t)row * DM + col) = w; }
                }
            }
    }
};

struct SrcCol { const float* p; int col; };
template <class Map>
__device__ __forceinline__ void tr_item(int ldw, const float* gain, bf16* WT, int K, int nblk, int item, LAS float* scr, int lane, const Map& cm) {
    const int kb = item / nblk, nb = item % nblk, k0 = 64 * kb, n0 = 32 * nb;
    const SrcCol sc = cm(n0 + (lane & 31));
#pragma unroll 8
    for (int i = 0; i < 32; ++i) { const int kk = 2 * i + (lane >> 5); float v = 0.f;
        if (sc.col >= 0) { v = sc.p[(size_t)(k0 + kk) * ldw + sc.col]; if (gain) v *= gain[k0 + kk]; }
        scr[kk * 33 + (lane & 31)] = v; }
    LDS_WAIT();
    const int c = lane & 7;
#pragma unroll
    for (int j = 0; j < 4; ++j) { const int n = (lane >> 3) + 8 * j; const LAS float* s = scr + (8 * c) * 33 + n;
        v4u o; o.x = pk2(s[0 * 33], s[1 * 33]); o.y = pk2(s[2 * 33], s[3 * 33]); o.z = pk2(s[4 * 33], s[5 * 33]); o.w = pk2(s[6 * 33], s[7 * 33]);
        *(v4u*)(WT + (size_t)(n0 + n) * K + k0 + 8 * c) = o; }
    LDS_WAIT();
}
struct MapGU { const float* p; __device__ __forceinline__ SrcCol operator()(int n) const { return SrcCol{p, (n >> 8) * 128 + (n & 127)}; } };
struct MapId { const float* p; __device__ __forceinline__ SrcCol operator()(int n) const { return SrcCol{p, n}; } };
struct MapWin { const float* p; __device__ __forceinline__ SrcCol operator()(int n) const {
    const int t = n >> 8, r = n & 255; int c;
    if (t < T_KVA) c = SRC_QA + n; else if (t < T_QB) c = SRC_KVA + (n - T_KVA * 256); else if (t < T_KB) c = SRC_QB + (n - T_QB * 256); else if (t < T_VB) c = SRC_KB + (n - T_KB * 256);
    else if (t < T_RB) c = SRC_VB + (n - T_VB * 256); else if (t < T_GM) c = SRC_RB + (n - T_RB * 256); else if (t < T_MISC) c = SRC_GM + (n - T_GM * 256);
    else c = r < 24 ? SRC_GA + r : (r < 40 ? SRC_ALR + (r - 24) : -1);
    return SrcCol{p, c}; } };

__device__ __forceinline__ void phase_conv(Frame& F, const Args& a, int l) {
    relaunder(F);
    LAS float* scr = (LAS float*)(F.lds + RING_OFF + F.wave * 16384);
    const int gw = F.bid * NWAVES + F.wave, NGW = F.G * NWAVES;
    unsigned char* ws = F.ws;
    constexpr int I_GU = (DM / 64) * (NGU / 32), I_D = (FF / 64) * (DM / 32), I_IN = (DM / 64) * (NIN / 32), I_C1 = (2048 / 64) * (256 / 32), I_N = (512 / 64) * (DM / 32), I_SQ = (DM / 64) * (DM / 32);
    constexpr int NITEMS = 2 * I_GU + 2 * I_D + I_IN + 2 * I_C1 + I_N + 2 * I_SQ;
    const size_t oG = (size_t)l * DM * FF, oD = (size_t)l * FF * DM;
    for (int it = gw; it < NITEMS; it += NGW) {
        int r = it;
        if (r < I_GU) { const bool up = (((r % (NGU / 32)) * 32) & 255) >= 128;
            if (up) tr_item(FF, inp(F, I_F1N) + l * DM, (bf16*)(ws + W_GU1), DM, NGU / 32, r, scr, F.lane, MapGU{inp(F, I_F1U) + oG});
            else tr_item(FF, inp(F, I_F1N) + l * DM, (bf16*)(ws + W_GU1), DM, NGU / 32, r, scr, F.lane, MapGU{inp(F, I_F1G) + oG});
            continue; } r -= I_GU;
        if (r < I_GU) { const bool up = (((r % (NGU / 32)) * 32) & 255) >= 128;
            if (up) tr_item(FF, inp(F, I_F2N) + l * DM, (bf16*)(ws + W_GU2), DM, NGU / 32, r, scr, F.lane, MapGU{inp(F, I_F2U) + oG});
            else tr_item(FF, inp(F, I_F2N) + l * DM, (bf16*)(ws + W_GU2), DM, NGU / 32, r, scr, F.lane, MapGU{inp(F, I_F2G) + oG});
            continue; } r -= I_GU;
        if (r < I_D) { tr_item(DM, nullptr, (bf16*)(ws + W_D1), FF, DM / 32, r, scr, F.lane, MapId{inp(F, I_F1D) + oD}); continue; } r -= I_D;
        if (r < I_D) { tr_item(DM, nullptr, (bf16*)(ws + W_D2), FF, DM / 32, r, scr, F.lane, MapId{inp(F, I_F2D) + oD}); continue; } r -= I_D;
        if (r < I_IN) { tr_item(DIN, inp(F, I_MIXN) + l * DM, (bf16*)(ws + W_IN), DM, NIN / 32, r, scr, F.lane, MapWin{inp(F, I_WIN) + (size_t)l * DM * DIN}); continue; } r -= I_IN;
        if (r < I_C1) { tr_item(256, nullptr, (bf16*)(ws + W_C1K), 2048, 256 / 32, r, scr, F.lane, MapId{inp(F, I_CKW1) + (size_t)l * 2048 * 256}); continue; } r -= I_C1;
        if (r < I_C1) { tr_item(256, nullptr, (bf16*)(ws + W_C1V), 2048, 256 / 32, r, scr, F.lane, MapId{inp(F, I_CVW1) + (size_t)l * 2048 * 256}); continue; } r -= I_C1;
        if (r < I_N) { tr_item(DM, nullptr, (bf16*)(ws + W_N), 512, DM / 32, r, scr, F.lane, MapId{inp(F, I_WBN) + (size_t)l * 512 * DM}); continue; } r -= I_N;
        if (r < I_SQ) { tr_item(DM, inp(F, I_GON) + l * DM, (bf16*)(ws + W_G), DM, DM / 32, r, scr, F.lane, MapId{inp(F, I_WBG) + (size_t)l * DM * DM}); continue; } r -= I_SQ;
        tr_item(DM, nullptr, (bf16*)(ws + W_O), DM, DM / 32, r, scr, F.lane, MapId{inp(F, I_WOUT) + (size_t)l * DM * DM});
    }
    __syncthreads();
    if (F.bid < 32) {
        const int kv = F.bid >> 4, nb = (F.bid & 15) * 16, c = F.tid & 15, ks = F.tid >> 4;
        const float* pos = inp(F, kv ? I_POSV : I_POSK) + (size_t)l * 2048; const float* w1 = inp(F, kv ? I_CVW1 : I_CKW1) + (size_t)l * 2048 * 256;
        float s = 0.f;
        for (int k = ks * 64; k < ks * 64 + 64; ++k) s += pos[k] * w1[(size_t)k * 256 + nb + c];
        LAS float* red = (LAS float*)(F.lds + RING_OFF);
        red[F.tid] = s; __syncthreads();
        if (F.tid < 16) { float t = 0.f; for (int i = 0; i < 32; ++i) t += red[i * 16 + F.tid]; ((float*)(ws + WS_POSB))[kv * 256 + nb + F.tid] = t; }
        __syncthreads();
    }
}
__device__ __forceinline__ void phase_lut(Frame& F, const Args& a) {
    relaunder(F);
    float* lut = (float*)(F.ws + WS_LUT); const float* tab = inp(F, I_REL);
    for (int i = F.bid * 512 + F.tid; i < 8 * 4096; i += F.G * 512) {
        const int h = i >> 12, n = i & 4095; int bk;
        if (n < 16) bk = n; else { const float nf = (float)n; int lb = 16 + (int)(logf(nf / 16.0f) / 4.1588830833596715f * 16.0f); bk = lb < 31 ? lb : 31; }
        lut[i] = tab[bk * 8 + h];
    }
}
__device__ __forceinline__ void phase_x0(Frame& F, const Args& a) {
    relaunder(F);
    const int gw = F.bid * NWAVES + F.wave, NGW = F.G * NWAVES;
    bf16* xb = (bf16*)(F.ws + WS_XB); float* ssp = (float*)(F.ws + WS_SSP);
    for (int m = gw; m < MTOK; m += NGW) {
        const f32x4* xr = (const f32x4*)(inp(F, I_X) + (size_t)m * DM) + F.lane; f32x4* orow = (f32x4*)(a.out + (size_t)m * DM) + F.lane;
        v2u* o8 = (v2u*)(xb + (size_t)m * DM) + F.lane; float s = 0.f;
#pragma unroll
        for (int j = 0; j < 4; ++j) { const f32x4 v = xr[64 * j]; orow[64 * j] = v; s += (v[0] * v[0] + v[1] * v[1]) + (v[2] * v[2] + v[3] * v[3]); v2u w; w.x = pk2(v[0], v[1]); w.y = pk2(v[2], v[3]); o8[64 * j] = w; }
        s = wave_sum(s);
        if (F.lane < 16) ssp[(size_t)m * 16 + F.lane] = F.lane == 0 ? s : 0.f;
    }
}
__device__ __forceinline__ void phase_final(Frame& F, const Args& a) {
    relaunder(F);
    const int gw = F.bid * NWAVES + F.wave, NGW = F.G * NWAVES; const f32x4* gn = (const f32x4*)inp(F, I_FIN) + F.lane;
    for (int m = gw; m < MTOK; m += NGW) {
        f32x4* xr = (f32x4*)(a.out + (size_t)m * DM) + F.lane; f32x4 v[4]; float s = 0.f;
#pragma unroll
        for (int j = 0; j < 4; ++j) { v[j] = xr[64 * j]; s += (v[j][0] * v[j][0] + v[j][1] * v[j][1]) + (v[j][2] * v[j][2] + v[j][3] * v[j][3]); }
        const float r = 1.0f / sqrtf(wave_sum(s) * (1.0f / DM) + EPSN);
#pragma unroll
        for (int j = 0; j < 4; ++j) xr[64 * j] = v[j] * r * gn[64 * j];
    }
}
__device__ __forceinline__ void phase_cmp2(Frame& F, const Args& a, int l) {
    relaunder(F);
    const int gw = F.bid * NWAVES + F.wave, NGW = F.G * NWAVES;
    const bf16* hid = (const bf16*)(F.ws + WS_HID); float* out = (float*)(F.ws + WS_KVCMP);
    for (int row = gw; row < 4096; row += NGW) {
        const int kv = row >> 11; const float* w2 = inp(F, kv ? I_CVW2 : I_CKW2) + (size_t)l * 256 * 64;
        const bf16* hr = hid + (size_t)row * 256; float s = 0.f;
        for (int k = 0; k < 256; k += 8) { const v4u hw = *(const v4u*)(hr + k);
            s += bflo(hw.x) * w2[(k + 0) * 64 + F.lane] + bfhi(hw.x) * w2[(k + 1) * 64 + F.lane] + bflo(hw.y) * w2[(k + 2) * 64 + F.lane] + bfhi(hw.y) * w2[(k + 3) * 64 + F.lane]
               + bflo(hw.z) * w2[(k + 4) * 64 + F.lane] + bfhi(hw.z) * w2[(k + 5) * 64 + F.lane] + bflo(hw.w) * w2[(k + 6) * 64 + F.lane] + bfhi(hw.w) * w2[(k + 7) * 64 + F.lane]; }
        out[(size_t)row * 64 + F.lane] = s; ((bf16*)(F.ws + WS_KVCMPB))[(size_t)row * 64 + F.lane] = (bf16)f2bf(s);
    }
}

__device__ __forceinline__ void dot4_bf16(const bf16* kp, const LAS float* qs, float (&s)[4]) {
    s[0] = s[1] = s[2] = s[3] = 0.f;
#pragma unroll 2
    for (int c = 0; c < 8; ++c) { const v4u kw = *(const v4u*)(kp + c * 8);
        const float kf[8] = {bflo(kw.x), bfhi(kw.x), bflo(kw.y), bfhi(kw.y), bflo(kw.z), bfhi(kw.z), bflo(kw.w), bfhi(kw.w)};
#pragma unroll
        for (int h = 0; h < 4; ++h) { const f32x4 q0 = *(const LAS f32x4*)(qs + h * 64 + c * 8), q1 = *(const LAS f32x4*)(qs + h * 64 + c * 8 + 4);
            s[h] += (kf[0] * q0[0] + kf[1] * q0[1]) + (kf[2] * q0[2] + kf[3] * q0[3]) + (kf[4] * q1[0] + kf[5] * q1[1]) + (kf[6] * q1[2] + kf[7] * q1[3]); } }
}
__device__ __forceinline__ void dot4_f32(const float* kp, const LAS float* qs, float (&s)[4]) {
    s[0] = s[1] = s[2] = s[3] = 0.f;
#pragma unroll 4
    for (int c = 0; c < 16; ++c) { const f32x4 kf = *(const f32x4*)(kp + c * 4);
#pragma unroll
        for (int h = 0; h < 4; ++h) { const f32x4 q0 = *(const LAS f32x4*)(qs + h * 64 + c * 4); s[h] += (kf[0] * q0[0] + kf[1] * q0[1]) + (kf[2] * q0[2] + kf[3] * q0[3]); } }
}
__device__ __forceinline__ void online_block(const float (&s)[4], bool kvalid, const bf16* vp, int vld, LAS float* ps, int lane, float (&m)[4], float (&lsum)[4], float (&o)[4]) {
    float p[4];
#pragma unroll
    for (int h = 0; h < 4; ++h) {
        const float sm = wave_max(kvalid ? s[h] : -INFINITY), mn = fmaxf(m[h], sm);
        const float sc = (m[h] == -INFINITY) ? 0.f : __expf(m[h] - mn);
        p[h] = (kvalid && mn > -INFINITY) ? __expf(s[h] - mn) : 0.f;
        lsum[h] = lsum[h] * sc + wave_sum(p[h]); o[h] *= sc; m[h] = mn;
    }
    *(LAS f32x4*)(ps + lane * 4) = (f32x4){p[0], p[1], p[2], p[3]};
    LDS_WAIT();
#pragma unroll 8
    for (int k = 0; k < 64; ++k) { const f32x4 pv = *(const LAS f32x4*)(ps + k * 4); const float v = bf2f(vp[(size_t)k * vld + lane]);
        o[0] += pv[0] * v; o[1] += pv[1] * v; o[2] += pv[2] * v; o[3] += pv[3] * v; }
    LDS_WAIT();
}
__device__ __forceinline__ void phase_nsa_naive(Frame& F) {
    relaunder(F);
    LAS float* wl = (LAS float*)(F.lds + RING_OFF + F.wave * 16384);
    LAS float* qs = wl; LAS float* ps = wl + 256; LAS float* psum = wl + 512; LAS float* scl = wl + 1024;
    const bf16* qa = (const bf16*)(F.ws + WS_QA); const bf16* kvs = (const bf16*)(F.ws + WS_KVS); const float* ga = (const float*)(F.ws + WS_GA);
    const float* kvcmp = (const float*)(F.ws + WS_KVCMP); const float* lut = (const float*)(F.ws + WS_LUT); bf16* oa = (bf16*)(F.ws + WS_OA);
    const int lane = F.lane;
    for (int wt = F.bid; wt < 4096; wt += F.G) {
        const int bg = wt & 7, tb = wt >> 3, b = bg >> 1, g = bg & 1, t = tb * 8 + F.wave, row = b * SEQ + t, jcur = t >> 6;
        const float* lutg = lut + (size_t)(g * 4) * 4096;
#pragma unroll
        for (int h = 0; h < 4; ++h) qs[h * 64 + lane] = bf2f(qa[(size_t)row * 512 + (g * 4 + h) * 64 + lane]);
        LDS_WAIT();
        float gate[4][3];
#pragma unroll
        for (int h = 0; h < 4; ++h)
#pragma unroll
            for (int br = 0; br < 3; ++br) gate[h][br] = ga[(size_t)row * 24 + (g * 4 + h) * 3 + br];
        float oacc[4] = {0.f, 0.f, 0.f, 0.f};
        const int ncv = t >= 31 ? ((t - 31) >> 4) + 1 : 0;
        float imp = 0.f;
        if (ncv > 0) {
            const float* kc = kvcmp + (size_t)(0 * 8 + bg) * 256 * 64; const float* vc = kvcmp + (size_t)(1 * 8 + bg) * 256 * 64;
            float mx[4] = {-INFINITY, -INFINITY, -INFINITY, -INFINITY};
            const int nblk = (ncv + 63) >> 6;
#pragma unroll 1
            for (int blk = 0; blk < nblk; ++blk) {
                const int c = blk * 64 + lane; const bool valid = c < ncv;
                float s[4]; dot4_f32(kc + (size_t)(c < 255 ? c : 255) * 64, qs, s);
                const int dist = valid ? t - (16 * c + 31) : 0;
#pragma unroll
                for (int h = 0; h < 4; ++h) { const float v = valid ? s[h] + lutg[h * 4096 + dist] : -INFINITY; scl[h * 256 + c] = v; mx[h] = fmaxf(mx[h], v); }
            }
            float ls[4] = {0.f, 0.f, 0.f, 0.f};
#pragma unroll
            for (int h = 0; h < 4; ++h) mx[h] = wave_max(mx[h]);
            LDS_WAIT();
#pragma unroll 1
            for (int blk = 0; blk < nblk; ++blk) {
                const int c = blk * 64 + lane;
#pragma unroll
                for (int h = 0; h < 4; ++h) { const float v = scl[h * 256 + c]; const float p = v > -INFINITY ? __expf(v - mx[h]) : 0.f; scl[h * 256 + c] = p; ls[h] += p; }
            }
#pragma unroll
            for (int h = 0; h < 4; ++h) ls[h] = 1.0f / wave_sum(ls[h]);
            LDS_WAIT();
            float oc[4] = {0.f, 0.f, 0.f, 0.f};
#pragma unroll 1
            for (int blk = 0; blk < 4; ++blk) {
                const int c = blk * 64 + lane; float pt = 0.f;
                if (blk < nblk) {
#pragma unroll
                    for (int h = 0; h < 4; ++h) { const float p = scl[h * 256 + c] * ls[h]; scl[h * 256 + c] = p; pt += p; }
                }
                psum[c] = pt;
            }
            LDS_WAIT();
#pragma unroll 2
            for (int k = 0; k < ncv; ++k) { const float v = vc[(size_t)k * 64 + lane];
                oc[0] += scl[k] * v; oc[1] += scl[256 + k] * v; oc[2] += scl[512 + k] * v; oc[3] += scl[768 + k] * v; }
#pragma unroll
            for (int i = -1; i <= 3; ++i) { const int c = 4 * lane + i; if (c >= 0 && c < 255) imp += psum[c]; }
#pragma unroll
            for (int h = 0; h < 4; ++h) oacc[h] += gate[h][0] * oc[h];
            LDS_WAIT();
        }
        const bool forced = (lane == 0) || (lane == jcur) || (lane == jcur - 1);
        const float score = forced ? 1e6f : (lane <= jcur ? imp : -1e6f);
        int rank = 0;
#pragma unroll 4
        for (int s2 = 0; s2 < 64; ++s2) { const float v2 = __shfl(score, s2); rank += (v2 > score || (v2 == score && s2 < lane)) ? 1 : 0; }
        unsigned long long selmask = __ballot(rank < 16);
        selmask &= (jcur == 63) ? ~0ull : ((1ull << (jcur + 1)) - 1ull);
        {
            float m[4] = {-INFINITY, -INFINITY, -INFINITY, -INFINITY}, lsum[4] = {0.f, 0.f, 0.f, 0.f}, o[4] = {0.f, 0.f, 0.f, 0.f};
#pragma unroll 1
            while (selmask) {
                const int j = __builtin_ctzll(selmask); selmask &= selmask - 1ull;
                const int pos = j * 64 + lane; const bool kvalid = pos <= t;
                float s[4]; dot4_bf16(kvs + (size_t)(b * SEQ + pos) * 512 + 0 * 128 + g * 64, qs, s);
                if (kvalid) {
#pragma unroll
                    for (int h = 0; h < 4; ++h) s[h] += lutg[h * 4096 + (t - pos)];
                }
                online_block(s, kvalid, kvs + (size_t)(b * SEQ + j * 64) * 512 + 1 * 128 + g * 64, 512, ps, lane, m, lsum, o);
            }
#pragma unroll
            for (int h = 0; h < 4; ++h) oacc[h] += gate[h][1] * o[h] / lsum[h];
        }
        {
            float m[4] = {-INFINITY, -INFINITY, -INFINITY, -INFINITY}, lsum[4] = {0.f, 0.f, 0.f, 0.f}, o[4] = {0.f, 0.f, 0.f, 0.f};
            const int lo = t - 511 > 0 ? t - 511 : 0;
#pragma unroll 1
            for (int j = lo >> 6; j <= jcur; ++j) {
                const int pos = j * 64 + lane; const bool kvalid = pos <= t && pos >= lo;
                float s[4]; dot4_bf16(kvs + (size_t)(b * SEQ + pos) * 512 + 2 * 128 + g * 64, qs, s);
                if (kvalid) {
#pragma unroll
                    for (int h = 0; h < 4; ++h) s[h] += lutg[h * 4096 + (t - pos)];
                }
                online_block(s, kvalid, kvs + (size_t)(b * SEQ + j * 64) * 512 + 3 * 128 + g * 64, 512, ps, lane, m, lsum, o);
            }
#pragma unroll
            for (int h = 0; h < 4; ++h) oacc[h] += gate[h][2] * o[h] / lsum[h];
        }
#pragma unroll
        for (int h = 0; h < 4; ++h) oa[(size_t)row * 512 + (g * 4 + h) * 64 + lane] = (bf16)f2bf(oacc[h]);
        LDS_WAIT();
    }
}


typedef float f32x16 __attribute__((ext_vector_type(16)));
typedef short v4i16_t __attribute__((ext_vector_type(4)));
constexpr int NSA_TS = 144;
constexpr int NL_K = 0, NL_V = 9216, NL_LUT = 18432, NL_IMP = NL_LUT + 32768, NL_SEL = NL_IMP + 4 * 64 * 65 * 4, NL_END = NL_SEL + 512;
static_assert(NL_END <= RING_BYTES, "nsa lds");
#define KLOC(i) (((i) & 3) + 8 * ((i) >> 2) + 4 * hf)

__device__ __forceinline__ void nsa_qk(const LAS unsigned char* Kt, const bf16x8 (&qf)[4], int r32, int hf, f32x16& p0, f32x16& p1) {
#pragma unroll
    for (int i = 0; i < 16; ++i) { p0[i] = 0.f; p1[i] = 0.f; }
#pragma unroll
    for (int ks = 0; ks < 4; ++ks) {
        const bf16x8 a0 = *(const LAS bf16x8*)(Kt + r32 * NSA_TS + ks * 32 + hf * 16);
        const bf16x8 a1 = *(const LAS bf16x8*)(Kt + (32 + r32) * NSA_TS + ks * 32 + hf * 16);
        p0 = __builtin_amdgcn_mfma_f32_32x32x16_bf16(a0, qf[ks], p0, 0, 0, 0);
        p1 = __builtin_amdgcn_mfma_f32_32x32x16_bf16(a1, qf[ks], p1, 0, 0, 0);
    }
}
__device__ __forceinline__ bf16x8 nsa_pack(const f32x16& p, const int s) {
    v4u w; w.x = pk2(p[8 * s + 0], p[8 * s + 1]); w.y = pk2(p[8 * s + 2], p[8 * s + 3]); w.z = pk2(p[8 * s + 4], p[8 * s + 5]); w.w = pk2(p[8 * s + 6], p[8 * s + 7]);
    return __builtin_bit_cast(bf16x8, w);
}
__device__ __forceinline__ void nsa_pv(const LAS unsigned char* Vt, const f32x16& p0, const f32x16& p1, int lane, int hf, f32x16 (&o)[2]) {
    bf16x8 pb[4]; pb[0] = nsa_pack(p0, 0); pb[1] = nsa_pack(p0, 1); pb[2] = nsa_pack(p1, 0); pb[3] = nsa_pack(p1, 1);
    const LAS unsigned char* base = Vt + (4 * hf + ((lane & 15) >> 2)) * NSA_TS + (16 * ((lane >> 4) & 1) + 4 * (lane & 3)) * 2;
#pragma unroll
    for (int dt = 0; dt < 2; ++dt)
#pragma unroll
        for (int ks = 0; ks < 4; ++ks) {
            const LAS unsigned char* ap = base + (16 * ks) * NSA_TS + dt * 64;
            const v4i16_t lo = __builtin_amdgcn_ds_read_tr16_b64_v4i16((LAS v4i16_t*)ap);
            const v4i16_t hi = __builtin_amdgcn_ds_read_tr16_b64_v4i16((LAS v4i16_t*)(ap + 8 * NSA_TS));
            const bf16x8 a = {lo[0], lo[1], lo[2], lo[3], hi[0], hi[1], hi[2], hi[3]};
            o[dt] = __builtin_amdgcn_mfma_f32_32x32x16_bf16(a, pb[ks], o[dt], 0, 0, 0);
        }
}
__device__ __forceinline__ void nsa_online(f32x16& p0, f32x16& p1, float& m, float& l, f32x16 (&o)[2]) {
    float bm = -INFINITY;
#pragma unroll
    for (int i = 0; i < 16; ++i) bm = fmaxf(bm, fmaxf(p0[i], p1[i]));
    bm = fmaxf(bm, __shfl_xor(bm, 32));
    const float mn = fmaxf(m, bm), mref = (mn == -INFINITY) ? 0.f : mn, sc = __expf(m - mref);
    float ps = 0.f;
#pragma unroll
    for (int i = 0; i < 16; ++i) { p0[i] = __expf(p0[i] - mref); p1[i] = __expf(p1[i] - mref); ps += p0[i] + p1[i]; }
    l = l * sc + ps; m = mn;
#pragma unroll
    for (int i = 0; i < 16; ++i) { o[0][i] *= sc; o[1][i] *= sc; }
}
__device__ __forceinline__ v4u nsa_ld16(const bf16* p) { return *(const v4u*)p; }

__device__ __forceinline__ void phase_nsa(Frame& F) {
    relaunder(F);
    LAS unsigned char* L = F.lds + RING_OFF;
    LAS unsigned char* Kt = L + NL_K; LAS unsigned char* Vt = L + NL_V;
    LAS float* lutL = (LAS float*)(L + NL_LUT); LAS float* impL = (LAS float*)(L + NL_IMP); LAS unsigned long long* selL = (LAS unsigned long long*)(L + NL_SEL);
    const bf16* qa = (const bf16*)(F.ws + WS_QA); const bf16* kvs = (const bf16*)(F.ws + WS_KVS); const float* ga = (const float*)(F.ws + WS_GA);
    const bf16* kvcb = (const bf16*)(F.ws + WS_KVCMPB); const float* lut = (const float*)(F.ws + WS_LUT); bf16* oa = (bf16*)(F.ws + WS_OA);
    const int tid = F.tid, lane = F.lane, wave = F.wave, r32 = lane & 31, hf = lane >> 5, hh = wave >> 1, qh = wave & 1;
    const int srow = tid >> 3, schunk = tid & 7;
    const int soff = srow * NSA_TS + schunk * 16;
    for (int i = tid; i < 8 * 1024; i += 512) lutL[i] = lut[(i >> 10) * 4096 + (i & 1023)];
    __syncthreads();
    for (int ui = 0; ui < 2; ++ui) {
        const int w = F.bid, bg = w & 7, a_ = (w >> 3) & 31, cq = ui == 0 ? 63 - a_ : a_;
        if (w >= 256) break;
        const int b = bg >> 1, g = bg & 1, head = g * 4 + hh, tq = cq * 64 + qh * 32 + r32;
        const size_t qrow = (size_t)b * SEQ + tq;
        const LAS float* lutH = lutL + head * 1024;
        bf16x8 qf[4];
#pragma unroll
        for (int ks = 0; ks < 4; ++ks) qf[ks] = *(const bf16x8*)(qa + qrow * 512 + head * 64 + ks * 16 + hf * 8);
        const float g_cmp = ga[qrow * 24 + head * 3 + 0], g_slc = ga[qrow * 24 + head * 3 + 1], g_win = ga[qrow * 24 + head * 3 + 2];
        f32x16 oc[2];
#pragma unroll
        for (int i = 0; i < 16; ++i) { oc[0][i] = 0.f; oc[1][i] = 0.f; }
        for (int i = tid; i < 4 * 64 * 65; i += 512) impL[i] = 0.f;
        const bf16* kc = kvcb + (size_t)(0 * 8 + bg) * 256 * 64; const bf16* vc = kvcb + (size_t)(1 * 8 + bg) * 256 * 64;
        const int ncb = (4 * cq + 2) / 64 + 1;
        float m = -INFINITY, l = 0.f;
        f32x16 p0, p1, o[2];
        for (int cb = 0; cb < ncb; ++cb) {
            __syncthreads();
            *(LAS v4u*)(Kt + soff) = nsa_ld16(kc + (size_t)(cb * 64 + srow) * 64 + schunk * 8);
            __syncthreads();
            nsa_qk(Kt, qf, r32, hf, p0, p1);
#pragma unroll
            for (int i = 0; i < 16; ++i) {
                const int d0 = tq - 31 - 16 * (cb * 64 + KLOC(i)), d1 = d0 - 512;
                p0[i] = d0 >= 0 ? p0[i] + lutH[d0 > 1023 ? 1023 : (d0 < 0 ? 0 : d0)] : -INFINITY;
                p1[i] = d1 >= 0 ? p1[i] + lutH[d1 > 1023 ? 1023 : (d1 < 0 ? 0 : d1)] : -INFINITY;
            }
            float bm = -INFINITY;
#pragma unroll
            for (int i = 0; i < 16; ++i) bm = fmaxf(bm, fmaxf(p0[i], p1[i]));
            bm = fmaxf(bm, __shfl_xor(bm, 32));
            const float mn = fmaxf(m, bm), mref = (mn == -INFINITY) ? 0.f : mn;
            float ps = 0.f;
#pragma unroll
            for (int i = 0; i < 16; ++i) ps += __expf(p0[i] - mref) + __expf(p1[i] - mref);
            l = l * __expf(m - mref) + ps; m = mn;
        }
        {
            const float lt = l + __shfl_xor(l, 32), invl = lt > 0.f ? 1.0f / lt : 0.f, mref = (m == -INFINITY) ? 0.f : m;
#pragma unroll
            for (int i = 0; i < 16; ++i) { o[0][i] = 0.f; o[1][i] = 0.f; }
            LAS float* impH = impL + hh * (64 * 65) + (qh * 32 + r32) * 65;
            for (int cb = 0; cb < ncb; ++cb) {
                __syncthreads();
                *(LAS v4u*)(Kt + soff) = nsa_ld16(kc + (size_t)(cb * 64 + srow) * 64 + schunk * 8);
                *(LAS v4u*)(Vt + soff) = nsa_ld16(vc + (size_t)(cb * 64 + srow) * 64 + schunk * 8);
                __syncthreads();
                nsa_qk(Kt, qf, r32, hf, p0, p1);
#pragma unroll
                for (int i = 0; i < 16; ++i) {
                    const int d0 = tq - 31 - 16 * (cb * 64 + KLOC(i)), d1 = d0 - 512;
                    p0[i] = d0 >= 0 ? __expf(p0[i] + lutH[d0 > 1023 ? 1023 : (d0 < 0 ? 0 : d0)] - mref) * invl : 0.f;
                    p1[i] = d1 >= 0 ? __expf(p1[i] + lutH[d1 > 1023 ? 1023 : (d1 < 0 ? 0 : d1)] - mref) * invl : 0.f;
                }
#pragma unroll
                for (int g4 = 0; g4 < 4; ++g4) {
                    const int u0 = cb * 16 + 2 * g4 + hf, u1 = u0 + 8;
                    impH[u0] += (p0[4 * g4] + p0[4 * g4 + 1]) + (p0[4 * g4 + 2] + p0[4 * g4 + 3]);
                    impH[u1] += (p1[4 * g4] + p1[4 * g4 + 1]) + (p1[4 * g4 + 2] + p1[4 * g4 + 3]);
                }
                LDS_WAIT();
#pragma unroll
                for (int g4 = 0; g4 < 4; ++g4) {
                    const int u0 = cb * 16 + 2 * g4 + hf + 1, u1 = u0 + 8;
                    if (u0 < 64) impH[u0] += p0[4 * g4 + 3];
                    if (u1 < 64) impH[u1] += p1[4 * g4 + 3];
                }
                nsa_pv(Vt, p0, p1, lane, hf, o);
            }
#pragma unroll
            for (int i = 0; i < 16; ++i) { oc[0][i] += g_cmp * o[0][i]; oc[1][i] += g_cmp * o[1][i]; }
        }
        __syncthreads();
        {
            const int q = tid >> 3, sub = tid & 7; float v[8];
#pragma unroll
            for (int k = 0; k < 8; ++k) { const int s = sub * 8 + k; const int idx = q * 65 + s;
                const float im = ((impL[idx] + impL[64 * 65 + idx]) + impL[2 * 64 * 65 + idx]) + impL[3 * 64 * 65 + idx];
                v[k] = (s == 0 || s == cq || s == cq - 1) ? 1e6f : (s <= cq ? im : -1e6f); }
            __syncthreads();
#pragma unroll
            for (int k = 0; k < 8; ++k) impL[q * 65 + sub * 8 + k] = v[k];
            __syncthreads();
            int cnt[8];
#pragma unroll
            for (int k = 0; k < 8; ++k) cnt[k] = 0;
#pragma unroll 4
            for (int s2 = 0; s2 < 64; ++s2) { const float x = impL[q * 65 + s2];
#pragma unroll
                for (int k = 0; k < 8; ++k) cnt[k] += (x > v[k] || (x == v[k] && s2 < sub * 8 + k)) ? 1 : 0; }
            unsigned byte = 0;
#pragma unroll
            for (int k = 0; k < 8; ++k) byte |= (cnt[k] < 16 ? 1u : 0u) << k;
            ((LAS unsigned char*)selL)[q * 8 + sub] = (unsigned char)byte;
        }
        __syncthreads();
        const unsigned long long vmask = (cq == 63) ? ~0ull : ((1ull << (cq + 1)) - 1ull);
        const unsigned long long mysel = selL[qh * 32 + r32] & vmask;
        unsigned long long U = selL[lane] & vmask;
#pragma unroll
        for (int off = 1; off < 64; off <<= 1) { const unsigned lo_ = __shfl_xor((unsigned)U, off), hi_ = __shfl_xor((unsigned)(U >> 32), off); U |= ((unsigned long long)hi_ << 32) | lo_; }
        U = ((unsigned long long)(unsigned)__builtin_amdgcn_readfirstlane((unsigned)(U >> 32)) << 32) | (unsigned)__builtin_amdgcn_readfirstlane((unsigned)U);
        {
            m = -INFINITY; l = 0.f;
#pragma unroll
            for (int i = 0; i < 16; ++i) { o[0][i] = 0.f; o[1][i] = 0.f; }
            unsigned long long rem = U;
            int j = __builtin_ctzll(rem); rem &= rem - 1ull;
            v4u kreg = nsa_ld16(kvs + ((size_t)b * SEQ + j * 64 + srow) * 512 + 0 * 128 + g * 64 + schunk * 8);
            v4u vreg = nsa_ld16(kvs + ((size_t)b * SEQ + j * 64 + srow) * 512 + 1 * 128 + g * 64 + schunk * 8);
            for (;;) {
                __syncthreads();
                *(LAS v4u*)(Kt + soff) = kreg; *(LAS v4u*)(Vt + soff) = vreg;
                __syncthreads();
                const int jc = j; const bool more = rem != 0ull;
                if (more) { j = __builtin_ctzll(rem); rem &= rem - 1ull;
                    kreg = nsa_ld16(kvs + ((size_t)b * SEQ + j * 64 + srow) * 512 + 0 * 128 + g * 64 + schunk * 8);
                    vreg = nsa_ld16(kvs + ((size_t)b * SEQ + j * 64 + srow) * 512 + 1 * 128 + g * 64 + schunk * 8); }
                nsa_qk(Kt, qf, r32, hf, p0, p1);
                const bool sel = (mysel >> jc) & 1ull;
                if (cq - jc >= 14) {
                    const float bias = lutH[1023];
#pragma unroll
                    for (int i = 0; i < 16; ++i) { p0[i] = sel ? p0[i] + bias : -INFINITY; p1[i] = sel ? p1[i] + bias : -INFINITY; }
                } else {
                    const int dbase = tq - jc * 64;
#pragma unroll
                    for (int i = 0; i < 16; ++i) { const int d0 = dbase - KLOC(i), d1 = d0 - 32;
                        p0[i] = (sel && d0 >= 0) ? p0[i] + lutH[d0 < 0 ? 0 : d0] : -INFINITY;
                        p1[i] = (sel && d1 >= 0) ? p1[i] + lutH[d1 < 0 ? 0 : d1] : -INFINITY; }
                }
                nsa_online(p0, p1, m, l, o);
                nsa_pv(Vt, p0, p1, lane, hf, o);
                if (!more) break;
            }
            const float lt = l + __shfl_xor(l, 32), sc = g_slc / lt;
#pragma unroll
            for (int i = 0; i < 16; ++i) { oc[0][i] += sc * o[0][i]; oc[1][i] += sc * o[1][i]; }
        }
        {
            m = -INFINITY; l = 0.f;
#pragma unroll
            for (int i = 0; i < 16; ++i) { o[0][i] = 0.f; o[1][i] = 0.f; }
            int j = cq - 8 > 0 ? cq - 8 : 0;
            v4u kreg = nsa_ld16(kvs + ((size_t)b * SEQ + j * 64 + srow) * 512 + 2 * 128 + g * 64 + schunk * 8);
            v4u vreg = nsa_ld16(kvs + ((size_t)b * SEQ + j * 64 + srow) * 512 + 3 * 128 + g * 64 + schunk * 8);
            for (;;) {
                __syncthreads();
                *(LAS v4u*)(Kt + soff) = kreg; *(LAS v4u*)(Vt + soff) = vreg;
                __syncthreads();
                const int jc = j; const bool more = jc < cq;
                if (more) { j = jc + 1;
                    kreg = nsa_ld16(kvs + ((size_t)b * SEQ + j * 64 + srow) * 512 + 2 * 128 + g * 64 + schunk * 8);
                    vreg = nsa_ld16(kvs + ((size_t)b * SEQ + j * 64 + srow) * 512 + 3 * 128 + g * 64 + schunk * 8); }
                nsa_qk(Kt, qf, r32, hf, p0, p1);
                const int dbase = tq - jc * 64;
#pragma unroll
                for (int i = 0; i < 16; ++i) { const int d0 = dbase - KLOC(i), d1 = d0 - 32;
                    p0[i] = (d0 >= 0 && d0 < 512) ? p0[i] + lutH[d0 < 0 ? 0 : d0] : -INFINITY;
                    p1[i] = (d1 >= 0 && d1 < 512) ? p1[i] + lutH[d1 < 0 ? 0 : d1] : -INFINITY; }
                nsa_online(p0, p1, m, l, o);
                nsa_pv(Vt, p0, p1, lane, hf, o);
                if (!more) break;
            }
            const float lt = l + __shfl_xor(l, 32), sc = g_win / lt;
#pragma unroll
            for (int i = 0; i < 16; ++i) { oc[0][i] += sc * o[0][i]; oc[1][i] += sc * o[1][i]; }
        }
#pragma unroll
        for (int dt = 0; dt < 2; ++dt)
#pragma unroll
            for (int g4 = 0; g4 < 4; ++g4) { v2u wv; wv.x = pk2(oc[dt][4 * g4], oc[dt][4 * g4 + 1]); wv.y = pk2(oc[dt][4 * g4 + 2], oc[dt][4 * g4 + 3]);
                *(v2u*)(oa + qrow * 512 + head * 64 + dt * 32 + 8 * g4 + 4 * hf) = wv; }
        __syncthreads();
    }
}
#undef KLOC


constexpr int GV_TS = 576;
constexpr int GL_V = 0, GL_KST = GL_V + 64 * GV_TS, GL_GS = GL_KST + 128 * 144, GL_ST = GL_GS + 2048, GL_END1 = GL_ST + 256 * 264;
static_assert(GL_END1 <= RING_BYTES, "gla lds");
__device__ __forceinline__ float log_sigmoid_(float z) { return fminf(z, 0.f) - log1pf(__expf(-fabsf(z))); }

__device__ __forceinline__ void gla_stage_v(Frame& F, LAS unsigned char* L, const bf16* vb, size_t row0, int h) {
#pragma unroll
    for (int i = 0; i < 4; ++i) { const int idx = F.tid + 512 * i, r = idx >> 5, c = idx & 31;
        *(LAS v4u*)(L + GL_V + r * GV_TS + c * 16) = *(const v4u*)(vb + (row0 + r) * 1024 + h * 256 + c * 8); }
}
__device__ __forceinline__ void phase_gla1(Frame& F, int l) {
    relaunder(F);
    LAS unsigned char* L = F.lds + RING_OFF;
    bf16* qb = (bf16*)(F.ws + WS_QB); bf16* kb = (bf16*)(F.ws + WS_KB); const bf16* vb = (const bf16*)(F.ws + WS_VB);
    const float* alr = (const float*)(F.ws + WS_ALR); bf16* gst = (bf16*)(F.ws + WS_GST); float* decay = (float*)(F.ws + WS_DECAY);
    const int tid = F.tid, lane = F.lane, wave = F.wave, r32 = lane & 31, hf = lane >> 5;
    const int d = tid & 127, tg = tid >> 7;
    LAS float* gs = (LAS float*)(L + GL_GS);
    for (int u = F.bid; u < 1024; u += F.G) {
        const int bh = u >> 6, n = u & 63, b = bh >> 2, h = bh & 3; const size_t row0 = (size_t)b * SEQ + n * 64;
        float w2r[16];
#pragma unroll
        for (int r = 0; r < 16; ++r) w2r[r] = inp(F, I_AW2)[(size_t)l * 16 * 512 + r * 512 + h * 128 + d];
        const float ab = inp(F, I_AB)[l * 512 + h * 128 + d];
        gla_stage_v(F, L, vb, row0, h);
        float bl[16]; float cum = 0.f;
#pragma unroll
        for (int i = 0; i < 16; ++i) { const f32x4* ar = (const f32x4*)(alr + (row0 + tg * 16 + i) * 16); float z = ab;
#pragma unroll
            for (int q = 0; q < 4; ++q) { const f32x4 av = ar[q]; z += av[0] * w2r[4 * q] + av[1] * w2r[4 * q + 1] + av[2] * w2r[4 * q + 2] + av[3] * w2r[4 * q + 3]; }
            cum += log_sigmoid_(z) * (1.0f / 16.0f); bl[i] = cum; }
        gs[tg * 128 + d] = cum;
        __syncthreads();
        float pre = 0.f, tot = 0.f;
#pragma unroll
        for (int g2 = 0; g2 < 4; ++g2) { const float x = gs[g2 * 128 + d]; tot += x; if (g2 < tg) pre += x; }
        if (tg == 0) decay[(size_t)u * 128 + d] = __expf(tot);
        unsigned ks[8];
#pragma unroll
        for (int i = 0; i < 16; i += 2) {
            float kst[2];
#pragma unroll
            for (int e = 0; e < 2; ++e) { const size_t a = (row0 + tg * 16 + i + e) * 512 + h * 128 + d; const float bb = bl[i + e] + pre;
                const float qv = bf2f(qb[a]), kv = bf2f(kb[a]);
                qb[a] = (bf16)f2bf(qv * __expf(bb)); kb[a] = (bf16)f2bf(kv * __expf(-bb)); kst[e] = kv * __expf(tot - bb); }
            ks[i >> 1] = pk2(kst[0], kst[1]);
        }
        *(LAS v4u*)(L + GL_KST + d * 144 + tg * 32) = (v4u){ks[0], ks[1], ks[2], ks[3]};
        *(LAS v4u*)(L + GL_KST + d * 144 + tg * 32 + 16) = (v4u){ks[4], ks[5], ks[6], ks[7]};
        __syncthreads();
        {
            const int dkb = wave & 3, dvh = wave >> 2;
            f32x16 acc[4];
#pragma unroll
            for (int t4 = 0; t4 < 4; ++t4)
#pragma unroll
                for (int i = 0; i < 16; ++i) acc[t4][i] = 0.f;
            const LAS unsigned char* vbase = L + GL_V + (8 * hf + ((lane & 15) >> 2)) * GV_TS + (dvh * 128 + 16 * ((lane >> 4) & 1) + 4 * (lane & 3)) * 2;
#pragma unroll
            for (int kk = 0; kk < 4; ++kk) {
                const bf16x8 a = *(const LAS bf16x8*)(L + GL_KST + (dkb * 32 + r32) * 144 + kk * 32 + hf * 16);
#pragma unroll
                for (int t4 = 0; t4 < 4; ++t4) {
                    const LAS unsigned char* bp = vbase + (16 * kk) * GV_TS + t4 * 64;
                    const v4i16_t lo = __builtin_amdgcn_ds_read_tr16_b64_v4i16((LAS v4i16_t*)bp);
                    const v4i16_t hi = __builtin_amdgcn_ds_read_tr16_b64_v4i16((LAS v4i16_t*)(bp + 4 * GV_TS));
                    const bf16x8 bv = {lo[0], lo[1], lo[2], lo[3], hi[0], hi[1], hi[2], hi[3]};
                    acc[t4] = __builtin_amdgcn_mfma_f32_32x32x16_bf16(a, bv, acc[t4], 0, 0, 0);
                }
            }
#pragma unroll
            for (int t4 = 0; t4 < 4; ++t4)
#pragma unroll
                for (int g4 = 0; g4 < 4; ++g4) { v2u wv; wv.x = pk2(acc[t4][4 * g4], acc[t4][4 * g4 + 1]); wv.y = pk2(acc[t4][4 * g4 + 2], acc[t4][4 * g4 + 3]);
                    *(LAS v2u*)(L + GL_ST + (dvh * 128 + t4 * 32 + r32) * 264 + (dkb * 32 + 8 * g4 + 4 * hf) * 2) = wv; }
        }
        __syncthreads();
        {
            bf16* dst = gst + (size_t)u * 32768;
#pragma unroll
            for (int i = 0; i < 8; ++i) { const int idx = tid + 512 * i, r = idx >> 4, c = idx & 15;
                const v2u x0 = *(const LAS v2u*)(L + GL_ST + r * 264 + c * 16), x1 = *(const LAS v2u*)(L + GL_ST + r * 264 + c * 16 + 8);
                *(v4u*)(dst + (size_t)r * 128 + c * 8) = (v4u){x0.x, x0.y, x1.x, x1.y}; }
        }
        __syncthreads();
    }
}
__device__ __forceinline__ void phase_gla2(Frame& F) {
    relaunder(F);
    bf16* gst = (bf16*)(F.ws + WS_GST); const float* decay = (const float*)(F.ws + WS_DECAY);
    for (int e = F.bid * 512 + F.tid; e < 16 * 8192; e += F.G * 512) {
        const int bh = e >> 13, off = (e & 8191) * 4, dk0 = off & 127;
        f32x4 S = {0.f, 0.f, 0.f, 0.f};
#pragma unroll 8
        for (int n = 0; n < 64; ++n) {
            v2u* p = (v2u*)(gst + (size_t)(bh * 64 + n) * 32768 + off);
            const v2u dv = *p; const f32x4 dec = *(const f32x4*)(decay + (size_t)(bh * 64 + n) * 128 + dk0);
            v2u sv; sv.x = pk2(S[0], S[1]); sv.y = pk2(S[2], S[3]); *p = sv;
            S[0] = dec[0] * S[0] + bflo(dv.x); S[1] = dec[1] * S[1] + bfhi(dv.x); S[2] = dec[2] * S[2] + bflo(dv.y); S[3] = dec[3] * S[3] + bfhi(dv.y);
        }
    }
}
__device__ __forceinline__ void phase_gla3(Frame& F) {
    relaunder(F);
    LAS unsigned char* L = F.lds + RING_OFF;
    const bf16* qb = (const bf16*)(F.ws + WS_QB); const bf16* kb = (const bf16*)(F.ws + WS_KB); const bf16* vb = (const bf16*)(F.ws + WS_VB);
    const bf16* gst = (const bf16*)(F.ws + WS_GST); const bf16* rb = (const bf16*)(F.ws + WS_RB); bf16* ob = (bf16*)(F.ws + WS_OB);
    const int lane = F.lane, wave = F.wave, r32 = lane & 31, hf = lane >> 5, ti = wave & 1, dvp = wave >> 1;
    LAS float* ssq = (LAS float*)(L + GL_KST);
    for (int u = F.bid; u < 1024; u += F.G) {
        const int bh = u >> 6, n = u & 63, b = bh >> 2, h = bh & 3; const size_t row0 = (size_t)b * SEQ + n * 64;
        gla_stage_v(F, L, vb, row0, h);
        bf16x8 qf[8];
        const bf16* qrow = qb + (row0 + ti * 32 + r32) * 512 + h * 128 + hf * 8;
#pragma unroll
        for (int kk = 0; kk < 8; ++kk) qf[kk] = *(const bf16x8*)(qrow + kk * 16);
        bf16x8 pb[2][2];
#pragma unroll
        for (int jt = 0; jt < 2; ++jt) {
            f32x16 pt;
#pragma unroll
            for (int i = 0; i < 16; ++i) pt[i] = 0.f;
            if (jt <= ti) {
                const bf16* krow = kb + (row0 + jt * 32 + r32) * 512 + h * 128 + hf * 8;
#pragma unroll
                for (int kk = 0; kk < 8; ++kk) pt = __builtin_amdgcn_mfma_f32_32x32x16_bf16(*(const bf16x8*)(krow + kk * 16), qf[kk], pt, 0, 0, 0);
                if (jt == ti) {
#pragma unroll
                    for (int i = 0; i < 16; ++i) if (((i & 3) + 8 * (i >> 2) + 4 * hf) > r32) pt[i] = 0.f;
                }
            }
            pb[jt][0] = nsa_pack(pt, 0); pb[jt][1] = nsa_pack(pt, 1);
        }
        f32x16 o[2];
#pragma unroll
        for (int i = 0; i < 16; ++i) { o[0][i] = 0.f; o[1][i] = 0.f; }
        const bf16* sbase = gst + (size_t)u * 32768 + (size_t)(dvp * 64 + r32) * 128 + hf * 8;
#pragma unroll
        for (int dvt = 0; dvt < 2; ++dvt)
#pragma unroll
            for (int kk = 0; kk < 8; ++kk) o[dvt] = __builtin_amdgcn_mfma_f32_32x32x16_bf16(*(const bf16x8*)(sbase + (size_t)dvt * 32 * 128 + kk * 16), qf[kk], o[dvt], 0, 0, 0);
        __syncthreads();
        {
            const LAS unsigned char* vbase = L + GL_V + (4 * hf + ((lane & 15) >> 2)) * GV_TS + (dvp * 64 + 16 * ((lane >> 4) & 1) + 4 * (lane & 3)) * 2;
#pragma unroll
            for (int dvt = 0; dvt < 2; ++dvt)
#pragma unroll
                for (int jt = 0; jt < 2; ++jt)
#pragma unroll
                    for (int s = 0; s < 2; ++s) {
                        if (jt <= ti) {
                            const LAS unsigned char* ap = vbase + (jt * 32 + 16 * s) * GV_TS + dvt * 64;
                            const v4i16_t lo = __builtin_amdgcn_ds_read_tr16_b64_v4i16((LAS v4i16_t*)ap);
                            const v4i16_t hi = __builtin_amdgcn_ds_read_tr16_b64_v4i16((LAS v4i16_t*)(ap + 8 * GV_TS));
                            const bf16x8 a = {lo[0], lo[1], lo[2], lo[3], hi[0], hi[1], hi[2], hi[3]};
                            o[dvt] = __builtin_amdgcn_mfma_f32_32x32x16_bf16(a, pb[jt][s], o[dvt], 0, 0, 0);
                        }
                    }
        }
        float ss = 0.f;
#pragma unroll
        for (int i = 0; i < 16; ++i) ss += o[0][i] * o[0][i] + o[1][i] * o[1][i];
        ss += __shfl_xor(ss, 32);
        if (hf == 0) ssq[dvp * 64 + ti * 32 + r32] = ss;
        __syncthreads();
        const float tot = (ssq[ti * 32 + r32] + ssq[64 + ti * 32 + r32]) + (ssq[128 + ti * 32 + r32] + ssq[192 + ti * 32 + r32]);
        const float rs = 1.0f / sqrtf(tot * (1.0f / 256.0f) + EPSN);
        const size_t orow = (row0 + ti * 32 + r32) * 1024 + h * 256 + dvp * 64;
#pragma unroll
        for (int dvt = 0; dvt < 2; ++dvt)
#pragma unroll
            for (int g4 = 0; g4 < 4; ++g4) { const int c0 = dvt * 32 + 8 * g4 + 4 * hf; const v2u rw = *(const v2u*)(rb + orow + c0);
                v2u wv; wv.x = pk2(o[dvt][4 * g4] * rs * bflo(rw.x), o[dvt][4 * g4 + 1] * rs * bfhi(rw.x)); wv.y = pk2(o[dvt][4 * g4 + 2] * rs * bflo(rw.y), o[dvt][4 * g4 + 3] * rs * bfhi(rw.y));
                *(v2u*)(ob + orow + c0) = wv; }
        __syncthreads();
    }
}

__device__ __forceinline__ void phase_gla_naive(Frame& F, const Args& a, int l) {
    relaunder(F);
    if (F.bid >= 64) return;
    const int bh = F.bid >> 2, cb = F.bid & 3, b = bh >> 2, h = bh & 3;
    LAS float* qL = (LAS float*)(F.lds + RING_OFF); LAS float* kL = qL + 32 * 128; LAS float* aL = kL + 32 * 128; LAS float* vL = aL + 32 * 128;
    const bf16* qb = (const bf16*)(F.ws + WS_QB); const bf16* kb = (const bf16*)(F.ws + WS_KB); const bf16* vb = (const bf16*)(F.ws + WS_VB);
    const float* alr = (const float*)(F.ws + WS_ALR); float* oraw = (float*)(F.ws + WS_ORAW);
    const int tid = F.tid, split = tid & 7, ci = tid >> 3, d_st = tid & 127;
    float w2r[16];
#pragma unroll
    for (int r = 0; r < 16; ++r) w2r[r] = inp(F, I_AW2)[(size_t)l * 16 * 512 + r * 512 + h * 128 + d_st];
    const float ab = inp(F, I_AB)[l * 512 + h * 128 + d_st];
    float S[16];
#pragma unroll
    for (int i = 0; i < 16; ++i) S[i] = 0.f;
    for (int tc = 0; tc < SEQ / 32; ++tc) {
        const int t0 = tc * 32;
        __syncthreads();
#pragma unroll
        for (int i = 0; i < 8; ++i) { const int idx = tid + 512 * i, tt = idx >> 7; const size_t row = (size_t)b * SEQ + t0 + tt;
            qL[idx] = bf2f(qb[row * 512 + h * 128 + d_st]); kL[idx] = bf2f(kb[row * 512 + h * 128 + d_st]);
            const f32x4* ar = (const f32x4*)(alr + row * 16); float z = ab;
#pragma unroll
            for (int q = 0; q < 4; ++q) { const f32x4 av = ar[q]; z += av[0] * w2r[4 * q] + av[1] * w2r[4 * q + 1] + av[2] * w2r[4 * q + 2] + av[3] * w2r[4 * q + 3]; }
            const float ls = fminf(z, 0.f) - log1pf(__expf(-fabsf(z)));
            aL[idx] = __expf(ls * (1.0f / 16.0f)); }
#pragma unroll
        for (int i = 0; i < 4; ++i) { const int idx = tid + 512 * i, tt = idx >> 6, c = idx & 63; vL[idx] = bf2f(vb[((size_t)b * SEQ + t0 + tt) * 1024 + h * 256 + cb * 64 + c]); }
        __syncthreads();
        for (int tt = 0; tt < 32; ++tt) {
            const float vt = vL[tt * 64 + ci]; float o = 0.f;
#pragma unroll
            for (int q = 0; q < 4; ++q) { const f32x4 av = *(const LAS f32x4*)(aL + tt * 128 + split * 16 + 4 * q), kv = *(const LAS f32x4*)(kL + tt * 128 + split * 16 + 4 * q), qv = *(const LAS f32x4*)(qL + tt * 128 + split * 16 + 4 * q);
#pragma unroll
                for (int j = 0; j < 4; ++j) { S[4 * q + j] = av[j] * S[4 * q + j] + kv[j] * vt; o += qv[j] * S[4 * q + j]; } }
            o += __shfl_xor(o, 1); o += __shfl_xor(o, 2); o += __shfl_xor(o, 4);
            if (split == 0) oraw[((size_t)b * SEQ + t0 + tt) * 1024 + h * 256 + cb * 64 + ci] = o;
        }
    }
    __syncthreads();
}
__device__ __forceinline__ void phase_gla_norm(Frame& F) {
    relaunder(F);
    const int gw = F.bid * NWAVES + F.wave, NGW = F.G * NWAVES;
    const float* oraw = (const float*)(F.ws + WS_ORAW); const bf16* rb = (const bf16*)(F.ws + WS_RB); bf16* ob = (bf16*)(F.ws + WS_OB);
    for (int i = gw; i < MTOK * 4; i += NGW) {
        const f32x4 v = *((const f32x4*)(oraw + (size_t)i * 256) + F.lane);
        const float s = wave_sum((v[0] * v[0] + v[1] * v[1]) + (v[2] * v[2] + v[3] * v[3]));
        const float r = 1.0f / sqrtf(s * (1.0f / 256.0f) + EPSN);
        const v2u rw = *((const v2u*)(rb + (size_t)i * 256) + F.lane);
        v2u w; w.x = pk2(v[0] * r * bflo(rw.x), v[1] * r * bfhi(rw.x)); w.y = pk2(v[2] * r * bflo(rw.y), v[3] * r * bfhi(rw.y));
        *((v2u*)(ob + (size_t)i * 256) + F.lane) = w;
    }
}

#ifndef GLA_NAIVE
#define GLA_NAIVE 0
#endif
#ifndef MK_PER_PHASE
#define MK_PER_PHASE 0
#endif
#ifndef PG8_SP2
#define PG8_SP2 true
#endif
constexpr int NPH_L = 12, NPHASES = NL * NPH_L + 1;

__global__ void __launch_bounds__(NWAVES * 64, 2) fwd(Args args) {
    extern __shared__ __attribute__((aligned(16))) unsigned char lds[];
    Frame F;
    F.lds = (LAS unsigned char*)lds;
    F.tid = threadIdx.x; F.lane = F.tid & 63; F.wave = __builtin_amdgcn_readfirstlane(F.tid >> 6);
    F.G = gridDim.x; F.bid = blockIdx.x; F.ws = args.ws;
    unsigned char* ws = args.ws;
    for (int u = F.tid; u < (LDS_BYTES - LDSCTL_OFF) / 4; u += NWAVES * 64) ((LAS unsigned*)(F.lds + LDSCTL_OFF))[u] = 0u;
    if (F.tid < 50) ((LAS unsigned*)(F.lds + LDSCTL_OFF))[F.tid] = ((const __attribute__((address_space(4))) unsigned*)__builtin_amdgcn_kernarg_segment_ptr())[F.tid];
    __syncthreads();
    XcdBarrier bar; bar.bar = (unsigned*)(ws + WS_CTL) + CW_BAR; bar.x = 0; bar.st = nullptr;
    if (!MK_PER_PHASE) bar = xcd_barrier_post((unsigned*)(ws + WS_CTL) + CW_BAR, (volatile LAS unsigned*)(F.lds + MISC_OFF) + 8);
    const int lo = args.ph_lo, hi = args.ph_hi;
#ifndef PH_MASK
#define PH_MASK 0xFFFF
#endif
#define INL(j) (((PH_MASK >> (j)) & 1) && lo <= (pb + (j)) && (pb + (j)) < hi)
#define IN(k) (lo <= (k) && (k) < hi)
#define SEAM(k) do { if (IN((k) + 1)) { if (MK_PER_PHASE) { } else xcd_barrier(bar); } } while (0)
    bf16* xb = (bf16*)(ws + WS_XB); float* ssp = (float*)(ws + WS_SSP); bf16* act = (bf16*)(ws + WS_ACT);

    for (int l = 0; l < NL; ++l) {
        const int pb = l * NPH_L;
        if (INL(0)) { phase_conv(F, args, l); if (l == 0) { phase_lut(F, args); phase_x0(F, args); } SEAM(pb + 0); }
        if (INL(1)) {
            pg8::Gemm g{xb, (const bf16*)(ws + W_GU1), MTOK, NGU, DM, DM}; pg8::StaticOrder S; S.init(MTOK, NGU, F.G, F.bid);
            EpiGU E{act, ssp};
            pg8::gemm_phase<EpiGU, pg8::StaticOrder, true, PG8_SP2>(F.lds + RING_OFF, g, S, E);
            SEAM(pb + 1);
        }
        if (INL(2)) {
            pg8::Gemm g{act, (const bf16*)(ws + W_D1), MTOK, DM, FF, FF}; pg8::StaticOrder S; S.init(MTOK, DM, F.G, F.bid);
            EpiResid E{args.out, xb, ssp, 0.5f};
            pg8::gemm_phase<EpiResid, pg8::StaticOrder, true, PG8_SP2>(F.lds + RING_OFF, g, S, E);
            SEAM(pb + 2);
        }
        if (INL(3)) {
            pg8::Gemm g{xb, (const bf16*)(ws + W_IN), MTOK, NIN, DM, DM}; pg8::StaticOrder S; S.init(MTOK, NIN, F.G, F.bid);
            EpiWin E{ws, ssp};
            pg8::gemm_phase<EpiWin, pg8::StaticOrder, true, PG8_SP2>(F.lds + RING_OFF, g, S, E);
            SEAM(pb + 3);
        }
        if (INL(4)) {
            const bf16* kvc = (const bf16*)(ws + WS_KVC); bf16* hid = (bf16*)(ws + WS_HID); const float* posb = (const float*)(ws + WS_POSB);
            { pg8::Gemm g{kvc, (const bf16*)(ws + W_C1K), 2048, 256, 2048, 1024}; pg8::StaticOrder S; S.init(2048, 256, F.G, F.bid);
              EpiCmp1 E{hid, posb};
              pg8::gemm_phase<EpiCmp1, pg8::StaticOrder, true, PG8_SP2>(F.lds + RING_OFF, g, S, E); }
            { pg8::Gemm g{kvc + (size_t)8 * SEQ * 64, (const bf16*)(ws + W_C1V), 2048, 256, 2048, 1024}; pg8::StaticOrder S; S.init(2048, 256, F.G, (F.bid + F.G - 8) % F.G);
              EpiCmp1 E{hid + (size_t)2048 * 256, posb + 256};
              pg8::gemm_phase<EpiCmp1, pg8::StaticOrder, true, PG8_SP2>(F.lds + RING_OFF, g, S, E); }
            SEAM(pb + 4);
        }
#if GLA_NAIVE
        if (INL(5)) { phase_cmp2(F, args, l); SEAM(pb + 5); }
        if (INL(6)) { phase_gla_naive(F, args, l); phase_nsa(F); SEAM(pb + 6); }
        if (INL(7)) { phase_gla_norm(F); SEAM(pb + 7); }
#else
        if (INL(5)) { phase_cmp2(F, args, l); phase_gla1(F, l); SEAM(pb + 5); }
        if (INL(6)) { phase_gla2(F); phase_nsa(F); SEAM(pb + 6); }
        if (INL(7)) { phase_gla3(F); SEAM(pb + 7); }
#endif
        if (INL(8)) {
            const bf16* gm = (const bf16*)(ws + WS_GM); float* yp = (float*)(ws + WS_YPART); bf16* y = (bf16*)(ws + WS_Y);
            { pg8::Gemm g{(const bf16*)(ws + WS_OA), (const bf16*)(ws + W_N), MTOK, DM, 512, 512}; pg8::StaticOrder S; S.init(MTOK, DM, F.G, F.bid);
              EpiMerge<1> E{gm, yp, y};
              pg8::gemm_phase<EpiMerge<1>, pg8::StaticOrder, true, PG8_SP2>(F.lds + RING_OFF, g, S, E); }
            { pg8::Gemm g{(const bf16*)(ws + WS_OB), (const bf16*)(ws + W_G), MTOK, DM, DM, DM}; pg8::StaticOrder S; S.init(MTOK, DM, F.G, F.bid);
              EpiMerge<2> E{gm, yp, y};
              pg8::gemm_phase<EpiMerge<2>, pg8::StaticOrder, true, PG8_SP2>(F.lds + RING_OFF, g, S, E); }
            SEAM(pb + 8);
        }
        if (INL(9)) {
            pg8::Gemm g{(const bf16*)(ws + WS_Y), (const bf16*)(ws + W_O), MTOK, DM, DM, DM}; pg8::StaticOrder S; S.init(MTOK, DM, F.G, F.bid);
            EpiResid E{args.out, xb, ssp, 1.0f};
            pg8::gemm_phase<EpiResid, pg8::StaticOrder, true, PG8_SP2>(F.lds + RING_OFF, g, S, E);
            SEAM(pb + 9);
        }
        if (INL(10)) {
            pg8::Gemm g{xb, (const bf16*)(ws + W_GU2), MTOK, NGU, DM, DM}; pg8::StaticOrder S; S.init(MTOK, NGU, F.G, F.bid);
            EpiGU E{act, ssp};
            pg8::gemm_phase<EpiGU, pg8::StaticOrder, true, PG8_SP2>(F.lds + RING_OFF, g, S, E);
            SEAM(pb + 10);
        }
        if (INL(11)) {
            pg8::Gemm g{act, (const bf16*)(ws + W_D2), MTOK, DM, FF, FF}; pg8::StaticOrder S; S.init(MTOK, DM, F.G, F.bid);
            EpiResid E{args.out, xb, ssp, 0.5f};
            pg8::gemm_phase<EpiResid, pg8::StaticOrder, true, PG8_SP2>(F.lds + RING_OFF, g, S, E);
            SEAM(pb + 11);
        }
    }
    if (IN(NL * NPH_L)) phase_final(F, args);
#undef IN
#undef SEAM
}

extern "C" void kernel_launch(void* const* d_in, const int* in_sizes, int n_in, void* d_out, int out_size, void* d_ws, size_t ws_size, hipStream_t stream) {
    static int grid = 0;
    if (grid == 0) {
        if (n_in != 25 || out_size != MTOK * DM || ws_size < WS_END) { fprintf(stderr, "kernel_launch: unexpected shapes (n_in %d, out %d, ws %zu, need %zu)\n", n_in, out_size, ws_size, (size_t)WS_END); grid = -1; return; }
        int dev = 0, cus = 0, per_cu = 0;
        if (hipGetDevice(&dev) != hipSuccess || hipDeviceGetAttribute(&cus, hipDeviceAttributeMultiprocessorCount, dev) != hipSuccess) { grid = -1; return; }
        if (hipFuncSetAttribute((const void*)fwd, hipFuncAttributeMaxDynamicSharedMemorySize, LDS_BYTES) != hipSuccess) { fprintf(stderr, "kernel_launch: hipFuncSetAttribute failed\n"); grid = -1; return; }
        if (hipOccupancyMaxActiveBlocksPerMultiprocessor(&per_cu, (const void*)fwd, NWAVES * 64, LDS_BYTES) != hipSuccess || per_cu < 1) { fprintf(stderr, "kernel_launch: occupancy query reports %d\n", per_cu); }
        (void)hipGetLastError();
        grid = cus;
    }
    if (grid < 0) return;
    (void)hipMemsetAsync((char*)d_ws + WS_CTL, 0, CTL_ZERO_BYTES, stream);
    Args a{};
    for (int i = 0; i < 25; ++i) a.in[i] = (const float*)d_in[i];
    a.out = (float*)d_out; a.ws = (unsigned char*)d_ws;
#if MK_PER_PHASE
    for (int p = 0; p < NPHASES; ++p) { a.ph_lo = p; a.ph_hi = p + 1; hipLaunchKernelGGL(fwd, dim3(grid), dim3(NWAVES * 64), LDS_BYTES, stream, a); }
#else
    a.ph_lo = 0; a.ph_hi = NPHASES;
    hipLaunchKernelGGL(fwd, dim3(grid), dim3(NWAVES * 64), LDS_BYTES, stream, a);
#endif
    const hipError_t le = hipPeekAtLastError();
    if (le != hipSuccess) fprintf(stderr, "kernel_launch: launch failed: %s\n", hipGetErrorName(le));
}
```

```cpp
#include <hip/hip_runtime.h>
#include <cstdio>
#include <cstdint>

namespace pg8 {
#define PG8_LAS __attribute__((address_space(3)))
typedef unsigned short bf16_t;
typedef short bf16x8 __attribute__((ext_vector_type(8)));
typedef float f32x4 __attribute__((ext_vector_type(4)));
typedef unsigned u32x4 __attribute__((ext_vector_type(4)));
constexpr int BM = 256, BK = 64, HALF = 128, HTB = HALF * BK * 2  , STAGE_BYTES = 8 * HTB, NXCD = 8, WGM = 8;

__host__ __device__ __forceinline__ int lds_byte(int r, int c) { const int st = (r >> 4) * 2 + (c >> 5), rr = r & 15, cc = c & 31, ob = rr * 64 + cc * 2; return st * 1024 + (ob ^ (((ob >> 9) & 1) << 5)); }
__host__ __device__ __forceinline__ void stage_rc(int b, int& R, int& C) { const int st = b / 1024, sb = b % 1024, swz = sb ^ (((sb >> 9) & 1) << 5); R = (st >> 1) * 16 + swz / 64; C = (st & 1) * 32 + (swz % 64) / 2; }
__host__ __device__ __forceinline__ int perm32(int rho) { const int n = rho >> 4, i = rho & 15; return 8 * (i >> 2) + 4 * n + (i & 3); }

struct Unit { int pm, pn; };
struct Gemm { const bf16_t* A; const bf16_t* Bt; int M, N, K, lda; };

struct StaticOrder {
    int nM, nN, nwg, G, c;
    __host__ __device__ __forceinline__ void init(int M, int N, int G_, int c_) { nM = M / BM; nN = N / BM; nwg = nM * nN; G = G_; c = c_; }
    __host__ __device__ __forceinline__ bool next(int i, Unit& u) const {
        const long L = (long)i * G + c; if (L >= nwg) return false;
        int wgid = (int)L; { const int q = nwg / NXCD, r = nwg % NXCD, xcd = wgid % NXCD, off = wgid / NXCD; wgid = (xcd < r ? xcd * (q + 1) : r * (q + 1) + (xcd - r) * q) + off; }
        const int nig = WGM * nN, gid = wgid / nig, fm = gid * WGM, gsz = (nM - fm) < WGM ? (nM - fm) : WGM;
        u.pm = fm + ((wgid % nig) % gsz); u.pn = (wgid % nig) / gsz; return true;
    }
    __device__ __forceinline__ void a_ready(const Unit&) const {}
    __device__ __forceinline__ void done(const Unit&) const {}
};
template <class Epi, class Sched, bool ALIGN_EPI = false, bool SP2 = false>
__device__ __forceinline__ void gemm_phase(PG8_LAS unsigned char* lds, const Gemm g, const Sched& S, const Epi& E) {
    int tid_ = threadIdx.x; asm volatile("" : "+v"(tid_));
    const int tid = tid_, wid = __builtin_amdgcn_readfirstlane(tid >> 6), lane = tid & 63, wr = wid >> 2, wc = wid & 3, fr = lane & 15, fq = lane >> 4;
    const int K = g.K, nt = K / BK;
    unsigned voffA[2], voffB[2];
#pragma unroll
    for (int i = 0; i < 2; ++i) { int R, C; stage_rc(tid * 16 + i * 8192, R, C); const int Rb = Epi::PERM ? ((R & ~31) + perm32(R & 31)) : R;
        voffA[i] = (unsigned)(R * g.lda + C) * 2u; voffB[i] = (unsigned)(Rb * K + C) * 2u; }
    const size_t kstep = (size_t)(BK * 2);
    const size_t hstep = (size_t)HALF * K * 2;
    const size_t tstep = 2 * hstep;
    const size_t hstepA = (size_t)HALF * g.lda * 2, tstepA = 2 * hstepA;
    const unsigned ldsw = (unsigned)wid * 1024u;
    const int aoff = lds_byte(wr * 64 + fr, fq * 8), boff = lds_byte(wc * 32 + fr, fq * 8);
#define PG8_SA(b, h) (((b) * 2 + (h)) * HTB)
#define PG8_SB(b, h) ((4 + (b) * 2 + (h)) * HTB)
#define PG8_STAGE(bufoff, gbase, voff) do { _Pragma("unroll") for (int _i = 0; _i < 2; ++_i) \
        __builtin_amdgcn_global_load_lds((const unsigned*)((const char*)(gbase) + (voff)[_i]), (PG8_LAS unsigned*)(lds + (bufoff) + ldsw + _i * 8192), 16, 0, 0); } while (0)
#define PG8_LDA(dst, b, h) do { _Pragma("unroll") for (int m = 0; m < 4; ++m) _Pragma("unroll") for (int k = 0; k < 2; ++k) dst[m][k] = *(const PG8_LAS bf16x8*)(lds + PG8_SA(b, h) + aoff + m * 2048 + k * 1024); } while (0)
#define PG8_LDB(dst, b, h) do { _Pragma("unroll") for (int n = 0; n < 2; ++n) _Pragma("unroll") for (int k = 0; k < 2; ++k) dst[n][k] = *(const PG8_LAS bf16x8*)(lds + PG8_SB(b, h) + boff + n * 2048 + k * 1024); } while (0)
#define PG8_MMA(ai, bj, At, Bt) do { __builtin_amdgcn_s_setprio(1); _Pragma("unroll") for (int m = 0; m < 4; ++m) _Pragma("unroll") for (int n = 0; n < 2; ++n) _Pragma("unroll") for (int k = 0; k < 2; ++k) \
        acc[ai][bj][m][n] = __builtin_amdgcn_mfma_f32_16x16x32_bf16(Bt[n][k], At[m][k], acc[ai][bj][m][n], 0, 0, 0); __builtin_amdgcn_s_setprio(0); } while (0)
#define PG8_WAIT_V(n) asm volatile("s_waitcnt vmcnt(" #n ")" ::: "memory")
#define PG8_WAIT_L(n) asm volatile("s_waitcnt lgkmcnt(" #n ")" ::: "memory")
#define PG8_BAR __builtin_amdgcn_s_barrier()
#define PG8_SCHED __builtin_amdgcn_sched_barrier(0)
    Unit cur, nxt; int ui = 0;
    if (!S.next(0, cur)) return;
    f32x4 acc[2][2][4][2];
#pragma unroll
    for (int a = 0; a < 2; ++a)
#pragma unroll
        for (int b = 0; b < 2; ++b)
#pragma unroll
            for (int m = 0; m < 4; ++m)
#pragma unroll
                for (int n = 0; n < 2; ++n) acc[a][b][m][n] = (f32x4){0.f, 0.f, 0.f, 0.f};
    bf16x8 At[4][2], B0[2][2], B1[2][2];
    const char* cA = (const char*)g.A + (size_t)cur.pm * tstepA; const char* cB = (const char*)g.Bt + (size_t)cur.pn * tstep;
    S.a_ready(cur);
    if constexpr (SP2) {
        PG8_STAGE(PG8_SB(0, 0), cB, voffB); PG8_STAGE(PG8_SB(0, 1), cB + hstep, voffB); PG8_STAGE(PG8_SA(0, 0), cA, voffA); PG8_STAGE(PG8_SA(0, 1), cA + hstepA, voffA);
        if (wr == 1) PG8_BAR;
        PG8_WAIT_V(2); PG8_BAR;
        PG8_STAGE(PG8_SB(1, 0), cB + kstep, voffB); PG8_STAGE(PG8_SA(1, 0), cA + kstep, voffA); PG8_STAGE(PG8_SB(1, 1), cB + hstep + kstep, voffB);
        PG8_WAIT_V(6); PG8_BAR;
    } else {
        PG8_STAGE(PG8_SB(0, 0), cB, voffB); PG8_STAGE(PG8_SA(0, 0), cA, voffA); PG8_STAGE(PG8_SB(0, 1), cB + hstep, voffB); PG8_STAGE(PG8_SA(0, 1), cA + hstepA, voffA);
        if (wr == 1) PG8_BAR;
        PG8_WAIT_V(4); PG8_BAR;
        PG8_STAGE(PG8_SB(1, 0), cB + kstep, voffB); PG8_STAGE(PG8_SA(1, 0), cA + kstep, voffA); PG8_STAGE(PG8_SB(1, 1), cB + hstep + kstep, voffB);
        PG8_WAIT_V(6); PG8_BAR;
    }
    for (;;) {
        const bool has_next = S.next(ui + 1, nxt);
        const char* nA = has_next ? (const char*)g.A + (size_t)nxt.pm * tstepA : cA; const char* nB = has_next ? (const char*)g.Bt + (size_t)nxt.pn * tstep : cB;
        for (int t = 0; t < nt; t += 2) {
            const bool last = (t == nt - 2);
            const char* a1 = cA + (size_t)(t + 1) * kstep;
            const char* a2 = last ? nA : cA + (size_t)(t + 2) * kstep; const char* b2 = last ? nB : cB + (size_t)(t + 2) * kstep;
            const char* a3 = a2 + kstep; const char* b3 = b2 + kstep;
            if (last && has_next) S.a_ready(nxt);
            if constexpr (SP2) {
            PG8_LDB(B0, 0, 0); PG8_LDB(B1, 0, 1); PG8_SCHED; PG8_LDA(At, 0, 0); PG8_STAGE(PG8_SA(1, 1), a1 + hstepA, voffA);
            PG8_WAIT_V(8); PG8_WAIT_L(0); PG8_BAR; PG8_MMA(0, 0, At, B0); PG8_MMA(0, 1, At, B1); PG8_BAR; PG8_SCHED;
            PG8_LDA(At, 0, 1); PG8_STAGE(PG8_SB(0, 0), b2, voffB); PG8_STAGE(PG8_SB(0, 1), b2 + hstep, voffB); PG8_STAGE(PG8_SA(0, 0), a2, voffA);
            PG8_WAIT_V(8); PG8_WAIT_L(0); PG8_BAR; PG8_MMA(1, 0, At, B0); PG8_MMA(1, 1, At, B1); PG8_BAR; PG8_SCHED;
            PG8_LDB(B0, 1, 0); PG8_LDB(B1, 1, 1); PG8_SCHED; PG8_LDA(At, 1, 0); PG8_STAGE(PG8_SA(0, 1), a2 + hstepA, voffA);
            PG8_WAIT_V(8); PG8_WAIT_L(0); PG8_BAR; PG8_MMA(0, 0, At, B0); PG8_MMA(0, 1, At, B1); PG8_BAR; PG8_SCHED;
            PG8_LDA(At, 1, 1); PG8_STAGE(PG8_SB(1, 0), b3, voffB); PG8_STAGE(PG8_SB(1, 1), b3 + hstep, voffB); PG8_STAGE(PG8_SA(1, 0), a3, voffA);
            PG8_WAIT_V(8); PG8_WAIT_L(0); PG8_BAR; PG8_MMA(1, 0, At, B0); PG8_MMA(1, 1, At, B1); PG8_BAR; PG8_SCHED;
            } else {
            PG8_LDB(B0, 0, 0); PG8_SCHED; PG8_LDA(At, 0, 0); PG8_STAGE(PG8_SA(1, 1), a1 + hstepA, voffA);
            PG8_WAIT_L(8); PG8_BAR; PG8_WAIT_L(0); PG8_MMA(0, 0, At, B0); PG8_BAR; PG8_SCHED;
            PG8_LDB(B1, 0, 1); PG8_STAGE(PG8_SB(0, 0), b2, voffB);
            PG8_BAR; PG8_WAIT_L(0); PG8_MMA(0, 1, At, B1); PG8_BAR;
            PG8_LDA(At, 0, 1); PG8_STAGE(PG8_SA(0, 0), a2, voffA);
            PG8_BAR; PG8_WAIT_L(0); PG8_MMA(1, 0, At, B0); PG8_BAR; PG8_SCHED;
            PG8_STAGE(PG8_SB(0, 1), b2 + hstep, voffB);
            PG8_WAIT_V(6); PG8_BAR; PG8_MMA(1, 1, At, B1); PG8_BAR;
            PG8_LDB(B0, 1, 0); PG8_SCHED; PG8_LDA(At, 1, 0); PG8_STAGE(PG8_SA(0, 1), a2 + hstepA, voffA);
            PG8_WAIT_L(8); PG8_BAR; PG8_WAIT_L(0); PG8_MMA(0, 0, At, B0); PG8_BAR; PG8_SCHED;
            PG8_LDB(B1, 1, 1); PG8_STAGE(PG8_SB(1, 0), b3, voffB);
            PG8_BAR; PG8_WAIT_L(0); PG8_MMA(0, 1, At, B1); PG8_BAR;
            PG8_LDA(At, 1, 1); PG8_STAGE(PG8_SA(1, 0), a3, voffA);
            PG8_BAR; PG8_WAIT_L(0); PG8_MMA(1, 0, At, B0); PG8_BAR; PG8_SCHED;
            PG8_STAGE(PG8_SB(1, 1), b3 + hstep, voffB);
            PG8_WAIT_V(6); PG8_BAR; PG8_MMA(1, 1, At, B1); PG8_BAR;
            }
        }
        if constexpr (ALIGN_EPI) { if (wr == 0) PG8_BAR; }
        if constexpr (!Epi::AFTER_DRAIN) { E(acc, cur, wr, wc, fr, fq); S.done(cur); }
        if (!has_next) break;
#pragma unroll
        for (int a = 0; a < 2; ++a)
#pragma unroll
            for (int b = 0; b < 2; ++b)
#pragma unroll
                for (int m = 0; m < 4; ++m)
#pragma unroll
                    for (int n = 0; n < 2; ++n) acc[a][b][m][n] = (f32x4){0.f, 0.f, 0.f, 0.f};
        cur = nxt; cA = nA; cB = nB; ++ui;
        if constexpr (ALIGN_EPI) { if (wr == 1) PG8_BAR; }
    }
    PG8_WAIT_V(0);
    if constexpr (!ALIGN_EPI) { if (wr == 0) PG8_BAR; }
    PG8_BAR;
    if constexpr (Epi::AFTER_DRAIN) { E.fused(acc, cur, wr, wc, fr, fq, lds, wid, lane); S.done(cur); }
#undef PG8_SA
#undef PG8_SB
#undef PG8_STAGE
#undef PG8_LDA
#undef PG8_LDB
#undef PG8_MMA
#undef PG8_WAIT_V
#undef PG8_WAIT_L
#undef PG8_BAR
#undef PG8_SCHED
}
}

constexpr int NB = 4, SEQ = 4096, DM = 1024, NL = 4, FF = 2816, MTOK = NB * SEQ;
constexpr int DIN = 6440, NIN = 6656;
constexpr int NGU = 2 * FF;
constexpr float EPSN = 1e-6f;
constexpr int SRC_QA = 0, SRC_KVA = 512, SRC_GA = 1280, SRC_QB = 1304, SRC_KB = 1816, SRC_VB = 2328, SRC_ALR = 3352, SRC_RB = 3368, SRC_GM = 4392;
constexpr int T_QA = 0, T_KVA = 2, T_QB = 5, T_KB = 7, T_VB = 9, T_RB = 13, T_GM = 17, T_MISC = 25;

constexpr size_t MiB = 1u << 20;
constexpr size_t WS_CTL = 0, CTL_ZERO_BYTES = 64 * 1024;
constexpr size_t WS_LUT = 1 * MiB;
constexpr size_t WS_POSB = WS_LUT + 128 * 1024;
constexpr size_t WS_W = 2 * MiB;
constexpr size_t W_GU1 = WS_W, W_D1 = W_GU1 + 11 * MiB, W_GU2 = W_D1 + 11 * MiB / 2, W_D2 = W_GU2 + 11 * MiB;
constexpr size_t W_IN = W_D2 + 11 * MiB / 2, W_C1K = W_IN + 13 * MiB, W_C1V = W_C1K + 1 * MiB, W_N = W_C1V + 1 * MiB, W_G = W_N + 1 * MiB, W_O = W_G + 2 * MiB;
constexpr size_t WS_XB = 58 * MiB;
constexpr size_t WS_SSP = 90 * MiB;
constexpr size_t WS_R = 92 * MiB;
constexpr size_t WS_ACT = WS_R;
constexpr size_t WS_QA = WS_R, WS_KVS = WS_QA + 16 * MiB, WS_KVC = WS_KVS + 16 * MiB, WS_GA = WS_KVC + 9 * MiB, WS_ALR = WS_GA + 2 * MiB;
constexpr size_t WS_QB = WS_ALR + 1 * MiB, WS_KB = WS_QB + 16 * MiB, WS_VB = WS_KB + 16 * MiB, WS_RB = WS_VB + 32 * MiB, WS_GM = WS_RB + 32 * MiB;
constexpr size_t WS_HID = WS_GM + 64 * MiB, WS_KVCMP = WS_HID + 2 * MiB, WS_OA = WS_KVCMP + 1 * MiB, WS_ORAW = WS_OA + 16 * MiB, WS_OB = WS_ORAW + 64 * MiB;
constexpr size_t WS_Y = WS_OB + 32 * MiB, WS_END = WS_Y + 32 * MiB;
constexpr size_t WS_YPART = WS_ORAW;
constexpr size_t WS_GST = WS_ORAW;
constexpr size_t WS_DECAY = WS_GA + 1536 * 1024;
constexpr size_t WS_KVCMPB = WS_KVC + 8 * MiB + 64 * 1024;
static_assert(W_O + 2 * MiB <= WS_XB, "weights fit");
static_assert(WS_END <= 460 * MiB, "workspace budget");

constexpr int CW_BAR = 1024;

constexpr int RING_OFF = 0, RING_BYTES = 131072;
constexpr int LDSCTL_OFF = RING_BYTES, MISC_OFF = LDSCTL_OFF + 320;
constexpr int LDS_BYTES = 147456;
constexpr int RS_OFF = RING_BYTES + 512;
constexpr int NWAVES = 8;

#define GAS __attribute__((address_space(1)))
#define LAS __attribute__((address_space(3)))
typedef unsigned short bf16;
typedef unsigned v4u __attribute__((ext_vector_type(4)));
typedef unsigned v2u __attribute__((ext_vector_type(2)));
typedef float f32x4 __attribute__((ext_vector_type(4)));
typedef short bf16x8 __attribute__((ext_vector_type(8)));
#define LDS_WAIT() asm volatile("s_waitcnt lgkmcnt(0)" ::: "memory")
#define VM_WAIT() asm volatile("s_waitcnt vmcnt(0)" ::: "memory")
__device__ __forceinline__ unsigned f2bf(float f) { unsigned u = __builtin_bit_cast(unsigned, f); return (u + 0x7fffu + ((u >> 16) & 1u)) >> 16; }
__device__ __forceinline__ unsigned pk2(float lo, float hi) { return f2bf(lo) | (f2bf(hi) << 16); }
__device__ __forceinline__ float bf2f(unsigned short b) { return __builtin_bit_cast(float, ((unsigned)b) << 16); }
__device__ __forceinline__ float bflo(unsigned w) { return __builtin_bit_cast(float, w << 16); }
__device__ __forceinline__ float bfhi(unsigned w) { return __builtin_bit_cast(float, w & 0xffff0000u); }
__device__ __forceinline__ float wave_sum(float v) {
#pragma unroll
    for (int o = 1; o < 64; o <<= 1) v += __shfl_xor(v, o);
    return v;
}
__device__ __forceinline__ float wave_max(float v) {
#pragma unroll
    for (int o = 1; o < 64; o <<= 1) v = fmaxf(v, __shfl_xor(v, o));
    return v;
}
__device__ __forceinline__ float sigmoidf_(float x) { return __builtin_amdgcn_rcpf(1.0f + __builtin_amdgcn_exp2f(x * -1.4426950408889634f)); }
__device__ __forceinline__ float siluf_(float x) { return x * __builtin_amdgcn_rcpf(1.0f + __builtin_amdgcn_exp2f(x * -1.4426950408889634f)); }

#define XB_TMO      128
#define XB_XCNT(j)  (256  + 64 * (j))
#define XB_XSUB(j)  (1280 + 64 * (j))
#define XB_XGEN(j)  (2304 + 64 * (j))
#define XB_TOP      3328
#define XB_TOPGEN   3392
#define XCD_BAR_WORDS 3456
#define XB_SPIN_CAP (1u << 18)

__device__ __forceinline__ unsigned xb_ld(unsigned* p)              { return __hip_atomic_load(p, __ATOMIC_RELAXED, __HIP_MEMORY_SCOPE_AGENT); }
__device__ __forceinline__ unsigned xb_add(unsigned* p, unsigned v) { return __hip_atomic_fetch_add(p, v, __ATOMIC_RELAXED, __HIP_MEMORY_SCOPE_AGENT); }
__device__ __forceinline__ unsigned xb_xcc_id() { return (unsigned)__builtin_amdgcn_s_getreg((3 << 11) | 20) & 0xFu; }
#define XB_SPIN(cond, bar) do { unsigned _sp = 0; while (cond) { __builtin_amdgcn_s_sleep(1); \
    if ((++_sp & 255u) == 0u) { if (xb_ld(&(bar)[XB_TMO])) break; if (_sp > XB_SPIN_CAP) { atomicAdd(&(bar)[XB_TMO], 1u); break; } } } } while (0)

struct XcdBarrier {
    unsigned* bar; unsigned x;
    volatile LAS unsigned* st;
};
__device__ __forceinline__ XcdBarrier xcd_barrier_post(unsigned* bar, volatile LAS unsigned* st) {
    XcdBarrier b; b.bar = bar; b.x = xb_xcc_id(); b.st = st;
    if (threadIdx.x == 0) (void)xb_add(&bar[XB_XCNT(b.x)], 1u);
    return b;
}
__device__ __forceinline__ void xcd_barrier_complete(unsigned* bar, unsigned x, unsigned& nloc, unsigned& nx) {
    const unsigned G = gridDim.x * gridDim.y * gridDim.z;
    unsigned sum, cnt, mine, sp = 0u;
    for (;;) {
        sum = 0u; cnt = 0u; mine = 0u;
#pragma unroll
        for (unsigned j = 0; j < 16; ++j) { const unsigned c = xb_ld(&bar[XB_XCNT(j)]); sum += c; cnt += (c > 0u) ? 1u : 0u; mine = (j == x) ? c : mine; }
        if (sum == G) break;
        __builtin_amdgcn_s_sleep(1);
        if ((++sp & 255u) == 0u) { if (xb_ld(&bar[XB_TMO])) break; if (sp > XB_SPIN_CAP) { atomicAdd(&bar[XB_TMO], 1u); break; } }
    }
    nloc = mine > 0u ? mine : 1u; nx = cnt > 0u ? cnt : 1u;
}
__device__ __forceinline__ void xcd_barrier(const XcdBarrier& b) {
    asm volatile("s_waitcnt vmcnt(0)" ::: "memory");
    __syncthreads();
    if (threadIdx.x == 0) {
        unsigned* bar = b.bar;
        __builtin_amdgcn_s_waitcnt(0);
        unsigned nloc = b.st[0], nx = b.st[1];
        if (nloc == 0u) { xcd_barrier_complete(bar, b.x, nloc, nx); b.st[0] = nloc; b.st[1] = nx; }
        const unsigned old = xb_add(&bar[XB_XSUB(b.x)], 1u);
        const unsigned gen = old / nloc;
        if (old + 1u == (gen + 1u) * nloc) {
            __builtin_amdgcn_fence(__ATOMIC_RELEASE, "agent");
            asm volatile("s_waitcnt vmcnt(0)" ::: "memory");
            const unsigned og = xb_add(&bar[XB_TOP], 1u);
            const unsigned tg = og / nx;
            if (og + 1u == (tg + 1u) * nx) xb_add(&bar[XB_TOPGEN], 1u);
            else XB_SPIN(xb_ld(&bar[XB_TOPGEN]) == tg, bar);
            __builtin_amdgcn_fence(__ATOMIC_ACQUIRE, "agent");
            xb_add(&bar[XB_XGEN(b.x)], 1u);
            asm volatile("s_waitcnt vmcnt(0)" ::: "memory");
        } else {
            XB_SPIN(xb_ld(&bar[XB_XGEN(b.x)]) == gen, bar);
            __builtin_amdgcn_fence(__ATOMIC_ACQUIRE, "agent");
            asm volatile("s_waitcnt vmcnt(0)" ::: "memory");
        }
    }
    __syncthreads();
}

struct Args { const float* in[25]; float* out; unsigned char* ws; int ph_lo, ph_hi; };
enum { I_X = 0, I_REL, I_F1N, I_F1G, I_F1U, I_F1D, I_MIXN, I_WIN, I_POSK, I_POSV, I_CKW1, I_CKW2, I_CVW1, I_CVW2, I_AW2, I_AB, I_GON, I_WBN, I_WBG, I_WOUT, I_F2N, I_F2G, I_F2U, I_F2D, I_FIN };

struct Frame {
    LAS unsigned char* lds;
    int tid, lane, wave, G, bid;
    unsigned char* ws;
};
__device__ __forceinline__ const float* inp(const Frame& F, int i) {
    const LAS unsigned* t = (const LAS unsigned*)(F.lds + LDSCTL_OFF);
    const unsigned lo = __builtin_amdgcn_readfirstlane(t[2 * i]), hi = __builtin_amdgcn_readfirstlane(t[2 * i + 1]);
    return (const float*)(((unsigned long long)hi << 32) | lo);
}
__device__ __forceinline__ void relaunder(Frame& F) { int t = threadIdx.x; asm volatile("" : "+v"(t)); F.tid = t; F.lane = t & 63; F.wave = __builtin_amdgcn_readfirstlane(t >> 6);
    unsigned char* w = F.ws; asm volatile("" : "+s"(w)); F.ws = w; }

using pg8::Unit;
__device__ __forceinline__ float row_rstd(const float* ssp, int row);
__device__ __forceinline__ void rstd8(const float* ssp, int rowbase, int fr, int fq, float (&rs)[2][4]);
__device__ __forceinline__ void rstd_table(const float* ssp, int pm, LAS float* rsL, int tid) {
    const int row = tid >> 1, half = tid & 1; const f32x4* p = (const f32x4*)(ssp + (size_t)(pm * 256 + row) * 16 + half * 8);
    const f32x4 a = p[0], b = p[1];
    float s = ((a[0] + a[1]) + (a[2] + a[3])) + ((b[0] + b[1]) + (b[2] + b[3]));
    s += __shfl_xor(s, 1);
    if (half == 0) rsL[row] = __builtin_amdgcn_rsqf(s * (1.0f / DM) + EPSN);
    __syncthreads();
}
__device__ __forceinline__ void rstd8_lds(const LAS float* rsL, const float* ssp, int pm0, const Unit& u, int wr, int fr, int fq, float (&rs)[2][4]) {
    if (u.pm == pm0) {
#pragma unroll
        for (int ai = 0; ai < 2; ++ai)
#pragma unroll
            for (int m = 0; m < 4; ++m) rs[ai][m] = rsL[ai * 128 + wr * 64 + m * 16 + fr];
    } else {
#pragma unroll 1
        for (int i = 0; i < 8; ++i) { const float r = row_rstd(ssp, u.pm * 256 + (i >> 2) * 128 + wr * 64 + (i & 3) * 16 + fr);
#pragma unroll
            for (int ai = 0; ai < 2; ++ai)
#pragma unroll
                for (int m = 0; m < 4; ++m) if (ai * 4 + m == i) rs[ai][m] = r; }
    }
}
__device__ __forceinline__ void rstd8(const float* ssp, int rowbase, int fr, int fq, float (&rs)[2][4]) {
    const int L = fq * 16 + fr; float r2[2];
    f32x4 t[2][4];
#pragma unroll
    for (int ai = 0; ai < 2; ++ai) { const f32x4* p = (const f32x4*)(ssp + (size_t)(rowbase + ai * 128 + L) * 16);
#pragma unroll
        for (int q = 0; q < 4; ++q) t[ai][q] = p[q]; }
#pragma unroll
    for (int ai = 0; ai < 2; ++ai) { const f32x4 a = t[ai][0], b = t[ai][1], c = t[ai][2], d = t[ai][3];
        const float s = ((a[0] + a[1]) + (a[2] + a[3])) + ((b[0] + b[1]) + (b[2] + b[3])) + ((c[0] + c[1]) + (c[2] + c[3])) + ((d[0] + d[1]) + (d[2] + d[3]));
        r2[ai] = __builtin_amdgcn_rsqf(s * (1.0f / DM) + EPSN); }
#pragma unroll
    for (int ai = 0; ai < 2; ++ai)
#pragma unroll
        for (int m = 0; m < 4; ++m) rs[ai][m] = __shfl(r2[ai], 16 * m + fr);
}
__device__ __forceinline__ float row_rstd(const float* ssp, int row) {
    const f32x4* p = (const f32x4*)(ssp + (size_t)row * 16);
    const f32x4 a = p[0], b = p[1], c = p[2], d = p[3];
    const float s = ((a[0] + a[1]) + (a[2] + a[3])) + ((b[0] + b[1]) + (b[2] + b[3])) + ((c[0] + c[1]) + (c[2] + c[3])) + ((d[0] + d[1]) + (d[2] + d[3]));
    return 1.0f / sqrtf(s * (1.0f / DM) + EPSN);
}
struct EpiGU {
    static constexpr bool PERM = true, AFTER_DRAIN = false;
    bf16* act; const float* ssp; const LAS float* rsL; int pm0;
    __device__ __forceinline__ void operator()(const f32x4 (&acc)[2][2][4][2], const Unit& u, int wr, int wc, int fr, int fq) const {
        const int row0 = u.pm * 256 + wr * 64 + fr, col0 = u.pn * 128 + wc * 32 + 8 * fq;
        float rs[2][4]; rstd8_lds(rsL, ssp, pm0, u, wr, fr, fq, rs);
#pragma unroll
        for (int ai = 0; ai < 2; ++ai)
#pragma unroll
            for (int m = 0; m < 4; ++m) {
                const int row = row0 + ai * 128 + m * 16; const float r = rs[ai][m];
                float h[8];
#pragma unroll
                for (int n = 0; n < 2; ++n)
#pragma unroll
                    for (int j = 0; j < 4; ++j) { const float g = acc[ai][0][m][n][j] * r, up = acc[ai][1][m][n][j] * r; h[n * 4 + j] = siluf_(g) * up; }
                v4u w; w.x = pk2(h[0], h[1]); w.y = pk2(h[2], h[3]); w.z = pk2(h[4], h[5]); w.w = pk2(h[6], h[7]);
                *(v4u*)(act + (size_t)row * FF + col0) = w;
            }
    }
};
struct EpiResid {
    static constexpr bool PERM = true, AFTER_DRAIN = false;
    bf16* xb; float* ssp; float alpha;
    __device__ __forceinline__ void operator()(const f32x4 (&acc)[2][2][4][2], const Unit& u, int wr, int wc, int fr, int fq) const {
        const int row0 = u.pm * 256 + wr * 64 + fr, col0 = u.pn * 256 + wc * 32 + 8 * fq;
#pragma unroll
        for (int ai = 0; ai < 2; ++ai)
#pragma unroll
            for (int m = 0; m < 4; ++m) {
                const int row = row0 + ai * 128 + m * 16; float ssq = 0.f;
#pragma unroll
                for (int bj = 0; bj < 2; ++bj) {
                    bf16* xp = xb + (size_t)row * DM + col0 + bj * 128;
                    const v4u xw = *(const v4u*)xp;
                    f32x4 x0 = {bflo(xw.x), bfhi(xw.x), bflo(xw.y), bfhi(xw.y)}, x1 = {bflo(xw.z), bfhi(xw.z), bflo(xw.w), bfhi(xw.w)};
                    x0 = x0 + acc[ai][bj][m][0] * alpha; x1 = x1 + acc[ai][bj][m][1] * alpha;
                    v4u w; w.x = pk2(x0[0], x0[1]); w.y = pk2(x0[2], x0[3]); w.z = pk2(x1[0], x1[1]); w.w = pk2(x1[2], x1[3]);
                    *(v4u*)xp = w;
                    x0 = (f32x4){bflo(w.x), bfhi(w.x), bflo(w.y), bfhi(w.y)}; x1 = (f32x4){bflo(w.z), bfhi(w.z), bflo(w.w), bfhi(w.w)};
                    ssq += (x0[0] * x0[0] + x0[1] * x0[1]) + (x0[2] * x0[2] + x0[3] * x0[3]) + (x1[0] * x1[0] + x1[1] * x1[1]) + (x1[2] * x1[2] + x1[3] * x1[3]);
                }
                ssq += __shfl_xor(ssq, 16); ssq += __shfl_xor(ssq, 32);
                if (fq == 0) ssp[(size_t)row * 16 + u.pn * 4 + wc] = ssq;
            }
    }
};
struct EpiWin {
    static constexpr bool PERM = true, AFTER_DRAIN = false;
    unsigned char* ws; const float* ssp; const LAS float* rsL; int pm0;
    __device__ __forceinline__ void operator()(const f32x4 (&acc)[2][2][4][2], const Unit& u, int wr, int wc, int fr, int fq) const {
        const int row0 = u.pm * 256 + wr * 64 + fr, pn = u.pn;
        bf16* dst = nullptr; int ld = 0, coff = 0, actk = 0; float scale = 1.f;
        if (pn < T_KVA) { dst = (bf16*)(ws + WS_QA); ld = 512; coff = (pn - T_QA) * 256; scale = 0.125f; }
        else if (pn == T_KVA) { }
        else if (pn < T_QB) { dst = (bf16*)(ws + WS_KVS); ld = 512; coff = (pn - T_KVA - 1) * 256; }
        else if (pn < T_KB) { dst = (bf16*)(ws + WS_QB); ld = 512; coff = (pn - T_QB) * 256; scale = 0.08838834764831845f; }
        else if (pn < T_VB) { dst = (bf16*)(ws + WS_KB); ld = 512; coff = (pn - T_KB) * 256; }
        else if (pn < T_RB) { dst = (bf16*)(ws + WS_VB); ld = 1024; coff = (pn - T_VB) * 256; }
        else if (pn < T_GM) { dst = (bf16*)(ws + WS_RB); ld = 1024; coff = (pn - T_RB) * 256; actk = 1; }
        else if (pn < T_MISC) { dst = (bf16*)(ws + WS_GM); ld = 2048; coff = (pn - T_GM) * 256; actk = 2; }
        float rs[2][4]; rstd8_lds(rsL, ssp, pm0, u, wr, fr, fq, rs);
#pragma unroll
        for (int ai = 0; ai < 2; ++ai)
#pragma unroll
            for (int m = 0; m < 4; ++m) {
                const int row = row0 + ai * 128 + m * 16; const float r = rs[ai][m];
                if (pn == T_MISC) {
                    float* ga = (float*)(ws + WS_GA); float* alr = (float*)(ws + WS_ALR);
#pragma unroll
                    for (int n = 0; n < 2; ++n)
#pragma unroll
                        for (int j = 0; j < 4; ++j) { const int c = wc * 32 + 8 * fq + 4 * n + j; const float v = acc[ai][0][m][n][j] * r;
                            if (c < 24) ga[(size_t)row * 24 + c] = sigmoidf_(v); else if (c < 40) alr[(size_t)row * 16 + (c - 24)] = v; }
                } else {
#pragma unroll
                    for (int bj = 0; bj < 2; ++bj) {
                        float h[8];
#pragma unroll
                        for (int n = 0; n < 2; ++n)
#pragma unroll
                            for (int j = 0; j < 4; ++j) { float v = acc[ai][bj][m][n][j] * r * scale; if (actk == 1) v = siluf_(v); else if (actk == 2) v = sigmoidf_(v); h[n * 4 + j] = v; }
                        v4u w; w.x = pk2(h[0], h[1]); w.y = pk2(h[2], h[3]); w.z = pk2(h[4], h[5]); w.w = pk2(h[6], h[7]);
                        if (pn == T_KVA) {
                            const int b = row >> 12, t = row & 4095, g = wc >> 1, d = (wc & 1) * 32 + 8 * fq;
                            bf16* kvc = (bf16*)(ws + WS_KVC);
                            *(v4u*)(kvc + ((size_t)((bj * 4 + b) * 2 + g) * SEQ + t) * 64 + d) = w;
                        } else {
                            *(v4u*)(dst + (size_t)row * ld + coff + bj * 128 + wc * 32 + 8 * fq) = w;
                        }
                    }
                }
            }
    }
};
struct EpiCmp1 {
    static constexpr bool PERM = true, AFTER_DRAIN = false;
    bf16* hid; const float* posb;
    __device__ __forceinline__ void operator()(const f32x4 (&acc)[2][2][4][2], const Unit& u, int wr, int wc, int fr, int fq) const {
        const int row0 = u.pm * 256 + wr * 64 + fr, col0 = wc * 32 + 8 * fq;
#pragma unroll
        for (int ai = 0; ai < 2; ++ai)
#pragma unroll
            for (int m = 0; m < 4; ++m) {
                const int row = row0 + ai * 128 + m * 16;
#pragma unroll
                for (int bj = 0; bj < 2; ++bj) {
                    const f32x4 b0 = *(const f32x4*)(posb + col0 + bj * 128), b1 = *(const f32x4*)(posb + col0 + bj * 128 + 4);
                    const f32x4 v0 = acc[ai][bj][m][0] + b0, v1 = acc[ai][bj][m][1] + b1;
                    v4u w; w.x = pk2(siluf_(v0[0]), siluf_(v0[1])); w.y = pk2(siluf_(v0[2]), siluf_(v0[3])); w.z = pk2(siluf_(v1[0]), siluf_(v1[1])); w.w = pk2(siluf_(v1[2]), siluf_(v1[3]));
                    *(v4u*)(hid + (size_t)row * 256 + col0 + bj * 128) = w;
                }
            }
    }
};
template <int STEP> struct EpiMerge {
    static constexpr bool PERM = true, AFTER_DRAIN = false;
    const bf16* gm; float* ypart; bf16* y;
    __device__ __forceinline__ void operator()(const f32x4 (&acc)[2][2][4][2], const Unit& u, int wr, int wc, int fr, int fq) const {
        const int row0 = u.pm * 256 + wr * 64 + fr, col0 = u.pn * 256 + wc * 32 + 8 * fq;
#pragma unroll
        for (int ai = 0; ai < 2; ++ai)
#pragma unroll
            for (int m = 0; m < 4; ++m) {
                const int row = row0 + ai * 128 + m * 16;
#pragma unroll
                for (int bj = 0; bj < 2; ++bj) {
                    const int col = col0 + bj * 128;
                    const v4u gw = *(const v4u*)(gm + (size_t)row * 2048 + (STEP == 1 ? 0 : 1024) + col);
                    f32x4 g0 = {bflo(gw.x), bfhi(gw.x), bflo(gw.y), bfhi(gw.y)}, g1 = {bflo(gw.z), bfhi(gw.z), bflo(gw.w), bfhi(gw.w)};
                    float* yp = ypart + (size_t)row * DM + col;
                    if (STEP == 1) { *(f32x4*)yp = g0 * acc[ai][bj][m][0]; *(f32x4*)(yp + 4) = g1 * acc[ai][bj][m][1]; }
                    else { const f32x4 v0 = *(const f32x4*)yp + g0 * acc[ai][bj][m][0], v1 = *(const f32x4*)(yp + 4) + g1 * acc[ai][bj][m][1];
                        v4u w; w.x = pk2(v0[0], v0[1]); w.y = pk2(v0[2], v0[3]); w.z = pk2(v1[0], v1[1]); w.w = pk2(v1[2], v1[3]);
                        *(v4u*)(y + (size_t)row * DM + col) = w; }
                }
            }
    }
};

struct SrcCol { const float* p; int col; };
template <class Map>
__device__ __forceinline__ void tr_item(int ldw, const float* gain, bf16* WT, int K, int nblk, int item, LAS float* scr, int lane, const Map& cm) {
    const int kb = item / nblk, nb = item % nblk, k0 = 64 * kb, n0 = 32 * nb;
    const SrcCol sc = cm(n0 + (lane & 31));
#pragma unroll 8
    for (int i = 0; i < 32; ++i) { const int kk = 2 * i + (lane >> 5); float v = 0.f;
        if (sc.col >= 0) { v = sc.p[(size_t)(k0 + kk) * ldw + sc.col]; if (gain) v *= gain[k0 + kk]; }
        scr[kk * 33 + (lane & 31)] = v; }
    LDS_WAIT();
    const int c = lane & 7;
#pragma unroll
    for (int j = 0; j < 4; ++j) { const int n = (lane >> 3) + 8 * j; const LAS float* s = scr + (8 * c) * 33 + n;
        v4u o; o.x = pk2(s[0 * 33], s[1 * 33]); o.y = pk2(s[2 * 33], s[3 * 33]); o.z = pk2(s[4 * 33], s[5 * 33]); o.w = pk2(s[6 * 33], s[7 * 33]);
        *(v4u*)(WT + (size_t)(n0 + n) * K + k0 + 8 * c) = o; }
    LDS_WAIT();
}
struct MapGU { const float* p; __device__ __forceinline__ SrcCol operator()(int n) const { return SrcCol{p, (n >> 8) * 128 + (n & 127)}; } };
struct MapId { const float* p; __device__ __forceinline__ SrcCol operator()(int n) const { return SrcCol{p, n}; } };
struct MapWin { const float* p; __device__ __forceinline__ SrcCol operator()(int n) const {
    const int t = n >> 8, r = n & 255; int c;
    if (t < T_KVA) c = SRC_QA + n; else if (t < T_QB) c = SRC_KVA + (n - T_KVA * 256); else if (t < T_KB) c = SRC_QB + (n - T_QB * 256); else if (t < T_VB) c = SRC_KB + (n - T_KB * 256);
    else if (t < T_RB) c = SRC_VB + (n - T_VB * 256); else if (t < T_GM) c = SRC_RB + (n - T_RB * 256); else if (t < T_MISC) c = SRC_GM + (n - T_GM * 256);
    else c = r < 24 ? SRC_GA + r : (r < 40 ? SRC_ALR + (r - 24) : -1);
    return SrcCol{p, c}; } };

__device__ __forceinline__ void phase_conv(Frame& F, const Args& a, int l) {
    relaunder(F);
    LAS float* scr = (LAS float*)(F.lds + RING_OFF + F.wave * 16384);
    const int gw = F.bid * NWAVES + F.wave, NGW = F.G * NWAVES;
    unsigned char* ws = F.ws;
    constexpr int I_GU = (DM / 64) * (NGU / 32), I_D = (FF / 64) * (DM / 32), I_IN = (DM / 64) * (NIN / 32), I_C1 = (2048 / 64) * (256 / 32), I_N = (512 / 64) * (DM / 32), I_SQ = (DM / 64) * (DM / 32);
    constexpr int NITEMS = 2 * I_GU + 2 * I_D + I_IN + 2 * I_C1 + I_N + 2 * I_SQ;
    const size_t oG = (size_t)l * DM * FF, oD = (size_t)l * FF * DM;
    for (int it = gw; it < NITEMS; it += NGW) {
        int r = it;
        if (r < I_GU) { const bool up = (((r % (NGU / 32)) * 32) & 255) >= 128;
            if (up) tr_item(FF, inp(F, I_F1N) + l * DM, (bf16*)(ws + W_GU1), DM, NGU / 32, r, scr, F.lane, MapGU{inp(F, I_F1U) + oG});
            else tr_item(FF, inp(F, I_F1N) + l * DM, (bf16*)(ws + W_GU1), DM, NGU / 32, r, scr, F.lane, MapGU{inp(F, I_F1G) + oG});
            continue; } r -= I_GU;
        if (r < I_GU) { const bool up = (((r % (NGU / 32)) * 32) & 255) >= 128;
            if (up) tr_item(FF, inp(F, I_F2N) + l * DM, (bf16*)(ws + W_GU2), DM, NGU / 32, r, scr, F.lane, MapGU{inp(F, I_F2U) + oG});
            else tr_item(FF, inp(F, I_F2N) + l * DM, (bf16*)(ws + W_GU2), DM, NGU / 32, r, scr, F.lane, MapGU{inp(F, I_F2G) + oG});
            continue; } r -= I_GU;
        if (r < I_D) { tr_item(DM, nullptr, (bf16*)(ws + W_D1), FF, DM / 32, r, scr, F.lane, MapId{inp(F, I_F1D) + oD}); continue; } r -= I_D;
        if (r < I_D) { tr_item(DM, nullptr, (bf16*)(ws + W_D2), FF, DM / 32, r, scr, F.lane, MapId{inp(F, I_F2D) + oD}); continue; } r -= I_D;
        if (r < I_IN) { tr_item(DIN, inp(F, I_MIXN) + l * DM, (bf16*)(ws + W_IN), DM, NIN / 32, r, scr, F.lane, MapWin{inp(F, I_WIN) + (size_t)l * DM * DIN}); continue; } r -= I_IN;
        if (r < I_C1) { tr_item(256, nullptr, (bf16*)(ws + W_C1K), 2048, 256 / 32, r, scr, F.lane, MapId{inp(F, I_CKW1) + (size_t)l * 2048 * 256}); continue; } r -= I_C1;
        if (r < I_C1) { tr_item(256, nullptr, (bf16*)(ws + W_C1V), 2048, 256 / 32, r, scr, F.lane, MapId{inp(F, I_CVW1) + (size_t)l * 2048 * 256}); continue; } r -= I_C1;
        if (r < I_N) { tr_item(DM, nullptr, (bf16*)(ws + W_N), 512, DM / 32, r, scr, F.lane, MapId{inp(F, I_WBN) + (size_t)l * 512 * DM}); continue; } r -= I_N;
        if (r < I_SQ) { tr_item(DM, inp(F, I_GON) + l * DM, (bf16*)(ws + W_G), DM, DM / 32, r, scr, F.lane, MapId{inp(F, I_WBG) + (size_t)l * DM * DM}); continue; } r -= I_SQ;
        tr_item(DM, nullptr, (bf16*)(ws + W_O), DM, DM / 32, r, scr, F.lane, MapId{inp(F, I_WOUT) + (size_t)l * DM * DM});
    }
    __syncthreads();
    if (F.bid < 32) {
        const int kv = F.bid >> 4, nb = (F.bid & 15) * 16, c = F.tid & 15, ks = F.tid >> 4;
        const float* pos = inp(F, kv ? I_POSV : I_POSK) + (size_t)l * 2048; const float* w1 = inp(F, kv ? I_CVW1 : I_CKW1) + (size_t)l * 2048 * 256;
        float s = 0.f;
        for (int k = ks * 64; k < ks * 64 + 64; ++k) s += pos[k] * w1[(size_t)k * 256 + nb + c];
        LAS float* red = (LAS float*)(F.lds + RING_OFF);
        red[F.tid] = s; __syncthreads();
        if (F.tid < 16) { float t = 0.f; for (int i = 0; i < 32; ++i) t += red[i * 16 + F.tid]; ((float*)(ws + WS_POSB))[kv * 256 + nb + F.tid] = t; }
        __syncthreads();
    }
}
__device__ __forceinline__ void phase_lut(Frame& F, const Args& a) {
    relaunder(F);
    float* lut = (float*)(F.ws + WS_LUT); const float* tab = inp(F, I_REL);
    for (int i = F.bid * 512 + F.tid; i < 8 * 4096; i += F.G * 512) {
        const int h = i >> 12, n = i & 4095; int bk;
        if (n < 16) bk = n; else { const float nf = (float)n; int lb = 16 + (int)(logf(nf / 16.0f) / 4.1588830833596715f * 16.0f); bk = lb < 31 ? lb : 31; }
        lut[i] = tab[bk * 8 + h];
    }
}
__device__ __forceinline__ void phase_x0(Frame& F, const Args& a) {
    relaunder(F);
    const int gw = F.bid * NWAVES + F.wave, NGW = F.G * NWAVES;
    bf16* xb = (bf16*)(F.ws + WS_XB); float* ssp = (float*)(F.ws + WS_SSP);
    for (int m = gw; m < MTOK; m += NGW) {
        const f32x4* xr = (const f32x4*)(inp(F, I_X) + (size_t)m * DM) + F.lane;
        v2u* o8 = (v2u*)(xb + (size_t)m * DM) + F.lane; float s = 0.f;
#pragma unroll
        for (int j = 0; j < 4; ++j) { const f32x4 v = xr[64 * j]; v2u w; w.x = pk2(v[0], v[1]); w.y = pk2(v[2], v[3]); o8[64 * j] = w; const float a0 = bflo(w.x), a1 = bfhi(w.x), a2 = bflo(w.y), a3 = bfhi(w.y); s += (a0 * a0 + a1 * a1) + (a2 * a2 + a3 * a3); }
        s = wave_sum(s);
        if (F.lane < 16) ssp[(size_t)m * 16 + F.lane] = F.lane == 0 ? s : 0.f;
    }
}
__device__ __forceinline__ void phase_final(Frame& F, const Args& a) {
    relaunder(F);
    const int gw = F.bid * NWAVES + F.wave, NGW = F.G * NWAVES; const f32x4* gn = (const f32x4*)inp(F, I_FIN) + F.lane;
    const bf16* xb = (const bf16*)(F.ws + WS_XB);
    for (int m = gw; m < MTOK; m += NGW) {
        const v2u* xr = (const v2u*)(xb + (size_t)m * DM) + F.lane; f32x4* orow = (f32x4*)(a.out + (size_t)m * DM) + F.lane; f32x4 v[4]; float s = 0.f;
#pragma unroll
        for (int j = 0; j < 4; ++j) { const v2u w = xr[64 * j]; v[j] = (f32x4){bflo(w.x), bfhi(w.x), bflo(w.y), bfhi(w.y)}; s += (v[j][0] * v[j][0] + v[j][1] * v[j][1]) + (v[j][2] * v[j][2] + v[j][3] * v[j][3]); }
        const float r = 1.0f / sqrtf(wave_sum(s) * (1.0f / DM) + EPSN);
#pragma unroll
        for (int j = 0; j < 4; ++j) orow[64 * j] = v[j] * r * gn[64 * j];
    }
}
__device__ __forceinline__ void phase_cmp2(Frame& F, const Args& a, int l) {
    relaunder(F);
    const int gw = F.bid * NWAVES + F.wave, NGW = F.G * NWAVES;
    const bf16* hid = (const bf16*)(F.ws + WS_HID); float* out = (float*)(F.ws + WS_KVCMP);
    for (int row = gw; row < 4096; row += NGW) {
        const int kv = row >> 11; const float* w2 = inp(F, kv ? I_CVW2 : I_CKW2) + (size_t)l * 256 * 64;
        const bf16* hr = hid + (size_t)row * 256; float s = 0.f;
        for (int k = 0; k < 256; k += 8) { const v4u hw = *(const v4u*)(hr + k);
            s += bflo(hw.x) * w2[(k + 0) * 64 + F.lane] + bfhi(hw.x) * w2[(k + 1) * 64 + F.lane] + bflo(hw.y) * w2[(k + 2) * 64 + F.lane] + bfhi(hw.y) * w2[(k + 3) * 64 + F.lane]
               + bflo(hw.z) * w2[(k + 4) * 64 + F.lane] + bfhi(hw.z) * w2[(k + 5) * 64 + F.lane] + bflo(hw.w) * w2[(k + 6) * 64 + F.lane] + bfhi(hw.w) * w2[(k + 7) * 64 + F.lane]; }
        out[(size_t)row * 64 + F.lane] = s; ((bf16*)(F.ws + WS_KVCMPB))[(size_t)row * 64 + F.lane] = (bf16)f2bf(s);
    }
}

__device__ __forceinline__ void dot4_bf16(const bf16* kp, const LAS float* qs, float (&s)[4]) {
    s[0] = s[1] = s[2] = s[3] = 0.f;
#pragma unroll 2
    for (int c = 0; c < 8; ++c) { const v4u kw = *(const v4u*)(kp + c * 8);
        const float kf[8] = {bflo(kw.x), bfhi(kw.x), bflo(kw.y), bfhi(kw.y), bflo(kw.z), bfhi(kw.z), bflo(kw.w), bfhi(kw.w)};
#pragma unroll
        for (int h = 0; h < 4; ++h) { const f32x4 q0 = *(const LAS f32x4*)(qs + h * 64 + c * 8), q1 = *(const LAS f32x4*)(qs + h * 64 + c * 8 + 4);
            s[h] += (kf[0] * q0[0] + kf[1] * q0[1]) + (kf[2] * q0[2] + kf[3] * q0[3]) + (kf[4] * q1[0] + kf[5] * q1[1]) + (kf[6] * q1[2] + kf[7] * q1[3]); } }
}
__device__ __forceinline__ void dot4_f32(const float* kp, const LAS float* qs, float (&s)[4]) {
    s[0] = s[1] = s[2] = s[3] = 0.f;
#pragma unroll 4
    for (int c = 0; c < 16; ++c) { const f32x4 kf = *(const f32x4*)(kp + c * 4);
#pragma unroll
        for (int h = 0; h < 4; ++h) { const f32x4 q0 = *(const LAS f32x4*)(qs + h * 64 + c * 4); s[h] += (kf[0] * q0[0] + kf[1] * q0[1]) + (kf[2] * q0[2] + kf[3] * q0[3]); } }
}
__device__ __forceinline__ void online_block(const float (&s)[4], bool kvalid, const bf16* vp, int vld, LAS float* ps, int lane, float (&m)[4], float (&lsum)[4], float (&o)[4]) {
    float p[4];
#pragma unroll
    for (int h = 0; h < 4; ++h) {
        const float sm = wave_max(kvalid ? s[h] : -INFINITY), mn = fmaxf(m[h], sm);
        const float sc = (m[h] == -INFINITY) ? 0.f : __expf(m[h] - mn);
        p[h] = (kvalid && mn > -INFINITY) ? __expf(s[h] - mn) : 0.f;
        lsum[h] = lsum[h] * sc + wave_sum(p[h]); o[h] *= sc; m[h] = mn;
    }
    *(LAS f32x4*)(ps + lane * 4) = (f32x4){p[0], p[1], p[2], p[3]};
    LDS_WAIT();
#pragma unroll 8
    for (int k = 0; k < 64; ++k) { const f32x4 pv = *(const LAS f32x4*)(ps + k * 4); const float v = bf2f(vp[(size_t)k * vld + lane]);
        o[0] += pv[0] * v; o[1] += pv[1] * v; o[2] += pv[2] * v; o[3] += pv[3] * v; }
    LDS_WAIT();
}
__device__ __forceinline__ void phase_nsa_naive(Frame& F) {
    relaunder(F);
    LAS float* wl = (LAS float*)(F.lds + RING_OFF + F.wave * 16384);
    LAS float* qs = wl; LAS float* ps = wl + 256; LAS float* psum = wl + 512; LAS float* scl = wl + 1024;
    const bf16* qa = (const bf16*)(F.ws + WS_QA); const bf16* kvs = (const bf16*)(F.ws + WS_KVS); const float* ga = (const float*)(F.ws + WS_GA);
    const float* kvcmp = (const float*)(F.ws + WS_KVCMP); const float* lut = (const float*)(F.ws + WS_LUT); bf16* oa = (bf16*)(F.ws + WS_OA);
    const int lane = F.lane;
    for (int wt = F.bid; wt < 4096; wt += F.G) {
        const int bg = wt & 7, tb = wt >> 3, b = bg >> 1, g = bg & 1, t = tb * 8 + F.wave, row = b * SEQ + t, jcur = t >> 6;
        const float* lutg = lut + (size_t)(g * 4) * 4096;
#pragma unroll
        for (int h = 0; h < 4; ++h) qs[h * 64 + lane] = bf2f(qa[(size_t)row * 512 + (g * 4 + h) * 64 + lane]);
        LDS_WAIT();
        float gate[4][3];
#pragma unroll
        for (int h = 0; h < 4; ++h)
#pragma unroll
            for (int br = 0; br < 3; ++br) gate[h][br] = ga[(size_t)row * 24 + (g * 4 + h) * 3 + br];
        float oacc[4] = {0.f, 0.f, 0.f, 0.f};
        const int ncv = t >= 31 ? ((t - 31) >> 4) + 1 : 0;
        float imp = 0.f;
        if (ncv > 0) {
            const float* kc = kvcmp + (size_t)(0 * 8 + bg) * 256 * 64; const float* vc = kvcmp + (size_t)(1 * 8 + bg) * 256 * 64;
            float mx[4] = {-INFINITY, -INFINITY, -INFINITY, -INFINITY};
            const int nblk = (ncv + 63) >> 6;
#pragma unroll 1
            for (int blk = 0; blk < nblk; ++blk) {
                const int c = blk * 64 + lane; const bool valid = c < ncv;
                float s[4]; dot4_f32(kc + (size_t)(c < 255 ? c : 255) * 64, qs, s);
                const int dist = valid ? t - (16 * c + 31) : 0;
#pragma unroll
                for (int h = 0; h < 4; ++h) { const float v = valid ? s[h] + lutg[h * 4096 + dist] : -INFINITY; scl[h * 256 + c] = v; mx[h] = fmaxf(mx[h], v); }
            }
            float ls[4] = {0.f, 0.f, 0.f, 0.f};
#pragma unroll
            for (int h = 0; h < 4; ++h) mx[h] = wave_max(mx[h]);
            LDS_WAIT();
#pragma unroll 1
            for (int blk = 0; blk < nblk; ++blk) {
                const int c = blk * 64 + lane;
#pragma unroll
                for (int h = 0; h < 4; ++h) { const float v = scl[h * 256 + c]; const float p = v > -INFINITY ? __expf(v - mx[h]) : 0.f; scl[h * 256 + c] = p; ls[h] += p; }
            }
#pragma unroll
            for (int h = 0; h < 4; ++h) ls[h] = 1.0f / wave_sum(ls[h]);
            LDS_WAIT();
            float oc[4] = {0.f, 0.f, 0.f, 0.f};
#pragma unroll 1
            for (int blk = 0; blk < 4; ++blk) {
                const int c = blk * 64 + lane; float pt = 0.f;
                if (blk < nblk) {
#pragma unroll
                    for (int h = 0; h < 4; ++h) { const float p = scl[h * 256 + c] * ls[h]; scl[h * 256 + c] = p; pt += p; }
                }
                psum[c] = pt;
            }
            LDS_WAIT();
#pragma unroll 2
            for (int k = 0; k < ncv; ++k) { const float v = vc[(size_t)k * 64 + lane];
                oc[0] += scl[k] * v; oc[1] += scl[256 + k] * v; oc[2] += scl[512 + k] * v; oc[3] += scl[768 + k] * v; }
#pragma unroll
            for (int i = -1; i <= 3; ++i) { const int c = 4 * lane + i; if (c >= 0 && c < 255) imp += psum[c]; }
#pragma unroll
            for (int h = 0; h < 4; ++h) oacc[h] += gate[h][0] * oc[h];
            LDS_WAIT();
        }
        const bool forced = (lane == 0) || (lane == jcur) || (lane == jcur - 1);
        const float score = forced ? 1e6f : (lane <= jcur ? imp : -1e6f);
        int rank = 0;
#pragma unroll 4
        for (int s2 = 0; s2 < 64; ++s2) { const float v2 = __shfl(score, s2); rank += (v2 > score || (v2 == score && s2 < lane)) ? 1 : 0; }
        unsigned long long selmask = __ballot(rank < 16);
        selmask &= (jcur == 63) ? ~0ull : ((1ull << (jcur + 1)) - 1ull);
        {
            float m[4] = {-INFINITY, -INFINITY, -INFINITY, -INFINITY}, lsum[4] = {0.f, 0.f, 0.f, 0.f}, o[4] = {0.f, 0.f, 0.f, 0.f};
#pragma unroll 1
            while (selmask) {
                const int j = __builtin_ctzll(selmask); selmask &= selmask - 1ull;
                const int pos = j * 64 + lane; const bool kvalid = pos <= t;
                float s[4]; dot4_bf16(kvs + (size_t)(b * SEQ + pos) * 512 + 0 * 128 + g * 64, qs, s);
                if (kvalid) {
#pragma unroll
                    for (int h = 0; h < 4; ++h) s[h] += lutg[h * 4096 + (t - pos)];
                }
                online_block(s, kvalid, kvs + (size_t)(b * SEQ + j * 64) * 512 + 1 * 128 + g * 64, 512, ps, lane, m, lsum, o);
            }
#pragma unroll
            for (int h = 0; h < 4; ++h) oacc[h] += gate[h][1] * o[h] / lsum[h];
        }
        {
            float m[4] = {-INFINITY, -INFINITY, -INFINITY, -INFINITY}, lsum[4] = {0.f, 0.f, 0.f, 0.f}, o[4] = {0.f, 0.f, 0.f, 0.f};
            const int lo = t - 511 > 0 ? t - 511 : 0;
#pragma unroll 1
            for (int j = lo >> 6; j <= jcur; ++j) {
                const int pos = j * 64 + lane; const bool kvalid = pos <= t && pos >= lo;
                float s[4]; dot4_bf16(kvs + (size_t)(b * SEQ + pos) * 512 + 2 * 128 + g * 64, qs, s);
                if (kvalid) {
#pragma unroll
                    for (int h = 0; h < 4; ++h) s[h] += lutg[h * 4096 + (t - pos)];
                }
                online_block(s, kvalid, kvs + (size_t)(b * SEQ + j * 64) * 512 + 3 * 128 + g * 64, 512, ps, lane, m, lsum, o);
            }
#pragma unroll
            for (int h = 0; h < 4; ++h) oacc[h] += gate[h][2] * o[h] / lsum[h];
        }
#pragma unroll
        for (int h = 0; h < 4; ++h) oa[(size_t)row * 512 + (g * 4 + h) * 64 + lane] = (bf16)f2bf(oacc[h]);
        LDS_WAIT();
    }
}


typedef float f32x16 __attribute__((ext_vector_type(16)));
typedef short v4i16_t __attribute__((ext_vector_type(4)));
constexpr int NSA_TS = 144;
constexpr int NL_K = 0, NL_V = 9216, NL_LUT = 18432, NL_IMP = NL_LUT + 32768, NL_SEL = NL_IMP + 4 * 64 * 65 * 4, NL_END = NL_SEL + 512;
static_assert(NL_END <= RING_BYTES, "nsa lds");
#define KLOC(i) (((i) & 3) + 8 * ((i) >> 2) + 4 * hf)

__device__ __forceinline__ void nsa_qk(const LAS unsigned char* Kt, const bf16x8 (&qf)[4], int r32, int hf, f32x16& p0, f32x16& p1) {
#pragma unroll
    for (int i = 0; i < 16; ++i) { p0[i] = 0.f; p1[i] = 0.f; }
#pragma unroll
    for (int ks = 0; ks < 4; ++ks) {
        const bf16x8 a0 = *(const LAS bf16x8*)(Kt + r32 * NSA_TS + ks * 32 + hf * 16);
        const bf16x8 a1 = *(const LAS bf16x8*)(Kt + (32 + r32) * NSA_TS + ks * 32 + hf * 16);
        p0 = __builtin_amdgcn_mfma_f32_32x32x16_bf16(a0, qf[ks], p0, 0, 0, 0);
        p1 = __builtin_amdgcn_mfma_f32_32x32x16_bf16(a1, qf[ks], p1, 0, 0, 0);
    }
}
__device__ __forceinline__ bf16x8 nsa_pack(const f32x16& p, const int s) {
    v4u w; w.x = pk2(p[8 * s + 0], p[8 * s + 1]); w.y = pk2(p[8 * s + 2], p[8 * s + 3]); w.z = pk2(p[8 * s + 4], p[8 * s + 5]); w.w = pk2(p[8 * s + 6], p[8 * s + 7]);
    return __builtin_bit_cast(bf16x8, w);
}
__device__ __forceinline__ void nsa_pv(const LAS unsigned char* Vt, const f32x16& p0, const f32x16& p1, int lane, int hf, f32x16 (&o)[2]) {
    bf16x8 pb[4]; pb[0] = nsa_pack(p0, 0); pb[1] = nsa_pack(p0, 1); pb[2] = nsa_pack(p1, 0); pb[3] = nsa_pack(p1, 1);
    const LAS unsigned char* base = Vt + (4 * hf + ((lane & 15) >> 2)) * NSA_TS + (16 * ((lane >> 4) & 1) + 4 * (lane & 3)) * 2;
#pragma unroll
    for (int dt = 0; dt < 2; ++dt)
#pragma unroll
        for (int ks = 0; ks < 4; ++ks) {
            const LAS unsigned char* ap = base + (16 * ks) * NSA_TS + dt * 64;
            const v4i16_t lo = __builtin_amdgcn_ds_read_tr16_b64_v4i16((LAS v4i16_t*)ap);
            const v4i16_t hi = __builtin_amdgcn_ds_read_tr16_b64_v4i16((LAS v4i16_t*)(ap + 8 * NSA_TS));
            const bf16x8 a = {lo[0], lo[1], lo[2], lo[3], hi[0], hi[1], hi[2], hi[3]};
            o[dt] = __builtin_amdgcn_mfma_f32_32x32x16_bf16(a, pb[ks], o[dt], 0, 0, 0);
        }
}
__device__ __forceinline__ void nsa_online(f32x16& p0, f32x16& p1, float& m, float& l, f32x16 (&o)[2]) {
    float bm = -INFINITY;
#pragma unroll
    for (int i = 0; i < 16; ++i) bm = fmaxf(bm, fmaxf(p0[i], p1[i]));
    bm = fmaxf(bm, __shfl_xor(bm, 32));
    const float mn = fmaxf(m, bm), mref = (mn == -INFINITY) ? 0.f : mn, sc = __expf(m - mref);
    float ps = 0.f;
#pragma unroll
    for (int i = 0; i < 16; ++i) { p0[i] = __expf(p0[i] - mref); p1[i] = __expf(p1[i] - mref); ps += p0[i] + p1[i]; }
    l = l * sc + ps; m = mn;
#pragma unroll
    for (int i = 0; i < 16; ++i) { o[0][i] *= sc; o[1][i] *= sc; }
}
__device__ __forceinline__ v4u nsa_ld16(const bf16* p) { return *(const v4u*)p; }

__device__ __forceinline__ void phase_nsa(Frame& F) {
    relaunder(F);
    LAS unsigned char* L = F.lds + RING_OFF;
    LAS unsigned char* Kt = L + NL_K; LAS unsigned char* Vt = L + NL_V;
    LAS float* lutL = (LAS float*)(L + NL_LUT); LAS float* impL = (LAS float*)(L + NL_IMP); LAS unsigned long long* selL = (LAS unsigned long long*)(L + NL_SEL);
    const bf16* qa = (const bf16*)(F.ws + WS_QA); const bf16* kvs = (const bf16*)(F.ws + WS_KVS); const float* ga = (const float*)(F.ws + WS_GA);
    const bf16* kvcb = (const bf16*)(F.ws + WS_KVCMPB); const float* lut = (const float*)(F.ws + WS_LUT); bf16* oa = (bf16*)(F.ws + WS_OA);
    const int tid = F.tid, lane = F.lane, wave = F.wave, r32 = lane & 31, hf = lane >> 5, hh = wave >> 1, qh = wave & 1;
    const int srow = tid >> 3, schunk = tid & 7;
    const int soff = srow * NSA_TS + schunk * 16;
    for (int i = tid; i < 8 * 1024; i += 512) lutL[i] = lut[(i >> 10) * 4096 + (i & 1023)];
    __syncthreads();
    for (int ui = 0; ui < 2; ++ui) {
        const int w = F.bid, bg = w & 7, a_ = (w >> 3) & 31, cq = ui == 0 ? 63 - a_ : a_;
        if (w >= 256) break;
        const int b = bg >> 1, g = bg & 1, head = g * 4 + hh, tq = cq * 64 + qh * 32 + r32;
        const size_t qrow = (size_t)b * SEQ + tq;
        const LAS float* lutH = lutL + head * 1024;
        bf16x8 qf[4];
#pragma unroll
        for (int ks = 0; ks < 4; ++ks) qf[ks] = *(const bf16x8*)(qa + qrow * 512 + head * 64 + ks * 16 + hf * 8);
        const float g_cmp = ga[qrow * 24 + head * 3 + 0], g_slc = ga[qrow * 24 + head * 3 + 1], g_win = ga[qrow * 24 + head * 3 + 2];
        f32x16 oc[2];
#pragma unroll
        for (int i = 0; i < 16; ++i) { oc[0][i] = 0.f; oc[1][i] = 0.f; }
        for (int i = tid; i < 4 * 64 * 65; i += 512) impL[i] = 0.f;
        const bf16* kc = kvcb + (size_t)(0 * 8 + bg) * 256 * 64; const bf16* vc = kvcb + (size_t)(1 * 8 + bg) * 256 * 64;
        const int ncb = (4 * cq + 2) / 64 + 1;
        float m = -INFINITY, l = 0.f;
        f32x16 p0, p1, o[2];
        for (int cb = 0; cb < ncb; ++cb) {
            __syncthreads();
            *(LAS v4u*)(Kt + soff) = nsa_ld16(kc + (size_t)(cb * 64 + srow) * 64 + schunk * 8);
            __syncthreads();
            nsa_qk(Kt, qf, r32, hf, p0, p1);
#pragma unroll
            for (int i = 0; i < 16; ++i) {
                const int d0 = tq - 31 - 16 * (cb * 64 + KLOC(i)), d1 = d0 - 512;
                p0[i] = d0 >= 0 ? p0[i] + lutH[d0 > 1023 ? 1023 : (d0 < 0 ? 0 : d0)] : -INFINITY;
                p1[i] = d1 >= 0 ? p1[i] + lutH[d1 > 1023 ? 1023 : (d1 < 0 ? 0 : d1)] : -INFINITY;
            }
            float bm = -INFINITY;
#pragma unroll
            for (int i = 0; i < 16; ++i) bm = fmaxf(bm, fmaxf(p0[i], p1[i]));
            bm = fmaxf(bm, __shfl_xor(bm, 32));
            const float mn = fmaxf(m, bm), mref = (mn == -INFINITY) ? 0.f : mn;
            float ps = 0.f;
#pragma unroll
            for (int i = 0; i < 16; ++i) ps += __expf(p0[i] - mref) + __expf(p1[i] - mref);
            l = l * __expf(m - mref) + ps; m = mn;
        }
        {
            const float lt = l + __shfl_xor(l, 32), invl = lt > 0.f ? 1.0f / lt : 0.f, mref = (m == -INFINITY) ? 0.f : m;
#pragma unroll
            for (int i = 0; i < 16; ++i) { o[0][i] = 0.f; o[1][i] = 0.f; }
            LAS float* impH = impL + hh * (64 * 65) + (qh * 32 + r32) * 65;
            for (int cb = 0; cb < ncb; ++cb) {
                __syncthreads();
                *(LAS v4u*)(Kt + soff) = nsa_ld16(kc + (size_t)(cb * 64 + srow) * 64 + schunk * 8);
                *(LAS v4u*)(Vt + soff) = nsa_ld16(vc + (size_t)(cb * 64 + srow) * 64 + schunk * 8);
                __syncthreads();
                nsa_qk(Kt, qf, r32, hf, p0, p1);
#pragma unroll
                for (int i = 0; i < 16; ++i) {
                    const int d0 = tq - 31 - 16 * (cb * 64 + KLOC(i)), d1 = d0 - 512;
                    p0[i] = d0 >= 0 ? __expf(p0[i] + lutH[d0 > 1023 ? 1023 : (d0 < 0 ? 0 : d0)] - mref) * invl : 0.f;
                    p1[i] = d1 >= 0 ? __expf(p1[i] + lutH[d1 > 1023 ? 1023 : (d1 < 0 ? 0 : d1)] - mref) * invl : 0.f;
                }
#pragma unroll
                for (int g4 = 0; g4 < 4; ++g4) {
                    const int u0 = cb * 16 + 2 * g4 + hf, u1 = u0 + 8;
                    impH[u0] += (p0[4 * g4] + p0[4 * g4 + 1]) + (p0[4 * g4 + 2] + p0[4 * g4 + 3]);
                    impH[u1] += (p1[4 * g4] + p1[4 * g4 + 1]) + (p1[4 * g4 + 2] + p1[4 * g4 + 3]);
                }
                LDS_WAIT();
#pragma unroll
                for (int g4 = 0; g4 < 4; ++g4) {
                    const int u0 = cb * 16 + 2 * g4 + hf + 1, u1 = u0 + 8;
                    if (u0 < 64) impH[u0] += p0[4 * g4 + 3];
                    if (u1 < 64) impH[u1] += p1[4 * g4 + 3];
                }
                nsa_pv(Vt, p0, p1, lane, hf, o);
            }
#pragma unroll
            for (int i = 0; i < 16; ++i) { oc[0][i] += g_cmp * o[0][i]; oc[1][i] += g_cmp * o[1][i]; }
        }
        __syncthreads();
        {
            const int q = tid >> 3, sub = tid & 7; float v[8];
#pragma unroll
            for (int k = 0; k < 8; ++k) { const int s = sub * 8 + k; const int idx = q * 65 + s;
                const float im = ((impL[idx] + impL[64 * 65 + idx]) + impL[2 * 64 * 65 + idx]) + impL[3 * 64 * 65 + idx];
                v[k] = (s == 0 || s == cq || s == cq - 1) ? 1e6f : (s <= cq ? im : -1e6f); }
            __syncthreads();
#pragma unroll
            for (int k = 0; k < 8; ++k) impL[q * 65 + sub * 8 + k] = v[k];
            __syncthreads();
            int cnt[8];
#pragma unroll
            for (int k = 0; k < 8; ++k) cnt[k] = 0;
#pragma unroll 4
            for (int s2 = 0; s2 < 64; ++s2) { const float x = impL[q * 65 + s2];
#pragma unroll
                for (int k = 0; k < 8; ++k) cnt[k] += (x > v[k] || (x == v[k] && s2 < sub * 8 + k)) ? 1 : 0; }
            unsigned byte = 0;
#pragma unroll
            for (int k = 0; k < 8; ++k) byte |= (cnt[k] < 16 ? 1u : 0u) << k;
            ((LAS unsigned char*)selL)[q * 8 + sub] = (unsigned char)byte;
        }
        __syncthreads();
        const unsigned long long vmask = (cq == 63) ? ~0ull : ((1ull << (cq + 1)) - 1ull);
        const unsigned long long mysel = selL[qh * 32 + r32] & vmask;
        unsigned long long U = selL[lane] & vmask;
#pragma unroll
        for (int off = 1; off < 64; off <<= 1) { const unsigned lo_ = __shfl_xor((unsigned)U, off), hi_ = __shfl_xor((unsigned)(U >> 32), off); U |= ((unsigned long long)hi_ << 32) | lo_; }
        U = ((unsigned long long)(unsigned)__builtin_amdgcn_readfirstlane((unsigned)(U >> 32)) << 32) | (unsigned)__builtin_amdgcn_readfirstlane((unsigned)U);
        LAS float* ocL = impL + wave * 2048 + lane;
#pragma unroll
        for (int i = 0; i < 16; ++i) { ocL[i * 64] = oc[0][i]; ocL[(16 + i) * 64] = oc[1][i]; }
        {
            m = -INFINITY; l = 0.f;
#pragma unroll
            for (int i = 0; i < 16; ++i) { o[0][i] = 0.f; o[1][i] = 0.f; }
            unsigned long long rem = U;
            int j = __builtin_ctzll(rem); rem &= rem - 1ull;
            v4u kreg = nsa_ld16(kvs + ((size_t)b * SEQ + j * 64 + srow) * 512 + 0 * 128 + g * 64 + schunk * 8);
            v4u vreg = nsa_ld16(kvs + ((size_t)b * SEQ + j * 64 + srow) * 512 + 1 * 128 + g * 64 + schunk * 8);
            for (;;) {
                __syncthreads();
                *(LAS v4u*)(Kt + soff) = kreg; *(LAS v4u*)(Vt + soff) = vreg;
                __syncthreads();
                const int jc = j; const bool more = rem != 0ull;
                if (more) { j = __builtin_ctzll(rem); rem &= rem - 1ull;
                    kreg = nsa_ld16(kvs + ((size_t)b * SEQ + j * 64 + srow) * 512 + 0 * 128 + g * 64 + schunk * 8);
                    vreg = nsa_ld16(kvs + ((size_t)b * SEQ + j * 64 + srow) * 512 + 1 * 128 + g * 64 + schunk * 8); }
                nsa_qk(Kt, qf, r32, hf, p0, p1);
                const bool sel = (mysel >> jc) & 1ull;
                if (cq - jc >= 14) {
                    const float bias = lutH[1023];
#pragma unroll
                    for (int i = 0; i < 16; ++i) { p0[i] = sel ? p0[i] + bias : -INFINITY; p1[i] = sel ? p1[i] + bias : -INFINITY; }
                } else {
                    const int dbase = tq - jc * 64;
#pragma unroll
                    for (int i = 0; i < 16; ++i) { const int d0 = dbase - KLOC(i), d1 = d0 - 32;
                        p0[i] = (sel && d0 >= 0) ? p0[i] + lutH[d0 < 0 ? 0 : d0] : -INFINITY;
                        p1[i] = (sel && d1 >= 0) ? p1[i] + lutH[d1 < 0 ? 0 : d1] : -INFINITY; }
                }
                nsa_online(p0, p1, m, l, o);
                nsa_pv(Vt, p0, p1, lane, hf, o);
                if (!more) break;
            }
            const float lt = l + __shfl_xor(l, 32), sc = g_slc / lt;
#pragma unroll
            for (int i = 0; i < 16; ++i) { ocL[i * 64] += sc * o[0][i]; ocL[(16 + i) * 64] += sc * o[1][i]; }
        }
        {
            m = -INFINITY; l = 0.f;
#pragma unroll
            for (int i = 0; i < 16; ++i) { o[0][i] = 0.f; o[1][i] = 0.f; }
            int j = cq - 8 > 0 ? cq - 8 : 0;
            v4u kreg = nsa_ld16(kvs + ((size_t)b * SEQ + j * 64 + srow) * 512 + 2 * 128 + g * 64 + schunk * 8);
            v4u vreg = nsa_ld16(kvs + ((size_t)b * SEQ + j * 64 + srow) * 512 + 3 * 128 + g * 64 + schunk * 8);
            for (;;) {
                __syncthreads();
                *(LAS v4u*)(Kt + soff) = kreg; *(LAS v4u*)(Vt + soff) = vreg;
                __syncthreads();
                const int jc = j; const bool more = jc < cq;
                if (more) { j = jc + 1;
                    kreg = nsa_ld16(kvs + ((size_t)b * SEQ + j * 64 + srow) * 512 + 2 * 128 + g * 64 + schunk * 8);
                    vreg = nsa_ld16(kvs + ((size_t)b * SEQ + j * 64 + srow) * 512 + 3 * 128 + g * 64 + schunk * 8); }
                nsa_qk(Kt, qf, r32, hf, p0, p1);
                const int dbase = tq - jc * 64;
#pragma unroll
                for (int i = 0; i < 16; ++i) { const int d0 = dbase - KLOC(i), d1 = d0 - 32;
                    p0[i] = (d0 >= 0 && d0 < 512) ? p0[i] + lutH[d0 < 0 ? 0 : d0] : -INFINITY;
                    p1[i] = (d1 >= 0 && d1 < 512) ? p1[i] + lutH[d1 < 0 ? 0 : d1] : -INFINITY; }
                nsa_online(p0, p1, m, l, o);
                nsa_pv(Vt, p0, p1, lane, hf, o);
                if (!more) break;
            }
            const float lt = l + __shfl_xor(l, 32), sc = g_win / lt;
#pragma unroll
            for (int i = 0; i < 16; ++i) { oc[0][i] = ocL[i * 64] + sc * o[0][i]; oc[1][i] = ocL[(16 + i) * 64] + sc * o[1][i]; }
        }
#pragma unroll
        for (int dt = 0; dt < 2; ++dt)
#pragma unroll
            for (int g4 = 0; g4 < 4; ++g4) { v2u wv; wv.x = pk2(oc[dt][4 * g4], oc[dt][4 * g4 + 1]); wv.y = pk2(oc[dt][4 * g4 + 2], oc[dt][4 * g4 + 3]);
                *(v2u*)(oa + qrow * 512 + head * 64 + dt * 32 + 8 * g4 + 4 * hf) = wv; }
        __syncthreads();
    }
}
#undef KLOC


constexpr int GV_TS = 576;
constexpr int GL_V = 0, GL_KST = GL_V + 64 * GV_TS, GL_GS = GL_KST + 128 * 144, GL_ST = GL_GS + 2048, GL_END1 = GL_ST + 256 * 264;
static_assert(GL_END1 <= RING_BYTES, "gla lds");
__device__ __forceinline__ float log_sigmoid_(float z) { return fminf(z, 0.f) - log1pf(__expf(-fabsf(z))); }

__device__ __forceinline__ void gla_stage_v(Frame& F, LAS unsigned char* L, const bf16* vb, size_t row0, int h) {
#pragma unroll
    for (int i = 0; i < 4; ++i) { const int idx = F.tid + 512 * i, r = idx >> 5, c = idx & 31;
        *(LAS v4u*)(L + GL_V + r * GV_TS + c * 16) = *(const v4u*)(vb + (row0 + r) * 1024 + h * 256 + c * 8); }
}
__device__ __forceinline__ void phase_gla1(Frame& F, int l) {
    relaunder(F);
    LAS unsigned char* L = F.lds + RING_OFF;
    bf16* qb = (bf16*)(F.ws + WS_QB); bf16* kb = (bf16*)(F.ws + WS_KB); const bf16* vb = (const bf16*)(F.ws + WS_VB);
    const float* alr = (const float*)(F.ws + WS_ALR); bf16* gst = (bf16*)(F.ws + WS_GST); float* decay = (float*)(F.ws + WS_DECAY);
    const int tid = F.tid, lane = F.lane, wave = F.wave, r32 = lane & 31, hf = lane >> 5;
    const int d = tid & 127, tg = tid >> 7;
    LAS float* gs = (LAS float*)(L + GL_GS);
    for (int u = F.bid - 16; u < 1024; u += F.G - 16) {
        const int bh = u >> 6, n = u & 63, b = bh >> 2, h = bh & 3; const size_t row0 = (size_t)b * SEQ + n * 64;
        float w2r[16];
#pragma unroll
        for (int r = 0; r < 16; ++r) w2r[r] = inp(F, I_AW2)[(size_t)l * 16 * 512 + r * 512 + h * 128 + d];
        const float ab = inp(F, I_AB)[l * 512 + h * 128 + d];
        gla_stage_v(F, L, vb, row0, h);
        float bl[16]; float cum = 0.f;
#pragma unroll
        for (int i = 0; i < 16; ++i) { const f32x4* ar = (const f32x4*)(alr + (row0 + tg * 16 + i) * 16); float z = ab;
#pragma unroll
            for (int q = 0; q < 4; ++q) { const f32x4 av = ar[q]; z += av[0] * w2r[4 * q] + av[1] * w2r[4 * q + 1] + av[2] * w2r[4 * q + 2] + av[3] * w2r[4 * q + 3]; }
            cum += log_sigmoid_(z) * (1.0f / 16.0f); bl[i] = cum; }
        gs[tg * 128 + d] = cum;
        __syncthreads();
        float pre = 0.f, tot = 0.f;
#pragma unroll
        for (int g2 = 0; g2 < 4; ++g2) { const float x = gs[g2 * 128 + d]; tot += x; if (g2 < tg) pre += x; }
        if (tg == 0) decay[(size_t)u * 128 + d] = __expf(tot);
        unsigned ks[8];
#pragma unroll
        for (int i = 0; i < 16; i += 2) {
            float kst[2];
#pragma unroll
            for (int e = 0; e < 2; ++e) { const size_t a = (row0 + tg * 16 + i + e) * 512 + h * 128 + d; const float bb = bl[i + e] + pre;
                const float qv = bf2f(qb[a]), kv = bf2f(kb[a]);
                qb[a] = (bf16)f2bf(qv * __expf(bb)); kb[a] = (bf16)f2bf(kv * __expf(-bb)); kst[e] = kv * __expf(tot - bb); }
            ks[i >> 1] = pk2(kst[0], kst[1]);
        }
        *(LAS v4u*)(L + GL_KST + d * 144 + tg * 32) = (v4u){ks[0], ks[1], ks[2], ks[3]};
        *(LAS v4u*)(L + GL_KST + d * 144 + tg * 32 + 16) = (v4u){ks[4], ks[5], ks[6], ks[7]};
        __syncthreads();
        {
            const int dkb = wave & 3, dvh = wave >> 2;
            f32x16 acc[4];
#pragma unroll
            for (int t4 = 0; t4 < 4; ++t4)
#pragma unroll
                for (int i = 0; i < 16; ++i) acc[t4][i] = 0.f;
            const LAS unsigned char* vbase = L + GL_V + (8 * hf + ((lane & 15) >> 2)) * GV_TS + (dvh * 128 + 16 * ((lane >> 4) & 1) + 4 * (lane & 3)) * 2;
#pragma unroll
            for (int kk = 0; kk < 4; ++kk) {
                const bf16x8 a = *(const LAS bf16x8*)(L + GL_KST + (dkb * 32 + r32) * 144 + kk * 32 + hf * 16);
#pragma unroll
                for (int t4 = 0; t4 < 4; ++t4) {
                    const LAS unsigned char* bp = vbase + (16 * kk) * GV_TS + t4 * 64;
                    const v4i16_t lo = __builtin_amdgcn_ds_read_tr16_b64_v4i16((LAS v4i16_t*)bp);
                    const v4i16_t hi = __builtin_amdgcn_ds_read_tr16_b64_v4i16((LAS v4i16_t*)(bp + 4 * GV_TS));
                    const bf16x8 bv = {lo[0], lo[1], lo[2], lo[3], hi[0], hi[1], hi[2], hi[3]};
                    acc[t4] = __builtin_amdgcn_mfma_f32_32x32x16_bf16(a, bv, acc[t4], 0, 0, 0);
                }
            }
#pragma unroll
            for (int t4 = 0; t4 < 4; ++t4)
#pragma unroll
                for (int g4 = 0; g4 < 4; ++g4) { v2u wv; wv.x = pk2(acc[t4][4 * g4], acc[t4][4 * g4 + 1]); wv.y = pk2(acc[t4][4 * g4 + 2], acc[t4][4 * g4 + 3]);
                    *(LAS v2u*)(L + GL_ST + (dvh * 128 + t4 * 32 + r32) * 264 + (dkb * 32 + 8 * g4 + 4 * hf) * 2) = wv; }
        }
        __syncthreads();
        {
            bf16* dst = gst + (size_t)u * 32768;
#pragma unroll
            for (int i = 0; i < 8; ++i) { const int idx = tid + 512 * i, r = idx >> 4, c = idx & 15;
                const v2u x0 = *(const LAS v2u*)(L + GL_ST + r * 264 + c * 16), x1 = *(const LAS v2u*)(L + GL_ST + r * 264 + c * 16 + 8);
                *(v4u*)(dst + (size_t)r * 128 + c * 8) = (v4u){x0.x, x0.y, x1.x, x1.y}; }
        }
        __syncthreads();
    }
}
__device__ __forceinline__ void phase_gla2(Frame& F) {
    relaunder(F);
    bf16* gst = (bf16*)(F.ws + WS_GST); const float* decay = (const float*)(F.ws + WS_DECAY);
    for (int e = F.bid * 512 + F.tid; e < 16 * 8192; e += F.G * 512) {
        const int bh = e >> 13, off = (e & 8191) * 4, dk0 = off & 127;
        f32x4 S = {0.f, 0.f, 0.f, 0.f};
#pragma unroll 8
        for (int n = 0; n < 64; ++n) {
            v2u* p = (v2u*)(gst + (size_t)(bh * 64 + n) * 32768 + off);
            const v2u dv = *p; const f32x4 dec = *(const f32x4*)(decay + (size_t)(bh * 64 + n) * 128 + dk0);
            v2u sv; sv.x = pk2(S[0], S[1]); sv.y = pk2(S[2], S[3]); *p = sv;
            S[0] = dec[0] * S[0] + bflo(dv.x); S[1] = dec[1] * S[1] + bfhi(dv.x); S[2] = dec[2] * S[2] + bflo(dv.y); S[3] = dec[3] * S[3] + bfhi(dv.y);
        }
    }
}
__device__ __forceinline__ void phase_gla3(Frame& F) {
    relaunder(F);
    LAS unsigned char* L = F.lds + RING_OFF;
    const bf16* qb = (const bf16*)(F.ws + WS_QB); const bf16* kb = (const bf16*)(F.ws + WS_KB); const bf16* vb = (const bf16*)(F.ws + WS_VB);
    const bf16* gst = (const bf16*)(F.ws + WS_GST); const bf16* rb = (const bf16*)(F.ws + WS_RB); bf16* ob = (bf16*)(F.ws + WS_OB);
    const int lane = F.lane, wave = F.wave, r32 = lane & 31, hf = lane >> 5, ti = wave & 1, dvp = wave >> 1;
    LAS float* ssq = (LAS float*)(L + GL_KST);
    for (int u = F.bid; u < 1024; u += F.G) {
        const int bh = u >> 6, n = u & 63, b = bh >> 2, h = bh & 3; const size_t row0 = (size_t)b * SEQ + n * 64;
        gla_stage_v(F, L, vb, row0, h);
        bf16x8 qf[8];
        const bf16* qrow = qb + (row0 + ti * 32 + r32) * 512 + h * 128 + hf * 8;
#pragma unroll
        for (int kk = 0; kk < 8; ++kk) qf[kk] = *(const bf16x8*)(qrow + kk * 16);
        bf16x8 pb[2][2];
#pragma unroll
        for (int jt = 0; jt < 2; ++jt) {
            f32x16 pt;
#pragma unroll
            for (int i = 0; i < 16; ++i) pt[i] = 0.f;
            if (jt <= ti) {
                const bf16* krow = kb + (row0 + jt * 32 + r32) * 512 + h * 128 + hf * 8;
#pragma unroll
                for (int kk = 0; kk < 8; ++kk) pt = __builtin_amdgcn_mfma_f32_32x32x16_bf16(*(const bf16x8*)(krow + kk * 16), qf[kk], pt, 0, 0, 0);
                if (jt == ti) {
#pragma unroll
                    for (int i = 0; i < 16; ++i) if (((i & 3) + 8 * (i >> 2) + 4 * hf) > r32) pt[i] = 0.f;
                }
            }
            pb[jt][0] = nsa_pack(pt, 0); pb[jt][1] = nsa_pack(pt, 1);
        }
        f32x16 o[2];
#pragma unroll
        for (int i = 0; i < 16; ++i) { o[0][i] = 0.f; o[1][i] = 0.f; }
        const bf16* sbase = gst + (size_t)u * 32768 + (size_t)(dvp * 64 + r32) * 128 + hf * 8;
#pragma unroll
        for (int dvt = 0; dvt < 2; ++dvt)
#pragma unroll
            for (int kk = 0; kk < 8; ++kk) o[dvt] = __builtin_amdgcn_mfma_f32_32x32x16_bf16(*(const bf16x8*)(sbase + (size_t)dvt * 32 * 128 + kk * 16), qf[kk], o[dvt], 0, 0, 0);
        __syncthreads();
        {
            const LAS unsigned char* vbase = L + GL_V + (4 * hf + ((lane & 15) >> 2)) * GV_TS + (dvp * 64 + 16 * ((lane >> 4) & 1) + 4 * (lane & 3)) * 2;
#pragma unroll
            for (int dvt = 0; dvt < 2; ++dvt)
#pragma unroll
                for (int jt = 0; jt < 2; ++jt)
#pragma unroll
                    for (int s = 0; s < 2; ++s) {
                        if (jt <= ti) {
                            const LAS unsigned char* ap = vbase + (jt * 32 + 16 * s) * GV_TS + dvt * 64;
                            const v4i16_t lo = __builtin_amdgcn_ds_read_tr16_b64_v4i16((LAS v4i16_t*)ap);
                            const v4i16_t hi = __builtin_amdgcn_ds_read_tr16_b64_v4i16((LAS v4i16_t*)(ap + 8 * GV_TS));
                            const bf16x8 a = {lo[0], lo[1], lo[2], lo[3], hi[0], hi[1], hi[2], hi[3]};
                            o[dvt] = __builtin_amdgcn_mfma_f32_32x32x16_bf16(a, pb[jt][s], o[dvt], 0, 0, 0);
                        }
                    }
        }
        float ss = 0.f;
#pragma unroll
        for (int i = 0; i < 16; ++i) ss += o[0][i] * o[0][i] + o[1][i] * o[1][i];
        ss += __shfl_xor(ss, 32);
        if (hf == 0) ssq[dvp * 64 + ti * 32 + r32] = ss;
        __syncthreads();
        const float tot = (ssq[ti * 32 + r32] + ssq[64 + ti * 32 + r32]) + (ssq[128 + ti * 32 + r32] + ssq[192 + ti * 32 + r32]);
        const float rs = 1.0f / sqrtf(tot * (1.0f / 256.0f) + EPSN);
        const size_t orow = (row0 + ti * 32 + r32) * 1024 + h * 256 + dvp * 64;
#pragma unroll
        for (int dvt = 0; dvt < 2; ++dvt)
#pragma unroll
            for (int g4 = 0; g4 < 4; ++g4) { const int c0 = dvt * 32 + 8 * g4 + 4 * hf; const v2u rw = *(const v2u*)(rb + orow + c0);
                v2u wv; wv.x = pk2(o[dvt][4 * g4] * rs * bflo(rw.x), o[dvt][4 * g4 + 1] * rs * bfhi(rw.x)); wv.y = pk2(o[dvt][4 * g4 + 2] * rs * bflo(rw.y), o[dvt][4 * g4 + 3] * rs * bfhi(rw.y));
                *(v2u*)(ob + orow + c0) = wv; }
        __syncthreads();
    }
}

__device__ __forceinline__ void phase_gla_naive(Frame& F, const Args& a, int l) {
    relaunder(F);
    if (F.bid >= 64) return;
    const int bh = F.bid >> 2, cb = F.bid & 3, b = bh >> 2, h = bh & 3;
    LAS float* qL = (LAS float*)(F.lds + RING_OFF); LAS float* kL = qL + 32 * 128; LAS float* aL = kL + 32 * 128; LAS float* vL = aL + 32 * 128;
    const bf16* qb = (const bf16*)(F.ws + WS_QB); const bf16* kb = (const bf16*)(F.ws + WS_KB); const bf16* vb = (const bf16*)(F.ws + WS_VB);
    const float* alr = (const float*)(F.ws + WS_ALR); float* oraw = (float*)(F.ws + WS_ORAW);
    const int tid = F.tid, split = tid & 7, ci = tid >> 3, d_st = tid & 127;
    float w2r[16];
#pragma unroll
    for (int r = 0; r < 16; ++r) w2r[r] = inp(F, I_AW2)[(size_t)l * 16 * 512 + r * 512 + h * 128 + d_st];
    const float ab = inp(F, I_AB)[l * 512 + h * 128 + d_st];
    float S[16];
#pragma unroll
    for (int i = 0; i < 16; ++i) S[i] = 0.f;
    for (int tc = 0; tc < SEQ / 32; ++tc) {
        const int t0 = tc * 32;
        __syncthreads();
#pragma unroll
        for (int i = 0; i < 8; ++i) { const int idx = tid + 512 * i, tt = idx >> 7; const size_t row = (size_t)b * SEQ + t0 + tt;
            qL[idx] = bf2f(qb[row * 512 + h * 128 + d_st]); kL[idx] = bf2f(kb[row * 512 + h * 128 + d_st]);
            const f32x4* ar = (const f32x4*)(alr + row * 16); float z = ab;
#pragma unroll
            for (int q = 0; q < 4; ++q) { const f32x4 av = ar[q]; z += av[0] * w2r[4 * q] + av[1] * w2r[4 * q + 1] + av[2] * w2r[4 * q + 2] + av[3] * w2r[4 * q + 3]; }
            const float ls = fminf(z, 0.f) - log1pf(__expf(-fabsf(z)));
            aL[idx] = __expf(ls * (1.0f / 16.0f)); }
#pragma unroll
        for (int i = 0; i < 4; ++i) { const int idx = tid + 512 * i, tt = idx >> 6, c = idx & 63; vL[idx] = bf2f(vb[((size_t)b * SEQ + t0 + tt) * 1024 + h * 256 + cb * 64 + c]); }
        __syncthreads();
        for (int tt = 0; tt < 32; ++tt) {
            const float vt = vL[tt * 64 + ci]; float o = 0.f;
#pragma unroll
            for (int q = 0; q < 4; ++q) { const f32x4 av = *(const LAS f32x4*)(aL + tt * 128 + split * 16 + 4 * q), kv = *(const LAS f32x4*)(kL + tt * 128 + split * 16 + 4 * q), qv = *(const LAS f32x4*)(qL + tt * 128 + split * 16 + 4 * q);
#pragma unroll
                for (int j = 0; j < 4; ++j) { S[4 * q + j] = av[j] * S[4 * q + j] + kv[j] * vt; o += qv[j] * S[4 * q + j]; } }
            o += __shfl_xor(o, 1); o += __shfl_xor(o, 2); o += __shfl_xor(o, 4);
            if (split == 0) oraw[((size_t)b * SEQ + t0 + tt) * 1024 + h * 256 + cb * 64 + ci] = o;
        }
    }
    __syncthreads();
}
__device__ __forceinline__ void phase_gla_norm(Frame& F) {
    relaunder(F);
    const int gw = F.bid * NWAVES + F.wave, NGW = F.G * NWAVES;
    const float* oraw = (const float*)(F.ws + WS_ORAW); const bf16* rb = (const bf16*)(F.ws + WS_RB); bf16* ob = (bf16*)(F.ws + WS_OB);
    for (int i = gw; i < MTOK * 4; i += NGW) {
        const f32x4 v = *((const f32x4*)(oraw + (size_t)i * 256) + F.lane);
        const float s = wave_sum((v[0] * v[0] + v[1] * v[1]) + (v[2] * v[2] + v[3] * v[3]));
        const float r = 1.0f / sqrtf(s * (1.0f / 256.0f) + EPSN);
        const v2u rw = *((const v2u*)(rb + (size_t)i * 256) + F.lane);
        v2u w; w.x = pk2(v[0] * r * bflo(rw.x), v[1] * r * bfhi(rw.x)); w.y = pk2(v[2] * r * bflo(rw.y), v[3] * r * bfhi(rw.y));
        *((v2u*)(ob + (size_t)i * 256) + F.lane) = w;
    }
}

#ifndef GLA_NAIVE
#define GLA_NAIVE 0
#endif
#ifndef MK_PER_PHASE
#define MK_PER_PHASE 0
#endif
#ifndef PG8_SP2
#define PG8_SP2 true
#endif
constexpr int NPH_L = 11, NPHASES = NL * NPH_L + 1;

__global__ void __launch_bounds__(NWAVES * 64, 2) fwd(Args args) {
    extern __shared__ __attribute__((aligned(16))) unsigned char lds[];
    Frame F;
    F.lds = (LAS unsigned char*)lds;
    F.tid = threadIdx.x; F.lane = F.tid & 63; F.wave = __builtin_amdgcn_readfirstlane(F.tid >> 6);
    F.G = gridDim.x; F.bid = blockIdx.x; F.ws = args.ws;
    unsigned char* ws = args.ws;
    for (int u = F.tid; u < (LDS_BYTES - LDSCTL_OFF) / 4; u += NWAVES * 64) ((LAS unsigned*)(F.lds + LDSCTL_OFF))[u] = 0u;
    if (F.tid < 50) ((LAS unsigned*)(F.lds + LDSCTL_OFF))[F.tid] = ((const __attribute__((address_space(4))) unsigned*)__builtin_amdgcn_kernarg_segment_ptr())[F.tid];
    __syncthreads();
    XcdBarrier bar; bar.bar = (unsigned*)(ws + WS_CTL) + CW_BAR; bar.x = 0; bar.st = nullptr;
    if (!MK_PER_PHASE) bar = xcd_barrier_post((unsigned*)(ws + WS_CTL) + CW_BAR, (volatile LAS unsigned*)(F.lds + MISC_OFF) + 8);
    const int lo = args.ph_lo, hi = args.ph_hi;
#ifndef PH_MASK
#define PH_MASK 0xFFFF
#endif
#ifndef DBL_MASK
#define DBL_MASK 0
#endif
#define DBL(j) ((DBL_MASK >> (j)) & 1)
#define INL(j) (((PH_MASK >> (j)) & 1) && lo <= (pb + (j)) && (pb + (j)) < hi)
#define IN(k) (lo <= (k) && (k) < hi)
#define SEAM(k) do { if (IN((k) + 1)) { if (MK_PER_PHASE) { } else { XcdBarrier b_ = bar; asm volatile("" : "+s"(b_.bar)); xcd_barrier(b_); } } } while (0)
#define PH_PTRS relaunder(F); unsigned char* const ws = F.ws; bf16* const xb = (bf16*)(ws + WS_XB); float* const ssp = (float*)(ws + WS_SSP); bf16* const act = (bf16*)(ws + WS_ACT); (void)xb; (void)ssp; (void)act

    for (int l = 0; l < NL; ++l) {
        const int pb = l * NPH_L;
        if (INL(0)) { phase_conv(F, args, l); if (DBL(0)) { __syncthreads(); phase_conv(F, args, l); } if (l == 0) { phase_lut(F, args); phase_x0(F, args); } SEAM(pb + 0); }
        if (INL(1)) {
            PH_PTRS;
            pg8::Gemm g{xb, (const bf16*)(ws + W_GU1), MTOK, NGU, DM, DM}; pg8::StaticOrder S; S.init(MTOK, NGU, F.G, F.bid);
            LAS float* rsL = (LAS float*)(F.lds + RS_OFF); pg8::Unit u0; int pm0 = -1; if (S.next(0, u0)) { pm0 = u0.pm; rstd_table(ssp, pm0, rsL, F.tid); }
            EpiGU E{act, ssp, rsL, pm0};
            pg8::gemm_phase<EpiGU, pg8::StaticOrder, true, PG8_SP2>(F.lds + RING_OFF, g, S, E);
            SEAM(pb + 1);
        }
        if (INL(2)) {
            PH_PTRS;
            pg8::Gemm g{act, (const bf16*)(ws + W_D1), MTOK, DM, FF, FF}; pg8::StaticOrder S; S.init(MTOK, DM, F.G, F.bid);
            EpiResid E{xb, ssp, 0.5f};
            pg8::gemm_phase<EpiResid, pg8::StaticOrder, true, PG8_SP2>(F.lds + RING_OFF, g, S, E);
            SEAM(pb + 2);
        }
        if (INL(3)) {
            PH_PTRS;
            pg8::Gemm g{xb, (const bf16*)(ws + W_IN), MTOK, NIN, DM, DM}; pg8::StaticOrder S; S.init(MTOK, NIN, F.G, F.bid);
            LAS float* rsL = (LAS float*)(F.lds + RS_OFF); pg8::Unit u0; int pm0 = -1; if (S.next(0, u0)) { pm0 = u0.pm; rstd_table(ssp, pm0, rsL, F.tid); }
            EpiWin E{ws, ssp, rsL, pm0};
            pg8::gemm_phase<EpiWin, pg8::StaticOrder, true, PG8_SP2>(F.lds + RING_OFF, g, S, E);
            SEAM(pb + 3);
        }
        if (INL(4)) {
            PH_PTRS;
            const bf16* kvc = (const bf16*)(ws + WS_KVC); bf16* hid = (bf16*)(ws + WS_HID); const float* posb = (const float*)(ws + WS_POSB);
            if (F.bid < 16) {
            { pg8::Gemm g{kvc, (const bf16*)(ws + W_C1K), 2048, 256, 2048, 1024}; pg8::StaticOrder S; S.init(2048, 256, F.G, F.bid);
              EpiCmp1 E{hid, posb};
              pg8::gemm_phase<EpiCmp1, pg8::StaticOrder, true, PG8_SP2>(F.lds + RING_OFF, g, S, E); }
            { pg8::Gemm g{kvc + (size_t)8 * SEQ * 64, (const bf16*)(ws + W_C1V), 2048, 256, 2048, 1024}; pg8::StaticOrder S; S.init(2048, 256, F.G, (F.bid + F.G - 8) % F.G);
              EpiCmp1 E{hid + (size_t)2048 * 256, posb + 256};
              pg8::gemm_phase<EpiCmp1, pg8::StaticOrder, true, PG8_SP2>(F.lds + RING_OFF, g, S, E); }
            } else phase_gla1(F, l);
            SEAM(pb + 4);
        }
        if (INL(5)) { phase_cmp2(F, args, l); phase_gla2(F); SEAM(pb + 5); }
        if (INL(6)) { phase_nsa(F); if (DBL(6)) { __syncthreads(); phase_nsa(F); } phase_gla3(F); SEAM(pb + 6); }
        if (INL(7)) {
            PH_PTRS;
            const bf16* gm = (const bf16*)(ws + WS_GM); float* yp = (float*)(ws + WS_YPART); bf16* y = (bf16*)(ws + WS_Y);
            { pg8::Gemm g{(const bf16*)(ws + WS_OA), (const bf16*)(ws + W_N), MTOK, DM, 512, 512}; pg8::StaticOrder S; S.init(MTOK, DM, F.G, F.bid);
              EpiMerge<1> E{gm, yp, y};
              pg8::gemm_phase<EpiMerge<1>, pg8::StaticOrder, true, PG8_SP2>(F.lds + RING_OFF, g, S, E); }
            { pg8::Gemm g{(const bf16*)(ws + WS_OB), (const bf16*)(ws + W_G), MTOK, DM, DM, DM}; pg8::StaticOrder S; S.init(MTOK, DM, F.G, F.bid);
              EpiMerge<2> E{gm, yp, y};
              pg8::gemm_phase<EpiMerge<2>, pg8::StaticOrder, true, PG8_SP2>(F.lds + RING_OFF, g, S, E); }
            SEAM(pb + 7);
        }
        if (INL(8)) {
            PH_PTRS;
            pg8::Gemm g{(const bf16*)(ws + WS_Y), (const bf16*)(ws + W_O), MTOK, DM, DM, DM}; pg8::StaticOrder S; S.init(MTOK, DM, F.G, F.bid);
            EpiResid E{xb, ssp, 1.0f};
            pg8::gemm_phase<EpiResid, pg8::StaticOrder, true, PG8_SP2>(F.lds + RING_OFF, g, S, E);
            SEAM(pb + 8);
        }
        if (INL(9)) {
            PH_PTRS;
            pg8::Gemm g{xb, (const bf16*)(ws + W_GU2), MTOK, NGU, DM, DM}; pg8::StaticOrder S; S.init(MTOK, NGU, F.G, F.bid);
            LAS float* rsL = (LAS float*)(F.lds + RS_OFF); pg8::Unit u0; int pm0 = -1; if (S.next(0, u0)) { pm0 = u0.pm; rstd_table(ssp, pm0, rsL, F.tid); }
            EpiGU E{act, ssp, rsL, pm0};
            pg8::gemm_phase<EpiGU, pg8::StaticOrder, true, PG8_SP2>(F.lds + RING_OFF, g, S, E);
            SEAM(pb + 9);
        }
        if (INL(10)) {
            PH_PTRS;
            pg8::Gemm g{act, (const bf16*)(ws + W_D2), MTOK, DM, FF, FF}; pg8::StaticOrder S; S.init(MTOK, DM, F.G, F.bid);
            EpiResid E{xb, ssp, 0.5f};
            pg8::gemm_phase<EpiResid, pg8::StaticOrder, true, PG8_SP2>(F.lds + RING_OFF, g, S, E);
            SEAM(pb + 10);
        }
    }
    if (IN(NL * NPH_L)) phase_final(F, args);
#undef IN
#undef SEAM
}

extern "C" void kernel_launch(void* const* d_in, const int* in_sizes, int n_in, void* d_out, int out_size, void* d_ws, size_t ws_size, hipStream_t stream) {
    static int grid = 0;
    if (grid == 0) {
        if (n_in != 25 || out_size != MTOK * DM || ws_size < WS_END) { fprintf(stderr, "kernel_launch: unexpected shapes (n_in %d, out %d, ws %zu, need %zu)\n", n_in, out_size, ws_size, (size_t)WS_END); grid = -1; return; }
        int dev = 0, cus = 0, per_cu = 0;
        if (hipGetDevice(&dev) != hipSuccess || hipDeviceGetAttribute(&cus, hipDeviceAttributeMultiprocessorCount, dev) != hipSuccess) { grid = -1; return; }
        if (hipFuncSetAttribute((const void*)fwd, hipFuncAttributeMaxDynamicSharedMemorySize, LDS_BYTES) != hipSuccess) { fprintf(stderr, "kernel_launch: hipFuncSetAttribute failed\n"); grid = -1; return; }
        if (hipOccupancyMaxActiveBlocksPerMultiprocessor(&per_cu, (const void*)fwd, NWAVES * 64, LDS_BYTES) != hipSuccess || per_cu < 1) { fprintf(stderr, "kernel_launch: occupancy query reports %d\n", per_cu); }
        (void)hipGetLastError();
        grid = cus;
    }
    if (grid < 0) return;
    (void)hipMemsetAsync((char*)d_ws + WS_CTL, 0, CTL_ZERO_BYTES, stream);
    Args a{};
    for (int i = 0; i < 25; ++i) a.in[i] = (const float*)d_in[i];
    a.out = (float*)d_out; a.ws = (unsigned char*)d_ws;
#if MK_PER_PHASE
    for (int p = 0; p < NPHASES; ++p) { a.ph_lo = p; a.ph_hi = p + 1; hipLaunchKernelGGL(fwd, dim3(grid), dim3(NWAVES * 64), LDS_BYTES, stream, a); }
#else
    a.ph_lo = 0; a.ph_hi = NPHASES;
    hipLaunchKernelGGL(fwd, dim3(grid), dim3(NWAVES * 64), LDS_BYTES, stream, a);
#endif
    const hipError_t le = hipPeekAtLastError();
    if (le != hipSuccess) fprintf(stderr, "kernel_launch: launch failed: %s\n", hipGetErrorName(le));
}
```

```cpp
#include <hip/hip_runtime.h>
#include <cstdio>
#include <cstdint>

namespace pg8 {
#define PG8_LAS __attribute__((address_space(3)))
typedef unsigned short bf16_t;
typedef short bf16x8 __attribute__((ext_vector_type(8)));
typedef float f32x4 __attribute__((ext_vector_type(4)));
typedef unsigned u32x4 __attribute__((ext_vector_type(4)));
constexpr int BM = 256, BK = 64, HALF = 128, HTB = HALF * BK * 2  , STAGE_BYTES = 8 * HTB, NXCD = 8, WGM = 8;

__host__ __device__ __forceinline__ int lds_byte(int r, int c) { const int st = (r >> 4) * 2 + (c >> 5), rr = r & 15, cc = c & 31, ob = rr * 64 + cc * 2; return st * 1024 + (ob ^ (((ob >> 9) & 1) << 5)); }
__host__ __device__ __forceinline__ void stage_rc(int b, int& R, int& C) { const int st = b / 1024, sb = b % 1024, swz = sb ^ (((sb >> 9) & 1) << 5); R = (st >> 1) * 16 + swz / 64; C = (st & 1) * 32 + (swz % 64) / 2; }
__host__ __device__ __forceinline__ int perm32(int rho) { const int n = rho >> 4, i = rho & 15; return 8 * (i >> 2) + 4 * n + (i & 3); }

struct Unit { int pm, pn; };
struct Gemm { const bf16_t* A; const bf16_t* Bt; int M, N, K, lda; };

struct StaticOrder {
    int nM, nN, nwg, G, c;
    __host__ __device__ __forceinline__ void init(int M, int N, int G_, int c_) { nM = M / BM; nN = N / BM; nwg = nM * nN; G = G_; c = c_; }
    __host__ __device__ __forceinline__ bool next(int i, Unit& u) const {
        const long L = (long)i * G + c; if (L >= nwg) return false;
        int wgid = (int)L; { const int q = nwg / NXCD, r = nwg % NXCD, xcd = wgid % NXCD, off = wgid / NXCD; wgid = (xcd < r ? xcd * (q + 1) : r * (q + 1) + (xcd - r) * q) + off; }
        const int nig = WGM * nN, gid = wgid / nig, fm = gid * WGM, gsz = (nM - fm) < WGM ? (nM - fm) : WGM;
        u.pm = fm + ((wgid % nig) % gsz); u.pn = (wgid % nig) / gsz; return true;
    }
    __device__ __forceinline__ void a_ready(const Unit&) const {}
    __device__ __forceinline__ void done(const Unit&) const {}
};
template <class Epi, class Sched, bool ALIGN_EPI = false, bool SP2 = false>
__device__ __forceinline__ void gemm_phase(PG8_LAS unsigned char* lds, const Gemm g, const Sched& S, const Epi& E) {
    int tid_ = threadIdx.x; asm volatile("" : "+v"(tid_));
    const int tid = tid_, wid = __builtin_amdgcn_readfirstlane(tid >> 6), lane = tid & 63, wr = wid >> 2, wc = wid & 3, fr = lane & 15, fq = lane >> 4;
    const int K = g.K, nt = K / BK;
    unsigned voffA[2], voffB[2];
#pragma unroll
    for (int i = 0; i < 2; ++i) { int R, C; stage_rc(tid * 16 + i * 8192, R, C); const int Rb = Epi::PERM ? ((R & ~31) + perm32(R & 31)) : R;
        voffA[i] = (unsigned)(R * g.lda + C) * 2u; voffB[i] = (unsigned)(Rb * K + C) * 2u; }
    const size_t kstep = (size_t)(BK * 2);
    const size_t hstep = (size_t)HALF * K * 2;
    const size_t tstep = 2 * hstep;
    const size_t hstepA = (size_t)HALF * g.lda * 2, tstepA = 2 * hstepA;
    const unsigned ldsw = (unsigned)wid * 1024u;
    const int aoff = lds_byte(wr * 64 + fr, fq * 8), boff = lds_byte(wc * 32 + fr, fq * 8);
#define PG8_SA(b, h) (((b) * 2 + (h)) * HTB)
#define PG8_SB(b, h) ((4 + (b) * 2 + (h)) * HTB)
#define PG8_STAGE(bufoff, gbase, voff) do { _Pragma("unroll") for (int _i = 0; _i < 2; ++_i) \
        __builtin_amdgcn_global_load_lds((const unsigned*)((const char*)(gbase) + (voff)[_i]), (PG8_LAS unsigned*)(lds + (bufoff) + ldsw + _i * 8192), 16, 0, 0); } while (0)
#define PG8_LDA(dst, b, h) do { _Pragma("unroll") for (int m = 0; m < 4; ++m) _Pragma("unroll") for (int k = 0; k < 2; ++k) dst[m][k] = *(const PG8_LAS bf16x8*)(lds + PG8_SA(b, h) + aoff + m * 2048 + k * 1024); } while (0)
#define PG8_LDB(dst, b, h) do { _Pragma("unroll") for (int n = 0; n < 2; ++n) _Pragma("unroll") for (int k = 0; k < 2; ++k) dst[n][k] = *(const PG8_LAS bf16x8*)(lds + PG8_SB(b, h) + boff + n * 2048 + k * 1024); } while (0)
#define PG8_MMA(ai, bj, At, Bt) do { __builtin_amdgcn_s_setprio(1); _Pragma("unroll") for (int m = 0; m < 4; ++m) _Pragma("unroll") for (int n = 0; n < 2; ++n) _Pragma("unroll") for (int k = 0; k < 2; ++k) \
        acc[ai][bj][m][n] = __builtin_amdgcn_mfma_f32_16x16x32_bf16(Bt[n][k], At[m][k], acc[ai][bj][m][n], 0, 0, 0); __builtin_amdgcn_s_setprio(0); } while (0)
#define PG8_WAIT_V(n) asm volatile("s_waitcnt vmcnt(" #n ")" ::: "memory")
#define PG8_WAIT_L(n) asm volatile("s_waitcnt lgkmcnt(" #n ")" ::: "memory")
#define PG8_BAR __builtin_amdgcn_s_barrier()
#define PG8_SCHED __builtin_amdgcn_sched_barrier(0)
    Unit cur, nxt; int ui = 0;
    if (!S.next(0, cur)) return;
    f32x4 acc[2][2][4][2];
#pragma unroll
    for (int a = 0; a < 2; ++a)
#pragma unroll
        for (int b = 0; b < 2; ++b)
#pragma unroll
            for (int m = 0; m < 4; ++m)
#pragma unroll
                for (int n = 0; n < 2; ++n) acc[a][b][m][n] = (f32x4){0.f, 0.f, 0.f, 0.f};
    bf16x8 At[4][2], B0[2][2], B1[2][2];
    const char* cA = (const char*)g.A + (size_t)cur.pm * tstepA; const char* cB = (const char*)g.Bt + (size_t)cur.pn * tstep;
    S.a_ready(cur);
    if constexpr (SP2) {
        PG8_STAGE(PG8_SB(0, 0), cB, voffB); PG8_STAGE(PG8_SB(0, 1), cB + hstep, voffB); PG8_STAGE(PG8_SA(0, 0), cA, voffA); PG8_STAGE(PG8_SA(0, 1), cA + hstepA, voffA);
        if (wr == 1) PG8_BAR;
        PG8_WAIT_V(2); PG8_BAR;
        PG8_STAGE(PG8_SB(1, 0), cB + kstep, voffB); PG8_STAGE(PG8_SA(1, 0), cA + kstep, voffA); PG8_STAGE(PG8_SB(1, 1), cB + hstep + kstep, voffB);
        PG8_WAIT_V(6); PG8_BAR;
    } else {
        PG8_STAGE(PG8_SB(0, 0), cB, voffB); PG8_STAGE(PG8_SA(0, 0), cA, voffA); PG8_STAGE(PG8_SB(0, 1), cB + hstep, voffB); PG8_STAGE(PG8_SA(0, 1), cA + hstepA, voffA);
        if (wr == 1) PG8_BAR;
        PG8_WAIT_V(4); PG8_BAR;
        PG8_STAGE(PG8_SB(1, 0), cB + kstep, voffB); PG8_STAGE(PG8_SA(1, 0), cA + kstep, voffA); PG8_STAGE(PG8_SB(1, 1), cB + hstep + kstep, voffB);
        PG8_WAIT_V(6); PG8_BAR;
    }
    for (;;) {
        const bool has_next = S.next(ui + 1, nxt);
        const char* nA = has_next ? (const char*)g.A + (size_t)nxt.pm * tstepA : cA; const char* nB = has_next ? (const char*)g.Bt + (size_t)nxt.pn * tstep : cB;
        for (int t = 0; t < nt; t += 2) {
            const bool last = (t == nt - 2);
            const char* a1 = cA + (size_t)(t + 1) * kstep;
            const char* a2 = last ? nA : cA + (size_t)(t + 2) * kstep; const char* b2 = last ? nB : cB + (size_t)(t + 2) * kstep;
            const char* a3 = a2 + kstep; const char* b3 = b2 + kstep;
            if (last && has_next) S.a_ready(nxt);
            if constexpr (Epi::MID_T > 0) { if (t == Epi::MID_T) E.mid(acc, cur, wr, wc, fr, fq); }
            if constexpr (SP2) {
            PG8_LDB(B0, 0, 0); PG8_LDB(B1, 0, 1); PG8_SCHED; PG8_LDA(At, 0, 0); PG8_STAGE(PG8_SA(1, 1), a1 + hstepA, voffA);
            PG8_WAIT_V(8); PG8_WAIT_L(0); PG8_BAR; PG8_MMA(0, 0, At, B0); PG8_MMA(0, 1, At, B1); PG8_BAR; PG8_SCHED;
            PG8_LDA(At, 0, 1); PG8_STAGE(PG8_SB(0, 0), b2, voffB); PG8_STAGE(PG8_SB(0, 1), b2 + hstep, voffB); PG8_STAGE(PG8_SA(0, 0), a2, voffA);
            PG8_WAIT_V(8); PG8_WAIT_L(0); PG8_BAR; PG8_MMA(1, 0, At, B0); PG8_MMA(1, 1, At, B1); PG8_BAR; PG8_SCHED;
            PG8_LDB(B0, 1, 0); PG8_LDB(B1, 1, 1); PG8_SCHED; PG8_LDA(At, 1, 0); PG8_STAGE(PG8_SA(0, 1), a2 + hstepA, voffA);
            PG8_WAIT_V(8); PG8_WAIT_L(0); PG8_BAR; PG8_MMA(0, 0, At, B0); PG8_MMA(0, 1, At, B1); PG8_BAR; PG8_SCHED;
            PG8_LDA(At, 1, 1); PG8_STAGE(PG8_SB(1, 0), b3, voffB); PG8_STAGE(PG8_SB(1, 1), b3 + hstep, voffB); PG8_STAGE(PG8_SA(1, 0), a3, voffA);
            PG8_WAIT_V(8); PG8_WAIT_L(0); PG8_BAR; PG8_MMA(1, 0, At, B0); PG8_MMA(1, 1, At, B1); PG8_BAR; PG8_SCHED;
            } else {
            PG8_LDB(B0, 0, 0); PG8_SCHED; PG8_LDA(At, 0, 0); PG8_STAGE(PG8_SA(1, 1), a1 + hstepA, voffA);
            PG8_WAIT_L(8); PG8_BAR; PG8_WAIT_L(0); PG8_MMA(0, 0, At, B0); PG8_BAR; PG8_SCHED;
            PG8_LDB(B1, 0, 1); PG8_STAGE(PG8_SB(0, 0), b2, voffB);
            PG8_BAR; PG8_WAIT_L(0); PG8_MMA(0, 1, At, B1); PG8_BAR;
            PG8_LDA(At, 0, 1); PG8_STAGE(PG8_SA(0, 0), a2, voffA);
            PG8_BAR; PG8_WAIT_L(0); PG8_MMA(1, 0, At, B0); PG8_BAR; PG8_SCHED;
            PG8_STAGE(PG8_SB(0, 1), b2 + hstep, voffB);
            PG8_WAIT_V(6); PG8_BAR; PG8_MMA(1, 1, At, B1); PG8_BAR;
            PG8_LDB(B0, 1, 0); PG8_SCHED; PG8_LDA(At, 1, 0); PG8_STAGE(PG8_SA(0, 1), a2 + hstepA, voffA);
            PG8_WAIT_L(8); PG8_BAR; PG8_WAIT_L(0); PG8_MMA(0, 0, At, B0); PG8_BAR; PG8_SCHED;
            PG8_LDB(B1, 1, 1); PG8_STAGE(PG8_SB(1, 0), b3, voffB);
            PG8_BAR; PG8_WAIT_L(0); PG8_MMA(0, 1, At, B1); PG8_BAR;
            PG8_LDA(At, 1, 1); PG8_STAGE(PG8_SA(1, 0), a3, voffA);
            PG8_BAR; PG8_WAIT_L(0); PG8_MMA(1, 0, At, B0); PG8_BAR; PG8_SCHED;
            PG8_STAGE(PG8_SB(1, 1), b3 + hstep, voffB);
            PG8_WAIT_V(6); PG8_BAR; PG8_MMA(1, 1, At, B1); PG8_BAR;
            }
        }
        if constexpr (ALIGN_EPI) { if (wr == 0) PG8_BAR; }
        if constexpr (!Epi::AFTER_DRAIN) { E(acc, cur, wr, wc, fr, fq); S.done(cur); }
        if (!has_next) break;
#pragma unroll
        for (int a = 0; a < 2; ++a)
#pragma unroll
            for (int b = 0; b < 2; ++b)
#pragma unroll
                for (int m = 0; m < 4; ++m)
#pragma unroll
                    for (int n = 0; n < 2; ++n) acc[a][b][m][n] = (f32x4){0.f, 0.f, 0.f, 0.f};
        cur = nxt; cA = nA; cB = nB; ++ui;
        if constexpr (ALIGN_EPI) { if (wr == 1) PG8_BAR; }
    }
    PG8_WAIT_V(0);
    if constexpr (!ALIGN_EPI) { if (wr == 0) PG8_BAR; }
    PG8_BAR;
    if constexpr (Epi::AFTER_DRAIN) { E.fused(acc, cur, wr, wc, fr, fq, lds, wid, lane); S.done(cur); }
#undef PG8_SA
#undef PG8_SB
#undef PG8_STAGE
#undef PG8_LDA
#undef PG8_LDB
#undef PG8_MMA
#undef PG8_WAIT_V
#undef PG8_WAIT_L
#undef PG8_BAR
#undef PG8_SCHED
}
}

constexpr int NB = 4, SEQ = 4096, DM = 1024, NL = 4, FF = 2816, MTOK = NB * SEQ;
constexpr int DIN = 6440, NIN = 6656;
constexpr int NGU = 2 * FF;
constexpr float EPSN = 1e-6f;
constexpr int SRC_QA = 0, SRC_KVA = 512, SRC_GA = 1280, SRC_QB = 1304, SRC_KB = 1816, SRC_VB = 2328, SRC_ALR = 3352, SRC_RB = 3368, SRC_GM = 4392;
constexpr int T_QA = 0, T_KVA = 2, T_QB = 5, T_KB = 7, T_VB = 9, T_RB = 13, T_GM = 17, T_MISC = 25;

constexpr size_t MiB = 1u << 20;
constexpr size_t WS_CTL = 0, CTL_ZERO_BYTES = 64 * 1024;
constexpr size_t WS_LUT = 1 * MiB;
constexpr size_t WS_POSB = WS_LUT + 128 * 1024;
constexpr size_t WS_W = 2 * MiB;
constexpr size_t W_GU1 = WS_W, W_D1 = W_GU1 + 11 * MiB, W_GU2 = W_D1 + 11 * MiB / 2, W_D2 = W_GU2 + 11 * MiB;
constexpr size_t W_IN = W_D2 + 11 * MiB / 2, W_C1K = W_IN + 13 * MiB, W_C1V = W_C1K + 1 * MiB, W_N = W_C1V + 1 * MiB, W_G = W_N + 1 * MiB, W_O = W_G + 2 * MiB;
constexpr size_t WS_XB = 58 * MiB;
constexpr size_t WS_SSP = 90 * MiB;
constexpr size_t WS_R = 92 * MiB;
constexpr size_t WS_ACT = WS_R;
constexpr size_t WS_QA = WS_R, WS_KVS = WS_QA + 16 * MiB, WS_KVC = WS_KVS + 16 * MiB, WS_GA = WS_KVC + 9 * MiB, WS_ALR = WS_GA + 2 * MiB;
constexpr size_t WS_QB = WS_ALR + 1 * MiB, WS_KB = WS_QB + 16 * MiB, WS_VB = WS_KB + 16 * MiB, WS_RB = WS_VB + 32 * MiB, WS_GM = WS_RB + 32 * MiB;
constexpr size_t WS_HID = WS_GM + 64 * MiB, WS_KVCMP = WS_HID + 2 * MiB, WS_OA = WS_KVCMP + 1 * MiB, WS_ORAW = WS_OA + 16 * MiB, WS_OB = WS_ORAW + 64 * MiB;
constexpr size_t WS_Y = WS_OB + 32 * MiB, WS_END = WS_Y + 32 * MiB;
constexpr size_t WS_YPART = WS_ORAW;
constexpr size_t WS_OAB = WS_OB;
constexpr size_t WS_Y2 = WS_ORAW;
constexpr size_t W_CAT = W_N;
constexpr size_t WS_GST = WS_ORAW;
constexpr size_t WS_DECAY = WS_GA + 1536 * 1024;
constexpr size_t WS_KVCMPB = WS_KVC + 8 * MiB + 64 * 1024;
static_assert(W_O + 2 * MiB <= WS_XB, "weights fit");
static_assert(WS_END <= 460 * MiB, "workspace budget");

constexpr int CW_BAR = 1024;

constexpr int RING_OFF = 0, RING_BYTES = 131072;
constexpr int LDSCTL_OFF = RING_BYTES, MISC_OFF = LDSCTL_OFF + 320;
constexpr int LDS_BYTES = 147456;
constexpr int RS_OFF = RING_BYTES + 512;
constexpr int NWAVES = 8;

#define GAS __attribute__((address_space(1)))
#define LAS __attribute__((address_space(3)))
typedef unsigned short bf16;
typedef unsigned v4u __attribute__((ext_vector_type(4)));
typedef unsigned v2u __attribute__((ext_vector_type(2)));
typedef float f32x4 __attribute__((ext_vector_type(4)));
typedef short bf16x8 __attribute__((ext_vector_type(8)));
#define LDS_WAIT() asm volatile("s_waitcnt lgkmcnt(0)" ::: "memory")
#define VM_WAIT() asm volatile("s_waitcnt vmcnt(0)" ::: "memory")
__device__ __forceinline__ unsigned f2bf(float f) { unsigned u = __builtin_bit_cast(unsigned, f); return (u + 0x7fffu + ((u >> 16) & 1u)) >> 16; }
__device__ __forceinline__ unsigned pk2(float lo, float hi) { return f2bf(lo) | (f2bf(hi) << 16); }
__device__ __forceinline__ float bf2f(unsigned short b) { return __builtin_bit_cast(float, ((unsigned)b) << 16); }
__device__ __forceinline__ float bflo(unsigned w) { return __builtin_bit_cast(float, w << 16); }
__device__ __forceinline__ float bfhi(unsigned w) { return __builtin_bit_cast(float, w & 0xffff0000u); }
__device__ __forceinline__ float wave_sum(float v) {
#pragma unroll
    for (int o = 1; o < 64; o <<= 1) v += __shfl_xor(v, o);
    return v;
}
__device__ __forceinline__ float wave_max(float v) {
#pragma unroll
    for (int o = 1; o < 64; o <<= 1) v = fmaxf(v, __shfl_xor(v, o));
    return v;
}
__device__ __forceinline__ float sigmoidf_(float x) { return __builtin_amdgcn_rcpf(1.0f + __builtin_amdgcn_exp2f(x * -1.4426950408889634f)); }
__device__ __forceinline__ float siluf_(float x) { return x * __builtin_amdgcn_rcpf(1.0f + __builtin_amdgcn_exp2f(x * -1.4426950408889634f)); }

#define XB_TMO      128
#define XB_XCNT(j)  (256  + 64 * (j))
#define XB_XSUB(j)  (1280 + 64 * (j))
#define XB_XGEN(j)  (2304 + 64 * (j))
#define XB_TOP      3328
#define XB_TOPGEN   3392
#define XCD_BAR_WORDS 3456
#define XB_SPIN_CAP (1u << 18)

__device__ __forceinline__ unsigned xb_ld(unsigned* p)              { return __hip_atomic_load(p, __ATOMIC_RELAXED, __HIP_MEMORY_SCOPE_AGENT); }
__device__ __forceinline__ unsigned xb_add(unsigned* p, unsigned v) { return __hip_atomic_fetch_add(p, v, __ATOMIC_RELAXED, __HIP_MEMORY_SCOPE_AGENT); }
__device__ __forceinline__ unsigned xb_xcc_id() { return (unsigned)__builtin_amdgcn_s_getreg((3 << 11) | 20) & 0xFu; }
#define XB_SPIN(cond, bar) do { unsigned _sp = 0; while (cond) { __builtin_amdgcn_s_sleep(1); \
    if ((++_sp & 255u) == 0u) { if (xb_ld(&(bar)[XB_TMO])) break; if (_sp > XB_SPIN_CAP) { atomicAdd(&(bar)[XB_TMO], 1u); break; } } } } while (0)

struct XcdBarrier {
    unsigned* bar; unsigned x;
    volatile LAS unsigned* st;
};
__device__ __forceinline__ XcdBarrier xcd_barrier_post(unsigned* bar, volatile LAS unsigned* st) {
    XcdBarrier b; b.bar = bar; b.x = xb_xcc_id(); b.st = st;
    if (threadIdx.x == 0) (void)xb_add(&bar[XB_XCNT(b.x)], 1u);
    return b;
}
__device__ __forceinline__ void xcd_barrier_complete(unsigned* bar, unsigned x, unsigned& nloc, unsigned& nx) {
    const unsigned G = gridDim.x * gridDim.y * gridDim.z;
    unsigned sum, cnt, mine, sp = 0u;
    for (;;) {
        sum = 0u; cnt = 0u; mine = 0u;
#pragma unroll
        for (unsigned j = 0; j < 16; ++j) { const unsigned c = xb_ld(&bar[XB_XCNT(j)]); sum += c; cnt += (c > 0u) ? 1u : 0u; mine = (j == x) ? c : mine; }
        if (sum == G) break;
        __builtin_amdgcn_s_sleep(1);
        if ((++sp & 255u) == 0u) { if (xb_ld(&bar[XB_TMO])) break; if (sp > XB_SPIN_CAP) { atomicAdd(&bar[XB_TMO], 1u); break; } }
    }
    nloc = mine > 0u ? mine : 1u; nx = cnt > 0u ? cnt : 1u;
}
__device__ __forceinline__ void xcd_barrier(const XcdBarrier& b) {
    asm volatile("s_waitcnt vmcnt(0)" ::: "memory");
    __syncthreads();
    if (threadIdx.x == 0) {
        unsigned* bar = b.bar;
        __builtin_amdgcn_s_waitcnt(0);
        unsigned nloc = b.st[0], nx = b.st[1];
        if (nloc == 0u) { xcd_barrier_complete(bar, b.x, nloc, nx); b.st[0] = nloc; b.st[1] = nx; }
        const unsigned old = xb_add(&bar[XB_XSUB(b.x)], 1u);
        const unsigned gen = old / nloc;
        if (old + 1u == (gen + 1u) * nloc) {
            __builtin_amdgcn_fence(__ATOMIC_RELEASE, "agent");
            asm volatile("s_waitcnt vmcnt(0)" ::: "memory");
            const unsigned og = xb_add(&bar[XB_TOP], 1u);
            const unsigned tg = og / nx;
            if (og + 1u == (tg + 1u) * nx) xb_add(&bar[XB_TOPGEN], 1u);
            else XB_SPIN(xb_ld(&bar[XB_TOPGEN]) == tg, bar);
            __builtin_amdgcn_fence(__ATOMIC_ACQUIRE, "agent");
            xb_add(&bar[XB_XGEN(b.x)], 1u);
            asm volatile("s_waitcnt vmcnt(0)" ::: "memory");
        } else {
            XB_SPIN(xb_ld(&bar[XB_XGEN(b.x)]) == gen, bar);
            __builtin_amdgcn_fence(__ATOMIC_ACQUIRE, "agent");
            asm volatile("s_waitcnt vmcnt(0)" ::: "memory");
        }
    }
    __syncthreads();
}

struct Args { const float* in[25]; float* out; unsigned char* ws; int ph_lo, ph_hi; };
enum { I_X = 0, I_REL, I_F1N, I_F1G, I_F1U, I_F1D, I_MIXN, I_WIN, I_POSK, I_POSV, I_CKW1, I_CKW2, I_CVW1, I_CVW2, I_AW2, I_AB, I_GON, I_WBN, I_WBG, I_WOUT, I_F2N, I_F2G, I_F2U, I_F2D, I_FIN };

struct Frame {
    LAS unsigned char* lds;
    int tid, lane, wave, G, bid;
    unsigned char* ws;
};
__device__ __forceinline__ const float* inp(const Frame& F, int i) {
    const LAS unsigned* t = (const LAS unsigned*)(F.lds + LDSCTL_OFF);
    const unsigned lo = __builtin_amdgcn_readfirstlane(t[2 * i]), hi = __builtin_amdgcn_readfirstlane(t[2 * i + 1]);
    return (const float*)(((unsigned long long)hi << 32) | lo);
}
__device__ __forceinline__ void relaunder(Frame& F) { int t = threadIdx.x; asm volatile("" : "+v"(t)); F.tid = t; F.lane = t & 63; F.wave = __builtin_amdgcn_readfirstlane(t >> 6);
    unsigned char* w = F.ws; asm volatile("" : "+s"(w)); F.ws = w; }

using pg8::Unit;
__device__ __forceinline__ float row_rstd(const float* ssp, int row);
__device__ __forceinline__ void rstd8(const float* ssp, int rowbase, int fr, int fq, float (&rs)[2][4]);
__device__ __forceinline__ void rstd_table(const float* ssp, int pm, LAS float* rsL, int tid) {
    const int row = tid >> 1, half = tid & 1; const f32x4* p = (const f32x4*)(ssp + (size_t)(pm * 256 + row) * 16 + half * 8);
    const f32x4 a = p[0], b = p[1];
    float s = ((a[0] + a[1]) + (a[2] + a[3])) + ((b[0] + b[1]) + (b[2] + b[3]));
    s += __shfl_xor(s, 1);
    if (half == 0) rsL[row] = __builtin_amdgcn_rsqf(s * (1.0f / DM) + EPSN);
    __syncthreads();
}
__device__ __forceinline__ void rstd8_lds(const LAS float* rsL, const float* ssp, int pm0, const Unit& u, int wr, int fr, int fq, float (&rs)[2][4]) {
    if (u.pm == pm0) {
#pragma unroll
        for (int ai = 0; ai < 2; ++ai)
#pragma unroll
            for (int m = 0; m < 4; ++m) rs[ai][m] = rsL[ai * 128 + wr * 64 + m * 16 + fr];
    } else {
#pragma unroll 1
        for (int i = 0; i < 8; ++i) { const float r = row_rstd(ssp, u.pm * 256 + (i >> 2) * 128 + wr * 64 + (i & 3) * 16 + fr);
#pragma unroll
            for (int ai = 0; ai < 2; ++ai)
#pragma unroll
                for (int m = 0; m < 4; ++m) if (ai * 4 + m == i) rs[ai][m] = r; }
    }
}
__device__ __forceinline__ void rstd8(const float* ssp, int rowbase, int fr, int fq, float (&rs)[2][4]) {
    const int L = fq * 16 + fr; float r2[2];
    f32x4 t[2][4];
#pragma unroll
    for (int ai = 0; ai < 2; ++ai) { const f32x4* p = (const f32x4*)(ssp + (size_t)(rowbase + ai * 128 + L) * 16);
#pragma unroll
        for (int q = 0; q < 4; ++q) t[ai][q] = p[q]; }
#pragma unroll
    for (int ai = 0; ai < 2; ++ai) { const f32x4 a = t[ai][0], b = t[ai][1], c = t[ai][2], d = t[ai][3];
        const float s = ((a[0] + a[1]) + (a[2] + a[3])) + ((b[0] + b[1]) + (b[2] + b[3])) + ((c[0] + c[1]) + (c[2] + c[3])) + ((d[0] + d[1]) + (d[2] + d[3]));
        r2[ai] = __builtin_amdgcn_rsqf(s * (1.0f / DM) + EPSN); }
#pragma unroll
    for (int ai = 0; ai < 2; ++ai)
#pragma unroll
        for (int m = 0; m < 4; ++m) rs[ai][m] = __shfl(r2[ai], 16 * m + fr);
}
__device__ __forceinline__ float row_rstd(const float* ssp, int row) {
    const f32x4* p = (const f32x4*)(ssp + (size_t)row * 16);
    const f32x4 a = p[0], b = p[1], c = p[2], d = p[3];
    const float s = ((a[0] + a[1]) + (a[2] + a[3])) + ((b[0] + b[1]) + (b[2] + b[3])) + ((c[0] + c[1]) + (c[2] + c[3])) + ((d[0] + d[1]) + (d[2] + d[3]));
    return 1.0f / sqrtf(s * (1.0f / DM) + EPSN);
}
struct EpiGU {
    static constexpr bool PERM = true, AFTER_DRAIN = false; static constexpr int MID_T = 0;
    bf16* act; const float* ssp; const LAS float* rsL; int pm0;
    __device__ __forceinline__ void operator()(const f32x4 (&acc)[2][2][4][2], const Unit& u, int wr, int wc, int fr, int fq) const {
        const int row0 = u.pm * 256 + wr * 64 + fr, col0 = u.pn * 128 + wc * 32 + 8 * fq;
        float rs[2][4]; rstd8_lds(rsL, ssp, pm0, u, wr, fr, fq, rs);
#pragma unroll
        for (int ai = 0; ai < 2; ++ai)
#pragma unroll
            for (int m = 0; m < 4; ++m) {
                const int row = row0 + ai * 128 + m * 16; const float r = rs[ai][m];
                float h[8];
#pragma unroll
                for (int n = 0; n < 2; ++n)
#pragma unroll
                    for (int j = 0; j < 4; ++j) { const float g = acc[ai][0][m][n][j] * r, up = acc[ai][1][m][n][j] * r; h[n * 4 + j] = siluf_(g) * up; }
                v4u w; w.x = pk2(h[0], h[1]); w.y = pk2(h[2], h[3]); w.z = pk2(h[4], h[5]); w.w = pk2(h[6], h[7]);
                *(v4u*)(act + (size_t)row * FF + col0) = w;
            }
    }
};
struct EpiResid {
    static constexpr bool PERM = true, AFTER_DRAIN = false; static constexpr int MID_T = 0;
    bf16* xb; float* ssp; float alpha;
    __device__ __forceinline__ void operator()(const f32x4 (&acc)[2][2][4][2], const Unit& u, int wr, int wc, int fr, int fq) const {
        const int row0 = u.pm * 256 + wr * 64 + fr, col0 = u.pn * 256 + wc * 32 + 8 * fq;
#pragma unroll
        for (int ai = 0; ai < 2; ++ai)
#pragma unroll
            for (int m = 0; m < 4; ++m) {
                const int row = row0 + ai * 128 + m * 16; float ssq = 0.f;
#pragma unroll
                for (int bj = 0; bj < 2; ++bj) {
                    bf16* xp = xb + (size_t)row * DM + col0 + bj * 128;
                    const v4u xw = *(const v4u*)xp;
                    f32x4 x0 = {bflo(xw.x), bfhi(xw.x), bflo(xw.y), bfhi(xw.y)}, x1 = {bflo(xw.z), bfhi(xw.z), bflo(xw.w), bfhi(xw.w)};
                    x0 = x0 + acc[ai][bj][m][0] * alpha; x1 = x1 + acc[ai][bj][m][1] * alpha;
                    v4u w; w.x = pk2(x0[0], x0[1]); w.y = pk2(x0[2], x0[3]); w.z = pk2(x1[0], x1[1]); w.w = pk2(x1[2], x1[3]);
                    *(v4u*)xp = w;
                    x0 = (f32x4){bflo(w.x), bfhi(w.x), bflo(w.y), bfhi(w.y)}; x1 = (f32x4){bflo(w.z), bfhi(w.z), bflo(w.w), bfhi(w.w)};
                    ssq += (x0[0] * x0[0] + x0[1] * x0[1]) + (x0[2] * x0[2] + x0[3] * x0[3]) + (x1[0] * x1[0] + x1[1] * x1[1]) + (x1[2] * x1[2] + x1[3] * x1[3]);
                }
                ssq += __shfl_xor(ssq, 16); ssq += __shfl_xor(ssq, 32);
                if (fq == 0) ssp[(size_t)row * 16 + u.pn * 4 + wc] = ssq;
            }
    }
};
struct EpiWin {
    static constexpr bool PERM = true, AFTER_DRAIN = false; static constexpr int MID_T = 0;
    unsigned char* ws; const float* ssp; const LAS float* rsL; int pm0;
    __device__ __forceinline__ void operator()(const f32x4 (&acc)[2][2][4][2], const Unit& u, int wr, int wc, int fr, int fq) const {
        const int row0 = u.pm * 256 + wr * 64 + fr, pn = u.pn;
        bf16* dst = nullptr; int ld = 0, coff = 0, actk = 0; float scale = 1.f;
        if (pn < T_KVA) { dst = (bf16*)(ws + WS_QA); ld = 512; coff = (pn - T_QA) * 256; scale = 0.125f; }
        else if (pn == T_KVA) { }
        else if (pn < T_QB) { dst = (bf16*)(ws + WS_KVS); ld = 512; coff = (pn - T_KVA - 1) * 256; }
        else if (pn < T_KB) { dst = (bf16*)(ws + WS_QB); ld = 512; coff = (pn - T_QB) * 256; scale = 0.08838834764831845f; }
        else if (pn < T_VB) { dst = (bf16*)(ws + WS_KB); ld = 512; coff = (pn - T_KB) * 256; }
        else if (pn < T_RB) { dst = (bf16*)(ws + WS_VB); ld = 1024; coff = (pn - T_VB) * 256; }
        else if (pn < T_GM) { dst = (bf16*)(ws + WS_RB); ld = 1024; coff = (pn - T_RB) * 256; actk = 1; }
        else if (pn < T_MISC) { }
        float rs[2][4]; rstd8_lds(rsL, ssp, pm0, u, wr, fr, fq, rs);
#pragma unroll
        for (int ai = 0; ai < 2; ++ai)
#pragma unroll
            for (int m = 0; m < 4; ++m) {
                const int row = row0 + ai * 128 + m * 16; const float r = rs[ai][m];
                if (pn >= T_GM && pn < T_MISC) {
                    float rr[8], g1[8];
#pragma unroll
                    for (int n = 0; n < 2; ++n)
#pragma unroll
                        for (int j = 0; j < 4; ++j) { const float ea = __builtin_amdgcn_exp2f(acc[ai][0][m][n][j] * r * -1.4426950408889634f), eb = __builtin_amdgcn_exp2f(acc[ai][1][m][n][j] * r * -1.4426950408889634f);
                            const float sb = __builtin_amdgcn_rcpf(1.0f + eb); g1[n * 4 + j] = sb; rr[n * 4 + j] = (1.0f + eb) * __builtin_amdgcn_rcpf(1.0f + ea); }
                    v4u w0; w0.x = pk2(rr[0], rr[1]); w0.y = pk2(rr[2], rr[3]); w0.z = pk2(rr[4], rr[5]); w0.w = pk2(rr[6], rr[7]);
                    v4u w1; w1.x = pk2(g1[0], g1[1]); w1.y = pk2(g1[2], g1[3]); w1.z = pk2(g1[4], g1[5]); w1.w = pk2(g1[6], g1[7]);
                    const size_t o = (size_t)row * DM + (pn - T_GM) * 128 + wc * 32 + 8 * fq;
                    *(v4u*)((bf16*)(ws + WS_GM) + o) = w0; *(v4u*)((bf16*)(ws + WS_GM + 32 * MiB) + o) = w1;
                } else if (pn == T_MISC) {
                    float* ga = (float*)(ws + WS_GA); float* alr = (float*)(ws + WS_ALR);
#pragma unroll
                    for (int n = 0; n < 2; ++n)
#pragma unroll
                        for (int j = 0; j < 4; ++j) { const int c = wc * 32 + 8 * fq + 4 * n + j; const float v = acc[ai][0][m][n][j] * r;
                            if (c < 24) ga[(size_t)row * 24 + c] = sigmoidf_(v); else if (c < 40) alr[(size_t)row * 16 + (c - 24)] = v; }
                } else {
#pragma unroll
                    for (int bj = 0; bj < 2; ++bj) {
                        float h[8];
#pragma unroll
                        for (int n = 0; n < 2; ++n)
#pragma unroll
                            for (int j = 0; j < 4; ++j) { float v = acc[ai][bj][m][n][j] * r * scale; if (actk == 1) v = siluf_(v); else if (actk == 2) v = sigmoidf_(v); h[n * 4 + j] = v; }
                        v4u w; w.x = pk2(h[0], h[1]); w.y = pk2(h[2], h[3]); w.z = pk2(h[4], h[5]); w.w = pk2(h[6], h[7]);
                        if (pn == T_KVA) {
                            const int b = row >> 12, t = row & 4095, g = wc >> 1, d = (wc & 1) * 32 + 8 * fq;
                            bf16* kvc = (bf16*)(ws + WS_KVC);
                            *(v4u*)(kvc + ((size_t)((bj * 4 + b) * 2 + g) * SEQ + t) * 64 + d) = w;
                        } else {
                            *(v4u*)(dst + (size_t)row * ld + coff + bj * 128 + wc * 32 + 8 * fq) = w;
                        }
                    }
                }
            }
    }
};
struct EpiCmp1 {
    static constexpr bool PERM = true, AFTER_DRAIN = false; static constexpr int MID_T = 0;
    bf16* hid; const float* posb;
    __device__ __forceinline__ void operator()(const f32x4 (&acc)[2][2][4][2], const Unit& u, int wr, int wc, int fr, int fq) const {
        const int row0 = u.pm * 256 + wr * 64 + fr, col0 = wc * 32 + 8 * fq;
#pragma unroll
        for (int ai = 0; ai < 2; ++ai)
#pragma unroll
            for (int m = 0; m < 4; ++m) {
                const int row = row0 + ai * 128 + m * 16;
#pragma unroll
                for (int bj = 0; bj < 2; ++bj) {
                    const f32x4 b0 = *(const f32x4*)(posb + col0 + bj * 128), b1 = *(const f32x4*)(posb + col0 + bj * 128 + 4);
                    const f32x4 v0 = acc[ai][bj][m][0] + b0, v1 = acc[ai][bj][m][1] + b1;
                    v4u w; w.x = pk2(siluf_(v0[0]), siluf_(v0[1])); w.y = pk2(siluf_(v0[2]), siluf_(v0[3])); w.z = pk2(siluf_(v1[0]), siluf_(v1[1])); w.w = pk2(siluf_(v1[2]), siluf_(v1[3]));
                    *(v4u*)(hid + (size_t)row * 256 + col0 + bj * 128) = w;
                }
            }
    }
};
struct EpiMergeF {
    static constexpr bool PERM = true, AFTER_DRAIN = false; static constexpr int MID_T = 8;
    const bf16* ratio; const bf16* g1; bf16* y;
    __device__ __forceinline__ void mid(f32x4 (&acc)[2][2][4][2], const Unit& u, int wr, int wc, int fr, int fq) const {
        int row0 = u.pm * 256 + wr * 64 + fr, col0 = u.pn * 256 + wc * 32 + 8 * fq;
        asm volatile("" : "+v"(row0), "+v"(col0));
#pragma unroll
        for (int ai = 0; ai < 2; ++ai)
#pragma unroll
            for (int m = 0; m < 4; ++m)
#pragma unroll
                for (int bj = 0; bj < 2; ++bj) {
                    const v4u gw = *(const v4u*)(ratio + (unsigned)((row0 + ai * 128 + m * 16) * DM + col0 + bj * 128));
                    acc[ai][bj][m][0] = acc[ai][bj][m][0] * (f32x4){bflo(gw.x), bfhi(gw.x), bflo(gw.y), bfhi(gw.y)};
                    acc[ai][bj][m][1] = acc[ai][bj][m][1] * (f32x4){bflo(gw.z), bfhi(gw.z), bflo(gw.w), bfhi(gw.w)};
                    if (bj == 1 && m == 3) asm volatile("" ::: "memory");
                }
    }
    __device__ __forceinline__ void operator()(const f32x4 (&acc)[2][2][4][2], const Unit& u, int wr, int wc, int fr, int fq) const {
        const int row0 = u.pm * 256 + wr * 64 + fr, col0 = u.pn * 256 + wc * 32 + 8 * fq;
#pragma unroll
        for (int ai = 0; ai < 2; ++ai)
#pragma unroll
            for (int m = 0; m < 4; ++m)
#pragma unroll
                for (int bj = 0; bj < 2; ++bj) {
                    const unsigned o = (unsigned)((row0 + ai * 128 + m * 16) * DM + col0 + bj * 128);
                    const v4u gw = *(const v4u*)(g1 + o);
                    const f32x4 v0 = acc[ai][bj][m][0] * (f32x4){bflo(gw.x), bfhi(gw.x), bflo(gw.y), bfhi(gw.y)}, v1 = acc[ai][bj][m][1] * (f32x4){bflo(gw.z), bfhi(gw.z), bflo(gw.w), bfhi(gw.w)};
                    v4u w; w.x = pk2(v0[0], v0[1]); w.y = pk2(v0[2], v0[3]); w.z = pk2(v1[0], v1[1]); w.w = pk2(v1[2], v1[3]);
                    *(v4u*)(y + o) = w;
                }
    }
};
template <int STEP> struct EpiMerge {
    static constexpr bool PERM = true, AFTER_DRAIN = false; static constexpr int MID_T = 0;
    const bf16* gm; float* ypart; bf16* y;
    __device__ __forceinline__ void operator()(const f32x4 (&acc)[2][2][4][2], const Unit& u, int wr, int wc, int fr, int fq) const {
        const int row0 = u.pm * 256 + wr * 64 + fr, col0 = u.pn * 256 + wc * 32 + 8 * fq;
#pragma unroll
        for (int ai = 0; ai < 2; ++ai)
#pragma unroll
            for (int m = 0; m < 4; ++m) {
                const int row = row0 + ai * 128 + m * 16;
#pragma unroll
                for (int bj = 0; bj < 2; ++bj) {
                    const int col = col0 + bj * 128;
                    const v4u gw = *(const v4u*)(gm + (size_t)row * 2048 + (STEP == 1 ? 0 : 1024) + col);
                    f32x4 g0 = {bflo(gw.x), bfhi(gw.x), bflo(gw.y), bfhi(gw.y)}, g1 = {bflo(gw.z), bfhi(gw.z), bflo(gw.w), bfhi(gw.w)};
                    float* yp = ypart + (size_t)row * DM + col;
                    if (STEP == 1) { *(f32x4*)yp = g0 * acc[ai][bj][m][0]; *(f32x4*)(yp + 4) = g1 * acc[ai][bj][m][1]; }
                    else { const f32x4 v0 = *(const f32x4*)yp + g0 * acc[ai][bj][m][0], v1 = *(const f32x4*)(yp + 4) + g1 * acc[ai][bj][m][1];
                        v4u w; w.x = pk2(v0[0], v0[1]); w.y = pk2(v0[2], v0[3]); w.z = pk2(v1[0], v1[1]); w.w = pk2(v1[2], v1[3]);
                        *(v4u*)(y + (size_t)row * DM + col) = w; }
                }
            }
    }
};

struct SrcCol { const float* p; int col; };
template <bool GAIN, class Map>
__device__ __forceinline__ void tr_item(int ldw, const float* gain, bf16* WT, int K, int nblk, int item, LAS float* scr, int lane, const Map& cm, int ldk = 0) {
    if (ldk == 0) ldk = K;
    const int kb = item / nblk, nb = item % nblk, k0 = 64 * kb, n0 = 32 * nb;
    const SrcCol sc = cm(n0 + (lane & 31));
    const float msk = sc.col >= 0 ? 1.f : 0.f;
    const float* src = sc.p + (size_t)(k0 + (lane >> 5)) * ldw + (sc.col >= 0 ? sc.col : 0);
    float v[32];
#pragma unroll
    for (int i = 0; i < 32; ++i) v[i] = src[(size_t)(2 * i) * ldw];
    if constexpr (GAIN) {
        const float* gp = gain + k0 + (lane >> 5);
#pragma unroll
        for (int i = 0; i < 32; ++i) v[i] *= gp[2 * i];
    }
#pragma unroll
    for (int i = 0; i < 32; ++i) scr[(2 * i + (lane >> 5)) * 33 + (lane & 31)] = v[i] * msk;
    LDS_WAIT();
    const int c = lane & 7;
#pragma unroll
    for (int j = 0; j < 4; ++j) { const int n = (lane >> 3) + 8 * j; const LAS float* s = scr + (8 * c) * 33 + n;
        v4u o; o.x = pk2(s[0 * 33], s[1 * 33]); o.y = pk2(s[2 * 33], s[3 * 33]); o.z = pk2(s[4 * 33], s[5 * 33]); o.w = pk2(s[6 * 33], s[7 * 33]);
        *(v4u*)(WT + (size_t)(n0 + n) * ldk + k0 + 8 * c) = o; }
    LDS_WAIT();
}
struct MapGU { const float* p; __device__ __forceinline__ SrcCol operator()(int n) const { return SrcCol{p, (n >> 8) * 128 + (n & 127)}; } };
struct MapId { const float* p; __device__ __forceinline__ SrcCol operator()(int n) const { return SrcCol{p, n}; } };
struct MapWin { const float* p; __device__ __forceinline__ SrcCol operator()(int n) const {
    const int t = n >> 8, r = n & 255; int c;
    if (t < T_KVA) c = SRC_QA + n; else if (t < T_QB) c = SRC_KVA + (n - T_KVA * 256); else if (t < T_KB) c = SRC_QB + (n - T_QB * 256); else if (t < T_VB) c = SRC_KB + (n - T_KB * 256);
    else if (t < T_RB) c = SRC_VB + (n - T_VB * 256); else if (t < T_GM) c = SRC_RB + (n - T_RB * 256); else if (t < T_MISC) c = SRC_GM + (t - T_GM) * 128 + (r & 127) + (r >= 128 ? 1024 : 0);
    else c = r < 24 ? SRC_GA + r : (r < 40 ? SRC_ALR + (r - 24) : -1);
    return SrcCol{p, c}; } };

__device__ __forceinline__ void phase_conv(Frame& F, const Args& a, int l) {
    relaunder(F);
    LAS float* scr = (LAS float*)(F.lds + RING_OFF + F.wave * 16384);
    const int gw = F.bid * NWAVES + F.wave, NGW = F.G * NWAVES;
    unsigned char* ws = F.ws;
    constexpr int I_GU = (DM / 64) * (NGU / 32), I_D = (FF / 64) * (DM / 32), I_IN = (DM / 64) * (NIN / 32), I_C1 = (2048 / 64) * (256 / 32), I_N = (512 / 64) * (DM / 32), I_SQ = (DM / 64) * (DM / 32);
    constexpr int NITEMS = 2 * I_GU + 2 * I_D + I_IN + 2 * I_C1 + I_N + 2 * I_SQ;
    const size_t oG = (size_t)l * DM * FF, oD = (size_t)l * FF * DM;
    for (int it = gw; it < NITEMS; it += NGW) {
        int r = it;
        if (r < I_GU) { const bool up = (((r % (NGU / 32)) * 32) & 255) >= 128;
            if (up) tr_item<true>(FF, inp(F, I_F1N) + l * DM, (bf16*)(ws + W_GU1), DM, NGU / 32, r, scr, F.lane, MapGU{inp(F, I_F1U) + oG});
            else tr_item<true>(FF, inp(F, I_F1N) + l * DM, (bf16*)(ws + W_GU1), DM, NGU / 32, r, scr, F.lane, MapGU{inp(F, I_F1G) + oG});
            continue; } r -= I_GU;
        if (r < I_GU) { const bool up = (((r % (NGU / 32)) * 32) & 255) >= 128;
            if (up) tr_item<true>(FF, inp(F, I_F2N) + l * DM, (bf16*)(ws + W_GU2), DM, NGU / 32, r, scr, F.lane, MapGU{inp(F, I_F2U) + oG});
            else tr_item<true>(FF, inp(F, I_F2N) + l * DM, (bf16*)(ws + W_GU2), DM, NGU / 32, r, scr, F.lane, MapGU{inp(F, I_F2G) + oG});
            continue; } r -= I_GU;
        if (r < I_D) { tr_item<false>(DM, nullptr, (bf16*)(ws + W_D1), FF, DM / 32, r, scr, F.lane, MapId{inp(F, I_F1D) + oD}); continue; } r -= I_D;
        if (r < I_D) { tr_item<false>(DM, nullptr, (bf16*)(ws + W_D2), FF, DM / 32, r, scr, F.lane, MapId{inp(F, I_F2D) + oD}); continue; } r -= I_D;
        if (r < I_IN) { tr_item<true>(DIN, inp(F, I_MIXN) + l * DM, (bf16*)(ws + W_IN), DM, NIN / 32, r, scr, F.lane, MapWin{inp(F, I_WIN) + (size_t)l * DM * DIN}); continue; } r -= I_IN;
        if (r < I_C1) { tr_item<false>(256, nullptr, (bf16*)(ws + W_C1K), 2048, 256 / 32, r, scr, F.lane, MapId{inp(F, I_CKW1) + (size_t)l * 2048 * 256}); continue; } r -= I_C1;
        if (r < I_C1) { tr_item<false>(256, nullptr, (bf16*)(ws + W_C1V), 2048, 256 / 32, r, scr, F.lane, MapId{inp(F, I_CVW1) + (size_t)l * 2048 * 256}); continue; } r -= I_C1;
        if (r < I_N) { tr_item<false>(DM, nullptr, (bf16*)(ws + W_CAT), 512, DM / 32, r, scr, F.lane, MapId{inp(F, I_WBN) + (size_t)l * 512 * DM}, 1536); continue; } r -= I_N;
        if (r < I_SQ) { tr_item<true>(DM, inp(F, I_GON) + l * DM, (bf16*)(ws + W_CAT) + 512, DM, DM / 32, r, scr, F.lane, MapId{inp(F, I_WBG) + (size_t)l * DM * DM}, 1536); continue; } r -= I_SQ;
        tr_item<false>(DM, nullptr, (bf16*)(ws + W_O), DM, DM / 32, r, scr, F.lane, MapId{inp(F, I_WOUT) + (size_t)l * DM * DM});
    }
    __syncthreads();
    if (F.bid < 32) {
        const int kv = F.bid >> 4, nb = (F.bid & 15) * 16, c = F.tid & 15, ks = F.tid >> 4;
        const float* pos = inp(F, kv ? I_POSV : I_POSK) + (size_t)l * 2048; const float* w1 = inp(F, kv ? I_CVW1 : I_CKW1) + (size_t)l * 2048 * 256;
        float s = 0.f;
#pragma unroll 32
        for (int k = ks * 64; k < ks * 64 + 64; ++k) s += pos[k] * w1[(size_t)k * 256 + nb + c];
        LAS float* red = (LAS float*)(F.lds + RING_OFF);
        red[F.tid] = s; __syncthreads();
        if (F.tid < 16) { float t = 0.f; for (int i = 0; i < 32; ++i) t += red[i * 16 + F.tid]; ((float*)(ws + WS_POSB))[kv * 256 + nb + F.tid] = t; }
        __syncthreads();
    }
}
__device__ __forceinline__ void phase_lut(Frame& F, const Args& a) {
    relaunder(F);
    float* lut = (float*)(F.ws + WS_LUT); const float* tab = inp(F, I_REL);
    for (int i = F.bid * 512 + F.tid; i < 8 * 4096; i += F.G * 512) {
        const int h = i >> 12, n = i & 4095; int bk;
        if (n < 16) bk = n; else { const float nf = (float)n; int lb = 16 + (int)(logf(nf / 16.0f) / 4.1588830833596715f * 16.0f); bk = lb < 31 ? lb : 31; }
        lut[i] = tab[bk * 8 + h];
    }
}
__device__ __forceinline__ void phase_x0(Frame& F, const Args& a) {
    relaunder(F);
    const int gw = F.bid * NWAVES + F.wave, NGW = F.G * NWAVES;
    bf16* xb = (bf16*)(F.ws + WS_XB); float* ssp = (float*)(F.ws + WS_SSP);
    for (int m = gw; m < MTOK; m += NGW) {
        const f32x4* xr = (const f32x4*)(inp(F, I_X) + (size_t)m * DM) + F.lane;
        v2u* o8 = (v2u*)(xb + (size_t)m * DM) + F.lane; float s = 0.f;
#pragma unroll
        for (int j = 0; j < 4; ++j) { const f32x4 v = xr[64 * j]; v2u w; w.x = pk2(v[0], v[1]); w.y = pk2(v[2], v[3]); o8[64 * j] = w; const float a0 = bflo(w.x), a1 = bfhi(w.x), a2 = bflo(w.y), a3 = bfhi(w.y); s += (a0 * a0 + a1 * a1) + (a2 * a2 + a3 * a3); }
        s = wave_sum(s);
        if (F.lane < 16) ssp[(size_t)m * 16 + F.lane] = F.lane == 0 ? s : 0.f;
    }
}
__device__ __forceinline__ void phase_final(Frame& F, const Args& a) {
    relaunder(F);
    const int gw = F.bid * NWAVES + F.wave, NGW = F.G * NWAVES; const f32x4* gnp = (const f32x4*)inp(F, I_FIN) + F.lane;
    const f32x4 gn[4] = {gnp[0], gnp[64], gnp[128], gnp[192]};
    const bf16* xb = (const bf16*)(F.ws + WS_XB);
    for (int m = gw; m < MTOK; m += NGW) {
        const v2u* xr = (const v2u*)(xb + (size_t)m * DM) + F.lane; f32x4* orow = (f32x4*)(a.out + (size_t)m * DM) + F.lane; f32x4 v[4]; float s = 0.f;
#pragma unroll
        for (int j = 0; j < 4; ++j) { const v2u w = xr[64 * j]; v[j] = (f32x4){bflo(w.x), bfhi(w.x), bflo(w.y), bfhi(w.y)}; s += (v[j][0] * v[j][0] + v[j][1] * v[j][1]) + (v[j][2] * v[j][2] + v[j][3] * v[j][3]); }
        const float r = __builtin_amdgcn_rsqf(wave_sum(s) * (1.0f / DM) + EPSN);
#pragma unroll
        for (int j = 0; j < 4; ++j) orow[64 * j] = v[j] * r * gn[j];
    }
}
__device__ __forceinline__ void phase_cmp2(Frame& F, const Args& a, int l) {
    relaunder(F);
    const int gw = F.bid * NWAVES + F.wave, NGW = F.G * NWAVES;
    const bf16* hid = (const bf16*)(F.ws + WS_HID); float* out = (float*)(F.ws + WS_KVCMP);
    for (int row = gw; row < 4096; row += NGW) {
        const int kv = row >> 11; const float* w2 = inp(F, kv ? I_CVW2 : I_CKW2) + (size_t)l * 256 * 64;
        const bf16* hr = hid + (size_t)row * 256; float s = 0.f;
        for (int k = 0; k < 256; k += 8) { const v4u hw = *(const v4u*)(hr + k);
            s += bflo(hw.x) * w2[(k + 0) * 64 + F.lane] + bfhi(hw.x) * w2[(k + 1) * 64 + F.lane] + bflo(hw.y) * w2[(k + 2) * 64 + F.lane] + bfhi(hw.y) * w2[(k + 3) * 64 + F.lane]
               + bflo(hw.z) * w2[(k + 4) * 64 + F.lane] + bfhi(hw.z) * w2[(k + 5) * 64 + F.lane] + bflo(hw.w) * w2[(k + 6) * 64 + F.lane] + bfhi(hw.w) * w2[(k + 7) * 64 + F.lane]; }
        out[(size_t)row * 64 + F.lane] = s; ((bf16*)(F.ws + WS_KVCMPB))[(size_t)row * 64 + F.lane] = (bf16)f2bf(s);
    }
}

__device__ __forceinline__ void dot4_bf16(const bf16* kp, const LAS float* qs, float (&s)[4]) {
    s[0] = s[1] = s[2] = s[3] = 0.f;
#pragma unroll 2
    for (int c = 0; c < 8; ++c) { const v4u kw = *(const v4u*)(kp + c * 8);
        const float kf[8] = {bflo(kw.x), bfhi(kw.x), bflo(kw.y), bfhi(kw.y), bflo(kw.z), bfhi(kw.z), bflo(kw.w), bfhi(kw.w)};
#pragma unroll
        for (int h = 0; h < 4; ++h) { const f32x4 q0 = *(const LAS f32x4*)(qs + h * 64 + c * 8), q1 = *(const LAS f32x4*)(qs + h * 64 + c * 8 + 4);
            s[h] += (kf[0] * q0[0] + kf[1] * q0[1]) + (kf[2] * q0[2] + kf[3] * q0[3]) + (kf[4] * q1[0] + kf[5] * q1[1]) + (kf[6] * q1[2] + kf[7] * q1[3]); } }
}
__device__ __forceinline__ void dot4_f32(const float* kp, const LAS float* qs, float (&s)[4]) {
    s[0] = s[1] = s[2] = s[3] = 0.f;
#pragma unroll 4
    for (int c = 0; c < 16; ++c) { const f32x4 kf = *(const f32x4*)(kp + c * 4);
#pragma unroll
        for (int h = 0; h < 4; ++h) { const f32x4 q0 = *(const LAS f32x4*)(qs + h * 64 + c * 4); s[h] += (kf[0] * q0[0] + kf[1] * q0[1]) + (kf[2] * q0[2] + kf[3] * q0[3]); } }
}
__device__ __forceinline__ void online_block(const float (&s)[4], bool kvalid, const bf16* vp, int vld, LAS float* ps, int lane, float (&m)[4], float (&lsum)[4], float (&o)[4]) {
    float p[4];
#pragma unroll
    for (int h = 0; h < 4; ++h) {
        const float sm = wave_max(kvalid ? s[h] : -INFINITY), mn = fmaxf(m[h], sm);
        const float sc = (m[h] == -INFINITY) ? 0.f : __expf(m[h] - mn);
        p[h] = (kvalid && mn > -INFINITY) ? __expf(s[h] - mn) : 0.f;
        lsum[h] = lsum[h] * sc + wave_sum(p[h]); o[h] *= sc; m[h] = mn;
    }
    *(LAS f32x4*)(ps + lane * 4) = (f32x4){p[0], p[1], p[2], p[3]};
    LDS_WAIT();
#pragma unroll 8
    for (int k = 0; k < 64; ++k) { const f32x4 pv = *(const LAS f32x4*)(ps + k * 4); const float v = bf2f(vp[(size_t)k * vld + lane]);
        o[0] += pv[0] * v; o[1] += pv[1] * v; o[2] += pv[2] * v; o[3] += pv[3] * v; }
    LDS_WAIT();
}
__device__ __forceinline__ void phase_nsa_naive(Frame& F) {
    relaunder(F);
    LAS float* wl = (LAS float*)(F.lds + RING_OFF + F.wave * 16384);
    LAS float* qs = wl; LAS float* ps = wl + 256; LAS float* psum = wl + 512; LAS float* scl = wl + 1024;
    const bf16* qa = (const bf16*)(F.ws + WS_QA); const bf16* kvs = (const bf16*)(F.ws + WS_KVS); const float* ga = (const float*)(F.ws + WS_GA);
    const float* kvcmp = (const float*)(F.ws + WS_KVCMP); const float* lut = (const float*)(F.ws + WS_LUT); bf16* oa = (bf16*)(F.ws + WS_OA);
    const int lane = F.lane;
    for (int wt = F.bid; wt < 4096; wt += F.G) {
        const int bg = wt & 7, tb = wt >> 3, b = bg >> 1, g = bg & 1, t = tb * 8 + F.wave, row = b * SEQ + t, jcur = t >> 6;
        const float* lutg = lut + (size_t)(g * 4) * 4096;
#pragma unroll
        for (int h = 0; h < 4; ++h) qs[h * 64 + lane] = bf2f(qa[(size_t)row * 512 + (g * 4 + h) * 64 + lane]);
        LDS_WAIT();
        float gate[4][3];
#pragma unroll
        for (int h = 0; h < 4; ++h)
#pragma unroll
            for (int br = 0; br < 3; ++br) gate[h][br] = ga[(size_t)row * 24 + (g * 4 + h) * 3 + br];
        float oacc[4] = {0.f, 0.f, 0.f, 0.f};
        const int ncv = t >= 31 ? ((t - 31) >> 4) + 1 : 0;
        float imp = 0.f;
        if (ncv > 0) {
            const float* kc = kvcmp + (size_t)(0 * 8 + bg) * 256 * 64; const float* vc = kvcmp + (size_t)(1 * 8 + bg) * 256 * 64;
            float mx[4] = {-INFINITY, -INFINITY, -INFINITY, -INFINITY};
            const int nblk = (ncv + 63) >> 6;
#pragma unroll 1
            for (int blk = 0; blk < nblk; ++blk) {
                const int c = blk * 64 + lane; const bool valid = c < ncv;
                float s[4]; dot4_f32(kc + (size_t)(c < 255 ? c : 255) * 64, qs, s);
                const int dist = valid ? t - (16 * c + 31) : 0;
#pragma unroll
                for (int h = 0; h < 4; ++h) { const float v = valid ? s[h] + lutg[h * 4096 + dist] : -INFINITY; scl[h * 256 + c] = v; mx[h] = fmaxf(mx[h], v); }
            }
            float ls[4] = {0.f, 0.f, 0.f, 0.f};
#pragma unroll
            for (int h = 0; h < 4; ++h) mx[h] = wave_max(mx[h]);
            LDS_WAIT();
#pragma unroll 1
            for (int blk = 0; blk < nblk; ++blk) {
                const int c = blk * 64 + lane;
#pragma unroll
                for (int h = 0; h < 4; ++h) { const float v = scl[h * 256 + c]; const float p = v > -INFINITY ? __expf(v - mx[h]) : 0.f; scl[h * 256 + c] = p; ls[h] += p; }
            }
#pragma unroll
            for (int h = 0; h < 4; ++h) ls[h] = 1.0f / wave_sum(ls[h]);
            LDS_WAIT();
            float oc[4] = {0.f, 0.f, 0.f, 0.f};
#pragma unroll 1
            for (int blk = 0; blk < 4; ++blk) {
                const int c = blk * 64 + lane; float pt = 0.f;
                if (blk < nblk) {
#pragma unroll
                    for (int h = 0; h < 4; ++h) { const float p = scl[h * 256 + c] * ls[h]; scl[h * 256 + c] = p; pt += p; }
                }
                psum[c] = pt;
            }
            LDS_WAIT();
#pragma unroll 2
            for (int k = 0; k < ncv; ++k) { const float v = vc[(size_t)k * 64 + lane];
                oc[0] += scl[k] * v; oc[1] += scl[256 + k] * v; oc[2] += scl[512 + k] * v; oc[3] += scl[768 + k] * v; }
#pragma unroll
            for (int i = -1; i <= 3; ++i) { const int c = 4 * lane + i; if (c >= 0 && c < 255) imp += psum[c]; }
#pragma unroll
            for (int h = 0; h < 4; ++h) oacc[h] += gate[h][0] * oc[h];
            LDS_WAIT();
        }
        const bool forced = (lane == 0) || (lane == jcur) || (lane == jcur - 1);
        const float score = forced ? 1e6f : (lane <= jcur ? imp : -1e6f);
        int rank = 0;
#pragma unroll 4
        for (int s2 = 0; s2 < 64; ++s2) { const float v2 = __shfl(score, s2); rank += (v2 > score || (v2 == score && s2 < lane)) ? 1 : 0; }
        unsigned long long selmask = __ballot(rank < 16);
        selmask &= (jcur == 63) ? ~0ull : ((1ull << (jcur + 1)) - 1ull);
        {
            float m[4] = {-INFINITY, -INFINITY, -INFINITY, -INFINITY}, lsum[4] = {0.f, 0.f, 0.f, 0.f}, o[4] = {0.f, 0.f, 0.f, 0.f};
#pragma unroll 1
            while (selmask) {
                const int j = __builtin_ctzll(selmask); selmask &= selmask - 1ull;
                const int pos = j * 64 + lane; const bool kvalid = pos <= t;
                float s[4]; dot4_bf16(kvs + (size_t)(b * SEQ + pos) * 512 + 0 * 128 + g * 64, qs, s);
                if (kvalid) {
#pragma unroll
                    for (int h = 0; h < 4; ++h) s[h] += lutg[h * 4096 + (t - pos)];
                }
                online_block(s, kvalid, kvs + (size_t)(b * SEQ + j * 64) * 512 + 1 * 128 + g * 64, 512, ps, lane, m, lsum, o);
            }
#pragma unroll
            for (int h = 0; h < 4; ++h) oacc[h] += gate[h][1] * o[h] / lsum[h];
        }
        {
            float m[4] = {-INFINITY, -INFINITY, -INFINITY, -INFINITY}, lsum[4] = {0.f, 0.f, 0.f, 0.f}, o[4] = {0.f, 0.f, 0.f, 0.f};
            const int lo = t - 511 > 0 ? t - 511 : 0;
#pragma unroll 1
            for (int j = lo >> 6; j <= jcur; ++j) {
                const int pos = j * 64 + lane; const bool kvalid = pos <= t && pos >= lo;
                float s[4]; dot4_bf16(kvs + (size_t)(b * SEQ + pos) * 512 + 2 * 128 + g * 64, qs, s);
                if (kvalid) {
#pragma unroll
                    for (int h = 0; h < 4; ++h) s[h] += lutg[h * 4096 + (t - pos)];
                }
                online_block(s, kvalid, kvs + (size_t)(b * SEQ + j * 64) * 512 + 3 * 128 + g * 64, 512, ps, lane, m, lsum, o);
            }
#pragma unroll
            for (int h = 0; h < 4; ++h) oacc[h] += gate[h][2] * o[h] / lsum[h];
        }
#pragma unroll
        for (int h = 0; h < 4; ++h) oa[(size_t)row * 512 + (g * 4 + h) * 64 + lane] = (bf16)f2bf(oacc[h]);
        LDS_WAIT();
    }
}


typedef float f32x16 __attribute__((ext_vector_type(16)));
typedef short v4i16_t __attribute__((ext_vector_type(4)));
constexpr int NSA_TS = 144;
constexpr int NL_K = 0, NL_V = 9216, NL_LUT = 18432, NL_IMP = NL_LUT + 32768, NL_SEL = NL_IMP + 4 * 64 * 65 * 4, NL_END = NL_SEL + 512;
static_assert(NL_END <= RING_BYTES, "nsa lds");
#define KLOC(i) (((i) & 3) + 8 * ((i) >> 2) + 4 * hf)

__device__ __forceinline__ void nsa_qk(const LAS unsigned char* Kt, const bf16x8 (&qf)[4], int r32, int hf, f32x16& p0, f32x16& p1) {
#pragma unroll
    for (int i = 0; i < 16; ++i) { p0[i] = 0.f; p1[i] = 0.f; }
#pragma unroll
    for (int ks = 0; ks < 4; ++ks) {
        const bf16x8 a0 = *(const LAS bf16x8*)(Kt + r32 * NSA_TS + ks * 32 + hf * 16);
        const bf16x8 a1 = *(const LAS bf16x8*)(Kt + (32 + r32) * NSA_TS + ks * 32 + hf * 16);
        p0 = __builtin_amdgcn_mfma_f32_32x32x16_bf16(a0, qf[ks], p0, 0, 0, 0);
        p1 = __builtin_amdgcn_mfma_f32_32x32x16_bf16(a1, qf[ks], p1, 0, 0, 0);
    }
}
__device__ __forceinline__ bf16x8 nsa_pack(const f32x16& p, const int s) {
    v4u w; w.x = pk2(p[8 * s + 0], p[8 * s + 1]); w.y = pk2(p[8 * s + 2], p[8 * s + 3]); w.z = pk2(p[8 * s + 4], p[8 * s + 5]); w.w = pk2(p[8 * s + 6], p[8 * s + 7]);
    return __builtin_bit_cast(bf16x8, w);
}
__device__ __forceinline__ void nsa_pv(const LAS unsigned char* Vt, const f32x16& p0, const f32x16& p1, int lane, int hf, f32x16 (&o)[2]) {
    bf16x8 pb[4]; pb[0] = nsa_pack(p0, 0); pb[1] = nsa_pack(p0, 1); pb[2] = nsa_pack(p1, 0); pb[3] = nsa_pack(p1, 1);
    const LAS unsigned char* base = Vt + (4 * hf + ((lane & 15) >> 2)) * NSA_TS + (16 * ((lane >> 4) & 1) + 4 * (lane & 3)) * 2;
#pragma unroll
    for (int dt = 0; dt < 2; ++dt)
#pragma unroll
        for (int ks = 0; ks < 4; ++ks) {
            const LAS unsigned char* ap = base + (16 * ks) * NSA_TS + dt * 64;
            const v4i16_t lo = __builtin_amdgcn_ds_read_tr16_b64_v4i16((LAS v4i16_t*)ap);
            const v4i16_t hi = __builtin_amdgcn_ds_read_tr16_b64_v4i16((LAS v4i16_t*)(ap + 8 * NSA_TS));
            const bf16x8 a = {lo[0], lo[1], lo[2], lo[3], hi[0], hi[1], hi[2], hi[3]};
            o[dt] = __builtin_amdgcn_mfma_f32_32x32x16_bf16(a, pb[ks], o[dt], 0, 0, 0);
        }
}
__device__ __forceinline__ void nsa_online(f32x16& p0, f32x16& p1, float& m, float& l, f32x16 (&o)[2]) {
    float bm = -INFINITY;
#pragma unroll
    for (int i = 0; i < 16; ++i) bm = fmaxf(bm, fmaxf(p0[i], p1[i]));
    bm = fmaxf(bm, __shfl_xor(bm, 32));
    const float mn = fmaxf(m, bm), mref = (mn == -INFINITY) ? 0.f : mn, sc = __expf(m - mref);
    float ps = 0.f;
#pragma unroll
    for (int i = 0; i < 16; ++i) { p0[i] = __expf(p0[i] - mref); p1[i] = __expf(p1[i] - mref); ps += p0[i] + p1[i]; }
    l = l * sc + ps; m = mn;
#pragma unroll
    for (int i = 0; i < 16; ++i) { o[0][i] *= sc; o[1][i] *= sc; }
}
__device__ __forceinline__ v4u nsa_ld16(const bf16* p) { return *(const v4u*)p; }

__device__ __forceinline__ void phase_nsa(Frame& F) {
    relaunder(F);
    LAS unsigned char* L = F.lds + RING_OFF;
    LAS unsigned char* Kt = L + NL_K; LAS unsigned char* Vt = L + NL_V;
    LAS float* lutL = (LAS float*)(L + NL_LUT); LAS float* impL = (LAS float*)(L + NL_IMP); LAS unsigned long long* selL = (LAS unsigned long long*)(L + NL_SEL);
    const bf16* qa = (const bf16*)(F.ws + WS_QA); const bf16* kvs = (const bf16*)(F.ws + WS_KVS); const float* ga = (const float*)(F.ws + WS_GA);
    const bf16* kvcb = (const bf16*)(F.ws + WS_KVCMPB); const float* lut = (const float*)(F.ws + WS_LUT); bf16* oa = (bf16*)(F.ws + WS_OAB);
    const int tid = F.tid, lane = F.lane, wave = F.wave, r32 = lane & 31, hf = lane >> 5, hh = wave >> 1, qh = wave & 1;
    const int srow = tid >> 3, schunk = tid & 7;
    const int soff = srow * NSA_TS + schunk * 16;
    for (int i = tid; i < 8 * 1024; i += 512) lutL[i] = lut[(i >> 10) * 4096 + (i & 1023)];
    __syncthreads();
    for (int ui = 0; ui < 2; ++ui) {
        const int w = F.bid, bg = w & 7, a_ = (w >> 3) & 31, cq = ui == 0 ? 63 - a_ : a_;
        if (w >= 256) break;
        const int b = bg >> 1, g = bg & 1, head = g * 4 + hh, tq = cq * 64 + qh * 32 + r32;
        const size_t qrow = (size_t)b * SEQ + tq;
        const LAS float* lutH = lutL + head * 1024;
        bf16x8 qf[4];
#pragma unroll
        for (int ks = 0; ks < 4; ++ks) qf[ks] = *(const bf16x8*)(qa + qrow * 512 + head * 64 + ks * 16 + hf * 8);
        const float g_cmp = ga[qrow * 24 + head * 3 + 0], g_slc = ga[qrow * 24 + head * 3 + 1], g_win = ga[qrow * 24 + head * 3 + 2];
        f32x16 oc[2];
#pragma unroll
        for (int i = 0; i < 16; ++i) { oc[0][i] = 0.f; oc[1][i] = 0.f; }
        for (int i = tid; i < 4 * 64 * 65; i += 512) impL[i] = 0.f;
        const bf16* kc = kvcb + (size_t)(0 * 8 + bg) * 256 * 64; const bf16* vc = kvcb + (size_t)(1 * 8 + bg) * 256 * 64;
        const int ncb = (4 * cq + 2) / 64 + 1;
        float m = -INFINITY, l = 0.f;
        f32x16 p0, p1, o[2];
        for (int cb = 0; cb < ncb; ++cb) {
            __syncthreads();
            *(LAS v4u*)(Kt + soff) = nsa_ld16(kc + (size_t)(cb * 64 + srow) * 64 + schunk * 8);
            __syncthreads();
            nsa_qk(Kt, qf, r32, hf, p0, p1);
#pragma unroll
            for (int i = 0; i < 16; ++i) {
                const int d0 = tq - 31 - 16 * (cb * 64 + KLOC(i)), d1 = d0 - 512;
                p0[i] = d0 >= 0 ? p0[i] + lutH[d0 > 1023 ? 1023 : (d0 < 0 ? 0 : d0)] : -INFINITY;
                p1[i] = d1 >= 0 ? p1[i] + lutH[d1 > 1023 ? 1023 : (d1 < 0 ? 0 : d1)] : -INFINITY;
            }
            float bm = -INFINITY;
#pragma unroll
            for (int i = 0; i < 16; ++i) bm = fmaxf(bm, fmaxf(p0[i], p1[i]));
            bm = fmaxf(bm, __shfl_xor(bm, 32));
            const float mn = fmaxf(m, bm), mref = (mn == -INFINITY) ? 0.f : mn;
            float ps = 0.f;
#pragma unroll
            for (int i = 0; i < 16; ++i) ps += __expf(p0[i] - mref) + __expf(p1[i] - mref);
            l = l * __expf(m - mref) + ps; m = mn;
        }
        {
            const float lt = l + __shfl_xor(l, 32), invl = lt > 0.f ? 1.0f / lt : 0.f, mref = (m == -INFINITY) ? 0.f : m;
#pragma unroll
            for (int i = 0; i < 16; ++i) { o[0][i] = 0.f; o[1][i] = 0.f; }
            LAS float* impH = impL + hh * (64 * 65) + (qh * 32 + r32) * 65;
            for (int cb = 0; cb < ncb; ++cb) {
                __syncthreads();
                *(LAS v4u*)(Kt + soff) = nsa_ld16(kc + (size_t)(cb * 64 + srow) * 64 + schunk * 8);
                *(LAS v4u*)(Vt + soff) = nsa_ld16(vc + (size_t)(cb * 64 + srow) * 64 + schunk * 8);
                __syncthreads();
                nsa_qk(Kt, qf, r32, hf, p0, p1);
#pragma unroll
                for (int i = 0; i < 16; ++i) {
                    const int d0 = tq - 31 - 16 * (cb * 64 + KLOC(i)), d1 = d0 - 512;
                    p0[i] = d0 >= 0 ? __expf(p0[i] + lutH[d0 > 1023 ? 1023 : (d0 < 0 ? 0 : d0)] - mref) * invl : 0.f;
                    p1[i] = d1 >= 0 ? __expf(p1[i] + lutH[d1 > 1023 ? 1023 : (d1 < 0 ? 0 : d1)] - mref) * invl : 0.f;
                }
#pragma unroll
                for (int g4 = 0; g4 < 4; ++g4) {
                    const int u0 = cb * 16 + 2 * g4 + hf, u1 = u0 + 8;
                    impH[u0] += (p0[4 * g4] + p0[4 * g4 + 1]) + (p0[4 * g4 + 2] + p0[4 * g4 + 3]);
                    impH[u1] += (p1[4 * g4] + p1[4 * g4 + 1]) + (p1[4 * g4 + 2] + p1[4 * g4 + 3]);
                }
                LDS_WAIT();
#pragma unroll
                for (int g4 = 0; g4 < 4; ++g4) {
                    const int u0 = cb * 16 + 2 * g4 + hf + 1, u1 = u0 + 8;
                    if (u0 < 64) impH[u0] += p0[4 * g4 + 3];
                    if (u1 < 64) impH[u1] += p1[4 * g4 + 3];
                }
                nsa_pv(Vt, p0, p1, lane, hf, o);
            }
#pragma unroll
            for (int i = 0; i < 16; ++i) { oc[0][i] += g_cmp * o[0][i]; oc[1][i] += g_cmp * o[1][i]; }
        }
        __syncthreads();
        {
            const int q = tid >> 3, sub = tid & 7; float v[8];
#pragma unroll
            for (int k = 0; k < 8; ++k) { const int s = sub * 8 + k; const int idx = q * 65 + s;
                const float im = ((impL[idx] + impL[64 * 65 + idx]) + impL[2 * 64 * 65 + idx]) + impL[3 * 64 * 65 + idx];
                v[k] = (s == 0 || s == cq || s == cq - 1) ? 1e6f : (s <= cq ? im : -1e6f); }
            __syncthreads();
#pragma unroll
            for (int k = 0; k < 8; ++k) impL[q * 65 + sub * 8 + k] = v[k];
            __syncthreads();
            int cnt[8];
#pragma unroll
            for (int k = 0; k < 8; ++k) cnt[k] = 0;
#pragma unroll 4
            for (int s2 = 0; s2 < 64; ++s2) { const float x = impL[q * 65 + s2];
#pragma unroll
                for (int k = 0; k < 8; ++k) cnt[k] += (x > v[k] || (x == v[k] && s2 < sub * 8 + k)) ? 1 : 0; }
            unsigned byte = 0;
#pragma unroll
            for (int k = 0; k < 8; ++k) byte |= (cnt[k] < 16 ? 1u : 0u) << k;
            ((LAS unsigned char*)selL)[q * 8 + sub] = (unsigned char)byte;
        }
        __syncthreads();
        const unsigned long long vmask = (cq == 63) ? ~0ull : ((1ull << (cq + 1)) - 1ull);
        const unsigned long long mysel = selL[qh * 32 + r32] & vmask;
        unsigned long long U = selL[lane] & vmask;
#pragma unroll
        for (int off = 1; off < 64; off <<= 1) { const unsigned lo_ = __shfl_xor((unsigned)U, off), hi_ = __shfl_xor((unsigned)(U >> 32), off); U |= ((unsigned long long)hi_ << 32) | lo_; }
        U = ((unsigned long long)(unsigned)__builtin_amdgcn_readfirstlane((unsigned)(U >> 32)) << 32) | (unsigned)__builtin_amdgcn_readfirstlane((unsigned)U);
        LAS float* ocL = impL + wave * 2048 + lane;
#pragma unroll
        for (int i = 0; i < 16; ++i) { ocL[i * 64] = oc[0][i]; ocL[(16 + i) * 64] = oc[1][i]; }
        {
            m = -INFINITY; l = 0.f;
#pragma unroll
            for (int i = 0; i < 16; ++i) { o[0][i] = 0.f; o[1][i] = 0.f; }
            unsigned long long rem = U;
            int j = __builtin_ctzll(rem); rem &= rem - 1ull;
            v4u kreg = nsa_ld16(kvs + ((size_t)b * SEQ + j * 64 + srow) * 512 + 0 * 128 + g * 64 + schunk * 8);
            v4u vreg = nsa_ld16(kvs + ((size_t)b * SEQ + j * 64 + srow) * 512 + 1 * 128 + g * 64 + schunk * 8);
            for (;;) {
                __syncthreads();
                *(LAS v4u*)(Kt + soff) = kreg; *(LAS v4u*)(Vt + soff) = vreg;
                __syncthreads();
                const int jc = j; const bool more = rem != 0ull;
                if (more) { j = __builtin_ctzll(rem); rem &= rem - 1ull;
                    kreg = nsa_ld16(kvs + ((size_t)b * SEQ + j * 64 + srow) * 512 + 0 * 128 + g * 64 + schunk * 8);
                    vreg = nsa_ld16(kvs + ((size_t)b * SEQ + j * 64 + srow) * 512 + 1 * 128 + g * 64 + schunk * 8); }
                nsa_qk(Kt, qf, r32, hf, p0, p1);
                const bool sel = (mysel >> jc) & 1ull;
                if (cq - jc >= 14) {
                    const float bias = lutH[1023];
#pragma unroll
                    for (int i = 0; i < 16; ++i) { p0[i] = sel ? p0[i] + bias : -INFINITY; p1[i] = sel ? p1[i] + bias : -INFINITY; }
                } else {
                    const int dbase = tq - jc * 64;
#pragma unroll
                    for (int i = 0; i < 16; ++i) { const int d0 = dbase - KLOC(i), d1 = d0 - 32;
                        p0[i] = (sel && d0 >= 0) ? p0[i] + lutH[d0 < 0 ? 0 : d0] : -INFINITY;
                        p1[i] = (sel && d1 >= 0) ? p1[i] + lutH[d1 < 0 ? 0 : d1] : -INFINITY; }
                }
                nsa_online(p0, p1, m, l, o);
                nsa_pv(Vt, p0, p1, lane, hf, o);
                if (!more) break;
            }
            const float lt = l + __shfl_xor(l, 32), sc = g_slc / lt;
#pragma unroll
            for (int i = 0; i < 16; ++i) { ocL[i * 64] += sc * o[0][i]; ocL[(16 + i) * 64] += sc * o[1][i]; }
        }
        {
            m = -INFINITY; l = 0.f;
#pragma unroll
            for (int i = 0; i < 16; ++i) { o[0][i] = 0.f; o[1][i] = 0.f; }
            int j = cq - 8 > 0 ? cq - 8 : 0;
            v4u kreg = nsa_ld16(kvs + ((size_t)b * SEQ + j * 64 + srow) * 512 + 2 * 128 + g * 64 + schunk * 8);
            v4u vreg = nsa_ld16(kvs + ((size_t)b * SEQ + j * 64 + srow) * 512 + 3 * 128 + g * 64 + schunk * 8);
            for (;;) {
                __syncthreads();
                *(LAS v4u*)(Kt + soff) = kreg; *(LAS v4u*)(Vt + soff) = vreg;
                __syncthreads();
                const int jc = j; const bool more = jc < cq;
                if (more) { j = jc + 1;
                    kreg = nsa_ld16(kvs + ((size_t)b * SEQ + j * 64 + srow) * 512 + 2 * 128 + g * 64 + schunk * 8);
                    vreg = nsa_ld16(kvs + ((size_t)b * SEQ + j * 64 + srow) * 512 + 3 * 128 + g * 64 + schunk * 8); }
                nsa_qk(Kt, qf, r32, hf, p0, p1);
                const int dbase = tq - jc * 64;
#pragma unroll
                for (int i = 0; i < 16; ++i) { const int d0 = dbase - KLOC(i), d1 = d0 - 32;
                    p0[i] = (d0 >= 0 && d0 < 512) ? p0[i] + lutH[d0 < 0 ? 0 : d0] : -INFINITY;
                    p1[i] = (d1 >= 0 && d1 < 512) ? p1[i] + lutH[d1 < 0 ? 0 : d1] : -INFINITY; }
                nsa_online(p0, p1, m, l, o);
                nsa_pv(Vt, p0, p1, lane, hf, o);
                if (!more) break;
            }
            const float lt = l + __shfl_xor(l, 32), sc = g_win / lt;
#pragma unroll
            for (int i = 0; i < 16; ++i) { oc[0][i] = ocL[i * 64] + sc * o[0][i]; oc[1][i] = ocL[(16 + i) * 64] + sc * o[1][i]; }
        }
#pragma unroll
        for (int dt = 0; dt < 2; ++dt)
#pragma unroll
            for (int g4 = 0; g4 < 4; ++g4) { v2u wv; wv.x = pk2(oc[dt][4 * g4], oc[dt][4 * g4 + 1]); wv.y = pk2(oc[dt][4 * g4 + 2], oc[dt][4 * g4 + 3]);
                *(v2u*)(oa + qrow * 1536 + head * 64 + dt * 32 + 8 * g4 + 4 * hf) = wv; }
        __syncthreads();
    }
}
#undef KLOC


constexpr int GV_TS = 576;
constexpr int GL_V = 0, GL_KST = GL_V + 64 * GV_TS, GL_GS = GL_KST + 128 * 144, GL_ST = GL_GS + 2048, GL_END1 = GL_ST + 256 * 264;
static_assert(GL_END1 <= RING_BYTES, "gla lds");
__device__ __forceinline__ float log_sigmoid_(float z) { return fminf(z, 0.f) - log1pf(__expf(-fabsf(z))); }

__device__ __forceinline__ void gla_stage_v(Frame& F, LAS unsigned char* L, const bf16* vb, size_t row0, int h) {
#pragma unroll
    for (int i = 0; i < 4; ++i) { const int idx = F.tid + 512 * i, r = idx >> 5, c = idx & 31;
        *(LAS v4u*)(L + GL_V + r * GV_TS + c * 16) = *(const v4u*)(vb + (row0 + r) * 1024 + h * 256 + c * 8); }
}
constexpr int GL_ALR = GL_END1;
static_assert(GL_ALR + 4096 <= RING_BYTES, "gla lds 2");
__device__ __forceinline__ void phase_gla1(Frame& F, int l, size_t o_qb = WS_QB, size_t o_kb = WS_KB, size_t o_gst = WS_GST, size_t o_dec = WS_DECAY) {
    relaunder(F);
    LAS unsigned char* L = F.lds + RING_OFF;
    bf16* qb = (bf16*)(F.ws + o_qb); bf16* kb = (bf16*)(F.ws + o_kb); const bf16* vb = (const bf16*)(F.ws + WS_VB);
    const float* alr = (const float*)(F.ws + WS_ALR); bf16* gst = (bf16*)(F.ws + o_gst); float* decay = (float*)(F.ws + o_dec);
    const int tid = F.tid, lane = F.lane, wave = F.wave, r32 = lane & 31, hf = lane >> 5;
    const int d = tid & 127, tg = tid >> 7;
    const int et = tid >> 3, ec = tid & 7;
    LAS float* gs = (LAS float*)(L + GL_GS); LAS float* bL = (LAS float*)(L + GL_ST); LAS float* alrL = (LAS float*)(L + GL_ALR);
    for (int u = F.bid - 16; u < 1024; u += F.G - 16) {
        const int bh = u >> 6, n = u & 63, b = bh >> 2, h = bh & 3; const size_t row0 = (size_t)b * SEQ + n * 64;
        float w2r[16];
#pragma unroll
        for (int r = 0; r < 16; ++r) w2r[r] = inp(F, I_AW2)[(size_t)l * 16 * 512 + r * 512 + h * 128 + d];
        const float ab = inp(F, I_AB)[l * 512 + h * 128 + d];
        const size_t ea = (row0 + et) * 512 + h * 128 + ec * 16;
        const v4u q0 = *(const v4u*)(qb + ea), q1 = *(const v4u*)(qb + ea + 8), k0 = *(const v4u*)(kb + ea), k1 = *(const v4u*)(kb + ea + 8);
        gla_stage_v(F, L, vb, row0, h);
        if (tid < 256) *(LAS f32x4*)(alrL + tid * 4) = *(const f32x4*)(alr + row0 * 16 + tid * 4);
        __syncthreads();
        float bl[16]; float cum = 0.f;
#pragma unroll
        for (int i = 0; i < 16; ++i) { const LAS f32x4* ar = (const LAS f32x4*)(alrL + (tg * 16 + i) * 16); float z = ab;
#pragma unroll
            for (int q = 0; q < 4; ++q) { const f32x4 av = ar[q]; z += av[0] * w2r[4 * q] + av[1] * w2r[4 * q + 1] + av[2] * w2r[4 * q + 2] + av[3] * w2r[4 * q + 3]; }
            cum += log_sigmoid_(z) * (1.0f / 16.0f); bl[i] = cum; }
        gs[tg * 128 + d] = cum;
        __syncthreads();
        float pre = 0.f, tot = 0.f;
#pragma unroll
        for (int g2 = 0; g2 < 4; ++g2) { const float x = gs[g2 * 128 + d]; tot += x; if (g2 < tg) pre += x; }
        if (tg == 0) decay[(size_t)u * 128 + d] = __expf(tot);
#pragma unroll
        for (int i = 0; i < 16; ++i) bL[(tg * 16 + i) * 128 + d] = bl[i] + pre;
        __syncthreads();
        {
            const unsigned qw[8] = {q0.x, q0.y, q0.z, q0.w, q1.x, q1.y, q1.z, q1.w}, kw[8] = {k0.x, k0.y, k0.z, k0.w, k1.x, k1.y, k1.z, k1.w};
            unsigned qo[8], ko[8];
#pragma unroll
            for (int j = 0; j < 8; ++j) {
                const int dd = ec * 16 + 2 * j;
                const float b0 = bL[et * 128 + dd], b1 = bL[et * 128 + dd + 1], t0 = bL[63 * 128 + dd], t1 = bL[63 * 128 + dd + 1];
                const float e0 = __expf(b0), e1 = __expf(b1);
                qo[j] = pk2(bflo(qw[j]) * e0, bfhi(qw[j]) * e1);
                ko[j] = pk2(bflo(kw[j]) * __builtin_amdgcn_rcpf(e0), bfhi(kw[j]) * __builtin_amdgcn_rcpf(e1));
                *(LAS unsigned short*)(L + GL_KST + dd * 144 + et * 2) = (unsigned short)f2bf(bflo(kw[j]) * __expf(t0 - b0));
                *(LAS unsigned short*)(L + GL_KST + (dd + 1) * 144 + et * 2) = (unsigned short)f2bf(bfhi(kw[j]) * __expf(t1 - b1));
            }
            *(v4u*)(qb + ea) = (v4u){qo[0], qo[1], qo[2], qo[3]}; *(v4u*)(qb + ea + 8) = (v4u){qo[4], qo[5], qo[6], qo[7]};
            *(v4u*)(kb + ea) = (v4u){ko[0], ko[1], ko[2], ko[3]}; *(v4u*)(kb + ea + 8) = (v4u){ko[4], ko[5], ko[6], ko[7]};
        }
        __syncthreads();
        {
            const int dkb = wave & 3, dvh = wave >> 2;
            f32x16 acc[4];
#pragma unroll
            for (int t4 = 0; t4 < 4; ++t4)
#pragma unroll
                for (int i = 0; i < 16; ++i) acc[t4][i] = 0.f;
            const LAS unsigned char* vbase = L + GL_V + (8 * hf + ((lane & 15) >> 2)) * GV_TS + (dvh * 128 + 16 * ((lane >> 4) & 1) + 4 * (lane & 3)) * 2;
#pragma unroll
            for (int kk = 0; kk < 4; ++kk) {
                const bf16x8 a = *(const LAS bf16x8*)(L + GL_KST + (dkb * 32 + r32) * 144 + kk * 32 + hf * 16);
#pragma unroll
                for (int t4 = 0; t4 < 4; ++t4) {
                    const LAS unsigned char* bp = vbase + (16 * kk) * GV_TS + t4 * 64;
                    const v4i16_t lo = __builtin_amdgcn_ds_read_tr16_b64_v4i16((LAS v4i16_t*)bp);
                    const v4i16_t hi = __builtin_amdgcn_ds_read_tr16_b64_v4i16((LAS v4i16_t*)(bp + 4 * GV_TS));
                    const bf16x8 bv = {lo[0], lo[1], lo[2], lo[3], hi[0], hi[1], hi[2], hi[3]};
                    acc[t4] = __builtin_amdgcn_mfma_f32_32x32x16_bf16(a, bv, acc[t4], 0, 0, 0);
                }
            }
#pragma unroll
            for (int t4 = 0; t4 < 4; ++t4)
#pragma unroll
                for (int g4 = 0; g4 < 4; ++g4) { v2u wv; wv.x = pk2(acc[t4][4 * g4], acc[t4][4 * g4 + 1]); wv.y = pk2(acc[t4][4 * g4 + 2], acc[t4][4 * g4 + 3]);
                    *(LAS v2u*)(L + GL_ST + (dvh * 128 + t4 * 32 + r32) * 264 + (dkb * 32 + 8 * g4 + 4 * hf) * 2) = wv; }
        }
        __syncthreads();
        {
            bf16* dst = gst + (size_t)u * 32768;
#pragma unroll
            for (int i = 0; i < 8; ++i) { const int idx = tid + 512 * i, r = idx >> 4, c = idx & 15;
                const v2u x0 = *(const LAS v2u*)(L + GL_ST + r * 264 + c * 16), x1 = *(const LAS v2u*)(L + GL_ST + r * 264 + c * 16 + 8);
                *(v4u*)(dst + (size_t)r * 128 + c * 8) = (v4u){x0.x, x0.y, x1.x, x1.y}; }
        }
        __syncthreads();
    }
}
__device__ __forceinline__ void phase_gla2(Frame& F, size_t o_gst = WS_GST) {
    relaunder(F);
    bf16* gst = (bf16*)(F.ws + o_gst); const float* decay = (const float*)(F.ws + WS_DECAY);
    for (int e = F.bid * 512 + F.tid; e < 16 * 8192; e += F.G * 512) {
        const int bh = e >> 13, off = (e & 8191) * 4, dk0 = off & 127;
        f32x4 S = {0.f, 0.f, 0.f, 0.f};
#pragma unroll 1
        for (int n0 = 0; n0 < 64; n0 += 16) {
            v2u dv[16]; f32x4 dec[16];
#pragma unroll
            for (int j = 0; j < 16; ++j) {
                dv[j] = *(const v2u*)(gst + (size_t)(bh * 64 + n0 + j) * 32768 + off);
                dec[j] = *(const f32x4*)(decay + (size_t)(bh * 64 + n0 + j) * 128 + dk0); }
#pragma unroll
            for (int j = 0; j < 16; ++j) {
                v2u sv; sv.x = pk2(S[0], S[1]); sv.y = pk2(S[2], S[3]); *(v2u*)(gst + (size_t)(bh * 64 + n0 + j) * 32768 + off) = sv;
                S[0] = dec[j][0] * S[0] + bflo(dv[j].x); S[1] = dec[j][1] * S[1] + bfhi(dv[j].x); S[2] = dec[j][2] * S[2] + bflo(dv[j].y); S[3] = dec[j][3] * S[3] + bfhi(dv[j].y); }
        }
    }
}
__device__ __forceinline__ void phase_gla3(Frame& F) {
    relaunder(F);
    LAS unsigned char* L = F.lds + RING_OFF;
    const bf16* qb = (const bf16*)(F.ws + WS_QB); const bf16* kb = (const bf16*)(F.ws + WS_KB); const bf16* vb = (const bf16*)(F.ws + WS_VB);
    const bf16* gst = (const bf16*)(F.ws + WS_GST); const bf16* rb = (const bf16*)(F.ws + WS_RB); bf16* ob = (bf16*)(F.ws + WS_OAB) + 512;
    const int lane = F.lane, wave = F.wave, r32 = lane & 31, hf = lane >> 5, ti = wave & 1, dvp = wave >> 1;
    LAS float* ssq = (LAS float*)(L + GL_KST);
    for (int u = F.bid; u < 1024; u += F.G) {
        const int bh = u >> 6, n = u & 63, b = bh >> 2, h = bh & 3; const size_t row0 = (size_t)b * SEQ + n * 64;
        gla_stage_v(F, L, vb, row0, h);
        bf16x8 qf[8];
        const bf16* qrow = qb + (row0 + ti * 32 + r32) * 512 + h * 128 + hf * 8;
#pragma unroll
        for (int kk = 0; kk < 8; ++kk) qf[kk] = *(const bf16x8*)(qrow + kk * 16);
        bf16x8 pb[2][2];
#pragma unroll
        for (int jt = 0; jt < 2; ++jt) {
            f32x16 pt;
#pragma unroll
            for (int i = 0; i < 16; ++i) pt[i] = 0.f;
            if (jt <= ti) {
                const bf16* krow = kb + (row0 + jt * 32 + r32) * 512 + h * 128 + hf * 8;
#pragma unroll
                for (int kk = 0; kk < 8; ++kk) pt = __builtin_amdgcn_mfma_f32_32x32x16_bf16(*(const bf16x8*)(krow + kk * 16), qf[kk], pt, 0, 0, 0);
                if (jt == ti) {
#pragma unroll
                    for (int i = 0; i < 16; ++i) if (((i & 3) + 8 * (i >> 2) + 4 * hf) > r32) pt[i] = 0.f;
                }
            }
            pb[jt][0] = nsa_pack(pt, 0); pb[jt][1] = nsa_pack(pt, 1);
        }
        f32x16 o[2];
#pragma unroll
        for (int i = 0; i < 16; ++i) { o[0][i] = 0.f; o[1][i] = 0.f; }
        const bf16* sbase = gst + (size_t)u * 32768 + (size_t)(dvp * 64 + r32) * 128 + hf * 8;
#pragma unroll
        for (int dvt = 0; dvt < 2; ++dvt)
#pragma unroll
            for (int kk = 0; kk < 8; ++kk) o[dvt] = __builtin_amdgcn_mfma_f32_32x32x16_bf16(*(const bf16x8*)(sbase + (size_t)dvt * 32 * 128 + kk * 16), qf[kk], o[dvt], 0, 0, 0);
        __syncthreads();
        {
            const LAS unsigned char* vbase = L + GL_V + (4 * hf + ((lane & 15) >> 2)) * GV_TS + (dvp * 64 + 16 * ((lane >> 4) & 1) + 4 * (lane & 3)) * 2;
#pragma unroll
            for (int dvt = 0; dvt < 2; ++dvt)
#pragma unroll
                for (int jt = 0; jt < 2; ++jt)
#pragma unroll
                    for (int s = 0; s < 2; ++s) {
                        if (jt <= ti) {
                            const LAS unsigned char* ap = vbase + (jt * 32 + 16 * s) * GV_TS + dvt * 64;
                            const v4i16_t lo = __builtin_amdgcn_ds_read_tr16_b64_v4i16((LAS v4i16_t*)ap);
                            const v4i16_t hi = __builtin_amdgcn_ds_read_tr16_b64_v4i16((LAS v4i16_t*)(ap + 8 * GV_TS));
                            const bf16x8 a = {lo[0], lo[1], lo[2], lo[3], hi[0], hi[1], hi[2], hi[3]};
                            o[dvt] = __builtin_amdgcn_mfma_f32_32x32x16_bf16(a, pb[jt][s], o[dvt], 0, 0, 0);
                        }
                    }
        }
        float ss = 0.f;
#pragma unroll
        for (int i = 0; i < 16; ++i) ss += o[0][i] * o[0][i] + o[1][i] * o[1][i];
        ss += __shfl_xor(ss, 32);
        if (hf == 0) ssq[dvp * 64 + ti * 32 + r32] = ss;
        __syncthreads();
        const float tot = (ssq[ti * 32 + r32] + ssq[64 + ti * 32 + r32]) + (ssq[128 + ti * 32 + r32] + ssq[192 + ti * 32 + r32]);
        const float rs = 1.0f / sqrtf(tot * (1.0f / 256.0f) + EPSN);
        const size_t orow = (row0 + ti * 32 + r32) * 1024 + h * 256 + dvp * 64;
#pragma unroll
        for (int dvt = 0; dvt < 2; ++dvt)
#pragma unroll
            for (int g4 = 0; g4 < 4; ++g4) { const int c0 = dvt * 32 + 8 * g4 + 4 * hf; const v2u rw = *(const v2u*)(rb + orow + c0);
                v2u wv; wv.x = pk2(o[dvt][4 * g4] * rs * bflo(rw.x), o[dvt][4 * g4 + 1] * rs * bfhi(rw.x)); wv.y = pk2(o[dvt][4 * g4 + 2] * rs * bflo(rw.y), o[dvt][4 * g4 + 3] * rs * bfhi(rw.y));
                *(v2u*)(ob + (row0 + ti * 32 + r32) * 1536 + h * 256 + dvp * 64 + c0) = wv; }
        __syncthreads();
    }
}

__device__ __forceinline__ void phase_gla_naive(Frame& F, const Args& a, int l) {
    relaunder(F);
    if (F.bid >= 64) return;
    const int bh = F.bid >> 2, cb = F.bid & 3, b = bh >> 2, h = bh & 3;
    LAS float* qL = (LAS float*)(F.lds + RING_OFF); LAS float* kL = qL + 32 * 128; LAS float* aL = kL + 32 * 128; LAS float* vL = aL + 32 * 128;
    const bf16* qb = (const bf16*)(F.ws + WS_QB); const bf16* kb = (const bf16*)(F.ws + WS_KB); const bf16* vb = (const bf16*)(F.ws + WS_VB);
    const float* alr = (const float*)(F.ws + WS_ALR); float* oraw = (float*)(F.ws + WS_ORAW);
    const int tid = F.tid, split = tid & 7, ci = tid >> 3, d_st = tid & 127;
    float w2r[16];
#pragma unroll
    for (int r = 0; r < 16; ++r) w2r[r] = inp(F, I_AW2)[(size_t)l * 16 * 512 + r * 512 + h * 128 + d_st];
    const float ab = inp(F, I_AB)[l * 512 + h * 128 + d_st];
    float S[16];
#pragma unroll
    for (int i = 0; i < 16; ++i) S[i] = 0.f;
    for (int tc = 0; tc < SEQ / 32; ++tc) {
        const int t0 = tc * 32;
        __syncthreads();
#pragma unroll
        for (int i = 0; i < 8; ++i) { const int idx = tid + 512 * i, tt = idx >> 7; const size_t row = (size_t)b * SEQ + t0 + tt;
            qL[idx] = bf2f(qb[row * 512 + h * 128 + d_st]); kL[idx] = bf2f(kb[row * 512 + h * 128 + d_st]);
            const f32x4* ar = (const f32x4*)(alr + row * 16); float z = ab;
#pragma unroll
            for (int q = 0; q < 4; ++q) { const f32x4 av = ar[q]; z += av[0] * w2r[4 * q] + av[1] * w2r[4 * q + 1] + av[2] * w2r[4 * q + 2] + av[3] * w2r[4 * q + 3]; }
            const float ls = fminf(z, 0.f) - log1pf(__expf(-fabsf(z)));
            aL[idx] = __expf(ls * (1.0f / 16.0f)); }
#pragma unroll
        for (int i = 0; i < 4; ++i) { const int idx = tid + 512 * i, tt = idx >> 6, c = idx & 63; vL[idx] = bf2f(vb[((size_t)b * SEQ + t0 + tt) * 1024 + h * 256 + cb * 64 + c]); }
        __syncthreads();
        for (int tt = 0; tt < 32; ++tt) {
            const float vt = vL[tt * 64 + ci]; float o = 0.f;
#pragma unroll
            for (int q = 0; q < 4; ++q) { const f32x4 av = *(const LAS f32x4*)(aL + tt * 128 + split * 16 + 4 * q), kv = *(const LAS f32x4*)(kL + tt * 128 + split * 16 + 4 * q), qv = *(const LAS f32x4*)(qL + tt * 128 + split * 16 + 4 * q);
#pragma unroll
                for (int j = 0; j < 4; ++j) { S[4 * q + j] = av[j] * S[4 * q + j] + kv[j] * vt; o += qv[j] * S[4 * q + j]; } }
            o += __shfl_xor(o, 1); o += __shfl_xor(o, 2); o += __shfl_xor(o, 4);
            if (split == 0) oraw[((size_t)b * SEQ + t0 + tt) * 1024 + h * 256 + cb * 64 + ci] = o;
        }
    }
    __syncthreads();
}
__device__ __forceinline__ void phase_gla_norm(Frame& F) {
    relaunder(F);
    const int gw = F.bid * NWAVES + F.wave, NGW = F.G * NWAVES;
    const float* oraw = (const float*)(F.ws + WS_ORAW); const bf16* rb = (const bf16*)(F.ws + WS_RB); bf16* ob = (bf16*)(F.ws + WS_OB);
    for (int i = gw; i < MTOK * 4; i += NGW) {
        const f32x4 v = *((const f32x4*)(oraw + (size_t)i * 256) + F.lane);
        const float s = wave_sum((v[0] * v[0] + v[1] * v[1]) + (v[2] * v[2] + v[3] * v[3]));
        const float r = 1.0f / sqrtf(s * (1.0f / 256.0f) + EPSN);
        const v2u rw = *((const v2u*)(rb + (size_t)i * 256) + F.lane);
        v2u w; w.x = pk2(v[0] * r * bflo(rw.x), v[1] * r * bfhi(rw.x)); w.y = pk2(v[2] * r * bflo(rw.y), v[3] * r * bfhi(rw.y));
        *((v2u*)(ob + (size_t)i * 256) + F.lane) = w;
    }
}

#ifndef GLA_NAIVE
#define GLA_NAIVE 0
#endif
#ifndef MK_PER_PHASE
#define MK_PER_PHASE 0
#endif
#ifndef PG8_SP2
#define PG8_SP2 true
#endif
constexpr int NPH_L = 11, NPHASES = NL * NPH_L + 1;

__global__ void __launch_bounds__(NWAVES * 64, 2) fwd(Args args) {
    extern __shared__ __attribute__((aligned(16))) unsigned char lds[];
    Frame F;
    F.lds = (LAS unsigned char*)lds;
    F.tid = threadIdx.x; F.lane = F.tid & 63; F.wave = __builtin_amdgcn_readfirstlane(F.tid >> 6);
    F.G = gridDim.x; F.bid = blockIdx.x; F.ws = args.ws;
    unsigned char* ws = args.ws;
    for (int u = F.tid; u < (LDS_BYTES - LDSCTL_OFF) / 4; u += NWAVES * 64) ((LAS unsigned*)(F.lds + LDSCTL_OFF))[u] = 0u;
    if (F.tid < 50) ((LAS unsigned*)(F.lds + LDSCTL_OFF))[F.tid] = ((const __attribute__((address_space(4))) unsigned*)__builtin_amdgcn_kernarg_segment_ptr())[F.tid];
    __syncthreads();
    XcdBarrier bar; bar.bar = (unsigned*)(ws + WS_CTL) + CW_BAR; bar.x = 0; bar.st = nullptr;
    if (!MK_PER_PHASE) bar = xcd_barrier_post((unsigned*)(ws + WS_CTL) + CW_BAR, (volatile LAS unsigned*)(F.lds + MISC_OFF) + 8);
    const int lo = args.ph_lo, hi = args.ph_hi;
#ifndef PH_MASK
#define PH_MASK 0xFFFF
#endif
#ifndef DBL_MASK
#define DBL_MASK 0
#endif
#define DBL(j) ((DBL_MASK >> (j)) & 1)
#define INL(j) (((PH_MASK >> (j)) & 1) && lo <= (pb + (j)) && (pb + (j)) < hi)
#define IN(k) (lo <= (k) && (k) < hi)
#define SEAM(k) do { if (IN((k) + 1)) { if (MK_PER_PHASE) { } else { XcdBarrier b_ = bar; asm volatile("" : "+s"(b_.bar)); xcd_barrier(b_); } } } while (0)
#define PH_PTRS relaunder(F); unsigned char* const ws = F.ws; bf16* const xb = (bf16*)(ws + WS_XB); float* const ssp = (float*)(ws + WS_SSP); bf16* const act = (bf16*)(ws + WS_ACT); (void)xb; (void)ssp; (void)act

    for (int l = 0; l < NL; ++l) {
        const int pb = l * NPH_L;
        if (INL(0)) { phase_conv(F, args, l); if (DBL(0)) { __syncthreads(); phase_conv(F, args, l); } if (l == 0) { phase_lut(F, args); phase_x0(F, args); } SEAM(pb + 0); }
        if (INL(1)) {
            PH_PTRS;
            pg8::Gemm g{xb, (const bf16*)(ws + W_GU1), MTOK, NGU, DM, DM}; pg8::StaticOrder S; S.init(MTOK, NGU, F.G, F.bid);
            LAS float* rsL = (LAS float*)(F.lds + RS_OFF); pg8::Unit u0; int pm0 = -1; if (S.next(0, u0)) { pm0 = u0.pm; rstd_table(ssp, pm0, rsL, F.tid); }
            EpiGU E{act, ssp, rsL, pm0};
            pg8::gemm_phase<EpiGU, pg8::StaticOrder, true, PG8_SP2>(F.lds + RING_OFF, g, S, E);
            SEAM(pb + 1);
        }
        if (INL(2)) {
            PH_PTRS;
            pg8::Gemm g{act, (const bf16*)(ws + W_D1), MTOK, DM, FF, FF}; pg8::StaticOrder S; S.init(MTOK, DM, F.G, F.bid);
            EpiResid E{xb, ssp, 0.5f};
            pg8::gemm_phase<EpiResid, pg8::StaticOrder, true, PG8_SP2>(F.lds + RING_OFF, g, S, E);
            SEAM(pb + 2);
        }
        if (INL(3)) {
            PH_PTRS;
            pg8::Gemm g{xb, (const bf16*)(ws + W_IN), MTOK, NIN, DM, DM}; pg8::StaticOrder S; S.init(MTOK, NIN, F.G, F.bid);
            LAS float* rsL = (LAS float*)(F.lds + RS_OFF); pg8::Unit u0; int pm0 = -1; if (S.next(0, u0)) { pm0 = u0.pm; rstd_table(ssp, pm0, rsL, F.tid); }
            EpiWin E{ws, ssp, rsL, pm0};
            pg8::gemm_phase<EpiWin, pg8::StaticOrder, true, PG8_SP2>(F.lds + RING_OFF, g, S, E);
            SEAM(pb + 3);
        }
        if (INL(4)) {
            PH_PTRS;
            const bf16* kvc = (const bf16*)(ws + WS_KVC); bf16* hid = (bf16*)(ws + WS_HID); const float* posb = (const float*)(ws + WS_POSB);
            if (F.bid < 16) {
            { pg8::Gemm g{kvc, (const bf16*)(ws + W_C1K), 2048, 256, 2048, 1024}; pg8::StaticOrder S; S.init(2048, 256, F.G, F.bid);
              EpiCmp1 E{hid, posb};
              pg8::gemm_phase<EpiCmp1, pg8::StaticOrder, true, PG8_SP2>(F.lds + RING_OFF, g, S, E); }
            { pg8::Gemm g{kvc + (size_t)8 * SEQ * 64, (const bf16*)(ws + W_C1V), 2048, 256, 2048, 1024}; pg8::StaticOrder S; S.init(2048, 256, F.G, (F.bid + F.G - 8) % F.G);
              EpiCmp1 E{hid + (size_t)2048 * 256, posb + 256};
              pg8::gemm_phase<EpiCmp1, pg8::StaticOrder, true, PG8_SP2>(F.lds + RING_OFF, g, S, E); }
            } else phase_gla1(F, l);
            SEAM(pb + 4);
        }
        if (INL(5)) { phase_cmp2(F, args, l); phase_gla2(F); SEAM(pb + 5); }
        if (INL(6)) { phase_nsa(F); if (DBL(6)) { __syncthreads(); phase_nsa(F); } phase_gla3(F); SEAM(pb + 6); }
        if (INL(7)) {
            PH_PTRS;
            pg8::Gemm g{(const bf16*)(ws + WS_OAB), (const bf16*)(ws + W_CAT), MTOK, DM, 1536, 1536}; pg8::StaticOrder S; S.init(MTOK, DM, F.G, F.bid);
            EpiMergeF E{(const bf16*)(ws + WS_GM), (const bf16*)(ws + WS_GM + 32 * MiB), (bf16*)(ws + WS_Y2)};
            pg8::gemm_phase<EpiMergeF, pg8::StaticOrder, true, PG8_SP2>(F.lds + RING_OFF, g, S, E);
            SEAM(pb + 7);
        }
        if (INL(8)) {
            PH_PTRS;
            pg8::Gemm g{(const bf16*)(ws + WS_Y2), (const bf16*)(ws + W_O), MTOK, DM, DM, DM}; pg8::StaticOrder S; S.init(MTOK, DM, F.G, F.bid);
            EpiResid E{xb, ssp, 1.0f};
            pg8::gemm_phase<EpiResid, pg8::StaticOrder, true, PG8_SP2>(F.lds + RING_OFF, g, S, E);
            SEAM(pb + 8);
        }
        if (INL(9)) {
            PH_PTRS;
            pg8::Gemm g{xb, (const bf16*)(ws + W_GU2), MTOK, NGU, DM, DM}; pg8::StaticOrder S; S.init(MTOK, NGU, F.G, F.bid);
            LAS float* rsL = (LAS float*)(F.lds + RS_OFF); pg8::Unit u0; int pm0 = -1; if (S.next(0, u0)) { pm0 = u0.pm; rstd_table(ssp, pm0, rsL, F.tid); }
            EpiGU E{act, ssp, rsL, pm0};
            pg8::gemm_phase<EpiGU, pg8::StaticOrder, true, PG8_SP2>(F.lds + RING_OFF, g, S, E);
            SEAM(pb + 9);
        }
        if (INL(10)) {
            PH_PTRS;
            pg8::Gemm g{act, (const bf16*)(ws + W_D2), MTOK, DM, FF, FF}; pg8::StaticOrder S; S.init(MTOK, DM, F.G, F.bid);
            EpiResid E{xb, ssp, 0.5f};
            pg8::gemm_phase<EpiResid, pg8::StaticOrder, true, PG8_SP2>(F.lds + RING_OFF, g, S, E);
            SEAM(pb + 10);
        }
    }
    if (IN(NL * NPH_L)) phase_final(F, args);
#undef IN
#undef SEAM
}

extern "C" void kernel_launch(void* const* d_in, const int* in_sizes, int n_in, void* d_out, int out_size, void* d_ws, size_t ws_size, hipStream_t stream) {
    static int grid = 0;
    if (grid == 0) {
        if (n_in != 25 || out_size != MTOK * DM || ws_size < WS_END) { fprintf(stderr, "kernel_launch: unexpected shapes (n_in %d, out %d, ws %zu, need %zu)\n", n_in, out_size, ws_size, (size_t)WS_END); grid = -1; return; }
        int dev = 0, cus = 0, per_cu = 0;
        if (hipGetDevice(&dev) != hipSuccess || hipDeviceGetAttribute(&cus, hipDeviceAttributeMultiprocessorCount, dev) != hipSuccess) { grid = -1; return; }
        if (hipFuncSetAttribute((const void*)fwd, hipFuncAttributeMaxDynamicSharedMemorySize, LDS_BYTES) != hipSuccess) { fprintf(stderr, "kernel_launch: hipFuncSetAttribute failed\n"); grid = -1; return; }
        if (hipOccupancyMaxActiveBlocksPerMultiprocessor(&per_cu, (const void*)fwd, NWAVES * 64, LDS_BYTES) != hipSuccess || per_cu < 1) { fprintf(stderr, "kernel_launch: occupancy query reports %d\n", per_cu); }
        (void)hipGetLastError();
        grid = cus;
    }
    if (grid < 0) return;
    (void)hipMemsetAsync((char*)d_ws + WS_CTL, 0, CTL_ZERO_BYTES, stream);
    Args a{};
    for (int i = 0; i < 25; ++i) a.in[i] = (const float*)d_in[i];
    a.out = (float*)d_out; a.ws = (unsigned char*)d_ws;
#if MK_PER_PHASE
    for (int p = 0; p < NPHASES; ++p) { a.ph_lo = p; a.ph_hi = p + 1; hipLaunchKernelGGL(fwd, dim3(grid), dim3(NWAVES * 64), LDS_BYTES, stream, a); }
#else
    a.ph_lo = 0; a.ph_hi = NPHASES;
    hipLaunchKernelGGL(fwd, dim3(grid), dim3(NWAVES * 64), LDS_BYTES, stream, a);
#endif
    const hipError_t le = hipPeekAtLastError();
    if (le != hipSuccess) fprintf(stderr, "kernel_launch: launch failed: %s\n", hipGetErrorName(le));
}
```

```cpp
#include <hip/hip_runtime.h>
#include <cstdio>
#include <cstdint>

__device__ __forceinline__ int lane_id_here_() { int z = 0; asm volatile("" : "+v"(z)); return __builtin_amdgcn_mbcnt_hi(~0u, __builtin_amdgcn_mbcnt_lo(~0u, z)); }
template <class T> __device__ __forceinline__ T shfl_xor_here_(T v, int mask) { static_assert(sizeof(T) == 4, "32-bit"); return __builtin_bit_cast(T, __builtin_amdgcn_ds_bpermute(((lane_id_here_() ^ mask) & 63) << 2, __builtin_bit_cast(int, v))); }
template <class T> __device__ __forceinline__ T shfl_here_(T v, int src) { static_assert(sizeof(T) == 4, "32-bit"); (void)lane_id_here_; return __builtin_bit_cast(T, __builtin_amdgcn_ds_bpermute((src & 63) << 2, __builtin_bit_cast(int, v))); }
#define __shfl_xor shfl_xor_here_
#define __shfl shfl_here_

namespace pg8 {
#define PG8_LAS __attribute__((address_space(3)))
typedef unsigned short bf16_t;
typedef short bf16x8 __attribute__((ext_vector_type(8)));
typedef float f32x4 __attribute__((ext_vector_type(4)));
typedef unsigned u32x4 __attribute__((ext_vector_type(4)));
constexpr int BM = 256, BK = 64, HALF = 128, HTB = HALF * BK * 2  , STAGE_BYTES = 8 * HTB, NXCD = 8, WGM = 8;

__host__ __device__ __forceinline__ int lds_byte(int r, int c) { const int st = (r >> 4) * 2 + (c >> 5), rr = r & 15, cc = c & 31, ob = rr * 64 + cc * 2; return st * 1024 + (ob ^ (((ob >> 9) & 1) << 5)); }
__host__ __device__ __forceinline__ void stage_rc(int b, int& R, int& C) { const int st = b / 1024, sb = b % 1024, swz = sb ^ (((sb >> 9) & 1) << 5); R = (st >> 1) * 16 + swz / 64; C = (st & 1) * 32 + (swz % 64) / 2; }
__host__ __device__ __forceinline__ int perm32(int rho) { const int n = rho >> 4, i = rho & 15; return 8 * (i >> 2) + 4 * n + (i & 3); }

struct Unit { int pm, pn; };
struct Gemm { const bf16_t* A; const bf16_t* Bt; int M, N, K, lda; int w0 = 0; };

__device__ __forceinline__ void zero_row(const f32x4 (&acc_)[2][2][4][2], int ai, int m) {
    f32x4 (&acc)[2][2][4][2] = const_cast<f32x4 (&)[2][2][4][2]>(acc_);
    bf16x8 z = {0, 0, 0, 0, 0, 0, 0, 0}; asm volatile("" : "+v"(z));
#pragma unroll
    for (int bj = 0; bj < 2; ++bj)
#pragma unroll
        for (int n = 0; n < 2; ++n) { asm volatile("" : "+v"(z)); acc[ai][bj][m][n] = __builtin_amdgcn_mfma_f32_16x16x32_bf16(z, z, (f32x4){0.f, 0.f, 0.f, 0.f}, 0, 0, 0); }
}
struct StaticOrder {
    int nM, nN, nwg, G, c;
    __host__ __device__ __forceinline__ void init(int M, int N, int G_, int c_) { nM = M / BM; nN = N / BM; nwg = nM * nN; G = G_; c = c_; }
    __host__ __device__ __forceinline__ bool next(int i, Unit& u) const {
        const long L = (long)i * G + c; if (L >= nwg) return false;
        int wgid = (int)L; { const int q = nwg / NXCD, r = nwg % NXCD, xcd = wgid % NXCD, off = wgid / NXCD; wgid = (xcd < r ? xcd * (q + 1) : r * (q + 1) + (xcd - r) * q) + off; }
        const int nig = WGM * nN, gid = wgid / nig, fm = gid * WGM, gsz = (nM - fm) < WGM ? (nM - fm) : WGM;
        u.pm = fm + ((wgid % nig) % gsz); u.pn = (wgid % nig) / gsz; return true;
    }
    __device__ __forceinline__ void a_ready(const Unit&) const {}
    __device__ __forceinline__ void done(const Unit&) const {}
};
template <class Epi, class Sched, bool ALIGN_EPI = false, bool SP2 = false>
__device__ __forceinline__ void gemm_phase(PG8_LAS unsigned char* lds, const Gemm g, const Sched& S, const Epi& E) {
    int tid_ = (g.w0 << 6) | lane_id_here_(); asm volatile("" : "+v"(tid_));
    const int tid = tid_, wid = __builtin_amdgcn_readfirstlane(tid >> 6), lane = tid & 63, wr = wid >> 2, wc = wid & 3, fr = lane & 15, fq = lane >> 4;
    const int K = g.K, nt = K / BK;
    unsigned voffA[2], voffB[2];
#pragma unroll
    for (int i = 0; i < 2; ++i) { int R, C; stage_rc(tid * 16 + i * 8192, R, C); const int Rb = Epi::PERM ? ((R & ~31) + perm32(R & 31)) : R;
        voffA[i] = (unsigned)(R * g.lda + C) * 2u; voffB[i] = (unsigned)(Rb * K + C) * 2u; }
    const size_t kstep = (size_t)(BK * 2);
    const size_t hstep = (size_t)HALF * K * 2;
    const size_t tstep = 2 * hstep;
    const size_t hstepA = (size_t)HALF * g.lda * 2, tstepA = 2 * hstepA;
    const unsigned ldsw = (unsigned)wid * 1024u;
    const int aoff = lds_byte(wr * 64 + fr, fq * 8), boff = lds_byte(wc * 32 + fr, fq * 8);
#define PG8_SA(b, h) (((b) * 2 + (h)) * HTB)
#define PG8_SB(b, h) ((4 + (b) * 2 + (h)) * HTB)
#define PG8_STAGE(bufoff, gbase, voff) do { _Pragma("unroll") for (int _i = 0; _i < 2; ++_i) \
        __builtin_amdgcn_global_load_lds((const unsigned*)((const char*)(gbase) + (voff)[_i]), (PG8_LAS unsigned*)(lds + (bufoff) + ldsw + _i * 8192), 16, 0, 0); } while (0)
#define PG8_LDA(dst, b, h) do { _Pragma("unroll") for (int m = 0; m < 4; ++m) _Pragma("unroll") for (int k = 0; k < 2; ++k) dst[m][k] = *(const PG8_LAS bf16x8*)(lds + PG8_SA(b, h) + aoff + m * 2048 + k * 1024); } while (0)
#define PG8_LDB(dst, b, h) do { _Pragma("unroll") for (int n = 0; n < 2; ++n) _Pragma("unroll") for (int k = 0; k < 2; ++k) dst[n][k] = *(const PG8_LAS bf16x8*)(lds + PG8_SB(b, h) + boff + n * 2048 + k * 1024); } while (0)
#define PG8_MMA(ai, bj, At, Bt) do { __builtin_amdgcn_s_setprio(1); _Pragma("unroll") for (int m = 0; m < 4; ++m) _Pragma("unroll") for (int n = 0; n < 2; ++n) _Pragma("unroll") for (int k = 0; k < 2; ++k) \
        acc[ai][bj][m][n] = __builtin_amdgcn_mfma_f32_16x16x32_bf16(Bt[n][k], At[m][k], acc[ai][bj][m][n], 0, 0, 0); __builtin_amdgcn_s_setprio(0); } while (0)
#define PG8_WAIT_V(n) asm volatile("s_waitcnt vmcnt(" #n ")" ::: "memory")
#define PG8_WAIT_L(n) asm volatile("s_waitcnt lgkmcnt(" #n ")" ::: "memory")
#define PG8_BAR __builtin_amdgcn_s_barrier()
#define PG8_SCHED __builtin_amdgcn_sched_barrier(0)
    Unit cur, nxt; int ui = 0;
    if (!S.next(0, cur)) return;
    f32x4 acc[2][2][4][2];
#pragma unroll
    for (int a = 0; a < 2; ++a)
#pragma unroll
        for (int b = 0; b < 2; ++b)
#pragma unroll
            for (int m = 0; m < 4; ++m)
#pragma unroll
                for (int n = 0; n < 2; ++n) acc[a][b][m][n] = (f32x4){0.f, 0.f, 0.f, 0.f};
    bf16x8 At[4][2], B0[2][2], B1[2][2];
    const char* cA = (const char*)g.A + (size_t)cur.pm * tstepA; const char* cB = (const char*)g.Bt + (size_t)cur.pn * tstep;
    S.a_ready(cur);
    if constexpr (SP2) {
        PG8_STAGE(PG8_SB(0, 0), cB, voffB); PG8_STAGE(PG8_SB(0, 1), cB + hstep, voffB); PG8_STAGE(PG8_SA(0, 0), cA, voffA); PG8_STAGE(PG8_SA(0, 1), cA + hstepA, voffA);
        if constexpr (Epi::HAS_PRE) E.pre(tid);
        if (wr == 1) PG8_BAR;
        PG8_WAIT_V(2); PG8_BAR;
        PG8_STAGE(PG8_SB(1, 0), cB + kstep, voffB); PG8_STAGE(PG8_SA(1, 0), cA + kstep, voffA); PG8_STAGE(PG8_SB(1, 1), cB + hstep + kstep, voffB);
        PG8_WAIT_V(6); PG8_BAR;
    } else {
        PG8_STAGE(PG8_SB(0, 0), cB, voffB); PG8_STAGE(PG8_SA(0, 0), cA, voffA); PG8_STAGE(PG8_SB(0, 1), cB + hstep, voffB); PG8_STAGE(PG8_SA(0, 1), cA + hstepA, voffA);
        if (wr == 1) PG8_BAR;
        PG8_WAIT_V(4); PG8_BAR;
        PG8_STAGE(PG8_SB(1, 0), cB + kstep, voffB); PG8_STAGE(PG8_SA(1, 0), cA + kstep, voffA); PG8_STAGE(PG8_SB(1, 1), cB + hstep + kstep, voffB);
        PG8_WAIT_V(6); PG8_BAR;
    }
    for (;;) {
        const bool has_next = S.next(ui + 1, nxt);
        const char* nA = has_next ? (const char*)g.A + (size_t)nxt.pm * tstepA : cA; const char* nB = has_next ? (const char*)g.Bt + (size_t)nxt.pn * tstep : cB;
        for (int t = 0; t < nt; t += 2) {
            const bool last = (t == nt - 2);
            const char* a1 = cA + (size_t)(t + 1) * kstep;
            const char* a2 = last ? nA : cA + (size_t)(t + 2) * kstep; const char* b2 = last ? nB : cB + (size_t)(t + 2) * kstep;
            const char* a3 = a2 + kstep; const char* b3 = b2 + kstep;
            if (last && has_next) S.a_ready(nxt);
            if constexpr (Epi::MID_T > 0) { if (t == Epi::MID_T) E.mid(acc, cur, wr, wc, fr, fq); }
            if constexpr (SP2) {
            PG8_LDB(B0, 0, 0); PG8_LDB(B1, 0, 1); PG8_SCHED; PG8_LDA(At, 0, 0); PG8_STAGE(PG8_SA(1, 1), a1 + hstepA, voffA);
            PG8_WAIT_V(8); PG8_WAIT_L(0); PG8_BAR; PG8_MMA(0, 0, At, B0); PG8_MMA(0, 1, At, B1); PG8_BAR; PG8_SCHED;
            PG8_LDA(At, 0, 1); PG8_STAGE(PG8_SB(0, 0), b2, voffB); PG8_STAGE(PG8_SB(0, 1), b2 + hstep, voffB); PG8_STAGE(PG8_SA(0, 0), a2, voffA);
            PG8_WAIT_V(8); PG8_WAIT_L(0); PG8_BAR; PG8_MMA(1, 0, At, B0); PG8_MMA(1, 1, At, B1); PG8_BAR; PG8_SCHED;
            PG8_LDB(B0, 1, 0); PG8_LDB(B1, 1, 1); PG8_SCHED; PG8_LDA(At, 1, 0); PG8_STAGE(PG8_SA(0, 1), a2 + hstepA, voffA);
            PG8_WAIT_V(8); PG8_WAIT_L(0); PG8_BAR; PG8_MMA(0, 0, At, B0); PG8_MMA(0, 1, At, B1); PG8_BAR; PG8_SCHED;
            PG8_LDA(At, 1, 1); PG8_STAGE(PG8_SB(1, 0), b3, voffB); PG8_STAGE(PG8_SB(1, 1), b3 + hstep, voffB); PG8_STAGE(PG8_SA(1, 0), a3, voffA);
            PG8_WAIT_V(8); PG8_WAIT_L(0); PG8_BAR; PG8_MMA(1, 0, At, B0); PG8_MMA(1, 1, At, B1); PG8_BAR; PG8_SCHED;
            } else {
            PG8_LDB(B0, 0, 0); PG8_SCHED; PG8_LDA(At, 0, 0); PG8_STAGE(PG8_SA(1, 1), a1 + hstepA, voffA);
            PG8_WAIT_L(8); PG8_BAR; PG8_WAIT_L(0); PG8_MMA(0, 0, At, B0); PG8_BAR; PG8_SCHED;
            PG8_LDB(B1, 0, 1); PG8_STAGE(PG8_SB(0, 0), b2, voffB);
            PG8_BAR; PG8_WAIT_L(0); PG8_MMA(0, 1, At, B1); PG8_BAR;
            PG8_LDA(At, 0, 1); PG8_STAGE(PG8_SA(0, 0), a2, voffA);
            PG8_BAR; PG8_WAIT_L(0); PG8_MMA(1, 0, At, B0); PG8_BAR; PG8_SCHED;
            PG8_STAGE(PG8_SB(0, 1), b2 + hstep, voffB);
            PG8_WAIT_V(6); PG8_BAR; PG8_MMA(1, 1, At, B1); PG8_BAR;
            PG8_LDB(B0, 1, 0); PG8_SCHED; PG8_LDA(At, 1, 0); PG8_STAGE(PG8_SA(0, 1), a2 + hstepA, voffA);
            PG8_WAIT_L(8); PG8_BAR; PG8_WAIT_L(0); PG8_MMA(0, 0, At, B0); PG8_BAR; PG8_SCHED;
            PG8_LDB(B1, 1, 1); PG8_STAGE(PG8_SB(1, 0), b3, voffB);
            PG8_BAR; PG8_WAIT_L(0); PG8_MMA(0, 1, At, B1); PG8_BAR;
            PG8_LDA(At, 1, 1); PG8_STAGE(PG8_SA(1, 0), a3, voffA);
            PG8_BAR; PG8_WAIT_L(0); PG8_MMA(1, 0, At, B0); PG8_BAR; PG8_SCHED;
            PG8_STAGE(PG8_SB(1, 1), b3 + hstep, voffB);
            PG8_WAIT_V(6); PG8_BAR; PG8_MMA(1, 1, At, B1); PG8_BAR;
            }
        }
        if constexpr (ALIGN_EPI) { if (wr == 0) PG8_BAR; }
        if constexpr (!Epi::AFTER_DRAIN) { E(acc, cur, wr, wc, fr, fq); S.done(cur); }
        if (!has_next) break;
        if constexpr (!Epi::ZEROES) {
#pragma unroll
        for (int a = 0; a < 2; ++a)
#pragma unroll
            for (int b = 0; b < 2; ++b)
#pragma unroll
                for (int m = 0; m < 4; ++m)
#pragma unroll
                    for (int n = 0; n < 2; ++n) acc[a][b][m][n] = (f32x4){0.f, 0.f, 0.f, 0.f};
        }
        cur = nxt; cA = nA; cB = nB; ++ui;
        if constexpr (ALIGN_EPI) { if (wr == 1) PG8_BAR; }
    }
    PG8_WAIT_V(0);
    if constexpr (!ALIGN_EPI) { if (wr == 0) PG8_BAR; }
    PG8_BAR;
    if constexpr (Epi::AFTER_DRAIN) { E.fused(acc, cur, wr, wc, fr, fq, lds, wid, lane); S.done(cur); }
#undef PG8_SA
#undef PG8_SB
#undef PG8_STAGE
#undef PG8_LDA
#undef PG8_LDB
#undef PG8_MMA
#undef PG8_WAIT_V
#undef PG8_WAIT_L
#undef PG8_BAR
#undef PG8_SCHED
}
}

constexpr int NB = 4, SEQ = 4096, DM = 1024, NL = 4, FF = 2816, MTOK = NB * SEQ;
constexpr int DIN = 6440, NIN = 6656;
constexpr int NGU = 2 * FF;
constexpr float EPSN = 1e-6f;
constexpr int SRC_QA = 0, SRC_KVA = 512, SRC_GA = 1280, SRC_QB = 1304, SRC_KB = 1816, SRC_VB = 2328, SRC_ALR = 3352, SRC_RB = 3368, SRC_GM = 4392;
constexpr int T_QA = 0, T_KVA = 2, T_QB = 5, T_KB = 7, T_VB = 9, T_RB = 13, T_GM = 17, T_MISC = 25;

constexpr size_t MiB = 1u << 20;
constexpr size_t WS_CTL = 0, CTL_ZERO_BYTES = 64 * 1024;
constexpr size_t WS_LUT = 1 * MiB;
constexpr size_t WS_POSB = WS_LUT + 128 * 1024;
constexpr size_t WS_W = 2 * MiB;
constexpr size_t W_GU1 = WS_W, W_D1 = W_GU1 + 11 * MiB, W_GU2 = W_D1 + 11 * MiB / 2, W_D2 = W_GU2 + 11 * MiB;
constexpr size_t W_IN = W_D2 + 11 * MiB / 2, W_C1K = W_IN + 13 * MiB, W_C1V = W_C1K + 1 * MiB, W_N = W_C1V + 1 * MiB, W_G = W_N + 1 * MiB, W_O = W_G + 2 * MiB;
constexpr size_t WS_XB = 58 * MiB;
constexpr size_t WS_SSP = 90 * MiB;
constexpr size_t WS_R = 92 * MiB;
constexpr size_t WS_ACT = WS_R;
constexpr size_t WS_QA = WS_R, WS_KVS = WS_QA + 16 * MiB, WS_KVC = WS_KVS + 16 * MiB, WS_GA = WS_KVC + 9 * MiB, WS_ALR = WS_GA + 2 * MiB;
constexpr size_t WS_QB = WS_ALR + 1 * MiB, WS_KB = WS_QB + 16 * MiB, WS_VB = WS_KB + 16 * MiB, WS_RB = WS_VB + 32 * MiB, WS_GM = WS_RB + 32 * MiB;
constexpr size_t WS_HID = WS_GM + 64 * MiB, WS_KVCMP = WS_HID + 2 * MiB, WS_OA = WS_KVCMP + 1 * MiB, WS_ORAW = WS_OA + 16 * MiB, WS_OB = WS_ORAW + 64 * MiB;
constexpr size_t WS_Y = WS_OB + 32 * MiB, WS_END = WS_Y + 32 * MiB;
constexpr size_t WS_YPART = WS_ORAW;
constexpr size_t WS_OAB = WS_OB;
constexpr size_t WS_Y2 = WS_ORAW;
constexpr size_t W_CAT = W_N;
constexpr size_t WS_GST = WS_ORAW;
constexpr size_t WS_DECAY = WS_GA + 1536 * 1024;
constexpr size_t WS_KVCMPB = WS_KVC + 8 * MiB + 64 * 1024;
static_assert(W_O + 2 * MiB <= WS_XB, "weights fit");
static_assert(WS_END <= 460 * MiB, "workspace budget");

constexpr int CW_BAR = 1024;

constexpr int RING_OFF = 0, RING_BYTES = 131072;
constexpr int LDSCTL_OFF = RING_BYTES, MISC_OFF = LDSCTL_OFF + 320;
constexpr int LDS_BYTES = 147456;
constexpr int RS_OFF = RING_BYTES + 512;
constexpr int NWAVES = 8;

#define GAS __attribute__((address_space(1)))
#define LAS __attribute__((address_space(3)))
typedef unsigned short bf16;
typedef unsigned v4u __attribute__((ext_vector_type(4)));
typedef unsigned v2u __attribute__((ext_vector_type(2)));
typedef float f32x4 __attribute__((ext_vector_type(4)));
typedef short bf16x8 __attribute__((ext_vector_type(8)));
#define LDS_WAIT() asm volatile("s_waitcnt lgkmcnt(0)" ::: "memory")
#define VM_WAIT() asm volatile("s_waitcnt vmcnt(0)" ::: "memory")
__device__ __forceinline__ unsigned f2bf(float f) { unsigned u = __builtin_bit_cast(unsigned, f); return (u + 0x7fffu + ((u >> 16) & 1u)) >> 16; }
typedef float f32x2_t __attribute__((ext_vector_type(2))); typedef __bf16 bf16x2_t __attribute__((ext_vector_type(2)));
__device__ __forceinline__ unsigned pk2(float lo, float hi) { const f32x2_t v = {lo, hi}; const bf16x2_t b = __builtin_convertvector(v, bf16x2_t); return __builtin_bit_cast(unsigned, b); }
__device__ __forceinline__ float bf2f(unsigned short b) { return __builtin_bit_cast(float, ((unsigned)b) << 16); }
__device__ __forceinline__ float bflo(unsigned w) { return __builtin_bit_cast(float, w << 16); }
__device__ __forceinline__ float bfhi(unsigned w) { return __builtin_bit_cast(float, w & 0xffff0000u); }
__device__ __forceinline__ float wave_sum(float v) {
#pragma unroll
    for (int o = 1; o < 64; o <<= 1) v += __shfl_xor(v, o);
    return v;
}
__device__ __forceinline__ float wave_max(float v) {
#pragma unroll
    for (int o = 1; o < 64; o <<= 1) v = fmaxf(v, __shfl_xor(v, o));
    return v;
}
__device__ __forceinline__ float sigmoidf_(float x) { return __builtin_amdgcn_rcpf(1.0f + __builtin_amdgcn_exp2f(x * -1.4426950408889634f)); }
__device__ __forceinline__ float siluf_(float x) { return x * __builtin_amdgcn_rcpf(1.0f + __builtin_amdgcn_exp2f(x * -1.4426950408889634f)); }

#define XB_TMO      128
#define XB_XCNT(j)  (256  + 64 * (j))
#define XB_XSUB(j)  (1280 + 64 * (j))
#define XB_XGEN(j)  (2304 + 64 * (j))
#define XB_TOP      3328
#define XB_TOPGEN   3392
#define XCD_BAR_WORDS 3456
#define XB_SPIN_CAP (1u << 18)

__device__ __forceinline__ unsigned xb_ld(unsigned* p)              { return __hip_atomic_load(p, __ATOMIC_RELAXED, __HIP_MEMORY_SCOPE_AGENT); }
__device__ __forceinline__ unsigned xb_add(unsigned* p, unsigned v) { return __hip_atomic_fetch_add(p, v, __ATOMIC_RELAXED, __HIP_MEMORY_SCOPE_AGENT); }
__device__ __forceinline__ unsigned xb_xcc_id() { return (unsigned)__builtin_amdgcn_s_getreg((3 << 11) | 20) & 0xFu; }
#define XB_SPIN(cond, bar) do { unsigned _sp = 0; while (cond) { __builtin_amdgcn_s_sleep(1); \
    if ((++_sp & 255u) == 0u) { if (xb_ld(&(bar)[XB_TMO])) break; if (_sp > XB_SPIN_CAP) { atomicAdd(&(bar)[XB_TMO], 1u); break; } } } } while (0)

struct XcdBarrier {
    unsigned* bar; unsigned x;
    volatile LAS unsigned* st;
    int w0;
};
__device__ __forceinline__ XcdBarrier xcd_barrier_post(unsigned* bar, volatile LAS unsigned* st, int w0) {
    XcdBarrier b; b.bar = bar; b.x = xb_xcc_id(); b.st = st; b.w0 = w0;
    if (w0 == 0 && lane_id_here_() == 0) (void)xb_add(&bar[XB_XCNT(b.x)], 1u);
    return b;
}
__device__ __forceinline__ void xcd_barrier_complete(unsigned* bar, unsigned x, unsigned& nloc, unsigned& nx) {
    const unsigned G = gridDim.x * gridDim.y * gridDim.z;
    unsigned sum, cnt, mine, sp = 0u;
    for (;;) {
        sum = 0u; cnt = 0u; mine = 0u;
#pragma unroll
        for (unsigned j = 0; j < 16; ++j) { const unsigned c = xb_ld(&bar[XB_XCNT(j)]); sum += c; cnt += (c > 0u) ? 1u : 0u; mine = (j == x) ? c : mine; }
        if (sum == G) break;
        __builtin_amdgcn_s_sleep(1);
        if ((++sp & 255u) == 0u) { if (xb_ld(&bar[XB_TMO])) break; if (sp > XB_SPIN_CAP) { atomicAdd(&bar[XB_TMO], 1u); break; } }
    }
    nloc = mine > 0u ? mine : 1u; nx = cnt > 0u ? cnt : 1u;
}
__device__ __forceinline__ void xcd_barrier(const XcdBarrier& b) {
    asm volatile("s_waitcnt vmcnt(0)" ::: "memory");
    __syncthreads();
    if (b.w0 == 0 && lane_id_here_() == 0) {
        unsigned* bar = b.bar;
        __builtin_amdgcn_s_waitcnt(0);
        unsigned nloc = b.st[0], nx = b.st[1];
        if (nloc == 0u) { xcd_barrier_complete(bar, b.x, nloc, nx); b.st[0] = nloc; b.st[1] = nx; }
        const unsigned old = xb_add(&bar[XB_XSUB(b.x)], 1u);
        const unsigned gen = old / nloc;
        if (old + 1u == (gen + 1u) * nloc) {
            __builtin_amdgcn_fence(__ATOMIC_RELEASE, "agent");
            asm volatile("s_waitcnt vmcnt(0)" ::: "memory");
            const unsigned og = xb_add(&bar[XB_TOP], 1u);
            const unsigned tg = og / nx;
            if (og + 1u == (tg + 1u) * nx) xb_add(&bar[XB_TOPGEN], 1u);
            else XB_SPIN(xb_ld(&bar[XB_TOPGEN]) == tg, bar);
            __builtin_amdgcn_fence(__ATOMIC_ACQUIRE, "agent");
            xb_add(&bar[XB_XGEN(b.x)], 1u);
            asm volatile("s_waitcnt vmcnt(0)" ::: "memory");
        } else {
            XB_SPIN(xb_ld(&bar[XB_XGEN(b.x)]) == gen, bar);
            __builtin_amdgcn_fence(__ATOMIC_ACQUIRE, "agent");
            asm volatile("s_waitcnt vmcnt(0)" ::: "memory");
        }
    }
    __syncthreads();
}


constexpr int CW_GRP = CW_BAR + 4096;
__device__ __forceinline__ void group_barrier(unsigned* ctl, int bid, int w0) {
    asm volatile("s_waitcnt vmcnt(0)" ::: "memory");
    __syncthreads();
    if (w0 == 0 && lane_id_here_() == 0) {
        unsigned* cnt = ctl + CW_GRP + 64 * (bid & 7); unsigned* gen = cnt + 32;
        __builtin_amdgcn_fence(__ATOMIC_RELEASE, "agent");
        asm volatile("s_waitcnt vmcnt(0)" ::: "memory");
        const unsigned old = xb_add(cnt, 1u), inst = old >> 5;
        if ((old & 31u) == 31u) xb_add(gen, 1u);
        else { unsigned sp = 0; while (xb_ld(gen) == inst) { __builtin_amdgcn_s_sleep(1); if (++sp > XB_SPIN_CAP * 16u) break; } }
        __builtin_amdgcn_fence(__ATOMIC_ACQUIRE, "agent");
        asm volatile("s_waitcnt vmcnt(0)" ::: "memory");
    }
    __syncthreads();
}

struct Args { const float* in[25]; float* out; unsigned char* ws; int ph_lo, ph_hi; };
enum { I_X = 0, I_REL, I_F1N, I_F1G, I_F1U, I_F1D, I_MIXN, I_WIN, I_POSK, I_POSV, I_CKW1, I_CKW2, I_CVW1, I_CVW2, I_AW2, I_AB, I_GON, I_WBN, I_WBG, I_WOUT, I_F2N, I_F2G, I_F2U, I_F2D, I_FIN };

struct Frame {
    LAS unsigned char* lds;
    int tid, lane, wave, G, bid, wave0;
    unsigned char* ws;
};
__device__ __forceinline__ const float* inp(const Frame& F, int i) {
    const LAS unsigned* t = (const LAS unsigned*)(F.lds + LDSCTL_OFF);
    const unsigned lo = __builtin_amdgcn_readfirstlane(t[2 * i]), hi = __builtin_amdgcn_readfirstlane(t[2 * i + 1]);
    return (const float*)(const GAS float*)(((unsigned long long)hi << 32) | lo);
}
__device__ __forceinline__ void relaunder(Frame& F) { int t = (F.wave0 << 6) | lane_id_here_(); asm volatile("" : "+v"(t)); F.tid = t; F.lane = t & 63; F.wave = __builtin_amdgcn_readfirstlane(t >> 6);
    GAS unsigned char* w = (GAS unsigned char*)F.ws; asm volatile("" : "+s"(w)); F.ws = (unsigned char*)w; }

using pg8::Unit;
#ifndef EPI_Z
#define EPI_Z true
#endif
#define ZROW(ai, m) do { if (EPI_Z) pg8::zero_row(acc, ai, m); } while (0)
__device__ __forceinline__ float row_rstd(const float* ssp, int row);
__device__ __forceinline__ void rstd8(const float* ssp, int rowbase, int fr, int fq, float (&rs)[2][4]);
__device__ __forceinline__ void rstd_table(const float* ssp, int pm, LAS float* rsL, int tid) {
    const int row = tid >> 1, half = tid & 1; const f32x4* p = (const f32x4*)(ssp + (size_t)(pm * 256 + row) * 16 + half * 8);
    const f32x4 a = p[0], b = p[1];
    float s = ((a[0] + a[1]) + (a[2] + a[3])) + ((b[0] + b[1]) + (b[2] + b[3]));
    s += __shfl_xor(s, 1);
    if (half == 0) rsL[row] = __builtin_amdgcn_rsqf(s * (1.0f / DM) + EPSN);
    __syncthreads();
}
__device__ __forceinline__ void rstd8_lds(const LAS float* rsL, const float* ssp, int pm0, const Unit& u, int wr, int fr, int fq, float (&rs)[2][4]) {
    if (u.pm == pm0) {
#pragma unroll
        for (int ai = 0; ai < 2; ++ai)
#pragma unroll
            for (int m = 0; m < 4; ++m) rs[ai][m] = rsL[ai * 128 + wr * 64 + m * 16 + fr];
    } else {
#pragma unroll 1
        for (int i = 0; i < 8; ++i) { const float r = row_rstd(ssp, u.pm * 256 + (i >> 2) * 128 + wr * 64 + (i & 3) * 16 + fr);
#pragma unroll
            for (int ai = 0; ai < 2; ++ai)
#pragma unroll
                for (int m = 0; m < 4; ++m) if (ai * 4 + m == i) rs[ai][m] = r; }
    }
}
__device__ __forceinline__ void rstd8(const float* ssp, int rowbase, int fr, int fq, float (&rs)[2][4]) {
    const int L = fq * 16 + fr; float r2[2];
    f32x4 t[2][4];
#pragma unroll
    for (int ai = 0; ai < 2; ++ai) { const f32x4* p = (const f32x4*)(ssp + (size_t)(rowbase + ai * 128 + L) * 16);
#pragma unroll
        for (int q = 0; q < 4; ++q) t[ai][q] = p[q]; }
#pragma unroll
    for (int ai = 0; ai < 2; ++ai) { const f32x4 a = t[ai][0], b = t[ai][1], c = t[ai][2], d = t[ai][3];
        const float s = ((a[0] + a[1]) + (a[2] + a[3])) + ((b[0] + b[1]) + (b[2] + b[3])) + ((c[0] + c[1]) + (c[2] + c[3])) + ((d[0] + d[1]) + (d[2] + d[3]));
        r2[ai] = __builtin_amdgcn_rsqf(s * (1.0f / DM) + EPSN); }
#pragma unroll
    for (int ai = 0; ai < 2; ++ai)
#pragma unroll
        for (int m = 0; m < 4; ++m) rs[ai][m] = __shfl(r2[ai], 16 * m + fr);
}
__device__ __forceinline__ float row_rstd(const float* ssp, int row) {
    const f32x4* p = (const f32x4*)(ssp + (size_t)row * 16);
    const f32x4 a = p[0], b = p[1], c = p[2], d = p[3];
    const float s = ((a[0] + a[1]) + (a[2] + a[3])) + ((b[0] + b[1]) + (b[2] + b[3])) + ((c[0] + c[1]) + (c[2] + c[3])) + ((d[0] + d[1]) + (d[2] + d[3]));
    return 1.0f / sqrtf(s * (1.0f / DM) + EPSN);
}
struct EpiGU {
    static constexpr bool PERM = true, AFTER_DRAIN = false, ZEROES = EPI_Z, HAS_PRE = true; static constexpr int MID_T = 0;
    bf16* act; const float* ssp; const LAS float* rsL; int pm0;
    __device__ __forceinline__ void pre(int tid) const { if (pm0 >= 0) rstd_table(ssp, pm0, (LAS float*)rsL, tid); else __syncthreads(); }
    __device__ __forceinline__ void operator()(const f32x4 (&acc)[2][2][4][2], const Unit& u, int wr, int wc, int fr, int fq) const {
        const int row0 = u.pm * 256 + wr * 64 + fr, col0 = u.pn * 128 + wc * 32 + 8 * fq;
        float rs[2][4]; rstd8_lds(rsL, ssp, pm0, u, wr, fr, fq, rs);
#pragma unroll
        for (int ai = 0; ai < 2; ++ai)
#pragma unroll
            for (int m = 0; m < 4; ++m) {
                const int row = row0 + ai * 128 + m * 16; const float r = rs[ai][m];
                float h[8];
                const float rn = r * -1.4426950408889634f, r2 = r * r;
#pragma unroll
                for (int n = 0; n < 2; ++n) {
                    const f32x4 g = acc[ai][0][m][n], up = acc[ai][1][m][n];
                    const f32x4 t = g * rn;
                    f32x4 d = {__builtin_amdgcn_exp2f(t[0]), __builtin_amdgcn_exp2f(t[1]), __builtin_amdgcn_exp2f(t[2]), __builtin_amdgcn_exp2f(t[3])};
                    d = d + 1.0f;
                    const f32x4 sg = {__builtin_amdgcn_rcpf(d[0]), __builtin_amdgcn_rcpf(d[1]), __builtin_amdgcn_rcpf(d[2]), __builtin_amdgcn_rcpf(d[3])};
                    const f32x4 hv = ((g * up) * r2) * sg;
#pragma unroll
                    for (int j = 0; j < 4; ++j) h[n * 4 + j] = hv[j];
                }
                ZROW(ai, m);
                v4u w; w.x = pk2(h[0], h[1]); w.y = pk2(h[2], h[3]); w.z = pk2(h[4], h[5]); w.w = pk2(h[6], h[7]);
                *(v4u*)(act + (size_t)row * FF + col0) = w;
            }
    }
};
struct EpiResid {
    static constexpr bool PERM = true, AFTER_DRAIN = false, ZEROES = EPI_Z, HAS_PRE = false; static constexpr int MID_T = 0;
    bf16* xb; float* ssp; float alpha;
    __device__ __forceinline__ void operator()(const f32x4 (&acc)[2][2][4][2], const Unit& u, int wr, int wc, int fr, int fq) const {
        const int row0 = u.pm * 256 + wr * 64 + fr, col0 = u.pn * 256 + wc * 32 + 8 * fq;
        v4u xw[2][4][2];
#pragma unroll
        for (int ai = 0; ai < 2; ++ai)
#pragma unroll
            for (int m = 0; m < 4; ++m)
#pragma unroll
                for (int bj = 0; bj < 2; ++bj) xw[ai][m][bj] = *(const v4u*)(xb + (unsigned)((row0 + ai * 128 + m * 16) * DM + col0 + bj * 128));
#pragma unroll
        for (int ai = 0; ai < 2; ++ai) {
#pragma unroll
            for (int m = 0; m < 4; ++m) {
                const int row = row0 + ai * 128 + m * 16; float ssq = 0.f;
#pragma unroll
                for (int bj = 0; bj < 2; ++bj) {
                    const v4u xv = xw[ai][m][bj];
                    f32x4 x0 = {bflo(xv.x), bfhi(xv.x), bflo(xv.y), bfhi(xv.y)}, x1 = {bflo(xv.z), bfhi(xv.z), bflo(xv.w), bfhi(xv.w)};
                    x0 = x0 + acc[ai][bj][m][0] * alpha; x1 = x1 + acc[ai][bj][m][1] * alpha;
                    v4u w; w.x = pk2(x0[0], x0[1]); w.y = pk2(x0[2], x0[3]); w.z = pk2(x1[0], x1[1]); w.w = pk2(x1[2], x1[3]);
                    *(v4u*)(xb + (unsigned)(row * DM + col0 + bj * 128)) = w;
                    x0 = (f32x4){bflo(w.x), bfhi(w.x), bflo(w.y), bfhi(w.y)}; x1 = (f32x4){bflo(w.z), bfhi(w.z), bflo(w.w), bfhi(w.w)};
                    ssq += (x0[0] * x0[0] + x0[1] * x0[1]) + (x0[2] * x0[2] + x0[3] * x0[3]) + (x1[0] * x1[0] + x1[1] * x1[1]) + (x1[2] * x1[2] + x1[3] * x1[3]);
                }
                ZROW(ai, m);
                ssq += __shfl_xor(ssq, 16); ssq += __shfl_xor(ssq, 32);
                if (fq == 0) ssp[(size_t)row * 16 + u.pn * 4 + wc] = ssq;
            }
        }
    }
};
struct EpiWin {
    static constexpr bool PERM = true, AFTER_DRAIN = false, ZEROES = EPI_Z, HAS_PRE = true; static constexpr int MID_T = 0;
    unsigned char* ws; const float* ssp; const LAS float* rsL; int pm0;
    __device__ __forceinline__ void pre(int tid) const { if (pm0 >= 0) rstd_table(ssp, pm0, (LAS float*)rsL, tid); else __syncthreads(); }
    __device__ __forceinline__ void operator()(const f32x4 (&acc)[2][2][4][2], const Unit& u, int wr, int wc, int fr, int fq) const {
        const int row0 = u.pm * 256 + wr * 64 + fr, pn = u.pn;
        bf16* dst = nullptr; int ld = 0, coff = 0, actk = 0; float scale = 1.f;
        if (pn < T_KVA) { dst = (bf16*)(ws + WS_QA); ld = 512; coff = (pn - T_QA) * 256; scale = 0.125f * 1.4426950408889634f; }
        else if (pn == T_KVA) { }
        else if (pn < T_QB) { dst = (bf16*)(ws + WS_KVS); ld = 512; coff = (pn - T_KVA - 1) * 256; }
        else if (pn < T_KB) { dst = (bf16*)(ws + WS_QB); ld = 512; coff = (pn - T_QB) * 256; scale = 0.08838834764831845f; }
        else if (pn < T_VB) { dst = (bf16*)(ws + WS_KB); ld = 512; coff = (pn - T_KB) * 256; }
        else if (pn < T_RB) { dst = (bf16*)(ws + WS_VB); ld = 1024; coff = (pn - T_VB) * 256; }
        else if (pn < T_GM) { dst = (bf16*)(ws + WS_RB); ld = 1024; coff = (pn - T_RB) * 256; actk = 1; }
        else if (pn < T_MISC) { }
        float rs[2][4]; rstd8_lds(rsL, ssp, pm0, u, wr, fr, fq, rs);
#pragma unroll
        for (int ai = 0; ai < 2; ++ai)
#pragma unroll
            for (int m = 0; m < 4; ++m) {
                const int row = row0 + ai * 128 + m * 16; const float r = rs[ai][m];
                if (pn >= T_GM && pn < T_MISC) {
                    float rr[8], g1[8]; const float rn = r * -1.4426950408889634f;
#pragma unroll
                    for (int n = 0; n < 2; ++n)
#pragma unroll
                        for (int j = 0; j < 4; ++j) { const float ea = __builtin_amdgcn_exp2f(acc[ai][0][m][n][j] * rn), eb = __builtin_amdgcn_exp2f(acc[ai][1][m][n][j] * rn);
                            const float sb = __builtin_amdgcn_rcpf(1.0f + eb); g1[n * 4 + j] = sb; rr[n * 4 + j] = (1.0f + eb) * __builtin_amdgcn_rcpf(1.0f + ea); }
                    v4u w0; w0.x = pk2(rr[0], rr[1]); w0.y = pk2(rr[2], rr[3]); w0.z = pk2(rr[4], rr[5]); w0.w = pk2(rr[6], rr[7]);
                    v4u w1; w1.x = pk2(g1[0], g1[1]); w1.y = pk2(g1[2], g1[3]); w1.z = pk2(g1[4], g1[5]); w1.w = pk2(g1[6], g1[7]);
                    const size_t o = (size_t)row * DM + (pn - T_GM) * 128 + wc * 32 + 8 * fq;
                    *(v4u*)((bf16*)(ws + WS_GM) + o) = w0; *(v4u*)((bf16*)(ws + WS_GM + 32 * MiB) + o) = w1;
                } else if (pn == T_MISC) {
                    float* ga = (float*)(ws + WS_GA); float* alr = (float*)(ws + WS_ALR);
#pragma unroll
                    for (int n = 0; n < 2; ++n)
#pragma unroll
                        for (int j = 0; j < 4; ++j) { const int c = wc * 32 + 8 * fq + 4 * n + j; const float v = acc[ai][0][m][n][j] * r;
                            if (c < 24) ga[(size_t)row * 24 + c] = sigmoidf_(v); else if (c < 40) alr[(size_t)row * 16 + (c - 24)] = v; }
                } else {
#pragma unroll
                    for (int bj = 0; bj < 2; ++bj) {
                        float h[8]; const float rsc = r * scale;
#pragma unroll
                        for (int n = 0; n < 2; ++n)
#pragma unroll
                            for (int j = 0; j < 4; ++j) { float v = acc[ai][bj][m][n][j] * rsc; if (actk == 1) v = siluf_(v); else if (actk == 2) v = sigmoidf_(v); h[n * 4 + j] = v; }
                        v4u w; w.x = pk2(h[0], h[1]); w.y = pk2(h[2], h[3]); w.z = pk2(h[4], h[5]); w.w = pk2(h[6], h[7]);
                        if (pn == T_KVA) {
                            const int b = row >> 12, t = row & 4095, g = wc >> 1, d = (wc & 1) * 32 + 8 * fq;
                            bf16* kvc = (bf16*)(ws + WS_KVC);
                            *(v4u*)(kvc + ((size_t)((bj * 4 + b) * 2 + g) * SEQ + t) * 64 + d) = w;
                        } else {
                            *(v4u*)(dst + (size_t)row * ld + coff + bj * 128 + wc * 32 + 8 * fq) = w;
                        }
                    }
                }
                ZROW(ai, m);
            }
    }
};
struct EpiCmp1 {
    static constexpr bool PERM = true, AFTER_DRAIN = false, ZEROES = EPI_Z, HAS_PRE = false; static constexpr int MID_T = 0;
    bf16* hid; const float* posb;
    __device__ __forceinline__ void operator()(const f32x4 (&acc)[2][2][4][2], const Unit& u, int wr, int wc, int fr, int fq) const {
        const int row0 = u.pm * 256 + wr * 64 + fr, col0 = wc * 32 + 8 * fq;
#pragma unroll
        for (int ai = 0; ai < 2; ++ai)
#pragma unroll
            for (int m = 0; m < 4; ++m) {
                const int row = row0 + ai * 128 + m * 16;
#pragma unroll
                for (int bj = 0; bj < 2; ++bj) {
                    const f32x4 b0 = *(const f32x4*)(posb + col0 + bj * 128), b1 = *(const f32x4*)(posb + col0 + bj * 128 + 4);
                    const f32x4 v0 = acc[ai][bj][m][0] + b0, v1 = acc[ai][bj][m][1] + b1;
                    v4u w; w.x = pk2(siluf_(v0[0]), siluf_(v0[1])); w.y = pk2(siluf_(v0[2]), siluf_(v0[3])); w.z = pk2(siluf_(v1[0]), siluf_(v1[1])); w.w = pk2(siluf_(v1[2]), siluf_(v1[3]));
                    *(v4u*)(hid + (size_t)row * 256 + col0 + bj * 128) = w;
                }
                ZROW(ai, m);
            }
    }
};
struct EpiMergeF {
    static constexpr bool PERM = true, AFTER_DRAIN = false, ZEROES = EPI_Z, HAS_PRE = false; static constexpr int MID_T = 8;
    const bf16* ratio; const bf16* g1; bf16* y;
    __device__ __forceinline__ void mid(f32x4 (&acc)[2][2][4][2], const Unit& u, int wr, int wc, int fr, int fq) const {
        int row0 = u.pm * 256 + wr * 64 + fr, col0 = u.pn * 256 + wc * 32 + 8 * fq;
        asm volatile("" : "+v"(row0), "+v"(col0));
#pragma unroll
        for (int ai = 0; ai < 2; ++ai)
#pragma unroll
            for (int m = 0; m < 4; ++m)
#pragma unroll
                for (int bj = 0; bj < 2; ++bj) {
                    const v4u gw = *(const v4u*)(ratio + (unsigned)((row0 + ai * 128 + m * 16) * DM + col0 + bj * 128));
                    acc[ai][bj][m][0] = acc[ai][bj][m][0] * (f32x4){bflo(gw.x), bfhi(gw.x), bflo(gw.y), bfhi(gw.y)};
                    acc[ai][bj][m][1] = acc[ai][bj][m][1] * (f32x4){bflo(gw.z), bfhi(gw.z), bflo(gw.w), bfhi(gw.w)};
                    if (bj == 1 && m == 3) asm volatile("" ::: "memory");
                }
    }
    __device__ __forceinline__ void operator()(const f32x4 (&acc)[2][2][4][2], const Unit& u, int wr, int wc, int fr, int fq) const {
        const int row0 = u.pm * 256 + wr * 64 + fr, col0 = u.pn * 256 + wc * 32 + 8 * fq;
#pragma unroll
        for (int ai = 0; ai < 2; ++ai) {
            v4u gq[4][2];
#pragma unroll
            for (int m = 0; m < 4; ++m)
#pragma unroll
                for (int bj = 0; bj < 2; ++bj) gq[m][bj] = *(const v4u*)(g1 + (unsigned)((row0 + ai * 128 + m * 16) * DM + col0 + bj * 128));
#pragma unroll
            for (int m = 0; m < 4; ++m) {
#pragma unroll
                for (int bj = 0; bj < 2; ++bj) {
                    const unsigned o = (unsigned)((row0 + ai * 128 + m * 16) * DM + col0 + bj * 128);
                    const v4u gw = gq[m][bj];
                    const f32x4 v0 = acc[ai][bj][m][0] * (f32x4){bflo(gw.x), bfhi(gw.x), bflo(gw.y), bfhi(gw.y)}, v1 = acc[ai][bj][m][1] * (f32x4){bflo(gw.z), bfhi(gw.z), bflo(gw.w), bfhi(gw.w)};
                    v4u w; w.x = pk2(v0[0], v0[1]); w.y = pk2(v0[2], v0[3]); w.z = pk2(v1[0], v1[1]); w.w = pk2(v1[2], v1[3]);
                    *(v4u*)(y + o) = w;
                }
                ZROW(ai, m);
            }
        }
    }
};
template <int STEP> struct EpiMerge {
    static constexpr bool PERM = true, AFTER_DRAIN = false, ZEROES = false, HAS_PRE = false; static constexpr int MID_T = 0;
    const bf16* gm; float* ypart; bf16* y;
    __device__ __forceinline__ void operator()(const f32x4 (&acc)[2][2][4][2], const Unit& u, int wr, int wc, int fr, int fq) const {
        const int row0 = u.pm * 256 + wr * 64 + fr, col0 = u.pn * 256 + wc * 32 + 8 * fq;
#pragma unroll
        for (int ai = 0; ai < 2; ++ai)
#pragma unroll
            for (int m = 0; m < 4; ++m) {
                const int row = row0 + ai * 128 + m * 16;
#pragma unroll
                for (int bj = 0; bj < 2; ++bj) {
                    const int col = col0 + bj * 128;
                    const v4u gw = *(const v4u*)(gm + (size_t)row * 2048 + (STEP == 1 ? 0 : 1024) + col);
                    f32x4 g0 = {bflo(gw.x), bfhi(gw.x), bflo(gw.y), bfhi(gw.y)}, g1 = {bflo(gw.z), bfhi(gw.z), bflo(gw.w), bfhi(gw.w)};
                    float* yp = ypart + (size_t)row * DM + col;
                    if (STEP == 1) { *(f32x4*)yp = g0 * acc[ai][bj][m][0]; *(f32x4*)(yp + 4) = g1 * acc[ai][bj][m][1]; }
                    else { const f32x4 v0 = *(const f32x4*)yp + g0 * acc[ai][bj][m][0], v1 = *(const f32x4*)(yp + 4) + g1 * acc[ai][bj][m][1];
                        v4u w; w.x = pk2(v0[0], v0[1]); w.y = pk2(v0[2], v0[3]); w.z = pk2(v1[0], v1[1]); w.w = pk2(v1[2], v1[3]);
                        *(v4u*)(y + (size_t)row * DM + col) = w; }
                }
            }
    }
};

struct SrcCol { const float* p; int col; };
template <bool GAIN, class Map>
__device__ __forceinline__ void tr_item(int ldw, const float* gain, bf16* WT, int K, int nblk, int item, LAS float* scr, int lane, const Map& cm, int ldk = 0) {
    if (ldk == 0) ldk = K;
    const int kb = item / nblk, nb = item % nblk, k0 = 64 * kb, n0 = 32 * nb;
    const SrcCol sc = cm(n0 + (lane & 31));
    const float msk = sc.col >= 0 ? 1.f : 0.f;
    const float* src = sc.p + (size_t)(k0 + (lane >> 5)) * ldw + (sc.col >= 0 ? sc.col : 0);
    float v[32];
#pragma unroll
    for (int i = 0; i < 32; ++i) v[i] = src[(size_t)(2 * i) * ldw];
    if constexpr (GAIN) {
        const float* gp = gain + k0 + (lane >> 5);
#pragma unroll
        for (int i = 0; i < 32; ++i) v[i] *= gp[2 * i];
    }
#pragma unroll
    for (int i = 0; i < 32; ++i) scr[(2 * i + (lane >> 5)) * 33 + (lane & 31)] = v[i] * msk;
    LDS_WAIT();
    const int c = lane & 7;
#pragma unroll
    for (int j = 0; j < 4; ++j) { const int n = (lane >> 3) + 8 * j; const LAS float* s = scr + (8 * c) * 33 + n;
        v4u o; o.x = pk2(s[0 * 33], s[1 * 33]); o.y = pk2(s[2 * 33], s[3 * 33]); o.z = pk2(s[4 * 33], s[5 * 33]); o.w = pk2(s[6 * 33], s[7 * 33]);
        *(v4u*)(WT + (size_t)(n0 + n) * ldk + k0 + 8 * c) = o; }
    LDS_WAIT();
}
struct MapGU { const float* p; __device__ __forceinline__ SrcCol operator()(int n) const { return SrcCol{p, (n >> 8) * 128 + (n & 127)}; } };
struct MapId { const float* p; __device__ __forceinline__ SrcCol operator()(int n) const { return SrcCol{p, n}; } };
struct MapWin { const float* p; __device__ __forceinline__ SrcCol operator()(int n) const {
    const int t = n >> 8, r = n & 255; int c;
    if (t < T_KVA) c = SRC_QA + n; else if (t < T_QB) c = SRC_KVA + (n - T_KVA * 256); else if (t < T_KB) c = SRC_QB + (n - T_QB * 256); else if (t < T_VB) c = SRC_KB + (n - T_KB * 256);
    else if (t < T_RB) c = SRC_VB + (n - T_VB * 256); else if (t < T_GM) c = SRC_RB + (n - T_RB * 256); else if (t < T_MISC) c = SRC_GM + (t - T_GM) * 128 + (r & 127) + (r >= 128 ? 1024 : 0);
    else c = r < 24 ? SRC_GA + r : (r < 40 ? SRC_ALR + (r - 24) : -1);
    return SrcCol{p, c}; } };

__device__ __forceinline__ void phase_conv(Frame& F, const Args& a, int l) {
    relaunder(F);
    LAS float* scr = (LAS float*)(F.lds + RING_OFF + F.wave * 16384);
    const int gw = F.bid * NWAVES + F.wave, NGW = F.G * NWAVES;
    unsigned char* ws = F.ws;
    constexpr int I_GU = (DM / 64) * (NGU / 32), I_D = (FF / 64) * (DM / 32), I_IN = (DM / 64) * (NIN / 32), I_C1 = (2048 / 64) * (256 / 32), I_N = (512 / 64) * (DM / 32), I_SQ = (DM / 64) * (DM / 32);
    constexpr int NITEMS = 2 * I_GU + 2 * I_D + I_IN + 2 * I_C1 + I_N + 2 * I_SQ;
    const size_t oG = (size_t)l * DM * FF, oD = (size_t)l * FF * DM;
    for (int it = gw; it < NITEMS; it += NGW) {
        int r = it;
        if (r < I_GU) { const bool up = (((r % (NGU / 32)) * 32) & 255) >= 128;
            if (up) tr_item<true>(FF, inp(F, I_F1N) + l * DM, (bf16*)(ws + W_GU1), DM, NGU / 32, r, scr, F.lane, MapGU{inp(F, I_F1U) + oG});
            else tr_item<true>(FF, inp(F, I_F1N) + l * DM, (bf16*)(ws + W_GU1), DM, NGU / 32, r, scr, F.lane, MapGU{inp(F, I_F1G) + oG});
            continue; } r -= I_GU;
        if (r < I_GU) { const bool up = (((r % (NGU / 32)) * 32) & 255) >= 128;
            if (up) tr_item<true>(FF, inp(F, I_F2N) + l * DM, (bf16*)(ws + W_GU2), DM, NGU / 32, r, scr, F.lane, MapGU{inp(F, I_F2U) + oG});
            else tr_item<true>(FF, inp(F, I_F2N) + l * DM, (bf16*)(ws + W_GU2), DM, NGU / 32, r, scr, F.lane, MapGU{inp(F, I_F2G) + oG});
            continue; } r -= I_GU;
        if (r < I_D) { tr_item<false>(DM, nullptr, (bf16*)(ws + W_D1), FF, DM / 32, r, scr, F.lane, MapId{inp(F, I_F1D) + oD}); continue; } r -= I_D;
        if (r < I_D) { tr_item<false>(DM, nullptr, (bf16*)(ws + W_D2), FF, DM / 32, r, scr, F.lane, MapId{inp(F, I_F2D) + oD}); continue; } r -= I_D;
        if (r < I_IN) { tr_item<true>(DIN, inp(F, I_MIXN) + l * DM, (bf16*)(ws + W_IN), DM, NIN / 32, r, scr, F.lane, MapWin{inp(F, I_WIN) + (size_t)l * DM * DIN}); continue; } r -= I_IN;
        if (r < I_C1) { tr_item<false>(256, nullptr, (bf16*)(ws + W_C1K), 2048, 256 / 32, r, scr, F.lane, MapId{inp(F, I_CKW1) + (size_t)l * 2048 * 256}); continue; } r -= I_C1;
        if (r < I_C1) { tr_item<false>(256, nullptr, (bf16*)(ws + W_C1V), 2048, 256 / 32, r, scr, F.lane, MapId{inp(F, I_CVW1) + (size_t)l * 2048 * 256}); continue; } r -= I_C1;
        if (r < I_N) { tr_item<false>(DM, nullptr, (bf16*)(ws + W_CAT), 512, DM / 32, r, scr, F.lane, MapId{inp(F, I_WBN) + (size_t)l * 512 * DM}, 1536); continue; } r -= I_N;
        if (r < I_SQ) { tr_item<true>(DM, inp(F, I_GON) + l * DM, (bf16*)(ws + W_CAT) + 512, DM, DM / 32, r, scr, F.lane, MapId{inp(F, I_WBG) + (size_t)l * DM * DM}, 1536); continue; } r -= I_SQ;
        tr_item<false>(DM, nullptr, (bf16*)(ws + W_O), DM, DM / 32, r, scr, F.lane, MapId{inp(F, I_WOUT) + (size_t)l * DM * DM});
    }
    __syncthreads();
    if (F.bid < 32) {
        const int kv = F.bid >> 4, nb = (F.bid & 15) * 16, c = F.tid & 15, ks = F.tid >> 4;
        const float* pos = inp(F, kv ? I_POSV : I_POSK) + (size_t)l * 2048; const float* w1 = inp(F, kv ? I_CVW1 : I_CKW1) + (size_t)l * 2048 * 256;
        float s = 0.f;
#pragma unroll 32
        for (int k = ks * 64; k < ks * 64 + 64; ++k) s += pos[k] * w1[(size_t)k * 256 + nb + c];
        LAS float* red = (LAS float*)(F.lds + RING_OFF);
        red[F.tid] = s; __syncthreads();
        if (F.tid < 16) { float t = 0.f; for (int i = 0; i < 32; ++i) t += red[i * 16 + F.tid]; ((float*)(ws + WS_POSB))[kv * 256 + nb + F.tid] = t; }
        __syncthreads();
    }
}
__device__ __forceinline__ void phase_lut(Frame& F, const Args& a) {
    relaunder(F);
    float* lut = (float*)(F.ws + WS_LUT); const float* tab = inp(F, I_REL);
    for (int i = F.bid * 512 + F.tid; i < 8 * 4096; i += F.G * 512) {
        const int h = i >> 12, n = i & 4095; int bk;
        if (n < 16) bk = n; else { const float nf = (float)n; int lb = 16 + (int)(logf(nf / 16.0f) / 4.1588830833596715f * 16.0f); bk = lb < 31 ? lb : 31; }
        lut[i] = tab[bk * 8 + h];
    }
}
__device__ __forceinline__ void phase_x0(Frame& F, const Args& a) {
    relaunder(F);
    const int gw = F.bid * NWAVES + F.wave, NGW = F.G * NWAVES;
    bf16* xb = (bf16*)(F.ws + WS_XB); float* ssp = (float*)(F.ws + WS_SSP);
    for (int m = gw; m < MTOK; m += NGW) {
        const f32x4* xr = (const f32x4*)(inp(F, I_X) + (size_t)m * DM) + F.lane;
        v2u* o8 = (v2u*)(xb + (size_t)m * DM) + F.lane; float s = 0.f;
#pragma unroll
        for (int j = 0; j < 4; ++j) { const f32x4 v = xr[64 * j]; v2u w; w.x = pk2(v[0], v[1]); w.y = pk2(v[2], v[3]); o8[64 * j] = w; const float a0 = bflo(w.x), a1 = bfhi(w.x), a2 = bflo(w.y), a3 = bfhi(w.y); s += (a0 * a0 + a1 * a1) + (a2 * a2 + a3 * a3); }
        s = wave_sum(s);
        if (F.lane < 16) ssp[(size_t)m * 16 + F.lane] = F.lane == 0 ? s : 0.f;
    }
}
__device__ __forceinline__ void phase_final(Frame& F, const Args& a) {
    relaunder(F);
    const int gw = F.bid * NWAVES + F.wave, NGW = F.G * NWAVES; const f32x4* gnp = (const f32x4*)inp(F, I_FIN) + F.lane;
    const f32x4 gn[4] = {gnp[0], gnp[64], gnp[128], gnp[192]};
    const bf16* xb = (const bf16*)(F.ws + WS_XB);
    for (int m = gw; m < MTOK; m += NGW) {
        const v2u* xr = (const v2u*)(xb + (size_t)m * DM) + F.lane; f32x4* orow = (f32x4*)(a.out + (size_t)m * DM) + F.lane; f32x4 v[4]; float s = 0.f;
#pragma unroll
        for (int j = 0; j < 4; ++j) { const v2u w = xr[64 * j]; v[j] = (f32x4){bflo(w.x), bfhi(w.x), bflo(w.y), bfhi(w.y)}; s += (v[j][0] * v[j][0] + v[j][1] * v[j][1]) + (v[j][2] * v[j][2] + v[j][3] * v[j][3]); }
        const float r = __builtin_amdgcn_rsqf(wave_sum(s) * (1.0f / DM) + EPSN);
#pragma unroll
        for (int j = 0; j < 4; ++j) orow[64 * j] = v[j] * r * gn[j];
    }
}
__device__ __forceinline__ void phase_cmp2(Frame& F, const Args& a, int l) {
    relaunder(F);
    const int gw = F.bid * NWAVES + F.wave, NGW = F.G * NWAVES;
    const bf16* hid = (const bf16*)(F.ws + WS_HID); float* out = (float*)(F.ws + WS_KVCMP);
    for (int row = gw; row < 4096; row += NGW) {
        const int kv = row >> 11; const float* w2 = inp(F, kv ? I_CVW2 : I_CKW2) + (size_t)l * 256 * 64;
        const bf16* hr = hid + (size_t)row * 256; float s = 0.f;
        v4u hw[2][8]; float w[2][64];
#define CMP2_LD(bf_, kb_) do { _Pragma("unroll") for (int j = 0; j < 8; ++j) hw[bf_][j] = *(const v4u*)(hr + (kb_) + 8 * j); \
            _Pragma("unroll") for (int j = 0; j < 64; ++j) w[bf_][j] = w2[((kb_) + j) * 64 + F.lane]; } while (0)
#define CMP2_FMA(bf_) do { _Pragma("unroll") for (int j = 0; j < 8; ++j) \
            s += bflo(hw[bf_][j].x) * w[bf_][8 * j + 0] + bfhi(hw[bf_][j].x) * w[bf_][8 * j + 1] + bflo(hw[bf_][j].y) * w[bf_][8 * j + 2] + bfhi(hw[bf_][j].y) * w[bf_][8 * j + 3] \
               + bflo(hw[bf_][j].z) * w[bf_][8 * j + 4] + bfhi(hw[bf_][j].z) * w[bf_][8 * j + 5] + bflo(hw[bf_][j].w) * w[bf_][8 * j + 6] + bfhi(hw[bf_][j].w) * w[bf_][8 * j + 7]; } while (0)
        CMP2_LD(0, 0);
        CMP2_LD(1, 64);  __builtin_amdgcn_sched_barrier(0); CMP2_FMA(0); __builtin_amdgcn_sched_barrier(0);
        CMP2_LD(0, 128); __builtin_amdgcn_sched_barrier(0); CMP2_FMA(1); __builtin_amdgcn_sched_barrier(0);
        CMP2_LD(1, 192); __builtin_amdgcn_sched_barrier(0); CMP2_FMA(0); __builtin_amdgcn_sched_barrier(0);
        CMP2_FMA(1);
#undef CMP2_LD
#undef CMP2_FMA
        out[(size_t)row * 64 + F.lane] = s; ((bf16*)(F.ws + WS_KVCMPB))[(size_t)row * 64 + F.lane] = (bf16)f2bf(s);
    }
}

__device__ __forceinline__ void dot4_bf16(const bf16* kp, const LAS float* qs, float (&s)[4]) {
    s[0] = s[1] = s[2] = s[3] = 0.f;
#pragma unroll 2
    for (int c = 0; c < 8; ++c) { const v4u kw = *(const v4u*)(kp + c * 8);
        const float kf[8] = {bflo(kw.x), bfhi(kw.x), bflo(kw.y), bfhi(kw.y), bflo(kw.z), bfhi(kw.z), bflo(kw.w), bfhi(kw.w)};
#pragma unroll
        for (int h = 0; h < 4; ++h) { const f32x4 q0 = *(const LAS f32x4*)(qs + h * 64 + c * 8), q1 = *(const LAS f32x4*)(qs + h * 64 + c * 8 + 4);
            s[h] += (kf[0] * q0[0] + kf[1] * q0[1]) + (kf[2] * q0[2] + kf[3] * q0[3]) + (kf[4] * q1[0] + kf[5] * q1[1]) + (kf[6] * q1[2] + kf[7] * q1[3]); } }
}
__device__ __forceinline__ void dot4_f32(const float* kp, const LAS float* qs, float (&s)[4]) {
    s[0] = s[1] = s[2] = s[3] = 0.f;
#pragma unroll 4
    for (int c = 0; c < 16; ++c) { const f32x4 kf = *(const f32x4*)(kp + c * 4);
#pragma unroll
        for (int h = 0; h < 4; ++h) { const f32x4 q0 = *(const LAS f32x4*)(qs + h * 64 + c * 4); s[h] += (kf[0] * q0[0] + kf[1] * q0[1]) + (kf[2] * q0[2] + kf[3] * q0[3]); } }
}
__device__ __forceinline__ void online_block(const float (&s)[4], bool kvalid, const bf16* vp, int vld, LAS float* ps, int lane, float (&m)[4], float (&lsum)[4], float (&o)[4]) {
    float p[4];
#pragma unroll
    for (int h = 0; h < 4; ++h) {
        const float sm = wave_max(kvalid ? s[h] : -INFINITY), mn = fmaxf(m[h], sm);
        const float sc = (m[h] == -INFINITY) ? 0.f : __expf(m[h] - mn);
        p[h] = (kvalid && mn > -INFINITY) ? __expf(s[h] - mn) : 0.f;
        lsum[h] = lsum[h] * sc + wave_sum(p[h]); o[h] *= sc; m[h] = mn;
    }
    *(LAS f32x4*)(ps + lane * 4) = (f32x4){p[0], p[1], p[2], p[3]};
    LDS_WAIT();
#pragma unroll 8
    for (int k = 0; k < 64; ++k) { const f32x4 pv = *(const LAS f32x4*)(ps + k * 4); const float v = bf2f(vp[(size_t)k * vld + lane]);
        o[0] += pv[0] * v; o[1] += pv[1] * v; o[2] += pv[2] * v; o[3] += pv[3] * v; }
    LDS_WAIT();
}
__device__ __forceinline__ void phase_nsa_naive(Frame& F) {
    relaunder(F);
    LAS float* wl = (LAS float*)(F.lds + RING_OFF + F.wave * 16384);
    LAS float* qs = wl; LAS float* ps = wl + 256; LAS float* psum = wl + 512; LAS float* scl = wl + 1024;
    const bf16* qa = (const bf16*)(F.ws + WS_QA); const bf16* kvs = (const bf16*)(F.ws + WS_KVS); const float* ga = (const float*)(F.ws + WS_GA);
    const float* kvcmp = (const float*)(F.ws + WS_KVCMP); const float* lut = (const float*)(F.ws + WS_LUT); bf16* oa = (bf16*)(F.ws + WS_OA);
    const int lane = F.lane;
    for (int wt = F.bid; wt < 4096; wt += F.G) {
        const int bg = wt & 7, tb = wt >> 3, b = bg >> 1, g = bg & 1, t = tb * 8 + F.wave, row = b * SEQ + t, jcur = t >> 6;
        const float* lutg = lut + (size_t)(g * 4) * 4096;
#pragma unroll
        for (int h = 0; h < 4; ++h) qs[h * 64 + lane] = bf2f(qa[(size_t)row * 512 + (g * 4 + h) * 64 + lane]);
        LDS_WAIT();
        float gate[4][3];
#pragma unroll
        for (int h = 0; h < 4; ++h)
#pragma unroll
            for (int br = 0; br < 3; ++br) gate[h][br] = ga[(size_t)row * 24 + (g * 4 + h) * 3 + br];
        float oacc[4] = {0.f, 0.f, 0.f, 0.f};
        const int ncv = t >= 31 ? ((t - 31) >> 4) + 1 : 0;
        float imp = 0.f;
        if (ncv > 0) {
            const float* kc = kvcmp + (size_t)(0 * 8 + bg) * 256 * 64; const float* vc = kvcmp + (size_t)(1 * 8 + bg) * 256 * 64;
            float mx[4] = {-INFINITY, -INFINITY, -INFINITY, -INFINITY};
            const int nblk = (ncv + 63) >> 6;
#pragma unroll 1
            for (int blk = 0; blk < nblk; ++blk) {
                const int c = blk * 64 + lane; const bool valid = c < ncv;
                float s[4]; dot4_f32(kc + (size_t)(c < 255 ? c : 255) * 64, qs, s);
                const int dist = valid ? t - (16 * c + 31) : 0;
#pragma unroll
                for (int h = 0; h < 4; ++h) { const float v = valid ? s[h] + lutg[h * 4096 + dist] : -INFINITY; scl[h * 256 + c] = v; mx[h] = fmaxf(mx[h], v); }
            }
            float ls[4] = {0.f, 0.f, 0.f, 0.f};
#pragma unroll
            for (int h = 0; h < 4; ++h) mx[h] = wave_max(mx[h]);
            LDS_WAIT();
#pragma unroll 1
            for (int blk = 0; blk < nblk; ++blk) {
                const int c = blk * 64 + lane;
#pragma unroll
                for (int h = 0; h < 4; ++h) { const float v = scl[h * 256 + c]; const float p = v > -INFINITY ? __expf(v - mx[h]) : 0.f; scl[h * 256 + c] = p; ls[h] += p; }
            }
#pragma unroll
            for (int h = 0; h < 4; ++h) ls[h] = 1.0f / wave_sum(ls[h]);
            LDS_WAIT();
            float oc[4] = {0.f, 0.f, 0.f, 0.f};
#pragma unroll 1
            for (int blk = 0; blk < 4; ++blk) {
                const int c = blk * 64 + lane; float pt = 0.f;
                if (blk < nblk) {
#pragma unroll
                    for (int h = 0; h < 4; ++h) { const float p = scl[h * 256 + c] * ls[h]; scl[h * 256 + c] = p; pt += p; }
                }
                psum[c] = pt;
            }
            LDS_WAIT();
#pragma unroll 2
            for (int k = 0; k < ncv; ++k) { const float v = vc[(size_t)k * 64 + lane];
                oc[0] += scl[k] * v; oc[1] += scl[256 + k] * v; oc[2] += scl[512 + k] * v; oc[3] += scl[768 + k] * v; }
#pragma unroll
            for (int i = -1; i <= 3; ++i) { const int c = 4 * lane + i; if (c >= 0 && c < 255) imp += psum[c]; }
#pragma unroll
            for (int h = 0; h < 4; ++h) oacc[h] += gate[h][0] * oc[h];
            LDS_WAIT();
        }
        const bool forced = (lane == 0) || (lane == jcur) || (lane == jcur - 1);
        const float score = forced ? 1e6f : (lane <= jcur ? imp : -1e6f);
        int rank = 0;
#pragma unroll 4
        for (int s2 = 0; s2 < 64; ++s2) { const float v2 = __shfl(score, s2); rank += (v2 > score || (v2 == score && s2 < lane)) ? 1 : 0; }
        unsigned long long selmask = __ballot(rank < 16);
        selmask &= (jcur == 63) ? ~0ull : ((1ull << (jcur + 1)) - 1ull);
        {
            float m[4] = {-INFINITY, -INFINITY, -INFINITY, -INFINITY}, lsum[4] = {0.f, 0.f, 0.f, 0.f}, o[4] = {0.f, 0.f, 0.f, 0.f};
#pragma unroll 1
            while (selmask) {
                const int j = __builtin_ctzll(selmask); selmask &= selmask - 1ull;
                const int pos = j * 64 + lane; const bool kvalid = pos <= t;
                float s[4]; dot4_bf16(kvs + (size_t)(b * SEQ + pos) * 512 + 0 * 128 + g * 64, qs, s);
                if (kvalid) {
#pragma unroll
                    for (int h = 0; h < 4; ++h) s[h] += lutg[h * 4096 + (t - pos)];
                }
                online_block(s, kvalid, kvs + (size_t)(b * SEQ + j * 64) * 512 + 1 * 128 + g * 64, 512, ps, lane, m, lsum, o);
            }
#pragma unroll
            for (int h = 0; h < 4; ++h) oacc[h] += gate[h][1] * o[h] / lsum[h];
        }
        {
            float m[4] = {-INFINITY, -INFINITY, -INFINITY, -INFINITY}, lsum[4] = {0.f, 0.f, 0.f, 0.f}, o[4] = {0.f, 0.f, 0.f, 0.f};
            const int lo = t - 511 > 0 ? t - 511 : 0;
#pragma unroll 1
            for (int j = lo >> 6; j <= jcur; ++j) {
                const int pos = j * 64 + lane; const bool kvalid = pos <= t && pos >= lo;
                float s[4]; dot4_bf16(kvs + (size_t)(b * SEQ + pos) * 512 + 2 * 128 + g * 64, qs, s);
                if (kvalid) {
#pragma unroll
                    for (int h = 0; h < 4; ++h) s[h] += lutg[h * 4096 + (t - pos)];
                }
                online_block(s, kvalid, kvs + (size_t)(b * SEQ + j * 64) * 512 + 3 * 128 + g * 64, 512, ps, lane, m, lsum, o);
            }
#pragma unroll
            for (int h = 0; h < 4; ++h) oacc[h] += gate[h][2] * o[h] / lsum[h];
        }
#pragma unroll
        for (int h = 0; h < 4; ++h) oa[(size_t)row * 512 + (g * 4 + h) * 64 + lane] = (bf16)f2bf(oacc[h]);
        LDS_WAIT();
    }
}


typedef float f32x16 __attribute__((ext_vector_type(16)));
typedef short v4i16_t __attribute__((ext_vector_type(4)));
constexpr int NSA_TS = 144;
constexpr int NSA_VS = 192;
constexpr int NL_K = 0, NL_V = 9216, NL_K1 = 9216 + 64 * 192, NL_V1 = NL_K1 + 9216, NL_LUT = NL_V1 + 64 * 192, NL_IMP = NL_LUT + 16384, NL_SEL = NL_IMP + 4 * 64 * 65 * 4, NL_ZERO = NL_SEL + 512, NL_INVL = NL_ZERO + 256, NL_END = NL_INVL + 1024;
static_assert(NL_END <= RING_BYTES, "nsa lds");
#define KLOC(i) (((i) & 3) + 8 * ((i) >> 2) + 4 * hf)

__device__ __forceinline__ void nsa_qk(const LAS unsigned char* Kt, const bf16x8 (&qf)[4], int r32, int hf, f32x16& p0, f32x16& p1) {
#pragma unroll
    for (int i = 0; i < 16; ++i) { p0[i] = 0.f; p1[i] = 0.f; }
    bf16x8 a0[4], a1[4];
#pragma unroll
    for (int ks = 0; ks < 4; ++ks) { a0[ks] = *(const LAS bf16x8*)(Kt + r32 * NSA_TS + ks * 32 + hf * 16); a1[ks] = *(const LAS bf16x8*)(Kt + (32 + r32) * NSA_TS + ks * 32 + hf * 16); }
    __builtin_amdgcn_sched_barrier(0);
#pragma unroll
    for (int ks = 0; ks < 4; ++ks) {
        p0 = __builtin_amdgcn_mfma_f32_32x32x16_bf16(a0[ks], qf[ks], p0, 0, 0, 0);
        p1 = __builtin_amdgcn_mfma_f32_32x32x16_bf16(a1[ks], qf[ks], p1, 0, 0, 0);
    }
}
__device__ __forceinline__ bf16x8 nsa_pack(const f32x16& p, const int s) {
    v4u w; w.x = pk2(p[8 * s + 0], p[8 * s + 1]); w.y = pk2(p[8 * s + 2], p[8 * s + 3]); w.z = pk2(p[8 * s + 4], p[8 * s + 5]); w.w = pk2(p[8 * s + 6], p[8 * s + 7]);
    return __builtin_bit_cast(bf16x8, w);
}
__device__ __forceinline__ void nsa_pv(const LAS unsigned char* Vt, const f32x16& p0, const f32x16& p1, int lane, int hf, f32x16 (&o)[2]) {
    __builtin_amdgcn_sched_barrier(0);
    bf16x8 pb[4]; pb[0] = nsa_pack(p0, 0); pb[1] = nsa_pack(p0, 1); pb[2] = nsa_pack(p1, 0); pb[3] = nsa_pack(p1, 1);
    const LAS unsigned char* base = Vt + (4 * hf + ((lane & 15) >> 2)) * NSA_VS + (16 * ((lane >> 4) & 1) + 4 * (lane & 3)) * 2;
    v4i16_t lo[2][4], hi[2][4];
#pragma unroll
    for (int dt = 0; dt < 2; ++dt)
#pragma unroll
        for (int ks = 0; ks < 4; ++ks) {
            const LAS unsigned char* ap = base + (16 * ks) * NSA_VS + dt * 64;
            lo[dt][ks] = __builtin_amdgcn_ds_read_tr16_b64_v4i16((LAS v4i16_t*)ap);
            hi[dt][ks] = __builtin_amdgcn_ds_read_tr16_b64_v4i16((LAS v4i16_t*)(ap + 8 * NSA_VS));
        }
    __builtin_amdgcn_sched_barrier(0);
#pragma unroll
    for (int ks = 0; ks < 4; ++ks)
#pragma unroll
        for (int dt = 0; dt < 2; ++dt) {
            const bf16x8 a = {lo[dt][ks][0], lo[dt][ks][1], lo[dt][ks][2], lo[dt][ks][3], hi[dt][ks][0], hi[dt][ks][1], hi[dt][ks][2], hi[dt][ks][3]};
            o[dt] = __builtin_amdgcn_mfma_f32_32x32x16_bf16(a, pb[ks], o[dt], 0, 0, 0);
        }
}
__device__ __forceinline__ void nsa_online(f32x16& p0, f32x16& p1, float& m, float& l, f32x16 (&o)[2]) {
    float bm = -INFINITY;
#pragma unroll
    for (int i = 0; i < 16; ++i) bm = fmaxf(bm, fmaxf(p0[i], p1[i]));
    bm = fmaxf(bm, __shfl_xor(bm, 32));
    const float mn = fmaxf(m, bm), mref = (mn == -INFINITY) ? 0.f : mn, sc = __expf(m - mref);
    float ps = 0.f;
#pragma unroll
    for (int i = 0; i < 16; ++i) { p0[i] = __expf(p0[i] - mref); p1[i] = __expf(p1[i] - mref); ps += p0[i] + p1[i]; }
    l = l * sc + ps; m = mn;
#pragma unroll
    for (int i = 0; i < 16; ++i) { o[0][i] *= sc; o[1][i] *= sc; }
}
__device__ __forceinline__ void nsa_qk_init(const LAS unsigned char* Kt, const bf16x8 (&qf)[4], int r32, int hf, float init, f32x16& p0, f32x16& p1) {
#pragma unroll
    for (int i = 0; i < 16; ++i) { p0[i] = init; p1[i] = init; }
    bf16x8 a0[4], a1[4];
#pragma unroll
    for (int ks = 0; ks < 4; ++ks) { a0[ks] = *(const LAS bf16x8*)(Kt + r32 * NSA_TS + ks * 32 + hf * 16); a1[ks] = *(const LAS bf16x8*)(Kt + (32 + r32) * NSA_TS + ks * 32 + hf * 16); }
    __builtin_amdgcn_sched_barrier(0);
#pragma unroll
    for (int ks = 0; ks < 4; ++ks) {
        p0 = __builtin_amdgcn_mfma_f32_32x32x16_bf16(a0[ks], qf[ks], p0, 0, 0, 0);
        p1 = __builtin_amdgcn_mfma_f32_32x32x16_bf16(a1[ks], qf[ks], p1, 0, 0, 0);
    }
}
constexpr float NSA_THR = 8.0f;
constexpr int NSA_GATE_OFF = RS_OFF + 1024;
static_assert(NSA_GATE_OFF + 4096 <= LDS_BYTES, "gate slots");
__device__ __forceinline__ void nsa_step(f32x16& p0, f32x16& p1, float& mr, bool& has, float& l, f32x16 (&o)[2]) {
    __builtin_amdgcn_sched_barrier(0);
    float bm = fmaxf(fmaxf(p0[0], p1[0]), fmaxf(p0[1], p1[1]));
#pragma unroll
    for (int i = 2; i < 16; i += 2) bm = fmaxf(bm, fmaxf(fmaxf(p0[i], p1[i]), fmaxf(p0[i + 1], p1[i + 1])));
    bm = fmaxf(bm, __shfl_xor(bm, 32));
    const bool valid = bm > -INFINITY, need = valid && (bm > NSA_THR || !has);
    if (__any(need)) {
        const float delta = need ? bm : 0.f, sc = (need && has) ? __builtin_amdgcn_exp2f(-delta) : 1.0f;
        mr += delta;
#pragma unroll
        for (int i = 0; i < 16; ++i) { p0[i] -= delta; p1[i] -= delta; o[0][i] *= sc; o[1][i] *= sc; }
        l *= sc;
    }
    has = has || valid;
    float ps = 0.f;
#pragma unroll
    for (int i = 0; i < 16; ++i) { p0[i] = __builtin_amdgcn_exp2f(p0[i]); p1[i] = __builtin_amdgcn_exp2f(p1[i]); ps += p0[i] + p1[i]; }
    l += ps;
}
template <bool MASKED> __device__ __forceinline__ void nsa_bias(f32x16& p0, f32x16& p1, const LAS float* lutH, int dbase, int hf, unsigned dhi) {
    int db = dbase - 4 * hf;
    __builtin_amdgcn_sched_barrier(0);
    asm volatile("" : "+v"(db));
    { float b0[16];
#pragma unroll
      for (int i = 0; i < 16; ++i) { const int d0 = db - ((i & 3) + 8 * (i >> 2)); b0[i] = lutH[MASKED ? min(max(d0, 0), 1023) : d0]; }
#pragma unroll
      for (int i = 0; i < 16; ++i) { const int d0 = db - ((i & 3) + 8 * (i >> 2)); p0[i] = (!MASKED || (unsigned)d0 < dhi) ? p0[i] + b0[i] : -INFINITY; } }
    __builtin_amdgcn_sched_barrier(0);
    { float b1[16];
#pragma unroll
      for (int i = 0; i < 16; ++i) { const int d1 = db - 32 - ((i & 3) + 8 * (i >> 2)); b1[i] = lutH[MASKED ? min(max(d1, 0), 1023) : d1]; }
#pragma unroll
      for (int i = 0; i < 16; ++i) { const int d1 = db - 32 - ((i & 3) + 8 * (i >> 2)); p1[i] = (!MASKED || (unsigned)d1 < dhi) ? p1[i] + b1[i] : -INFINITY; } }
    __builtin_amdgcn_sched_barrier(0);
}
__device__ __forceinline__ v4u nsa_ld16(const bf16* p) { return *(const v4u*)p; }
#define LDS_BARRIER() asm volatile("s_waitcnt lgkmcnt(0)\n\ts_barrier" ::: "memory")

#define NS_SBAR() __builtin_amdgcn_sched_barrier(0)
#define NS_PIN(x) asm volatile("" : "+v"(x))
#define NS_MFMA(a, b, c) __builtin_amdgcn_mfma_f32_32x32x16_bf16(a, b, c, 0, 0, 0)
#define NS_MX3(a, b, c) __builtin_fmaxf(__builtin_fmaxf((a), (b)), (c))
__device__ __forceinline__ float nsa_rowmax(const f32x16& p0, const f32x16& p1) {
    float a = NS_MX3(p0[0], p0[1], p1[0]), b = NS_MX3(p0[2], p0[3], p1[1]); a = NS_MX3(a, p1[2], p1[3]);
#pragma unroll
    for (int r = 4; r < 16; r += 4) { a = NS_MX3(a, p0[r], p0[r + 1]); b = NS_MX3(b, p0[r + 2], p0[r + 3]); a = NS_MX3(a, p1[r], p1[r + 1]); b = NS_MX3(b, p1[r + 2], p1[r + 3]); }
    const float m = __builtin_fmaxf(a, b); auto rr = __builtin_amdgcn_permlane32_swap(__float_as_uint(m), __float_as_uint(m), false, false);
    return __builtin_fmaxf(__uint_as_float(rr[0]), __uint_as_float(rr[1]));
}
template <bool SLC>
__device__ __forceinline__ void nsa_stream(LAS unsigned char* L, const bf16* kvs, const LAS float* lutH, const bf16x8 (&qf)[4], int b, int g, int cq, int tq, int lane, int r32, int hf,
                                           int srow, int schunk, unsigned long long U, const LAS unsigned* selq, float& l_out, f32x16 (&o)[2]) {
    constexpr int KC = SLC ? 0 : 2, VC = SLC ? 1 : 3;
    const int soff = srow * NSA_TS + schunk * 16, svoff = srow * NSA_VS + schunk * 16;
    LAS unsigned char* const K0 = L + NL_K; LAS unsigned char* const K1 = L + NL_K1; LAS unsigned char* const V0 = L + NL_V; LAS unsigned char* const V1 = L + NL_V1;
    const int kfo = r32 * NSA_TS + hf * 16;
    const int vfo = (4 * hf + ((lane & 15) >> 2)) * NSA_VS + (16 * ((lane >> 4) & 1) + 4 * (lane & 3)) * 2;
    const float bias_far = lutH[1023];
    const int jlo = cq - 8 > 0 ? cq - 8 : 0;
    const int n = SLC ? __builtin_popcountll(U) : cq - jlo + 1;
    unsigned long long rem = U; int nj = cq, jlast = 0;
#define NS_NEXT(dst) do { if (SLC) { if (rem != 0ull) { jlast = __builtin_ctzll(rem); rem &= rem - 1ull; } } else { if (nj >= jlo) { jlast = nj; --nj; } } dst = jlast; } while (0)
#define NS_LD(j_, kv_) nsa_ld16(kvs + ((size_t)b * SEQ + (j_) * 64 + srow) * 512 + (kv_) * 128 + g * 64 + schunk * 8)
#define NS_KRD(KS, d0) do { kf[2 * (d0)] = *(const LAS bf16x8*)((KS) + kfo + (d0) * 32); kf[2 * (d0) + 1] = *(const LAS bf16x8*)((KS) + kfo + 32 * NSA_TS + (d0) * 32); } while (0)
#define NS_VRD(VS, i) do { const LAS unsigned char* ap_ = (VS) + vfo + (16 * ((i) >> 1)) * NSA_VS + ((i) & 1) * 64; \
        vlo[i] = __builtin_amdgcn_ds_read_tr16_b64_v4i16((LAS v4i16_t*)ap_); vhi[i] = __builtin_amdgcn_ds_read_tr16_b64_v4i16((LAS v4i16_t*)(ap_ + 8 * NSA_VS)); } while (0)
#define NS_VFR(i) (bf16x8){vlo[i][0], vlo[i][1], vlo[i][2], vlo[i][3], vhi[i][0], vhi[i][1], vhi[i][2], vhi[i][3]}
#define NS_PB(k) __builtin_bit_cast(bf16x8, pw##k)
#define NS_PK(P, i) pk2(P[i], P[i + 1])
#define NS_EX(v) __builtin_amdgcn_exp2f((v) + nmh)
#define NS_INITV(j_) (SLC ? ((((selq[(j_) >> 5] >> ((j_) & 31)) & 1u) != 0u) ? ((cq - (j_) >= 14) ? bias_far : 0.f) : -INFINITY) : 0.f)
#define NS_NEAR(j_) (SLC ? (cq - (j_) < 14) : true)
#define NS_MASKED(j_) (SLC ? ((j_) == cq) : ((j_) == cq || (j_) == cq - 8))
#define NS_DHI(j_) ((j_) == cq ? 0x7fffffffu : 512u)
#define NS_BP(j_) (NS_NEAR(j_) ? lutH + (tq - (j_) * 64 - 4 * hf - 63) : (const LAS float*)(L + NL_ZERO))
#define NS_BL(P, r, h_) P[r] = bpn[63 - ((h_) * 32 + ((r) & 3) + 8 * ((r) >> 2))]
#define NS_BLD4(P0, P1, g) do { { if ((g) < 4) { NS_BL(P0, 4 * (g), 0); NS_BL(P0, 4 * (g) + 1, 0); NS_BL(P0, 4 * (g) + 2, 0); NS_BL(P0, 4 * (g) + 3, 0); } \
        else { NS_BL(P1, 4 * ((g) - 4), 1); NS_BL(P1, 4 * ((g) - 4) + 1, 1); NS_BL(P1, 4 * ((g) - 4) + 2, 1); NS_BL(P1, 4 * ((g) - 4) + 3, 1); } } } while (0)
#define NS_MASK(C0, C1, j_) do { const int dbc_ = tq - (j_) * 64 - 4 * hf; const unsigned dhi_ = NS_DHI(j_); \
        _Pragma("unroll") for (int r = 0; r < 16; ++r) { const int d0_ = dbc_ - ((r & 3) + 8 * (r >> 2)); C0[r] = ((unsigned)d0_ < dhi_) ? C0[r] : -INFINITY; C1[r] = ((unsigned)(d0_ - 32) < dhi_) ? C1[r] : -INFINITY; } } while (0)
#define NS_GAPA(MF, a0, a1, a2, a3, W0, W1, PW) do { MF; sacc += a0; sacc += a1; sacc += a2; sacc += a3; W0; W1; NS_PIN(PW); NS_PIN(sacc); NS_SBAR(); } while (0)
#define NS_GAPB(MF, X, i) do { MF; X[i] = NS_EX(X[i]); X[i + 1] = NS_EX(X[i + 1]); X[i + 2] = NS_EX(X[i + 2]); X[i + 3] = NS_EX(X[i + 3]); NS_PIN(X); NS_SBAR(); } while (0)
    const f32x16 z16 = {0.f, 0.f, 0.f, 0.f, 0.f, 0.f, 0.f, 0.f, 0.f, 0.f, 0.f, 0.f, 0.f, 0.f, 0.f, 0.f};
    f32x16 pA0, pA1, pB0, pB1; bf16x8 kf[8]; v4i16_t vlo[8], vhi[8]; v4u pw0, pw1, pw2, pw3;
    float mhat = 0.f, l = 0.f, fsc = 1.f; bool resc = false;
    int ja, jb, jc, jd; NS_NEXT(ja); NS_NEXT(jb); NS_NEXT(jc); NS_NEXT(jd);
    v4u kreg, vreg;
    {
        const v4u k0 = NS_LD(ja, KC), k1 = NS_LD(jb, KC); kreg = NS_LD(jc, KC); vreg = NS_LD(ja, VC);
        LDS_BARRIER();
        *(LAS v4u*)(K0 + soff) = k0; *(LAS v4u*)(K1 + soff) = k1;
    }
    LDS_BARRIER();
#pragma unroll
    for (int d0 = 0; d0 < 4; ++d0) NS_KRD(K0, d0);
    LDS_BARRIER();
    {
        const LAS float* bpn = NS_BP(ja);
        NS_BLD4(pA0, pA1, 0); NS_BLD4(pA0, pA1, 1); NS_BLD4(pA0, pA1, 2); NS_BLD4(pA0, pA1, 3); NS_BLD4(pA0, pA1, 4); NS_BLD4(pA0, pA1, 5); NS_BLD4(pA0, pA1, 6); NS_BLD4(pA0, pA1, 7);
        if (NS_MASKED(ja)) NS_MASK(pA0, pA1, ja);
        pA0 = NS_MFMA(kf[0], qf[0], pA0); pA1 = NS_MFMA(kf[1], qf[0], pA1);
    }
    pA0 = NS_MFMA(kf[2], qf[1], pA0); pA1 = NS_MFMA(kf[3], qf[1], pA1);
    pA0 = NS_MFMA(kf[4], qf[2], pA0); pA1 = NS_MFMA(kf[5], qf[2], pA1); pA0 = NS_MFMA(kf[6], qf[3], pA0); pA1 = NS_MFMA(kf[7], qf[3], pA1);
    *(LAS v4u*)(K0 + soff) = kreg; *(LAS v4u*)(V0 + svoff) = vreg;
    kreg = NS_LD(jd, KC); vreg = NS_LD(jb, VC);
    { const float iv = NS_INITV(ja); mhat = nsa_rowmax(pA0, pA1) + iv; const float nmh = iv - mhat;
#pragma unroll
      for (int r = 0; r < 16; ++r) { pA0[r] = NS_EX(pA0[r]); pA1[r] = NS_EX(pA1[r]); } }
#pragma unroll
    for (int d0 = 0; d0 < 4; ++d0) NS_KRD(K1, d0);
    { const LAS float* bpn = NS_BP(jb);
      NS_BLD4(pB0, pB1, 0); NS_BLD4(pB0, pB1, 1); NS_BLD4(pB0, pB1, 2); NS_BLD4(pB0, pB1, 3); NS_BLD4(pB0, pB1, 4); NS_BLD4(pB0, pB1, 5); NS_BLD4(pB0, pB1, 6); NS_BLD4(pB0, pB1, 7); }
    LDS_BARRIER();
    ja = jb; jb = jc; jc = jd; NS_NEXT(jd);
#define NS_STEP(C0, C1, P0, P1, KW, VW, VR, KR) do { NS_SBAR(); \
    if (NS_NEAR(ja) && NS_MASKED(ja)) { NS_MASK(C0, C1, ja); NS_SBAR(); } \
    NS_VRD(VR, 0); NS_SBAR(); float sacc = P0[0] + P0[1]; \
                           NS_GAPA(C0 = NS_MFMA(kf[0], qf[0], C0), P0[2], P0[3], P0[4], P0[5],     pw0[0] = NS_PK(P0, 0),  pw0[1] = NS_PK(P0, 2),  pw0); \
    NS_VRD(VR, 1); NS_SBAR(); NS_GAPA(C1 = NS_MFMA(kf[1], qf[0], C1), P0[6], P0[7], P0[8], P0[9],     pw0[2] = NS_PK(P0, 4),  pw0[3] = NS_PK(P0, 6),  pw0); \
    NS_VRD(VR, 2); NS_SBAR(); NS_GAPA(C0 = NS_MFMA(kf[2], qf[1], C0),  P0[10], P0[11], P0[12], P0[13], pw1[0] = NS_PK(P0, 8),  pw1[1] = NS_PK(P0, 10), pw1); \
    NS_VRD(VR, 3); NS_SBAR(); NS_GAPA(C1 = NS_MFMA(kf[3], qf[1], C1),  P0[14], P0[15], P1[0], P1[1],   pw1[2] = NS_PK(P0, 12), pw1[3] = NS_PK(P0, 14), pw1); \
    NS_VRD(VR, 4); NS_SBAR(); NS_GAPA(C0 = NS_MFMA(kf[4], qf[2], C0),  P1[2], P1[3], P1[4], P1[5],     pw2[0] = NS_PK(P1, 0),  pw2[1] = NS_PK(P1, 2),  pw2); \
    NS_VRD(VR, 5); NS_SBAR(); NS_GAPA(C1 = NS_MFMA(kf[5], qf[2], C1),  P1[6], P1[7], P1[8], P1[9],     pw2[2] = NS_PK(P1, 4),  pw2[3] = NS_PK(P1, 6),  pw2); \
    NS_VRD(VR, 6); NS_SBAR(); NS_GAPA(C0 = NS_MFMA(kf[6], qf[3], C0),  P1[10], P1[11], P1[12], P1[13], pw3[0] = NS_PK(P1, 8),  pw3[1] = NS_PK(P1, 10), pw3); \
    NS_VRD(VR, 7); NS_SBAR(); NS_GAPA(C1 = NS_MFMA(kf[7], qf[3], C1),  P1[14], P1[15], 0.f, 0.f,       pw3[2] = NS_PK(P1, 12), pw3[3] = NS_PK(P1, 14), pw3); \
    l += sacc; \
    *(LAS v4u*)((KW) + soff) = kreg; *(LAS v4u*)((VW) + svoff) = vreg; \
    kreg = NS_LD(jd, KC); vreg = NS_LD(jb, VC); \
    const LAS float* bpn = NS_BP(jb); \
    const float iv_ = NS_INITV(ja); \
    { const float rm = (nsa_rowmax(C0, C1) + iv_) - mhat; resc = false; \
      if (__builtin_expect(__any(rm > NSA_THR), 0)) { const float dl = __builtin_fmaxf(rm, 0.f); mhat += dl; fsc = __builtin_amdgcn_exp2f(-dl); l *= fsc; resc = true; } } \
    const float nmh = iv_ - mhat; NS_SBAR(); \
    NS_BLD4(P0, P1, 0); NS_SBAR(); NS_GAPB(o[0] = NS_MFMA(NS_VFR(0), NS_PB(0), o[0]), C0, 0);  NS_BLD4(P0, P1, 1); NS_SBAR(); NS_GAPB(o[1] = NS_MFMA(NS_VFR(1), NS_PB(0), o[1]), C0, 4); \
    NS_KRD(KR, 0); NS_BLD4(P0, P1, 2); NS_SBAR(); NS_GAPB(o[0] = NS_MFMA(NS_VFR(2), NS_PB(1), o[0]), C0, 8);  NS_KRD(KR, 1); NS_BLD4(P0, P1, 3); NS_SBAR(); NS_GAPB(o[1] = NS_MFMA(NS_VFR(3), NS_PB(1), o[1]), C0, 12); \
    NS_KRD(KR, 2); NS_BLD4(P0, P1, 4); NS_SBAR(); NS_GAPB(o[0] = NS_MFMA(NS_VFR(4), NS_PB(2), o[0]), C1, 0);  NS_KRD(KR, 3); NS_BLD4(P0, P1, 5); NS_SBAR(); NS_GAPB(o[1] = NS_MFMA(NS_VFR(5), NS_PB(2), o[1]), C1, 4); \
    NS_BLD4(P0, P1, 6); NS_SBAR(); NS_GAPB(o[0] = NS_MFMA(NS_VFR(6), NS_PB(3), o[0]), C1, 8);  NS_BLD4(P0, P1, 7); NS_SBAR(); NS_GAPB(o[1] = NS_MFMA(NS_VFR(7), NS_PB(3), o[1]), C1, 12); \
    LDS_BARRIER(); \
    if (resc) { _Pragma("unroll") for (int r = 0; r < 16; ++r) { o[0][r] *= fsc; o[1][r] *= fsc; } }        \
    ja = jb; jb = jc; jc = jd; NS_NEXT(jd); \
    } while (0)
    int t = 1;
    for (; t + 1 < n; t += 2) {
        NS_STEP(pB0, pB1, pA0, pA1, K1, V1, V0, K0);
        NS_STEP(pA0, pA1, pB0, pB1, K0, V0, V1, K1);
    }
    if (t < n) NS_STEP(pB0, pB1, pA0, pA1, K1, V1, V0, K0);
#define NS_DRAIN(P0, P1, VR) do { float sacc = P0[0] + P0[1]; \
      _Pragma("unroll") for (int r = 2; r < 16; ++r) sacc += P0[r]; \
      _Pragma("unroll") for (int r = 0; r < 16; ++r) sacc += P1[r]; \
      l += sacc; \
      pw0 = (v4u){NS_PK(P0, 0), NS_PK(P0, 2), NS_PK(P0, 4), NS_PK(P0, 6)}; pw1 = (v4u){NS_PK(P0, 8), NS_PK(P0, 10), NS_PK(P0, 12), NS_PK(P0, 14)}; \
      pw2 = (v4u){NS_PK(P1, 0), NS_PK(P1, 2), NS_PK(P1, 4), NS_PK(P1, 6)}; pw3 = (v4u){NS_PK(P1, 8), NS_PK(P1, 10), NS_PK(P1, 12), NS_PK(P1, 14)}; \
      _Pragma("unroll") for (int i = 0; i < 8; ++i) NS_VRD(VR, i); \
      NS_SBAR(); \
      o[0] = NS_MFMA(NS_VFR(0), NS_PB(0), o[0]); o[1] = NS_MFMA(NS_VFR(1), NS_PB(0), o[1]); o[0] = NS_MFMA(NS_VFR(2), NS_PB(1), o[0]); o[1] = NS_MFMA(NS_VFR(3), NS_PB(1), o[1]); \
      o[0] = NS_MFMA(NS_VFR(4), NS_PB(2), o[0]); o[1] = NS_MFMA(NS_VFR(5), NS_PB(2), o[1]); o[0] = NS_MFMA(NS_VFR(6), NS_PB(3), o[0]); o[1] = NS_MFMA(NS_VFR(7), NS_PB(3), o[1]); } while (0)
    if (n & 1) NS_DRAIN(pA0, pA1, V0); else NS_DRAIN(pB0, pB1, V1);
    l_out = l;
    (void)kreg; (void)vreg;
#undef NS_NEXT
#undef NS_LD
#undef NS_KRD
#undef NS_VRD
#undef NS_VFR
#undef NS_PB
#undef NS_PK
#undef NS_EX
#undef NS_INITV
#undef NS_NEAR
#undef NS_MASKED
#undef NS_DHI
#undef NS_BP
#undef NS_BL
#undef NS_BLD4
#undef NS_MASK
#undef NS_GAPA
#undef NS_GAPB
#undef NS_STEP
#undef NS_DRAIN
}

__device__ __forceinline__ void phase_nsa(Frame& F) {
    relaunder(F);
    LAS unsigned char* L = F.lds + RING_OFF;
    LAS unsigned char* Kt = L + NL_K; LAS unsigned char* Vt = L + NL_V;
    LAS float* lutL = (LAS float*)(L + NL_LUT); LAS float* impL = (LAS float*)(L + NL_IMP); LAS unsigned long long* selL = (LAS unsigned long long*)(L + NL_SEL);
    const bf16* qa = (const bf16*)(F.ws + WS_QA); const bf16* kvs = (const bf16*)(F.ws + WS_KVS); const float* ga = (const float*)(F.ws + WS_GA);
    const bf16* kvcb = (const bf16*)(F.ws + WS_KVCMPB); const float* lut = (const float*)(F.ws + WS_LUT); bf16* oa = (bf16*)(F.ws + WS_OAB);
    const int wave = F.wave, hh = wave >> 1, qh = wave & 1;
    if (F.tid < 64) ((LAS float*)(L + NL_ZERO))[F.tid] = 0.f;
    for (int i = F.tid; i < 4 * 1024; i += 512) lutL[i] = lut[((F.bid & 1) * 4 + (i >> 10)) * 4096 + (i & 1023)] * 1.4426950408889634f;
    __syncthreads();
#pragma unroll 1
    for (int ui = 0; ui < 2; ++ui) {
        int tid = (F.wave0 << 6) | lane_id_here_(); asm volatile("" : "+v"(tid));
        const int lane = tid & 63, r32 = lane & 31, hf = lane >> 5;
        const int srow = tid >> 3, schunk = tid & 7;
        const int soff = srow * NSA_TS + schunk * 16, svoff = srow * NSA_VS + schunk * 16;
        const int w = F.bid, bg = w & 7, a_ = (w >> 3) & 31, cq = ui == 0 ? 63 - a_ : a_;
        if (w >= 256) break;
        const int b = bg >> 1, g = bg & 1, head = g * 4 + hh, tq = cq * 64 + qh * 32 + r32;
        const unsigned qrow = (unsigned)(b * SEQ + tq);
#define QROW_LATE() ({ int tq_ = tq; asm volatile("" : "+v"(tq_)); (unsigned)(b * SEQ + tq_); })
        const float g_cmp0 = ga[qrow * 24u + head * 3 + 0], g_slc0 = ga[qrow * 24u + head * 3 + 1], g_win0 = ga[qrow * 24u + head * 3 + 2];
        LAS float* const gpark = (LAS float*)(F.lds + NSA_GATE_OFF) + tid;
        const LAS float* lutH = lutL + hh * 1024;
        bf16x8 qf[4];
#pragma unroll
        for (int ks = 0; ks < 4; ++ks) qf[ks] = *(const bf16x8*)(qa + (size_t)qrow * 512 + head * 64 + ks * 16 + hf * 8);
        f32x16 oc[2];
#pragma unroll
        for (int i = 0; i < 16; ++i) { oc[0][i] = 0.f; oc[1][i] = 0.f; }
        for (int i = tid; i < 4 * 64 * 65; i += 512) impL[i] = 0.f;
        const bf16* kc = kvcb + (size_t)(0 * 8 + bg) * 256 * 64; const bf16* vc = kvcb + (size_t)(1 * 8 + bg) * 256 * 64;
        const int ncb = (4 * cq + 2) / 64 + 1;
        float l = 0.f;
        f32x16 p0, p1, o[2];
        {
            float mr = 0.f; bool has = false;
#pragma unroll
            for (int i = 0; i < 16; ++i) { o[0][i] = 0.f; o[1][i] = 0.f; }
            LAS float* impH = impL + hh * (64 * 65) + (qh * 32 + r32) * 65;
            v4u ckreg = nsa_ld16(kc + (size_t)srow * 64 + schunk * 8), cvreg = nsa_ld16(vc + (size_t)srow * 64 + schunk * 8);
            for (int cb = 0; cb < ncb; ++cb) {
                __syncthreads();
                *(LAS v4u*)(Kt + soff) = ckreg; *(LAS v4u*)(Vt + svoff) = cvreg;
                __syncthreads();
                if (cb + 1 < ncb) { ckreg = nsa_ld16(kc + (size_t)((cb + 1) * 64 + srow) * 64 + schunk * 8); cvreg = nsa_ld16(vc + (size_t)((cb + 1) * 64 + srow) * 64 + schunk * 8); }
                nsa_qk(Kt, qf, r32, hf, p0, p1);
                {
                    __builtin_amdgcn_sched_barrier(0);
                    { float b0[16];
#pragma unroll
                      for (int i = 0; i < 16; ++i) b0[i] = lutH[min(max(tq - 31 - 16 * (cb * 64 + KLOC(i)), 0), 1023)];
#pragma unroll
                      for (int i = 0; i < 16; ++i) p0[i] = (tq - 31 - 16 * (cb * 64 + KLOC(i))) >= 0 ? p0[i] + b0[i] : -INFINITY; }
                    __builtin_amdgcn_sched_barrier(0);
                    { float b1[16];
#pragma unroll
                      for (int i = 0; i < 16; ++i) b1[i] = lutH[min(max(tq - 543 - 16 * (cb * 64 + KLOC(i)), 0), 1023)];
#pragma unroll
                      for (int i = 0; i < 16; ++i) p1[i] = (tq - 543 - 16 * (cb * 64 + KLOC(i))) >= 0 ? p1[i] + b1[i] : -INFINITY; }
                    __builtin_amdgcn_sched_barrier(0);
                }
                float bm = -INFINITY;
#pragma unroll
                for (int i = 0; i < 16; ++i) bm = fmaxf(bm, fmaxf(p0[i], p1[i]));
                bm = fmaxf(bm, __shfl_xor(bm, 32));
                const bool valid = bm > -INFINITY, need = valid && (!has || bm - mr > NSA_THR);
                if (__any(need)) {
                    const float delta = need ? bm - mr : 0.f, sc = (need && has) ? __builtin_amdgcn_exp2f(-delta) : 1.0f;
                    mr += delta; l *= sc;
#pragma unroll
                    for (int i = 0; i < 16; ++i) { o[0][i] *= sc; o[1][i] *= sc; }
                    if (__any(need && has)) {
#pragma unroll 8
                        for (int k = 0; k < 32; ++k) impH[2 * k + hf] *= sc;
                        LDS_WAIT();
                    }
                }
                has = has || valid;
                float ps = 0.f;
#pragma unroll
                for (int i = 0; i < 16; ++i) { p0[i] = __builtin_amdgcn_exp2f(p0[i] - mr); p1[i] = __builtin_amdgcn_exp2f(p1[i] - mr); ps += p0[i] + p1[i]; }
                l += ps;
#pragma unroll
                for (int g4 = 0; g4 < 4; ++g4) {
                    const int u0 = cb * 16 + 2 * g4 + hf, u1 = u0 + 8;
                    impH[u0] += (p0[4 * g4] + p0[4 * g4 + 1]) + (p0[4 * g4 + 2] + p0[4 * g4 + 3]);
                    impH[u1] += (p1[4 * g4] + p1[4 * g4 + 1]) + (p1[4 * g4 + 2] + p1[4 * g4 + 3]);
                }
                LDS_WAIT();
#pragma unroll
                for (int g4 = 0; g4 < 4; ++g4) {
                    const int u0 = cb * 16 + 2 * g4 + hf + 1, u1 = u0 + 8;
                    if (u0 < 64) impH[u0] += p0[4 * g4 + 3];
                    if (u1 < 64) impH[u1] += p1[4 * g4 + 3];
                }
                nsa_pv(Vt, p0, p1, lane, hf, o);
            }
            const float lt = l + __shfl_xor(l, 32), invl = lt > 0.f ? 1.0f / lt : 0.f;
            gpark[0] = g_slc0; gpark[512] = g_win0;
            if (hf == 0) ((LAS float*)(L + NL_INVL))[hh * 64 + qh * 32 + r32] = invl;
#pragma unroll
            for (int i = 0; i < 16; ++i) { const float g_cmp = g_cmp0 * invl; oc[0][i] += g_cmp * o[0][i]; oc[1][i] += g_cmp * o[1][i]; }
        }
        __syncthreads();
        {
            const int q = tid >> 3, sub = tid & 7; unsigned v[8];
#pragma unroll
            for (int k = 0; k < 8; ++k) { const int s = sub * 8 + k; const int idx = q * 65 + s;
                const LAS float* ivl = (const LAS float*)(L + NL_INVL) + q;
                const float im = ((impL[idx] * ivl[0] + impL[64 * 65 + idx] * ivl[64]) + impL[2 * 64 * 65 + idx] * ivl[128]) + impL[3 * 64 * 65 + idx] * ivl[192];
                const float vf = (s == 0 || s == cq || s == cq - 1) ? 1e6f : (s <= cq ? im : -1e6f);
                const unsigned bits = __float_as_uint(vf), mono = bits ^ ((bits >> 31) ? 0xFFFFFFFFu : 0x80000000u);
                v[k] = (mono & ~63u) | (unsigned)(63 - s); }
            __syncthreads();
            LAS unsigned* keyL = (LAS unsigned*)impL;
#pragma unroll
            for (int k = 0; k < 8; ++k) keyL[q * 65 + sub * 8 + k] = v[k];
            __syncthreads();
            int cnt[8];
#pragma unroll
            for (int k = 0; k < 8; ++k) cnt[k] = 0;
#pragma unroll 1
            for (int s0 = 0; s0 < 64; s0 += 32) {
                unsigned xk[32];
#pragma unroll
                for (int j = 0; j < 32; ++j) xk[j] = keyL[q * 65 + s0 + j];
                __builtin_amdgcn_sched_barrier(0);
#pragma unroll
                for (int j = 0; j < 32; ++j)
#pragma unroll
                    for (int k = 0; k < 8; ++k) cnt[k] += (xk[j] > v[k]) ? 1 : 0;
            }
            unsigned byte = 0;
#pragma unroll
            for (int k = 0; k < 8; ++k) byte |= (cnt[k] < 16 ? 1u : 0u) << k;
            ((LAS unsigned char*)selL)[q * 8 + sub] = (unsigned char)byte;
        }
        __syncthreads();
        const unsigned long long vmask = (cq == 63) ? ~0ull : ((1ull << (cq + 1)) - 1ull);
        const unsigned long long mysel = selL[qh * 32 + r32] & vmask;
        unsigned long long U = selL[lane] & vmask;
#pragma unroll
        for (int off = 1; off < 64; off <<= 1) { const unsigned lo_ = __shfl_xor((unsigned)U, off), hi_ = __shfl_xor((unsigned)(U >> 32), off); U |= ((unsigned long long)hi_ << 32) | lo_; }
        U = ((unsigned long long)(unsigned)__builtin_amdgcn_readfirstlane((unsigned)(U >> 32)) << 32) | (unsigned)__builtin_amdgcn_readfirstlane((unsigned)U);
        LAS float* ocL = impL + wave * 2048 + lane;
#pragma unroll
        for (int i = 0; i < 16; ++i) { ocL[i * 64] = oc[0][i]; ocL[(16 + i) * 64] = oc[1][i]; }
        {
            l = 0.f;
#pragma unroll
            for (int i = 0; i < 16; ++i) { o[0][i] = 0.f; o[1][i] = 0.f; }
            nsa_stream<true>(L, kvs, lutH, qf, b, g, cq, tq, lane, r32, hf, srow, schunk, U, (const LAS unsigned*)(selL + qh * 32 + r32), l, o);
            const float lt = l + __shfl_xor(l, 32), sc = gpark[0] / lt;
#pragma unroll
            for (int i = 0; i < 16; ++i) { ocL[i * 64] += sc * o[0][i]; ocL[(16 + i) * 64] += sc * o[1][i]; }
        }
        {
            l = 0.f;
#pragma unroll
            for (int i = 0; i < 16; ++i) { o[0][i] = 0.f; o[1][i] = 0.f; }
            nsa_stream<false>(L, kvs, lutH, qf, b, g, cq, tq, lane, r32, hf, srow, schunk, U, (const LAS unsigned*)(selL + qh * 32 + r32), l, o);
            const float lt = l + __shfl_xor(l, 32), sc = gpark[512] / lt;
#pragma unroll
            for (int i = 0; i < 16; ++i) { oc[0][i] = ocL[i * 64] + sc * o[0][i]; oc[1][i] = ocL[(16 + i) * 64] + sc * o[1][i]; }
        }
#pragma unroll
        for (int dt = 0; dt < 2; ++dt)
#pragma unroll
            for (int g4 = 0; g4 < 4; ++g4) { v2u wv; wv.x = pk2(oc[dt][4 * g4], oc[dt][4 * g4 + 1]); wv.y = pk2(oc[dt][4 * g4 + 2], oc[dt][4 * g4 + 3]);
                *(v2u*)(oa + (size_t)QROW_LATE() * 1536 + head * 64 + dt * 32 + 8 * g4 + 4 * hf) = wv; }
        __syncthreads();
    }
}
#undef KLOC


constexpr int GV_TS = 576;
constexpr int GL_V = 0, GL_KST = GL_V + 64 * GV_TS, GL_GS = GL_KST + 128 * 144, GL_ST = GL_GS + 2048, GL_END1 = GL_ST + 256 * 264;
static_assert(GL_END1 <= RING_BYTES, "gla lds");
__device__ __forceinline__ float log_sigmoid_(float z) { return fminf(z, 0.f) - __logf(1.0f + __expf(-fabsf(z))); }

__device__ __forceinline__ void gla_stage_v(Frame& F, LAS unsigned char* L, const bf16* vb, size_t row0, int h) {
#pragma unroll
    for (int i = 0; i < 4; ++i) { const int idx = F.tid + 512 * i, r = idx >> 5, c = idx & 31;
        *(LAS v4u*)(L + GL_V + r * GV_TS + c * 16) = *(const v4u*)(vb + (row0 + r) * 1024 + h * 256 + c * 8); }
}
constexpr int GL_ALR = GL_END1;
static_assert(GL_ALR + 4096 <= RING_BYTES, "gla lds 2");
__device__ __forceinline__ void phase_gla1(Frame& F, int l, size_t o_qb = WS_QB, size_t o_kb = WS_KB, size_t o_gst = WS_GST, size_t o_dec = WS_DECAY) {
    relaunder(F);
    LAS unsigned char* L = F.lds + RING_OFF;
    bf16* qb = (bf16*)(F.ws + o_qb); bf16* kb = (bf16*)(F.ws + o_kb); const bf16* vb = (const bf16*)(F.ws + WS_VB);
    const float* alr = (const float*)(F.ws + WS_ALR); bf16* gst = (bf16*)(F.ws + o_gst); float* decay = (float*)(F.ws + o_dec);
    const float* aw2 = inp(F, I_AW2) + (size_t)l * 16 * 512; const float* abp = inp(F, I_AB) + l * 512;
    const int tid = F.tid, lane = F.lane, wave = F.wave, r32 = lane & 31, hf = lane >> 5;
    const int d = tid & 127, tg = tid >> 7;
    const int et = tid >> 3, ec = tid & 7;
    LAS float* gs = (LAS float*)(L + GL_GS); LAS float* bL = (LAS float*)(L + GL_ST); LAS float* alrL = (LAS float*)(L + GL_ALR);
    v4u q0, q1, k0, k1, vr[4]; f32x4 ar = {0.f, 0.f, 0.f, 0.f}; float w2r[16], ab;
#define GLA1_LOAD(u_) do { const int bh_ = (u_) >> 6, n_ = (u_) & 63, b_ = bh_ >> 2, h_ = bh_ & 3; const size_t row0_ = (size_t)b_ * SEQ + n_ * 64; \
        const size_t ea_ = (row0_ + et) * 512 + h_ * 128 + ec * 16; \
        q0 = *(const v4u*)(qb + ea_); q1 = *(const v4u*)(qb + ea_ + 8); k0 = *(const v4u*)(kb + ea_); k1 = *(const v4u*)(kb + ea_ + 8); \
        _Pragma("unroll") for (int i_ = 0; i_ < 4; ++i_) { const int idx_ = tid + 512 * i_; vr[i_] = *(const v4u*)(vb + (row0_ + (idx_ >> 5)) * 1024 + h_ * 256 + (idx_ & 31) * 8); } \
        if (tid < 256) ar = *(const f32x4*)(alr + row0_ * 16 + tid * 4); \
        _Pragma("unroll") for (int r_ = 0; r_ < 16; ++r_) w2r[r_] = aw2[r_ * 512 + h_ * 128 + d]; \
        ab = abp[h_ * 128 + d]; } while (0)
    const int ustep = F.G - 16;
    int u = __builtin_amdgcn_readfirstlane(F.bid - 16);
    asm volatile("" : "+s"(u));
    if (u < 1024) GLA1_LOAD(u);
    for (; u < 1024; u += ustep) {
        const int bh = u >> 6, n = u & 63, b = bh >> 2, h = bh & 3; const size_t row0 = (size_t)b * SEQ + n * 64;
        const size_t ea = (row0 + et) * 512 + h * 128 + ec * 16;
#pragma unroll
        for (int i = 0; i < 4; ++i) { const int idx = tid + 512 * i; *(LAS v4u*)(L + GL_V + (idx >> 5) * GV_TS + (idx & 31) * 16) = vr[i]; }
        if (tid < 256) *(LAS f32x4*)(alrL + tid * 4) = ar;
        LDS_BARRIER();
        float bl[16]; float cum = 0.f;
#pragma unroll
        for (int i = 0; i < 16; ++i) { const LAS f32x4* arow = (const LAS f32x4*)(alrL + (tg * 16 + i) * 16); float z = ab;
#pragma unroll
            for (int q = 0; q < 4; ++q) { const f32x4 av = arow[q]; z += av[0] * w2r[4 * q] + av[1] * w2r[4 * q + 1] + av[2] * w2r[4 * q + 2] + av[3] * w2r[4 * q + 3]; }
            cum += log_sigmoid_(z) * (1.0f / 16.0f); bl[i] = cum; }
        gs[tg * 128 + d] = cum;
        LDS_BARRIER();
        float pre = 0.f, tot = 0.f;
#pragma unroll
        for (int g2 = 0; g2 < 4; ++g2) { const float x = gs[g2 * 128 + d]; tot += x; if (g2 < tg) pre += x; }
        if (tg == 0) decay[(size_t)u * 128 + d] = __expf(tot);
#pragma unroll
        for (int i = 0; i < 16; ++i) bL[(tg * 16 + i) * 128 + d] = bl[i] + pre;
        LDS_BARRIER();
        {
            const unsigned qw[8] = {q0.x, q0.y, q0.z, q0.w, q1.x, q1.y, q1.z, q1.w}, kw[8] = {k0.x, k0.y, k0.z, k0.w, k1.x, k1.y, k1.z, k1.w};
            unsigned qo[8], ko[8];
#pragma unroll
            for (int j = 0; j < 8; ++j) {
                const int dd = ec * 16 + 2 * j;
                const float b0 = bL[et * 128 + dd], b1 = bL[et * 128 + dd + 1], t0 = bL[63 * 128 + dd], t1 = bL[63 * 128 + dd + 1];
                const float e0 = __expf(b0), e1 = __expf(b1);
                qo[j] = pk2(bflo(qw[j]) * e0, bfhi(qw[j]) * e1);
                ko[j] = pk2(bflo(kw[j]) * __builtin_amdgcn_rcpf(e0), bfhi(kw[j]) * __builtin_amdgcn_rcpf(e1));
                *(LAS unsigned short*)(L + GL_KST + dd * 144 + et * 2) = (unsigned short)f2bf(bflo(kw[j]) * __expf(t0 - b0));
                *(LAS unsigned short*)(L + GL_KST + (dd + 1) * 144 + et * 2) = (unsigned short)f2bf(bfhi(kw[j]) * __expf(t1 - b1));
            }
            *(v4u*)(qb + ea) = (v4u){qo[0], qo[1], qo[2], qo[3]}; *(v4u*)(qb + ea + 8) = (v4u){qo[4], qo[5], qo[6], qo[7]};
            *(v4u*)(kb + ea) = (v4u){ko[0], ko[1], ko[2], ko[3]}; *(v4u*)(kb + ea + 8) = (v4u){ko[4], ko[5], ko[6], ko[7]};
        }
        if (u + ustep < 1024) GLA1_LOAD(u + ustep);
        LDS_BARRIER();
        {
            const int dkb = wave & 3, dvh = wave >> 2;
            f32x16 acc[4];
#pragma unroll
            for (int t4 = 0; t4 < 4; ++t4)
#pragma unroll
                for (int i = 0; i < 16; ++i) acc[t4][i] = 0.f;
            const LAS unsigned char* vbase = L + GL_V + (8 * hf + ((lane & 15) >> 2)) * GV_TS + (dvh * 128 + 16 * ((lane >> 4) & 1) + 4 * (lane & 3)) * 2;
#pragma unroll
            for (int kp = 0; kp < 2; ++kp) {
                bf16x8 af[2]; v4i16_t blo[2][4], bhi[2][4];
#pragma unroll
                for (int k2 = 0; k2 < 2; ++k2) { const int kk = kp * 2 + k2;
                    af[k2] = *(const LAS bf16x8*)(L + GL_KST + (dkb * 32 + r32) * 144 + kk * 32 + hf * 16);
#pragma unroll
                    for (int t4 = 0; t4 < 4; ++t4) { const LAS unsigned char* bp = vbase + (16 * kk) * GV_TS + t4 * 64;
                        blo[k2][t4] = __builtin_amdgcn_ds_read_tr16_b64_v4i16((LAS v4i16_t*)bp);
                        bhi[k2][t4] = __builtin_amdgcn_ds_read_tr16_b64_v4i16((LAS v4i16_t*)(bp + 4 * GV_TS)); } }
                __builtin_amdgcn_sched_barrier(0);
#pragma unroll
                for (int k2 = 0; k2 < 2; ++k2)
#pragma unroll
                    for (int t4 = 0; t4 < 4; ++t4) { const v4i16_t lo = blo[k2][t4], hi = bhi[k2][t4];
                        const bf16x8 bv = {lo[0], lo[1], lo[2], lo[3], hi[0], hi[1], hi[2], hi[3]};
                        acc[t4] = __builtin_amdgcn_mfma_f32_32x32x16_bf16(af[k2], bv, acc[t4], 0, 0, 0); }
                __builtin_amdgcn_sched_barrier(0);
            }
#pragma unroll
            for (int t4 = 0; t4 < 4; ++t4)
#pragma unroll
                for (int g4 = 0; g4 < 4; ++g4) { v2u wv; wv.x = pk2(acc[t4][4 * g4], acc[t4][4 * g4 + 1]); wv.y = pk2(acc[t4][4 * g4 + 2], acc[t4][4 * g4 + 3]);
                    *(LAS v2u*)(L + GL_ST + (dvh * 128 + t4 * 32 + r32) * 264 + (dkb * 32 + 8 * g4 + 4 * hf) * 2) = wv; }
        }
        LDS_BARRIER();
        {
            bf16* dst = gst + (size_t)u * 32768;
#pragma unroll
            for (int i = 0; i < 8; ++i) { const int idx = tid + 512 * i, r = idx >> 4, c = idx & 15;
                const v2u x0 = *(const LAS v2u*)(L + GL_ST + r * 264 + c * 16), x1 = *(const LAS v2u*)(L + GL_ST + r * 264 + c * 16 + 8);
                *(v4u*)(dst + (size_t)r * 128 + c * 8) = (v4u){x0.x, x0.y, x1.x, x1.y}; }
        }
        LDS_BARRIER();
    }
#undef GLA1_LOAD
}
__device__ __forceinline__ void phase_gla2(Frame& F, size_t o_gst = WS_GST) {
    relaunder(F);
    bf16* gst = (bf16*)(F.ws + o_gst); const float* decay = (const float*)(F.ws + WS_DECAY);
    for (int e = F.bid * 512 + F.tid; e < 16 * 8192; e += F.G * 512) {
        const int bh = e >> 13, off = (e & 8191) * 4, dk0 = off & 127;
        f32x4 S = {0.f, 0.f, 0.f, 0.f};
#pragma unroll 1
        for (int n0 = 0; n0 < 64; n0 += 16) {
            v2u dv[16]; f32x4 dec[16];
#pragma unroll
            for (int j = 0; j < 16; ++j) {
                dv[j] = *(const v2u*)(gst + (size_t)(bh * 64 + n0 + j) * 32768 + off);
                dec[j] = *(const f32x4*)(decay + (size_t)(bh * 64 + n0 + j) * 128 + dk0); }
#pragma unroll
            for (int j = 0; j < 16; ++j) {
                v2u sv; sv.x = pk2(S[0], S[1]); sv.y = pk2(S[2], S[3]); *(v2u*)(gst + (size_t)(bh * 64 + n0 + j) * 32768 + off) = sv;
                S[0] = dec[j][0] * S[0] + bflo(dv[j].x); S[1] = dec[j][1] * S[1] + bfhi(dv[j].x); S[2] = dec[j][2] * S[2] + bflo(dv[j].y); S[3] = dec[j][3] * S[3] + bfhi(dv[j].y); }
        }
    }
}
__device__ __forceinline__ void phase_gla3(Frame& F) {
    relaunder(F);
    LAS unsigned char* L = F.lds + RING_OFF;
    const bf16* qb = (const bf16*)(F.ws + WS_QB); const bf16* kb = (const bf16*)(F.ws + WS_KB); const bf16* vb = (const bf16*)(F.ws + WS_VB);
    const bf16* gst = (const bf16*)(F.ws + WS_GST); const bf16* rb = (const bf16*)(F.ws + WS_RB); bf16* ob = (bf16*)(F.ws + WS_OAB) + 512;
    const int wave = F.wave, ti = wave & 1, dvp = wave >> 1;
    int tid = F.tid, lane = tid & 63, r32 = lane & 31, hf = lane >> 5;
    LAS float* ssq = (LAS float*)(L + GL_GS);
    constexpr int GK_TS = 272;
    static_assert(64 * GK_TS <= 128 * 144, "k tile fits the ksT slot");
    v4u vr[4], kr[2]; bf16x8 qf[8], sf[8];
#define GLA3_LOAD(u_) do { const int bh_ = (u_) >> 6, n_ = (u_) & 63, b_ = bh_ >> 2, h_ = bh_ & 3; const size_t row0_ = (size_t)b_ * SEQ + n_ * 64; \
        _Pragma("unroll") for (int i_ = 0; i_ < 4; ++i_) { const int idx_ = tid + 512 * i_; vr[i_] = *(const v4u*)(vb + (row0_ + (idx_ >> 5)) * 1024 + h_ * 256 + (idx_ & 31) * 8); } \
        _Pragma("unroll") for (int i_ = 0; i_ < 2; ++i_) { const int idx_ = tid + 512 * i_; kr[i_] = *(const v4u*)(kb + (row0_ + (idx_ >> 4)) * 512 + h_ * 128 + (idx_ & 15) * 8); } \
        const bf16* qrow_ = qb + (row0_ + ti * 32 + r32) * 512 + h_ * 128 + hf * 8; \
        _Pragma("unroll") for (int kk_ = 0; kk_ < 8; ++kk_) qf[kk_] = *(const bf16x8*)(qrow_ + kk_ * 16); \
        const bf16* sb_ = gst + (size_t)(u_) * 32768 + (size_t)(dvp * 64 + r32) * 128 + hf * 8; \
        _Pragma("unroll") for (int x_ = 0; x_ < 8; ++x_) sf[x_] = *(const bf16x8*)(sb_ + x_ * 16); } while (0)
    int u = __builtin_amdgcn_readfirstlane(F.bid); asm volatile("" : "+s"(u));
    if (u < 1024) GLA3_LOAD(u);
    for (; u < 1024; u += F.G) {
        const int bh = u >> 6, n = u & 63, b = bh >> 2, h = bh & 3; const size_t row0 = (size_t)b * SEQ + n * 64;
        tid = (F.wave0 << 6) | lane_id_here_(); asm volatile("" : "+v"(tid)); lane = tid & 63; r32 = lane & 31; hf = lane >> 5;
#pragma unroll
        for (int i = 0; i < 4; ++i) { const int idx = tid + 512 * i; *(LAS v4u*)(L + GL_V + (idx >> 5) * GV_TS + (idx & 31) * 16) = vr[i]; }
#pragma unroll
        for (int i = 0; i < 2; ++i) { const int idx = tid + 512 * i; *(LAS v4u*)(L + GL_KST + (idx >> 4) * GK_TS + (idx & 15) * 16) = kr[i]; }
        f32x16 o[2];
#pragma unroll
        for (int i = 0; i < 16; ++i) { o[0][i] = 0.f; o[1][i] = 0.f; }
        bf16x8 sg[8];
        { const bf16* sb1 = gst + (size_t)u * 32768 + (size_t)(dvp * 64 + 32 + r32) * 128 + hf * 8;
#pragma unroll
          for (int kk = 0; kk < 8; ++kk) sg[kk] = *(const bf16x8*)(sb1 + kk * 16); }
#pragma unroll
        for (int kk = 0; kk < 8; ++kk) o[0] = __builtin_amdgcn_mfma_f32_32x32x16_bf16(sf[kk], qf[kk], o[0], 0, 0, 0);
        LDS_BARRIER();
        bf16x8 pb[2][2];
#pragma unroll
        for (int jt = 0; jt < 2; ++jt) {
            f32x16 pt;
#pragma unroll
            for (int i = 0; i < 16; ++i) pt[i] = 0.f;
            if (jt <= ti) {
                bf16x8 kfr[8];
#pragma unroll
                for (int kk = 0; kk < 8; ++kk) kfr[kk] = *(const LAS bf16x8*)(L + GL_KST + (jt * 32 + r32) * GK_TS + kk * 32 + hf * 16);
                __builtin_amdgcn_sched_barrier(0);
#pragma unroll
                for (int kk = 0; kk < 8; ++kk) pt = __builtin_amdgcn_mfma_f32_32x32x16_bf16(kfr[kk], qf[kk], pt, 0, 0, 0);
                if (jt == ti) {
#pragma unroll
                    for (int i = 0; i < 16; ++i) if (((i & 3) + 8 * (i >> 2) + 4 * hf) > r32) pt[i] = 0.f;
                }
            }
            pb[jt][0] = nsa_pack(pt, 0); pb[jt][1] = nsa_pack(pt, 1);
        }
#pragma unroll
        for (int kk = 0; kk < 8; ++kk) o[1] = __builtin_amdgcn_mfma_f32_32x32x16_bf16(sg[kk], qf[kk], o[1], 0, 0, 0);
        const size_t orow = (row0 + ti * 32 + r32) * 1024 + h * 256 + dvp * 64;
        v2u rw[8];
#pragma unroll
        for (int x = 0; x < 8; ++x) rw[x] = *(const v2u*)(rb + orow + (x >> 2) * 32 + 8 * (x & 3) + 4 * hf);
        if (u + F.G < 1024) GLA3_LOAD(u + F.G);
        {
            const LAS unsigned char* vbase = L + GL_V + (4 * hf + ((lane & 15) >> 2)) * GV_TS + (dvp * 64 + 16 * ((lane >> 4) & 1) + 4 * (lane & 3)) * 2;
#pragma unroll
            for (int dvt = 0; dvt < 2; ++dvt) {
                v4i16_t vlo[2][2], vhi[2][2];
#pragma unroll
                for (int jt = 0; jt < 2; ++jt)
#pragma unroll
                    for (int s2 = 0; s2 < 2; ++s2) {
                        if (jt <= ti) {
                            const LAS unsigned char* ap = vbase + (jt * 32 + 16 * s2) * GV_TS + dvt * 64;
                            vlo[jt][s2] = __builtin_amdgcn_ds_read_tr16_b64_v4i16((LAS v4i16_t*)ap);
                            vhi[jt][s2] = __builtin_amdgcn_ds_read_tr16_b64_v4i16((LAS v4i16_t*)(ap + 8 * GV_TS));
                        }
                    }
                __builtin_amdgcn_sched_barrier(0);
#pragma unroll
                for (int jt = 0; jt < 2; ++jt)
#pragma unroll
                    for (int s2 = 0; s2 < 2; ++s2) {
                        if (jt <= ti) {
                            const v4i16_t lo = vlo[jt][s2], hi = vhi[jt][s2];
                            const bf16x8 a = {lo[0], lo[1], lo[2], lo[3], hi[0], hi[1], hi[2], hi[3]};
                            o[dvt] = __builtin_amdgcn_mfma_f32_32x32x16_bf16(a, pb[jt][s2], o[dvt], 0, 0, 0);
                        }
                    }
                __builtin_amdgcn_sched_barrier(0);
            }
        }
        float ss = 0.f;
#pragma unroll
        for (int i = 0; i < 16; ++i) ss += o[0][i] * o[0][i] + o[1][i] * o[1][i];
        ss += __shfl_xor(ss, 32);
        if (hf == 0) ssq[dvp * 64 + ti * 32 + r32] = ss;
        LDS_BARRIER();
        const float tot = (ssq[ti * 32 + r32] + ssq[64 + ti * 32 + r32]) + (ssq[128 + ti * 32 + r32] + ssq[192 + ti * 32 + r32]);
        const float rs = __builtin_amdgcn_rsqf(tot * (1.0f / 256.0f) + EPSN);
#pragma unroll
        for (int dvt = 0; dvt < 2; ++dvt)
#pragma unroll
            for (int g4 = 0; g4 < 4; ++g4) { const int c0 = dvt * 32 + 8 * g4 + 4 * hf; const v2u rwv = rw[dvt * 4 + g4];
                v2u wv; wv.x = pk2(o[dvt][4 * g4] * rs * bflo(rwv.x), o[dvt][4 * g4 + 1] * rs * bfhi(rwv.x)); wv.y = pk2(o[dvt][4 * g4 + 2] * rs * bflo(rwv.y), o[dvt][4 * g4 + 3] * rs * bfhi(rwv.y));
                *(v2u*)(ob + (row0 + ti * 32 + r32) * 1536 + h * 256 + dvp * 64 + c0) = wv; }
        LDS_BARRIER();
    }
#undef GLA3_LOAD
}

__device__ __forceinline__ void phase_gla_naive(Frame& F, const Args& a, int l) {
    relaunder(F);
    if (F.bid >= 64) return;
    const int bh = F.bid >> 2, cb = F.bid & 3, b = bh >> 2, h = bh & 3;
    LAS float* qL = (LAS float*)(F.lds + RING_OFF); LAS float* kL = qL + 32 * 128; LAS float* aL = kL + 32 * 128; LAS float* vL = aL + 32 * 128;
    const bf16* qb = (const bf16*)(F.ws + WS_QB); const bf16* kb = (const bf16*)(F.ws + WS_KB); const bf16* vb = (const bf16*)(F.ws + WS_VB);
    const float* alr = (const float*)(F.ws + WS_ALR); float* oraw = (float*)(F.ws + WS_ORAW);
    const int tid = F.tid, split = tid & 7, ci = tid >> 3, d_st = tid & 127;
    float w2r[16];
#pragma unroll
    for (int r = 0; r < 16; ++r) w2r[r] = inp(F, I_AW2)[(size_t)l * 16 * 512 + r * 512 + h * 128 + d_st];
    const float ab = inp(F, I_AB)[l * 512 + h * 128 + d_st];
    float S[16];
#pragma unroll
    for (int i = 0; i < 16; ++i) S[i] = 0.f;
    for (int tc = 0; tc < SEQ / 32; ++tc) {
        const int t0 = tc * 32;
        __syncthreads();
#pragma unroll
        for (int i = 0; i < 8; ++i) { const int idx = tid + 512 * i, tt = idx >> 7; const size_t row = (size_t)b * SEQ + t0 + tt;
            qL[idx] = bf2f(qb[row * 512 + h * 128 + d_st]); kL[idx] = bf2f(kb[row * 512 + h * 128 + d_st]);
            const f32x4* ar = (const f32x4*)(alr + row * 16); float z = ab;
#pragma unroll
            for (int q = 0; q < 4; ++q) { const f32x4 av = ar[q]; z += av[0] * w2r[4 * q] + av[1] * w2r[4 * q + 1] + av[2] * w2r[4 * q + 2] + av[3] * w2r[4 * q + 3]; }
            const float ls = fminf(z, 0.f) - log1pf(__expf(-fabsf(z)));
            aL[idx] = __expf(ls * (1.0f / 16.0f)); }
#pragma unroll
        for (int i = 0; i < 4; ++i) { const int idx = tid + 512 * i, tt = idx >> 6, c = idx & 63; vL[idx] = bf2f(vb[((size_t)b * SEQ + t0 + tt) * 1024 + h * 256 + cb * 64 + c]); }
        __syncthreads();
        for (int tt = 0; tt < 32; ++tt) {
            const float vt = vL[tt * 64 + ci]; float o = 0.f;
#pragma unroll
            for (int q = 0; q < 4; ++q) { const f32x4 av = *(const LAS f32x4*)(aL + tt * 128 + split * 16 + 4 * q), kv = *(const LAS f32x4*)(kL + tt * 128 + split * 16 + 4 * q), qv = *(const LAS f32x4*)(qL + tt * 128 + split * 16 + 4 * q);
#pragma unroll
                for (int j = 0; j < 4; ++j) { S[4 * q + j] = av[j] * S[4 * q + j] + kv[j] * vt; o += qv[j] * S[4 * q + j]; } }
            o += __shfl_xor(o, 1); o += __shfl_xor(o, 2); o += __shfl_xor(o, 4);
            if (split == 0) oraw[((size_t)b * SEQ + t0 + tt) * 1024 + h * 256 + cb * 64 + ci] = o;
        }
    }
    __syncthreads();
}
__device__ __forceinline__ void phase_gla_norm(Frame& F) {
    relaunder(F);
    const int gw = F.bid * NWAVES + F.wave, NGW = F.G * NWAVES;
    const float* oraw = (const float*)(F.ws + WS_ORAW); const bf16* rb = (const bf16*)(F.ws + WS_RB); bf16* ob = (bf16*)(F.ws + WS_OB);
    for (int i = gw; i < MTOK * 4; i += NGW) {
        const f32x4 v = *((const f32x4*)(oraw + (size_t)i * 256) + F.lane);
        const float s = wave_sum((v[0] * v[0] + v[1] * v[1]) + (v[2] * v[2] + v[3] * v[3]));
        const float r = 1.0f / sqrtf(s * (1.0f / 256.0f) + EPSN);
        const v2u rw = *((const v2u*)(rb + (size_t)i * 256) + F.lane);
        v2u w; w.x = pk2(v[0] * r * bflo(rw.x), v[1] * r * bfhi(rw.x)); w.y = pk2(v[2] * r * bflo(rw.y), v[3] * r * bfhi(rw.y));
        *((v2u*)(ob + (size_t)i * 256) + F.lane) = w;
    }
}

__device__ __forceinline__ void stagger_wait(unsigned ticks  ) {
    const unsigned long long t0 = __builtin_amdgcn_s_memrealtime();
    while (__builtin_amdgcn_s_memrealtime() - t0 < (unsigned long long)ticks) __builtin_amdgcn_s_sleep(32);
}
#ifndef STAGGER_GU
#define STAGGER_GU 0
#endif
#ifndef STAGGER_WIN
#define STAGGER_WIN 0
#endif
#ifndef GLA_NAIVE
#define GLA_NAIVE 0
#endif
#ifndef GROUP_SEAMS
#define GROUP_SEAMS 1
#endif
#ifndef MK_PER_PHASE
#define MK_PER_PHASE 0
#endif
#ifndef PG8_SP2
#define PG8_SP2 true
#endif
constexpr int NPH_L = 11, NPHASES = NL * NPH_L + 1;

__global__ void __launch_bounds__(NWAVES * 64, 2) fwd(Args args) {
    extern __shared__ __attribute__((aligned(16))) unsigned char lds[];
    Frame F;
    F.lds = (LAS unsigned char*)lds;
    F.tid = threadIdx.x; F.lane = F.tid & 63; F.wave = __builtin_amdgcn_readfirstlane(F.tid >> 6); F.wave0 = F.wave;
    F.G = gridDim.x; F.bid = blockIdx.x; F.ws = args.ws;
    unsigned char* ws = args.ws;
    for (int u = F.tid; u < (LDS_BYTES - LDSCTL_OFF) / 4; u += NWAVES * 64) ((LAS unsigned*)(F.lds + LDSCTL_OFF))[u] = 0u;
    if (F.tid < 50) ((LAS unsigned*)(F.lds + LDSCTL_OFF))[F.tid] = ((const __attribute__((address_space(4))) unsigned*)__builtin_amdgcn_kernarg_segment_ptr())[F.tid];
    __syncthreads();
    XcdBarrier bar; bar.bar = (unsigned*)(ws + WS_CTL) + CW_BAR; bar.x = 0; bar.st = nullptr; bar.w0 = F.wave0;
    if (!MK_PER_PHASE) bar = xcd_barrier_post((unsigned*)(ws + WS_CTL) + CW_BAR, (volatile LAS unsigned*)(F.lds + MISC_OFF) + 8, F.wave0);
    const int lo = args.ph_lo, hi = args.ph_hi;
#ifndef PH_MASK
#define PH_MASK 0xFFFF
#endif
#ifndef DBL_MASK
#define DBL_MASK 0
#endif
#define DBL(j) ((DBL_MASK >> (j)) & 1)
#define INL(j) (((PH_MASK >> (j)) & 1) && lo <= (pb + (j)) && (pb + (j)) < hi)
#define IN(k) (lo <= (k) && (k) < hi)
#define SEAM(k) do { if (IN((k) + 1)) { if (MK_PER_PHASE) { } else { XcdBarrier b_ = bar; GAS unsigned* bp_ = (GAS unsigned*)b_.bar; asm volatile("" : "+s"(bp_)); b_.bar = (unsigned*)bp_; xcd_barrier(b_); } } } while (0)
#define GSEAM(k) do { if (IN((k) + 1)) { if (MK_PER_PHASE || !GROUP_SEAMS || F.G != 256) { SEAM(k); } else { GAS unsigned* cp_ = (GAS unsigned*)((unsigned*)(F.ws + WS_CTL)); asm volatile("" : "+s"(cp_)); group_barrier((unsigned*)cp_, F.bid, F.wave0); } } } while (0)
#define PH_PTRS relaunder(F); unsigned char* const ws = F.ws; bf16* const xb = (bf16*)(ws + WS_XB); float* const ssp = (float*)(ws + WS_SSP); bf16* const act = (bf16*)(ws + WS_ACT); (void)xb; (void)ssp; (void)act

    for (int l = 0; l < NL; ++l) {
        const int pb = l * NPH_L;
        if (INL(0)) { phase_conv(F, args, l); if (DBL(0)) { __syncthreads(); phase_conv(F, args, l); } if (l == 0) { phase_lut(F, args); phase_x0(F, args); } SEAM(pb + 0); }
        if (INL(1)) {
            PH_PTRS;
            pg8::Gemm g{xb, (const bf16*)(ws + W_GU1), MTOK, NGU, DM, DM}; g.w0 = F.wave; pg8::StaticOrder S; S.init(MTOK, NGU, F.G, F.bid);
            LAS float* rsL = (LAS float*)(F.lds + RS_OFF); pg8::Unit u0; int pm0 = -1; if (S.next(0, u0)) pm0 = u0.pm;
            EpiGU E{act, ssp, rsL, pm0};
            { pg8::Unit ul; if (STAGGER_GU && !S.next(5, ul)) stagger_wait(STAGGER_GU); }
            pg8::gemm_phase<EpiGU, pg8::StaticOrder, true, PG8_SP2>(F.lds + RING_OFF, g, S, E);
            GSEAM(pb + 1);
        }
        if (INL(2)) {
            PH_PTRS;
            pg8::Gemm g{act, (const bf16*)(ws + W_D1), MTOK, DM, FF, FF}; g.w0 = F.wave; pg8::StaticOrder S; S.init(MTOK, DM, F.G, F.bid);
            EpiResid E{xb, ssp, 0.5f};
            pg8::gemm_phase<EpiResid, pg8::StaticOrder, true, PG8_SP2>(F.lds + RING_OFF, g, S, E);
            GSEAM(pb + 2);
        }
        if (INL(3)) {
            PH_PTRS;
            pg8::Gemm g{xb, (const bf16*)(ws + W_IN), MTOK, NIN, DM, DM}; g.w0 = F.wave; pg8::StaticOrder S; S.init(MTOK, NIN, F.G, F.bid);
            LAS float* rsL = (LAS float*)(F.lds + RS_OFF); pg8::Unit u0; int pm0 = -1; if (S.next(0, u0)) pm0 = u0.pm;
            EpiWin E{ws, ssp, rsL, pm0};
            { pg8::Unit ul; if (STAGGER_WIN && !S.next(6, ul)) stagger_wait(STAGGER_WIN); }
            pg8::gemm_phase<EpiWin, pg8::StaticOrder, true, PG8_SP2>(F.lds + RING_OFF, g, S, E);
            SEAM(pb + 3);
        }
        if (INL(4)) {
            PH_PTRS;
            const bf16* kvc = (const bf16*)(ws + WS_KVC); bf16* hid = (bf16*)(ws + WS_HID); const float* posb = (const float*)(ws + WS_POSB);
            if (F.bid < 16) {
            { pg8::Gemm g{kvc, (const bf16*)(ws + W_C1K), 2048, 256, 2048, 1024}; g.w0 = F.wave; pg8::StaticOrder S; S.init(2048, 256, F.G, F.bid);
              EpiCmp1 E{hid, posb};
              pg8::gemm_phase<EpiCmp1, pg8::StaticOrder, true, PG8_SP2>(F.lds + RING_OFF, g, S, E); }
            { pg8::Gemm g{kvc + (size_t)8 * SEQ * 64, (const bf16*)(ws + W_C1V), 2048, 256, 2048, 1024}; g.w0 = F.wave; pg8::StaticOrder S; S.init(2048, 256, F.G, (F.bid + F.G - 8) % F.G);
              EpiCmp1 E{hid + (size_t)2048 * 256, posb + 256};
              pg8::gemm_phase<EpiCmp1, pg8::StaticOrder, true, PG8_SP2>(F.lds + RING_OFF, g, S, E); }
            } else phase_gla1(F, l);
            SEAM(pb + 4);
        }
        if (INL(5)) { phase_cmp2(F, args, l); phase_gla2(F); SEAM(pb + 5); }
        if (INL(6)) { phase_nsa(F); if (DBL(6)) { __syncthreads(); phase_nsa(F); } phase_gla3(F); SEAM(pb + 6); }
        if (INL(7)) {
            PH_PTRS;
            pg8::Gemm g{(const bf16*)(ws + WS_OAB), (const bf16*)(ws + W_CAT), MTOK, DM, 1536, 1536}; g.w0 = F.wave; pg8::StaticOrder S; S.init(MTOK, DM, F.G, F.bid);
            EpiMergeF E{(const bf16*)(ws + WS_GM), (const bf16*)(ws + WS_GM + 32 * MiB), (bf16*)(ws + WS_Y2)};
            pg8::gemm_phase<EpiMergeF, pg8::StaticOrder, true, PG8_SP2>(F.lds + RING_OFF, g, S, E);
            GSEAM(pb + 7);
        }
        if (INL(8)) {
            PH_PTRS;
            pg8::Gemm g{(const bf16*)(ws + WS_Y2), (const bf16*)(ws + W_O), MTOK, DM, DM, DM}; g.w0 = F.wave; pg8::StaticOrder S; S.init(MTOK, DM, F.G, F.bid);
            EpiResid E{xb, ssp, 1.0f};
            pg8::gemm_phase<EpiResid, pg8::StaticOrder, true, PG8_SP2>(F.lds + RING_OFF, g, S, E);
            GSEAM(pb + 8);
        }
        if (INL(9)) {
            PH_PTRS;
            pg8::Gemm g{xb, (const bf16*)(ws + W_GU2), MTOK, NGU, DM, DM}; g.w0 = F.wave; pg8::StaticOrder S; S.init(MTOK, NGU, F.G, F.bid);
            LAS float* rsL = (LAS float*)(F.lds + RS_OFF); pg8::Unit u0; int pm0 = -1; if (S.next(0, u0)) pm0 = u0.pm;
            EpiGU E{act, ssp, rsL, pm0};
            { pg8::Unit ul; if (STAGGER_GU && !S.next(5, ul)) stagger_wait(STAGGER_GU); }
            pg8::gemm_phase<EpiGU, pg8::StaticOrder, true, PG8_SP2>(F.lds + RING_OFF, g, S, E);
            GSEAM(pb + 9);
        }
        if (INL(10)) {
            PH_PTRS;
            pg8::Gemm g{act, (const bf16*)(ws + W_D2), MTOK, DM, FF, FF}; g.w0 = F.wave; pg8::StaticOrder S; S.init(MTOK, DM, F.G, F.bid);
            EpiResid E{xb, ssp, 0.5f};
            pg8::gemm_phase<EpiResid, pg8::StaticOrder, true, PG8_SP2>(F.lds + RING_OFF, g, S, E);
            SEAM(pb + 10);
        }
    }
    if (IN(NL * NPH_L)) phase_final(F, args);
#undef IN
#undef SEAM
}

extern "C" void kernel_launch(void* const* d_in, const int* in_sizes, int n_in, void* d_out, int out_size, void* d_ws, size_t ws_size, hipStream_t stream) {
    static int grid = 0;
    if (grid == 0) {
        if (n_in != 25 || out_size != MTOK * DM || ws_size < WS_END) { fprintf(stderr, "kernel_launch: unexpected shapes (n_in %d, out %d, ws %zu, need %zu)\n", n_in, out_size, ws_size, (size_t)WS_END); grid = -1; return; }
        int dev = 0, cus = 0, per_cu = 0;
        if (hipGetDevice(&dev) != hipSuccess || hipDeviceGetAttribute(&cus, hipDeviceAttributeMultiprocessorCount, dev) != hipSuccess) { grid = -1; return; }
        if (hipFuncSetAttribute((const void*)fwd, hipFuncAttributeMaxDynamicSharedMemorySize, LDS_BYTES) != hipSuccess) { fprintf(stderr, "kernel_launch: hipFuncSetAttribute failed\n"); grid = -1; return; }
        if (hipOccupancyMaxActiveBlocksPerMultiprocessor(&per_cu, (const void*)fwd, NWAVES * 64, LDS_BYTES) != hipSuccess || per_cu < 1) { fprintf(stderr, "kernel_launch: occupancy query reports %d\n", per_cu); }
        (void)hipGetLastError();
        grid = cus;
    }
    if (grid < 0) return;
    (void)hipMemsetAsync((char*)d_ws + WS_CTL, 0, CTL_ZERO_BYTES, stream);
    Args a{};
    for (int i = 0; i < 25; ++i) a.in[i] = (const float*)d_in[i];
    a.out = (float*)d_out; a.ws = (unsigned char*)d_ws;
#if MK_PER_PHASE
    for (int p = 0; p < NPHASES; ++p) { a.ph_lo = p; a.ph_hi = p + 1; hipLaunchKernelGGL(fwd, dim3(grid), dim3(NWAVES * 64), LDS_BYTES, stream, a); }
#else
    a.ph_lo = 0; a.ph_hi = NPHASES;
    hipLaunchKernelGGL(fwd, dim3(grid), dim3(NWAVES * 64), LDS_BYTES, stream, a);
#endif
    const hipError_t le = hipPeekAtLastError();
    if (le != hipSuccess) fprintf(stderr, "kernel_launch: launch failed: %s\n", hipGetErrorName(le));
}
```

```cpp
#include <hip/hip_runtime.h>
#include <cstdio>
#include <cstdint>

__device__ __forceinline__ int lane_id_here_() { int z = 0; asm volatile("" : "+v"(z)); return __builtin_amdgcn_mbcnt_hi(~0u, __builtin_amdgcn_mbcnt_lo(~0u, z)); }
template <class T> __device__ __forceinline__ T shfl_xor_here_(T v, int mask) { static_assert(sizeof(T) == 4, "32-bit"); return __builtin_bit_cast(T, __builtin_amdgcn_ds_bpermute(((lane_id_here_() ^ mask) & 63) << 2, __builtin_bit_cast(int, v))); }
template <class T> __device__ __forceinline__ T shfl_here_(T v, int src) { static_assert(sizeof(T) == 4, "32-bit"); (void)lane_id_here_; return __builtin_bit_cast(T, __builtin_amdgcn_ds_bpermute((src & 63) << 2, __builtin_bit_cast(int, v))); }
#define __shfl_xor shfl_xor_here_
#define __shfl shfl_here_

namespace pg8 {
#define PG8_LAS __attribute__((address_space(3)))
typedef unsigned short bf16_t;
typedef short bf16x8 __attribute__((ext_vector_type(8)));
typedef float f32x4 __attribute__((ext_vector_type(4)));
typedef unsigned u32x4 __attribute__((ext_vector_type(4)));
constexpr int BM = 256, BK = 64, HALF = 128, HTB = HALF * BK * 2  , STAGE_BYTES = 8 * HTB, NXCD = 8, WGM = 8;

__host__ __device__ __forceinline__ int lds_byte(int r, int c) { const int st = (r >> 4) * 2 + (c >> 5), rr = r & 15, cc = c & 31, ob = rr * 64 + cc * 2; return st * 1024 + (ob ^ (((ob >> 9) & 1) << 5)); }
__host__ __device__ __forceinline__ void stage_rc(int b, int& R, int& C) { const int st = b / 1024, sb = b % 1024, swz = sb ^ (((sb >> 9) & 1) << 5); R = (st >> 1) * 16 + swz / 64; C = (st & 1) * 32 + (swz % 64) / 2; }
__host__ __device__ __forceinline__ int perm32(int rho) { const int n = rho >> 4, i = rho & 15; return 8 * (i >> 2) + 4 * n + (i & 3); }

struct Unit { int pm, pn; };
struct Gemm { const bf16_t* A; const bf16_t* Bt; int M, N, K, lda; int w0 = 0; };

__device__ __forceinline__ void zero_row(const f32x4 (&acc_)[2][2][4][2], int ai, int m) {
    f32x4 (&acc)[2][2][4][2] = const_cast<f32x4 (&)[2][2][4][2]>(acc_);
    bf16x8 z = {0, 0, 0, 0, 0, 0, 0, 0}; asm volatile("" : "+v"(z));
#pragma unroll
    for (int bj = 0; bj < 2; ++bj)
#pragma unroll
        for (int n = 0; n < 2; ++n) { asm volatile("" : "+v"(z)); acc[ai][bj][m][n] = __builtin_amdgcn_mfma_f32_16x16x32_bf16(z, z, (f32x4){0.f, 0.f, 0.f, 0.f}, 0, 0, 0); }
}
struct StaticOrder {
    int nM, nN, nwg, G, c;
    __host__ __device__ __forceinline__ void init(int M, int N, int G_, int c_) { nM = M / BM; nN = N / BM; nwg = nM * nN; G = G_; c = c_; }
    __host__ __device__ __forceinline__ bool next(int i, Unit& u) const {
        const long L = (long)i * G + c; if (L >= nwg) return false;
        int wgid = (int)L; { const int q = nwg / NXCD, r = nwg % NXCD, xcd = wgid % NXCD, off = wgid / NXCD; wgid = (xcd < r ? xcd * (q + 1) : r * (q + 1) + (xcd - r) * q) + off; }
        const int nig = WGM * nN, gid = wgid / nig, fm = gid * WGM, gsz = (nM - fm) < WGM ? (nM - fm) : WGM;
        u.pm = fm + ((wgid % nig) % gsz); u.pn = (wgid % nig) / gsz; return true;
    }
    __device__ __forceinline__ void a_ready(const Unit&) const {}
    __device__ __forceinline__ void done(const Unit&) const {}
};
template <class Epi, class Sched, bool ALIGN_EPI = false, bool SP2 = false>
__device__ __forceinline__ void gemm_phase(PG8_LAS unsigned char* lds, const Gemm g, const Sched& S, const Epi& E) {
    int tid_ = (g.w0 << 6) | lane_id_here_(); asm volatile("" : "+v"(tid_));
    const int tid = tid_, wid = __builtin_amdgcn_readfirstlane(tid >> 6), lane = tid & 63, wr = wid >> 2, wc = wid & 3, fr = lane & 15, fq = lane >> 4;
    const int K = g.K, nt = K / BK;
    unsigned voffA[2], voffB[2];
#pragma unroll
    for (int i = 0; i < 2; ++i) { int R, C; stage_rc(tid * 16 + i * 8192, R, C); const int Rb = Epi::PERM ? ((R & ~31) + perm32(R & 31)) : R;
        voffA[i] = (unsigned)(R * g.lda + C) * 2u; voffB[i] = (unsigned)(Rb * K + C) * 2u; }
    const size_t kstep = (size_t)(BK * 2);
    const size_t hstep = (size_t)HALF * K * 2;
    const size_t tstep = 2 * hstep;
    const size_t hstepA = (size_t)HALF * g.lda * 2, tstepA = 2 * hstepA;
    const unsigned ldsw = (unsigned)wid * 1024u;
    const int aoff = lds_byte(wr * 64 + fr, fq * 8), boff = lds_byte(wc * 32 + fr, fq * 8);
#define PG8_SA(b, h) (((b) * 2 + (h)) * HTB)
#define PG8_SB(b, h) ((4 + (b) * 2 + (h)) * HTB)
#define PG8_STAGE(bufoff, gbase, voff) do { _Pragma("unroll") for (int _i = 0; _i < 2; ++_i) \
        __builtin_amdgcn_global_load_lds((const unsigned*)((const char*)(gbase) + (voff)[_i]), (PG8_LAS unsigned*)(lds + (bufoff) + ldsw + _i * 8192), 16, 0, 0); } while (0)
#define PG8_LDA(dst, b, h) do { _Pragma("unroll") for (int m = 0; m < 4; ++m) _Pragma("unroll") for (int k = 0; k < 2; ++k) dst[m][k] = *(const PG8_LAS bf16x8*)(lds + PG8_SA(b, h) + aoff + m * 2048 + k * 1024); } while (0)
#define PG8_LDB(dst, b, h) do { _Pragma("unroll") for (int n = 0; n < 2; ++n) _Pragma("unroll") for (int k = 0; k < 2; ++k) dst[n][k] = *(const PG8_LAS bf16x8*)(lds + PG8_SB(b, h) + boff + n * 2048 + k * 1024); } while (0)
#define PG8_MMA(ai, bj, At, Bt) do { __builtin_amdgcn_s_setprio(1); _Pragma("unroll") for (int m = 0; m < 4; ++m) _Pragma("unroll") for (int n = 0; n < 2; ++n) _Pragma("unroll") for (int k = 0; k < 2; ++k) \
        acc[ai][bj][m][n] = __builtin_amdgcn_mfma_f32_16x16x32_bf16(Bt[n][k], At[m][k], acc[ai][bj][m][n], 0, 0, 0); __builtin_amdgcn_s_setprio(0); } while (0)
#define PG8_WAIT_V(n) asm volatile("s_waitcnt vmcnt(" #n ")" ::: "memory")
#define PG8_WAIT_L(n) asm volatile("s_waitcnt lgkmcnt(" #n ")" ::: "memory")
#define PG8_BAR __builtin_amdgcn_s_barrier()
#define PG8_SCHED __builtin_amdgcn_sched_barrier(0)
    Unit cur, nxt; int ui = 0;
    if (!S.next(0, cur)) return;
    f32x4 acc[2][2][4][2];
#pragma unroll
    for (int a = 0; a < 2; ++a)
#pragma unroll
        for (int b = 0; b < 2; ++b)
#pragma unroll
            for (int m = 0; m < 4; ++m)
#pragma unroll
                for (int n = 0; n < 2; ++n) acc[a][b][m][n] = (f32x4){0.f, 0.f, 0.f, 0.f};
    bf16x8 At[4][2], B0[2][2], B1[2][2];
    const char* cA = (const char*)g.A + (size_t)cur.pm * tstepA; const char* cB = (const char*)g.Bt + (size_t)cur.pn * tstep;
    S.a_ready(cur);
    if constexpr (SP2) {
        PG8_STAGE(PG8_SB(0, 0), cB, voffB); PG8_STAGE(PG8_SB(0, 1), cB + hstep, voffB); PG8_STAGE(PG8_SA(0, 0), cA, voffA); PG8_STAGE(PG8_SA(0, 1), cA + hstepA, voffA);
        if constexpr (Epi::HAS_PRE) E.pre(tid);
        if (wr == 1) PG8_BAR;
        PG8_WAIT_V(2); PG8_BAR;
        PG8_STAGE(PG8_SB(1, 0), cB + kstep, voffB); PG8_STAGE(PG8_SA(1, 0), cA + kstep, voffA); PG8_STAGE(PG8_SB(1, 1), cB + hstep + kstep, voffB);
        PG8_WAIT_V(6); PG8_BAR;
    } else {
        PG8_STAGE(PG8_SB(0, 0), cB, voffB); PG8_STAGE(PG8_SA(0, 0), cA, voffA); PG8_STAGE(PG8_SB(0, 1), cB + hstep, voffB); PG8_STAGE(PG8_SA(0, 1), cA + hstepA, voffA);
        if (wr == 1) PG8_BAR;
        PG8_WAIT_V(4); PG8_BAR;
        PG8_STAGE(PG8_SB(1, 0), cB + kstep, voffB); PG8_STAGE(PG8_SA(1, 0), cA + kstep, voffA); PG8_STAGE(PG8_SB(1, 1), cB + hstep + kstep, voffB);
        PG8_WAIT_V(6); PG8_BAR;
    }
    for (;;) {
        const bool has_next = S.next(ui + 1, nxt);
        const char* nA = has_next ? (const char*)g.A + (size_t)nxt.pm * tstepA : cA; const char* nB = has_next ? (const char*)g.Bt + (size_t)nxt.pn * tstep : cB;
        for (int t = 0; t < nt; t += 2) {
            const bool last = (t == nt - 2);
            const char* a1 = cA + (size_t)(t + 1) * kstep;
            const char* a2 = last ? nA : cA + (size_t)(t + 2) * kstep; const char* b2 = last ? nB : cB + (size_t)(t + 2) * kstep;
            const char* a3 = a2 + kstep; const char* b3 = b2 + kstep;
            if (last && has_next) S.a_ready(nxt);
            if constexpr (Epi::MID_T > 0) { if (t == Epi::MID_T) E.mid(acc, cur, wr, wc, fr, fq); }
            if constexpr (SP2) {
            PG8_LDB(B0, 0, 0); PG8_LDB(B1, 0, 1); PG8_SCHED; PG8_LDA(At, 0, 0); PG8_STAGE(PG8_SA(1, 1), a1 + hstepA, voffA);
            PG8_WAIT_V(8); PG8_WAIT_L(0); PG8_BAR; PG8_MMA(0, 0, At, B0); PG8_MMA(0, 1, At, B1); PG8_BAR; PG8_SCHED;
            PG8_LDA(At, 0, 1); PG8_STAGE(PG8_SB(0, 0), b2, voffB); PG8_STAGE(PG8_SB(0, 1), b2 + hstep, voffB); PG8_STAGE(PG8_SA(0, 0), a2, voffA);
            PG8_WAIT_V(8); PG8_WAIT_L(0); PG8_BAR; PG8_MMA(1, 0, At, B0); PG8_MMA(1, 1, At, B1); PG8_BAR; PG8_SCHED;
            PG8_LDB(B0, 1, 0); PG8_LDB(B1, 1, 1); PG8_SCHED; PG8_LDA(At, 1, 0); PG8_STAGE(PG8_SA(0, 1), a2 + hstepA, voffA);
            PG8_WAIT_V(8); PG8_WAIT_L(0); PG8_BAR; PG8_MMA(0, 0, At, B0); PG8_MMA(0, 1, At, B1); PG8_BAR; PG8_SCHED;
            PG8_LDA(At, 1, 1); PG8_STAGE(PG8_SB(1, 0), b3, voffB); PG8_STAGE(PG8_SB(1, 1), b3 + hstep, voffB); PG8_STAGE(PG8_SA(1, 0), a3, voffA);
            PG8_WAIT_V(8); PG8_WAIT_L(0); PG8_BAR; PG8_MMA(1, 0, At, B0); PG8_MMA(1, 1, At, B1); PG8_BAR; PG8_SCHED;
            } else {
            PG8_LDB(B0, 0, 0); PG8_SCHED; PG8_LDA(At, 0, 0); PG8_STAGE(PG8_SA(1, 1), a1 + hstepA, voffA);
            PG8_WAIT_L(8); PG8_BAR; PG8_WAIT_L(0); PG8_MMA(0, 0, At, B0); PG8_BAR; PG8_SCHED;
            PG8_LDB(B1, 0, 1); PG8_STAGE(PG8_SB(0, 0), b2, voffB);
            PG8_BAR; PG8_WAIT_L(0); PG8_MMA(0, 1, At, B1); PG8_BAR;
            PG8_LDA(At, 0, 1); PG8_STAGE(PG8_SA(0, 0), a2, voffA);
            PG8_BAR; PG8_WAIT_L(0); PG8_MMA(1, 0, At, B0); PG8_BAR; PG8_SCHED;
            PG8_STAGE(PG8_SB(0, 1), b2 + hstep, voffB);
            PG8_WAIT_V(6); PG8_BAR; PG8_MMA(1, 1, At, B1); PG8_BAR;
            PG8_LDB(B0, 1, 0); PG8_SCHED; PG8_LDA(At, 1, 0); PG8_STAGE(PG8_SA(0, 1), a2 + hstepA, voffA);
            PG8_WAIT_L(8); PG8_BAR; PG8_WAIT_L(0); PG8_MMA(0, 0, At, B0); PG8_BAR; PG8_SCHED;
            PG8_LDB(B1, 1, 1); PG8_STAGE(PG8_SB(1, 0), b3, voffB);
            PG8_BAR; PG8_WAIT_L(0); PG8_MMA(0, 1, At, B1); PG8_BAR;
            PG8_LDA(At, 1, 1); PG8_STAGE(PG8_SA(1, 0), a3, voffA);
            PG8_BAR; PG8_WAIT_L(0); PG8_MMA(1, 0, At, B0); PG8_BAR; PG8_SCHED;
            PG8_STAGE(PG8_SB(1, 1), b3 + hstep, voffB);
            PG8_WAIT_V(6); PG8_BAR; PG8_MMA(1, 1, At, B1); PG8_BAR;
            }
        }
        if constexpr (ALIGN_EPI) { if (wr == 0) PG8_BAR; }
        if constexpr (!Epi::AFTER_DRAIN) { E(acc, cur, wr, wc, fr, fq); S.done(cur); }
        if (!has_next) break;
        if constexpr (!Epi::ZEROES) {
#pragma unroll
        for (int a = 0; a < 2; ++a)
#pragma unroll
            for (int b = 0; b < 2; ++b)
#pragma unroll
                for (int m = 0; m < 4; ++m)
#pragma unroll
                    for (int n = 0; n < 2; ++n) acc[a][b][m][n] = (f32x4){0.f, 0.f, 0.f, 0.f};
        }
        cur = nxt; cA = nA; cB = nB; ++ui;
        if constexpr (ALIGN_EPI) { if (wr == 1) PG8_BAR; }
    }
    PG8_WAIT_V(0);
    if constexpr (!ALIGN_EPI) { if (wr == 0) PG8_BAR; }
    PG8_BAR;
    if constexpr (Epi::AFTER_DRAIN) { E.fused(acc, cur, wr, wc, fr, fq, lds, wid, lane); S.done(cur); }
#undef PG8_SA
#undef PG8_SB
#undef PG8_STAGE
#undef PG8_LDA
#undef PG8_LDB
#undef PG8_MMA
#undef PG8_WAIT_V
#undef PG8_WAIT_L
#undef PG8_BAR
#undef PG8_SCHED
}
}

constexpr int NB = 4, SEQ = 4096, DM = 1024, NL = 4, FF = 2816, MTOK = NB * SEQ;
constexpr int DIN = 6440, NIN = 6656;
constexpr int NGU = 2 * FF;
constexpr float EPSN = 1e-6f;
constexpr int SRC_QA = 0, SRC_KVA = 512, SRC_GA = 1280, SRC_QB = 1304, SRC_KB = 1816, SRC_VB = 2328, SRC_ALR = 3352, SRC_RB = 3368, SRC_GM = 4392;
constexpr int T_QA = 0, T_KVA = 2, T_QB = 5, T_KB = 7, T_VB = 9, T_RB = 13, T_GM = 17, T_MISC = 25;

constexpr size_t MiB = 1u << 20;
constexpr size_t WS_CTL = 0, CTL_ZERO_BYTES = 64 * 1024;
constexpr size_t WS_LUT = 1 * MiB;
constexpr size_t WS_POSB = WS_LUT + 128 * 1024;
constexpr size_t WS_W = 2 * MiB;
constexpr size_t W_GU1 = WS_W, W_D1 = W_GU1 + 11 * MiB, W_GU2 = W_D1 + 11 * MiB / 2, W_D2 = W_GU2 + 11 * MiB;
constexpr size_t W_IN = W_D2 + 11 * MiB / 2, W_C1K = W_IN + 13 * MiB, W_C1V = W_C1K + 1 * MiB, W_N = W_C1V + 1 * MiB, W_G = W_N + 1 * MiB, W_O = W_G + 2 * MiB;
constexpr size_t WS_XB = 58 * MiB;
constexpr size_t WS_SSP = 90 * MiB;
constexpr size_t WS_R = 92 * MiB;
constexpr size_t WS_ACT = WS_R;
constexpr size_t WS_QA = WS_R, WS_KVS = WS_QA + 16 * MiB, WS_KVC = WS_KVS + 16 * MiB, WS_GA = WS_KVC + 9 * MiB, WS_ALR = WS_GA + 2 * MiB;
constexpr size_t WS_QB = WS_ALR + 1 * MiB, WS_KB = WS_QB + 16 * MiB, WS_VB = WS_KB + 16 * MiB, WS_RB = WS_VB + 32 * MiB, WS_GM = WS_RB + 32 * MiB;
constexpr size_t WS_HID = WS_GM + 64 * MiB, WS_KVCMP = WS_HID + 2 * MiB, WS_OA = WS_KVCMP + 1 * MiB, WS_ORAW = WS_OA + 16 * MiB, WS_OB = WS_ORAW + 64 * MiB;
constexpr size_t WS_Y = WS_OB + 32 * MiB, WS_END = WS_Y + 32 * MiB;
constexpr size_t WS_YPART = WS_ORAW;
constexpr size_t WS_OAB = WS_OB;
constexpr size_t WS_Y2 = WS_ORAW;
constexpr size_t W_CAT = W_N;
constexpr size_t WS_GST = WS_ORAW;
constexpr size_t WS_DECAY = WS_GA + 1536 * 1024;
constexpr size_t WS_KVCMPB = WS_KVC + 8 * MiB + 64 * 1024;
static_assert(W_O + 2 * MiB <= WS_XB, "weights fit");
static_assert(WS_END <= 460 * MiB, "workspace budget");

constexpr int CW_BAR = 1024;

constexpr int RING_OFF = 0, RING_BYTES = 131072;
constexpr int LDSCTL_OFF = RING_BYTES, MISC_OFF = LDSCTL_OFF + 320;
constexpr int LDS_BYTES = 147456;
constexpr int RS_OFF = RING_BYTES + 512;
constexpr int NWAVES = 8;

#define GAS __attribute__((address_space(1)))
#define LAS __attribute__((address_space(3)))
typedef unsigned short bf16;
typedef unsigned v4u __attribute__((ext_vector_type(4)));
typedef unsigned v2u __attribute__((ext_vector_type(2)));
typedef float f32x4 __attribute__((ext_vector_type(4)));
typedef short bf16x8 __attribute__((ext_vector_type(8)));
#define LDS_WAIT() asm volatile("s_waitcnt lgkmcnt(0)" ::: "memory")
#define VM_WAIT() asm volatile("s_waitcnt vmcnt(0)" ::: "memory")
__device__ __forceinline__ unsigned f2bf(float f) { unsigned u = __builtin_bit_cast(unsigned, f); return (u + 0x7fffu + ((u >> 16) & 1u)) >> 16; }
typedef float f32x2_t __attribute__((ext_vector_type(2))); typedef __bf16 bf16x2_t __attribute__((ext_vector_type(2)));
__device__ __forceinline__ unsigned pk2(float lo, float hi) { const f32x2_t v = {lo, hi}; const bf16x2_t b = __builtin_convertvector(v, bf16x2_t); return __builtin_bit_cast(unsigned, b); }
__device__ __forceinline__ float bf2f(unsigned short b) { return __builtin_bit_cast(float, ((unsigned)b) << 16); }
__device__ __forceinline__ float bflo(unsigned w) { return __builtin_bit_cast(float, w << 16); }
__device__ __forceinline__ float bfhi(unsigned w) { return __builtin_bit_cast(float, w & 0xffff0000u); }
__device__ __forceinline__ float wave_sum(float v) {
#pragma unroll
    for (int o = 1; o < 64; o <<= 1) v += __shfl_xor(v, o);
    return v;
}
__device__ __forceinline__ float wave_max(float v) {
#pragma unroll
    for (int o = 1; o < 64; o <<= 1) v = fmaxf(v, __shfl_xor(v, o));
    return v;
}
__device__ __forceinline__ float sigmoidf_(float x) { return __builtin_amdgcn_rcpf(1.0f + __builtin_amdgcn_exp2f(x * -1.4426950408889634f)); }
__device__ __forceinline__ float siluf_(float x) { return x * __builtin_amdgcn_rcpf(1.0f + __builtin_amdgcn_exp2f(x * -1.4426950408889634f)); }

#define XB_TMO      128
#define XB_XCNT(j)  (256  + 64 * (j))
#define XB_XSUB(j)  (1280 + 64 * (j))
#define XB_XGEN(j)  (2304 + 64 * (j))
#define XB_TOP      3328
#define XB_TOPGEN   3392
#define XCD_BAR_WORDS 3456
#define XB_SPIN_CAP (1u << 18)

__device__ __forceinline__ unsigned xb_ld(unsigned* p)              { return __hip_atomic_load(p, __ATOMIC_RELAXED, __HIP_MEMORY_SCOPE_AGENT); }
__device__ __forceinline__ unsigned xb_add(unsigned* p, unsigned v) { return __hip_atomic_fetch_add(p, v, __ATOMIC_RELAXED, __HIP_MEMORY_SCOPE_AGENT); }
__device__ __forceinline__ unsigned xb_xcc_id() { return (unsigned)__builtin_amdgcn_s_getreg((3 << 11) | 20) & 0xFu; }
#define XB_SPIN(cond, bar) do { unsigned _sp = 0; while (cond) { __builtin_amdgcn_s_sleep(1); \
    if ((++_sp & 255u) == 0u) { if (xb_ld(&(bar)[XB_TMO])) break; if (_sp > XB_SPIN_CAP) { atomicAdd(&(bar)[XB_TMO], 1u); break; } } } } while (0)

struct XcdBarrier {
    unsigned* bar; unsigned x;
    volatile LAS unsigned* st;
    int w0;
};
__device__ __forceinline__ XcdBarrier xcd_barrier_post(unsigned* bar, volatile LAS unsigned* st, int w0) {
    XcdBarrier b; b.bar = bar; b.x = xb_xcc_id(); b.st = st; b.w0 = w0;
    if (w0 == 0 && lane_id_here_() == 0) (void)xb_add(&bar[XB_XCNT(b.x)], 1u);
    return b;
}
__device__ __forceinline__ void xcd_barrier_complete(unsigned* bar, unsigned x, unsigned& nloc, unsigned& nx) {
    const unsigned G = gridDim.x * gridDim.y * gridDim.z;
    unsigned sum, cnt, mine, sp = 0u;
    for (;;) {
        sum = 0u; cnt = 0u; mine = 0u;
#pragma unroll
        for (unsigned j = 0; j < 16; ++j) { const unsigned c = xb_ld(&bar[XB_XCNT(j)]); sum += c; cnt += (c > 0u) ? 1u : 0u; mine = (j == x) ? c : mine; }
        if (sum == G) break;
        __builtin_amdgcn_s_sleep(1);
        if ((++sp & 255u) == 0u) { if (xb_ld(&bar[XB_TMO])) break; if (sp > XB_SPIN_CAP) { atomicAdd(&bar[XB_TMO], 1u); break; } }
    }
    nloc = mine > 0u ? mine : 1u; nx = cnt > 0u ? cnt : 1u;
}
__device__ __forceinline__ void xcd_barrier(const XcdBarrier& b) {
    asm volatile("s_waitcnt vmcnt(0)" ::: "memory");
    __syncthreads();
    if (b.w0 == 0 && lane_id_here_() == 0) {
        unsigned* bar = b.bar;
        __builtin_amdgcn_s_waitcnt(0);
        unsigned nloc = b.st[0], nx = b.st[1];
        if (nloc == 0u) { xcd_barrier_complete(bar, b.x, nloc, nx); b.st[0] = nloc; b.st[1] = nx; }
        const unsigned old = xb_add(&bar[XB_XSUB(b.x)], 1u);
        const unsigned gen = old / nloc;
        if (old + 1u == (gen + 1u) * nloc) {
            __builtin_amdgcn_fence(__ATOMIC_RELEASE, "agent");
            asm volatile("s_waitcnt vmcnt(0)" ::: "memory");
            const unsigned og = xb_add(&bar[XB_TOP], 1u);
            const unsigned tg = og / nx;
            if (og + 1u == (tg + 1u) * nx) xb_add(&bar[XB_TOPGEN], 1u);
            else XB_SPIN(xb_ld(&bar[XB_TOPGEN]) == tg, bar);
            __builtin_amdgcn_fence(__ATOMIC_ACQUIRE, "agent");
            xb_add(&bar[XB_XGEN(b.x)], 1u);
            asm volatile("s_waitcnt vmcnt(0)" ::: "memory");
        } else {
            XB_SPIN(xb_ld(&bar[XB_XGEN(b.x)]) == gen, bar);
            __builtin_amdgcn_fence(__ATOMIC_ACQUIRE, "agent");
            asm volatile("s_waitcnt vmcnt(0)" ::: "memory");
        }
    }
    __syncthreads();
}

struct Args { const float* in[25]; float* out; unsigned char* ws; int ph_lo, ph_hi; };
enum { I_X = 0, I_REL, I_F1N, I_F1G, I_F1U, I_F1D, I_MIXN, I_WIN, I_POSK, I_POSV, I_CKW1, I_CKW2, I_CVW1, I_CVW2, I_AW2, I_AB, I_GON, I_WBN, I_WBG, I_WOUT, I_F2N, I_F2G, I_F2U, I_F2D, I_FIN };

struct Frame {
    LAS unsigned char* lds;
    int tid, lane, wave, G, bid, wave0;
    unsigned char* ws;
};
__device__ __forceinline__ const float* inp(const Frame& F, int i) {
    const LAS unsigned* t = (const LAS unsigned*)(F.lds + LDSCTL_OFF);
    const unsigned lo = __builtin_amdgcn_readfirstlane(t[2 * i]), hi = __builtin_amdgcn_readfirstlane(t[2 * i + 1]);
    return (const float*)(const GAS float*)(((unsigned long long)hi << 32) | lo);
}
__device__ __forceinline__ void relaunder(Frame& F) { int t = (F.wave0 << 6) | lane_id_here_(); asm volatile("" : "+v"(t)); F.tid = t; F.lane = t & 63; F.wave = __builtin_amdgcn_readfirstlane(t >> 6);
    GAS unsigned char* w = (GAS unsigned char*)F.ws; asm volatile("" : "+s"(w)); F.ws = (unsigned char*)w; }

using pg8::Unit;
#ifndef EPI_Z
#define EPI_Z true
#endif
#define ZROW(ai, m) do { if (EPI_Z) pg8::zero_row(acc, ai, m); } while (0)
__device__ __forceinline__ float row_rstd(const float* ssp, int row);
__device__ __forceinline__ void rstd8(const float* ssp, int rowbase, int fr, int fq, float (&rs)[2][4]);
__device__ __forceinline__ void rstd_table(const float* ssp, int pm, LAS float* rsL, int tid) {
    const int row = tid >> 1, half = tid & 1; const f32x4* p = (const f32x4*)(ssp + (size_t)(pm * 256 + row) * 16 + half * 8);
    const f32x4 a = p[0], b = p[1];
    float s = ((a[0] + a[1]) + (a[2] + a[3])) + ((b[0] + b[1]) + (b[2] + b[3]));
    s += __shfl_xor(s, 1);
    if (half == 0) rsL[row] = __builtin_amdgcn_rsqf(s * (1.0f / DM) + EPSN);
    __syncthreads();
}
__device__ __forceinline__ void rstd8_lds(const LAS float* rsL, const float* ssp, int pm0, const Unit& u, int wr, int fr, int fq, float (&rs)[2][4]) {
    if (u.pm == pm0) {
#pragma unroll
        for (int ai = 0; ai < 2; ++ai)
#pragma unroll
            for (int m = 0; m < 4; ++m) rs[ai][m] = rsL[ai * 128 + wr * 64 + m * 16 + fr];
    } else {
#pragma unroll 1
        for (int i = 0; i < 8; ++i) { const float r = row_rstd(ssp, u.pm * 256 + (i >> 2) * 128 + wr * 64 + (i & 3) * 16 + fr);
#pragma unroll
            for (int ai = 0; ai < 2; ++ai)
#pragma unroll
                for (int m = 0; m < 4; ++m) if (ai * 4 + m == i) rs[ai][m] = r; }
    }
}
__device__ __forceinline__ void rstd8(const float* ssp, int rowbase, int fr, int fq, float (&rs)[2][4]) {
    const int L = fq * 16 + fr; float r2[2];
    f32x4 t[2][4];
#pragma unroll
    for (int ai = 0; ai < 2; ++ai) { const f32x4* p = (const f32x4*)(ssp + (size_t)(rowbase + ai * 128 + L) * 16);
#pragma unroll
        for (int q = 0; q < 4; ++q) t[ai][q] = p[q]; }
#pragma unroll
    for (int ai = 0; ai < 2; ++ai) { const f32x4 a = t[ai][0], b = t[ai][1], c = t[ai][2], d = t[ai][3];
        const float s = ((a[0] + a[1]) + (a[2] + a[3])) + ((b[0] + b[1]) + (b[2] + b[3])) + ((c[0] + c[1]) + (c[2] + c[3])) + ((d[0] + d[1]) + (d[2] + d[3]));
        r2[ai] = __builtin_amdgcn_rsqf(s * (1.0f / DM) + EPSN); }
#pragma unroll
    for (int ai = 0; ai < 2; ++ai)
#pragma unroll
        for (int m = 0; m < 4; ++m) rs[ai][m] = __shfl(r2[ai], 16 * m + fr);
}
__device__ __forceinline__ float row_rstd(const float* ssp, int row) {
    const f32x4* p = (const f32x4*)(ssp + (size_t)row * 16);
    const f32x4 a = p[0], b = p[1], c = p[2], d = p[3];
    const float s = ((a[0] + a[1]) + (a[2] + a[3])) + ((b[0] + b[1]) + (b[2] + b[3])) + ((c[0] + c[1]) + (c[2] + c[3])) + ((d[0] + d[1]) + (d[2] + d[3]));
    return 1.0f / sqrtf(s * (1.0f / DM) + EPSN);
}
struct EpiGU {
    static constexpr bool PERM = true, AFTER_DRAIN = false, ZEROES = EPI_Z, HAS_PRE = true; static constexpr int MID_T = 0;
    bf16* act; const float* ssp; const LAS float* rsL; int pm0;
    __device__ __forceinline__ void pre(int tid) const { if (pm0 >= 0) rstd_table(ssp, pm0, (LAS float*)rsL, tid); else __syncthreads(); }
    __device__ __forceinline__ void operator()(const f32x4 (&acc)[2][2][4][2], const Unit& u, int wr, int wc, int fr, int fq) const {
        const int row0 = u.pm * 256 + wr * 64 + fr, col0 = u.pn * 128 + wc * 32 + 8 * fq;
        float rs[2][4]; rstd8_lds(rsL, ssp, pm0, u, wr, fr, fq, rs);
#pragma unroll
        for (int ai = 0; ai < 2; ++ai)
#pragma unroll
            for (int m = 0; m < 4; ++m) {
                const int row = row0 + ai * 128 + m * 16; const float r = rs[ai][m];
                float h[8];
                const float rn = r * -1.4426950408889634f, r2 = r * r;
#pragma unroll
                for (int n = 0; n < 2; ++n) {
                    const f32x4 g = acc[ai][0][m][n], up = acc[ai][1][m][n];
                    const f32x4 t = g * rn;
                    f32x4 d = {__builtin_amdgcn_exp2f(t[0]), __builtin_amdgcn_exp2f(t[1]), __builtin_amdgcn_exp2f(t[2]), __builtin_amdgcn_exp2f(t[3])};
                    d = d + 1.0f;
                    const f32x4 sg = {__builtin_amdgcn_rcpf(d[0]), __builtin_amdgcn_rcpf(d[1]), __builtin_amdgcn_rcpf(d[2]), __builtin_amdgcn_rcpf(d[3])};
                    const f32x4 hv = ((g * up) * r2) * sg;
#pragma unroll
                    for (int j = 0; j < 4; ++j) h[n * 4 + j] = hv[j];
                }
                ZROW(ai, m);
                v4u w; w.x = pk2(h[0], h[1]); w.y = pk2(h[2], h[3]); w.z = pk2(h[4], h[5]); w.w = pk2(h[6], h[7]);
                *(v4u*)(act + (size_t)row * FF + col0) = w;
            }
    }
};
struct EpiResid {
    static constexpr bool PERM = true, AFTER_DRAIN = false, ZEROES = EPI_Z, HAS_PRE = false; static constexpr int MID_T = 0;
    bf16* xb; float* ssp; float alpha;
    __device__ __forceinline__ void operator()(const f32x4 (&acc)[2][2][4][2], const Unit& u, int wr, int wc, int fr, int fq) const {
        const int row0 = u.pm * 256 + wr * 64 + fr, col0 = u.pn * 256 + wc * 32 + 8 * fq;
        v4u xw[2][4][2];
#pragma unroll
        for (int ai = 0; ai < 2; ++ai)
#pragma unroll
            for (int m = 0; m < 4; ++m)
#pragma unroll
                for (int bj = 0; bj < 2; ++bj) xw[ai][m][bj] = *(const v4u*)(xb + (unsigned)((row0 + ai * 128 + m * 16) * DM + col0 + bj * 128));
#pragma unroll
        for (int ai = 0; ai < 2; ++ai) {
#pragma unroll
            for (int m = 0; m < 4; ++m) {
                const int row = row0 + ai * 128 + m * 16; float ssq = 0.f;
#pragma unroll
                for (int bj = 0; bj < 2; ++bj) {
                    const v4u xv = xw[ai][m][bj];
                    f32x4 x0 = {bflo(xv.x), bfhi(xv.x), bflo(xv.y), bfhi(xv.y)}, x1 = {bflo(xv.z), bfhi(xv.z), bflo(xv.w), bfhi(xv.w)};
                    x0 = x0 + acc[ai][bj][m][0] * alpha; x1 = x1 + acc[ai][bj][m][1] * alpha;
                    v4u w; w.x = pk2(x0[0], x0[1]); w.y = pk2(x0[2], x0[3]); w.z = pk2(x1[0], x1[1]); w.w = pk2(x1[2], x1[3]);
                    *(v4u*)(xb + (unsigned)(row * DM + col0 + bj * 128)) = w;
                    x0 = (f32x4){bflo(w.x), bfhi(w.x), bflo(w.y), bfhi(w.y)}; x1 = (f32x4){bflo(w.z), bfhi(w.z), bflo(w.w), bfhi(w.w)};
                    ssq += (x0[0] * x0[0] + x0[1] * x0[1]) + (x0[2] * x0[2] + x0[3] * x0[3]) + (x1[0] * x1[0] + x1[1] * x1[1]) + (x1[2] * x1[2] + x1[3] * x1[3]);
                }
                ZROW(ai, m);
                ssq += __shfl_xor(ssq, 16); ssq += __shfl_xor(ssq, 32);
                if (fq == 0) ssp[(size_t)row * 16 + u.pn * 4 + wc] = ssq;
            }
        }
    }
};
struct EpiWin {
    static constexpr bool PERM = true, AFTER_DRAIN = false, ZEROES = EPI_Z, HAS_PRE = true; static constexpr int MID_T = 0;
    unsigned char* ws; const float* ssp; const LAS float* rsL; int pm0;
    __device__ __forceinline__ void pre(int tid) const { if (pm0 >= 0) rstd_table(ssp, pm0, (LAS float*)rsL, tid); else __syncthreads(); }
    __device__ __forceinline__ void operator()(const f32x4 (&acc)[2][2][4][2], const Unit& u, int wr, int wc, int fr, int fq) const {
        const int row0 = u.pm * 256 + wr * 64 + fr, pn = u.pn;
        bf16* dst = nullptr; int ld = 0, coff = 0, actk = 0; float scale = 1.f;
        if (pn < T_KVA) { dst = (bf16*)(ws + WS_QA); ld = 512; coff = (pn - T_QA) * 256; scale = 0.125f * 1.4426950408889634f; }
        else if (pn == T_KVA) { }
        else if (pn < T_QB) { dst = (bf16*)(ws + WS_KVS); ld = 512; coff = (pn - T_KVA - 1) * 256; }
        else if (pn < T_KB) { dst = (bf16*)(ws + WS_QB); ld = 512; coff = (pn - T_QB) * 256; scale = 0.08838834764831845f; }
        else if (pn < T_VB) { dst = (bf16*)(ws + WS_KB); ld = 512; coff = (pn - T_KB) * 256; }
        else if (pn < T_RB) { dst = (bf16*)(ws + WS_VB); ld = 1024; coff = (pn - T_VB) * 256; }
        else if (pn < T_GM) { dst = (bf16*)(ws + WS_RB); ld = 1024; coff = (pn - T_RB) * 256; actk = 1; }
        else if (pn < T_MISC) { }
        float rs[2][4]; rstd8_lds(rsL, ssp, pm0, u, wr, fr, fq, rs);
#pragma unroll
        for (int ai = 0; ai < 2; ++ai)
#pragma unroll
            for (int m = 0; m < 4; ++m) {
                const int row = row0 + ai * 128 + m * 16; const float r = rs[ai][m];
                if (pn >= T_GM && pn < T_MISC) {
                    float rr[8], g1[8]; const float rn = r * -1.4426950408889634f;
#pragma unroll
                    for (int n = 0; n < 2; ++n)
#pragma unroll
                        for (int j = 0; j < 4; ++j) { const float ea = __builtin_amdgcn_exp2f(acc[ai][0][m][n][j] * rn), eb = __builtin_amdgcn_exp2f(acc[ai][1][m][n][j] * rn);
                            const float sb = __builtin_amdgcn_rcpf(1.0f + eb); g1[n * 4 + j] = sb; rr[n * 4 + j] = (1.0f + eb) * __builtin_amdgcn_rcpf(1.0f + ea); }
                    v4u w0; w0.x = pk2(rr[0], rr[1]); w0.y = pk2(rr[2], rr[3]); w0.z = pk2(rr[4], rr[5]); w0.w = pk2(rr[6], rr[7]);
                    v4u w1; w1.x = pk2(g1[0], g1[1]); w1.y = pk2(g1[2], g1[3]); w1.z = pk2(g1[4], g1[5]); w1.w = pk2(g1[6], g1[7]);
                    const size_t o = (size_t)row * DM + (pn - T_GM) * 128 + wc * 32 + 8 * fq;
                    *(v4u*)((bf16*)(ws + WS_GM) + o) = w0; *(v4u*)((bf16*)(ws + WS_GM + 32 * MiB) + o) = w1;
                } else if (pn == T_MISC) {
                    float* ga = (float*)(ws + WS_GA); float* alr = (float*)(ws + WS_ALR);
#pragma unroll
                    for (int n = 0; n < 2; ++n)
#pragma unroll
                        for (int j = 0; j < 4; ++j) { const int c = wc * 32 + 8 * fq + 4 * n + j; const float v = acc[ai][0][m][n][j] * r;
                            if (c < 24) ga[(size_t)row * 24 + c] = sigmoidf_(v); else if (c < 40) alr[(size_t)row * 16 + (c - 24)] = v; }
                } else {
#pragma unroll
                    for (int bj = 0; bj < 2; ++bj) {
                        float h[8]; const float rsc = r * scale;
#pragma unroll
                        for (int n = 0; n < 2; ++n)
#pragma unroll
                            for (int j = 0; j < 4; ++j) { float v = acc[ai][bj][m][n][j] * rsc; if (actk == 1) v = siluf_(v); else if (actk == 2) v = sigmoidf_(v); h[n * 4 + j] = v; }
                        v4u w; w.x = pk2(h[0], h[1]); w.y = pk2(h[2], h[3]); w.z = pk2(h[4], h[5]); w.w = pk2(h[6], h[7]);
                        if (pn == T_KVA) {
                            const int b = row >> 12, t = row & 4095, g = wc >> 1, d = (wc & 1) * 32 + 8 * fq;
                            bf16* kvc = (bf16*)(ws + WS_KVC);
                            *(v4u*)(kvc + ((size_t)((bj * 4 + b) * 2 + g) * SEQ + t) * 64 + d) = w;
                        } else {
                            *(v4u*)(dst + (size_t)row * ld + coff + bj * 128 + wc * 32 + 8 * fq) = w;
                        }
                    }
                }
                ZROW(ai, m);
            }
    }
};
struct EpiCmp1 {
    static constexpr bool PERM = true, AFTER_DRAIN = false, ZEROES = EPI_Z, HAS_PRE = false; static constexpr int MID_T = 0;
    bf16* hid; const float* posb;
    __device__ __forceinline__ void operator()(const f32x4 (&acc)[2][2][4][2], const Unit& u, int wr, int wc, int fr, int fq) const {
        const int row0 = u.pm * 256 + wr * 64 + fr, col0 = wc * 32 + 8 * fq;
#pragma unroll
        for (int ai = 0; ai < 2; ++ai)
#pragma unroll
            for (int m = 0; m < 4; ++m) {
                const int row = row0 + ai * 128 + m * 16;
#pragma unroll
                for (int bj = 0; bj < 2; ++bj) {
                    const f32x4 b0 = *(const f32x4*)(posb + col0 + bj * 128), b1 = *(const f32x4*)(posb + col0 + bj * 128 + 4);
                    const f32x4 v0 = acc[ai][bj][m][0] + b0, v1 = acc[ai][bj][m][1] + b1;
                    v4u w; w.x = pk2(siluf_(v0[0]), siluf_(v0[1])); w.y = pk2(siluf_(v0[2]), siluf_(v0[3])); w.z = pk2(siluf_(v1[0]), siluf_(v1[1])); w.w = pk2(siluf_(v1[2]), siluf_(v1[3]));
                    *(v4u*)(hid + (size_t)row * 256 + col0 + bj * 128) = w;
                }
                ZROW(ai, m);
            }
    }
};
struct EpiMergeF {
    static constexpr bool PERM = true, AFTER_DRAIN = false, ZEROES = EPI_Z, HAS_PRE = false; static constexpr int MID_T = 8;
    const bf16* ratio; const bf16* g1; bf16* y;
    __device__ __forceinline__ void mid(f32x4 (&acc)[2][2][4][2], const Unit& u, int wr, int wc, int fr, int fq) const {
        int row0 = u.pm * 256 + wr * 64 + fr, col0 = u.pn * 256 + wc * 32 + 8 * fq;
        asm volatile("" : "+v"(row0), "+v"(col0));
#pragma unroll
        for (int ai = 0; ai < 2; ++ai)
#pragma unroll
            for (int m = 0; m < 4; ++m)
#pragma unroll
                for (int bj = 0; bj < 2; ++bj) {
                    const v4u gw = *(const v4u*)(ratio + (unsigned)((row0 + ai * 128 + m * 16) * DM + col0 + bj * 128));
                    acc[ai][bj][m][0] = acc[ai][bj][m][0] * (f32x4){bflo(gw.x), bfhi(gw.x), bflo(gw.y), bfhi(gw.y)};
                    acc[ai][bj][m][1] = acc[ai][bj][m][1] * (f32x4){bflo(gw.z), bfhi(gw.z), bflo(gw.w), bfhi(gw.w)};
                    if (bj == 1 && m == 3) asm volatile("" ::: "memory");
                }
    }
    __device__ __forceinline__ void operator()(const f32x4 (&acc)[2][2][4][2], const Unit& u, int wr, int wc, int fr, int fq) const {
        const int row0 = u.pm * 256 + wr * 64 + fr, col0 = u.pn * 256 + wc * 32 + 8 * fq;
#pragma unroll
        for (int ai = 0; ai < 2; ++ai) {
            v4u gq[4][2];
#pragma unroll
            for (int m = 0; m < 4; ++m)
#pragma unroll
                for (int bj = 0; bj < 2; ++bj) gq[m][bj] = *(const v4u*)(g1 + (unsigned)((row0 + ai * 128 + m * 16) * DM + col0 + bj * 128));
#pragma unroll
            for (int m = 0; m < 4; ++m) {
#pragma unroll
                for (int bj = 0; bj < 2; ++bj) {
                    const unsigned o = (unsigned)((row0 + ai * 128 + m * 16) * DM + col0 + bj * 128);
                    const v4u gw = gq[m][bj];
                    const f32x4 v0 = acc[ai][bj][m][0] * (f32x4){bflo(gw.x), bfhi(gw.x), bflo(gw.y), bfhi(gw.y)}, v1 = acc[ai][bj][m][1] * (f32x4){bflo(gw.z), bfhi(gw.z), bflo(gw.w), bfhi(gw.w)};
                    v4u w; w.x = pk2(v0[0], v0[1]); w.y = pk2(v0[2], v0[3]); w.z = pk2(v1[0], v1[1]); w.w = pk2(v1[2], v1[3]);
                    *(v4u*)(y + o) = w;
                }
                ZROW(ai, m);
            }
        }
    }
};
template <int STEP> struct EpiMerge {
    static constexpr bool PERM = true, AFTER_DRAIN = false, ZEROES = false, HAS_PRE = false; static constexpr int MID_T = 0;
    const bf16* gm; float* ypart; bf16* y;
    __device__ __forceinline__ void operator()(const f32x4 (&acc)[2][2][4][2], const Unit& u, int wr, int wc, int fr, int fq) const {
        const int row0 = u.pm * 256 + wr * 64 + fr, col0 = u.pn * 256 + wc * 32 + 8 * fq;
#pragma unroll
        for (int ai = 0; ai < 2; ++ai)
#pragma unroll
            for (int m = 0; m < 4; ++m) {
                const int row = row0 + ai * 128 + m * 16;
#pragma unroll
                for (int bj = 0; bj < 2; ++bj) {
                    const int col = col0 + bj * 128;
                    const v4u gw = *(const v4u*)(gm + (size_t)row * 2048 + (STEP == 1 ? 0 : 1024) + col);
                    f32x4 g0 = {bflo(gw.x), bfhi(gw.x), bflo(gw.y), bfhi(gw.y)}, g1 = {bflo(gw.z), bfhi(gw.z), bflo(gw.w), bfhi(gw.w)};
                    float* yp = ypart + (size_t)row * DM + col;
                    if (STEP == 1) { *(f32x4*)yp = g0 * acc[ai][bj][m][0]; *(f32x4*)(yp + 4) = g1 * acc[ai][bj][m][1]; }
                    else { const f32x4 v0 = *(const f32x4*)yp + g0 * acc[ai][bj][m][0], v1 = *(const f32x4*)(yp + 4) + g1 * acc[ai][bj][m][1];
                        v4u w; w.x = pk2(v0[0], v0[1]); w.y = pk2(v0[2], v0[3]); w.z = pk2(v1[0], v1[1]); w.w = pk2(v1[2], v1[3]);
                        *(v4u*)(y + (size_t)row * DM + col) = w; }
                }
            }
    }
};

struct SrcCol { const float* p; int col; };
template <bool GAIN, class Map>
__device__ __forceinline__ void tr_item(int ldw, const float* gain, bf16* WT, int K, int nblk, int item, LAS float* scr, int lane, const Map& cm, int ldk = 0) {
    if (ldk == 0) ldk = K;
    const int kb = item / nblk, nb = item % nblk, k0 = 64 * kb, n0 = 32 * nb;
    const SrcCol sc = cm(n0 + (lane & 31));
    const float msk = sc.col >= 0 ? 1.f : 0.f;
    const float* src = sc.p + (size_t)(k0 + (lane >> 5)) * ldw + (sc.col >= 0 ? sc.col : 0);
    float v[32];
#pragma unroll
    for (int i = 0; i < 32; ++i) v[i] = src[(size_t)(2 * i) * ldw];
    if constexpr (GAIN) {
        const float* gp = gain + k0 + (lane >> 5);
#pragma unroll
        for (int i = 0; i < 32; ++i) v[i] *= gp[2 * i];
    }
#pragma unroll
    for (int i = 0; i < 32; ++i) scr[(2 * i + (lane >> 5)) * 33 + (lane & 31)] = v[i] * msk;
    LDS_WAIT();
    const int c = lane & 7;
#pragma unroll
    for (int j = 0; j < 4; ++j) { const int n = (lane >> 3) + 8 * j; const LAS float* s = scr + (8 * c) * 33 + n;
        v4u o; o.x = pk2(s[0 * 33], s[1 * 33]); o.y = pk2(s[2 * 33], s[3 * 33]); o.z = pk2(s[4 * 33], s[5 * 33]); o.w = pk2(s[6 * 33], s[7 * 33]);
        *(v4u*)(WT + (size_t)(n0 + n) * ldk + k0 + 8 * c) = o; }
    LDS_WAIT();
}
struct MapGU { const float* p; __device__ __forceinline__ SrcCol operator()(int n) const { return SrcCol{p, (n >> 8) * 128 + (n & 127)}; } };
struct MapId { const float* p; __device__ __forceinline__ SrcCol operator()(int n) const { return SrcCol{p, n}; } };
struct MapWin { const float* p; __device__ __forceinline__ SrcCol operator()(int n) const {
    const int t = n >> 8, r = n & 255; int c;
    if (t < T_KVA) c = SRC_QA + n; else if (t < T_QB) c = SRC_KVA + (n - T_KVA * 256); else if (t < T_KB) c = SRC_QB + (n - T_QB * 256); else if (t < T_VB) c = SRC_KB + (n - T_KB * 256);
    else if (t < T_RB) c = SRC_VB + (n - T_VB * 256); else if (t < T_GM) c = SRC_RB + (n - T_RB * 256); else if (t < T_MISC) c = SRC_GM + (t - T_GM) * 128 + (r & 127) + (r >= 128 ? 1024 : 0);
    else c = r < 24 ? SRC_GA + r : (r < 40 ? SRC_ALR + (r - 24) : -1);
    return SrcCol{p, c}; } };

__device__ __forceinline__ void phase_conv(Frame& F, const Args& a, int l) {
    relaunder(F);
    LAS float* scr = (LAS float*)(F.lds + RING_OFF + F.wave * 16384);
    const int gw = F.bid * NWAVES + F.wave, NGW = F.G * NWAVES;
    unsigned char* ws = F.ws;
    constexpr int I_GU = (DM / 64) * (NGU / 32), I_D = (FF / 64) * (DM / 32), I_IN = (DM / 64) * (NIN / 32), I_C1 = (2048 / 64) * (256 / 32), I_N = (512 / 64) * (DM / 32), I_SQ = (DM / 64) * (DM / 32);
    constexpr int NITEMS = 2 * I_GU + 2 * I_D + I_IN + 2 * I_C1 + I_N + 2 * I_SQ;
    const size_t oG = (size_t)l * DM * FF, oD = (size_t)l * FF * DM;
    for (int it = gw; it < NITEMS; it += NGW) {
        int r = it;
        if (r < I_GU) { const bool up = (((r % (NGU / 32)) * 32) & 255) >= 128;
            if (up) tr_item<true>(FF, inp(F, I_F1N) + l * DM, (bf16*)(ws + W_GU1), DM, NGU / 32, r, scr, F.lane, MapGU{inp(F, I_F1U) + oG});
            else tr_item<true>(FF, inp(F, I_F1N) + l * DM, (bf16*)(ws + W_GU1), DM, NGU / 32, r, scr, F.lane, MapGU{inp(F, I_F1G) + oG});
            continue; } r -= I_GU;
        if (r < I_GU) { const bool up = (((r % (NGU / 32)) * 32) & 255) >= 128;
            if (up) tr_item<true>(FF, inp(F, I_F2N) + l * DM, (bf16*)(ws + W_GU2), DM, NGU / 32, r, scr, F.lane, MapGU{inp(F, I_F2U) + oG});
            else tr_item<true>(FF, inp(F, I_F2N) + l * DM, (bf16*)(ws + W_GU2), DM, NGU / 32, r, scr, F.lane, MapGU{inp(F, I_F2G) + oG});
            continue; } r -= I_GU;
        if (r < I_D) { tr_item<false>(DM, nullptr, (bf16*)(ws + W_D1), FF, DM / 32, r, scr, F.lane, MapId{inp(F, I_F1D) + oD}); continue; } r -= I_D;
        if (r < I_D) { tr_item<false>(DM, nullptr, (bf16*)(ws + W_D2), FF, DM / 32, r, scr, F.lane, MapId{inp(F, I_F2D) + oD}); continue; } r -= I_D;
        if (r < I_IN) { tr_item<true>(DIN, inp(F, I_MIXN) + l * DM, (bf16*)(ws + W_IN), DM, NIN / 32, r, scr, F.lane, MapWin{inp(F, I_WIN) + (size_t)l * DM * DIN}); continue; } r -= I_IN;
        if (r < I_C1) { tr_item<false>(256, nullptr, (bf16*)(ws + W_C1K), 2048, 256 / 32, r, scr, F.lane, MapId{inp(F, I_CKW1) + (size_t)l * 2048 * 256}); continue; } r -= I_C1;
        if (r < I_C1) { tr_item<false>(256, nullptr, (bf16*)(ws + W_C1V), 2048, 256 / 32, r, scr, F.lane, MapId{inp(F, I_CVW1) + (size_t)l * 2048 * 256}); continue; } r -= I_C1;
        if (r < I_N) { tr_item<false>(DM, nullptr, (bf16*)(ws + W_CAT), 512, DM / 32, r, scr, F.lane, MapId{inp(F, I_WBN) + (size_t)l * 512 * DM}, 1536); continue; } r -= I_N;
        if (r < I_SQ) { tr_item<true>(DM, inp(F, I_GON) + l * DM, (bf16*)(ws + W_CAT) + 512, DM, DM / 32, r, scr, F.lane, MapId{inp(F, I_WBG) + (size_t)l * DM * DM}, 1536); continue; } r -= I_SQ;
        tr_item<false>(DM, nullptr, (bf16*)(ws + W_O), DM, DM / 32, r, scr, F.lane, MapId{inp(F, I_WOUT) + (size_t)l * DM * DM});
    }
    __syncthreads();
    if (l == 0 && F.bid < 32 * NL) {
        const int lyr = F.bid >> 5, kv = (F.bid >> 4) & 1, nb = (F.bid & 15) * 16, c = F.tid & 15, ks = F.tid >> 4;
        const float* pos = inp(F, kv ? I_POSV : I_POSK) + (size_t)lyr * 2048; const float* w1 = inp(F, kv ? I_CVW1 : I_CKW1) + (size_t)lyr * 2048 * 256;
        float s = 0.f;
#pragma unroll 32
        for (int k = ks * 64; k < ks * 64 + 64; ++k) s += pos[k] * w1[(size_t)k * 256 + nb + c];
        LAS float* red = (LAS float*)(F.lds + RING_OFF);
        red[F.tid] = s; __syncthreads();
        if (F.tid < 16) { float t = 0.f; for (int i = 0; i < 32; ++i) t += red[i * 16 + F.tid]; ((float*)(ws + WS_POSB))[lyr * 512 + kv * 256 + nb + F.tid] = t; }
        __syncthreads();
    }
}
__device__ __forceinline__ void phase_lut(Frame& F, const Args& a) {
    relaunder(F);
    float* lut = (float*)(F.ws + WS_LUT); const float* tab = inp(F, I_REL);
    for (int i = F.bid * 512 + F.tid; i < 8 * 4096; i += F.G * 512) {
        const int h = i >> 12, n = i & 4095; int bk;
        if (n < 16) bk = n; else { const float nf = (float)n; int lb = 16 + (int)(logf(nf / 16.0f) / 4.1588830833596715f * 16.0f); bk = lb < 31 ? lb : 31; }
        lut[i] = tab[bk * 8 + h];
    }
}
__device__ __forceinline__ void phase_x0(Frame& F, const Args& a) {
    relaunder(F);
    const int gw = F.bid * NWAVES + F.wave, NGW = F.G * NWAVES;
    bf16* xb = (bf16*)(F.ws + WS_XB); float* ssp = (float*)(F.ws + WS_SSP);
    for (int m = gw; m < MTOK; m += NGW) {
        const f32x4* xr = (const f32x4*)(inp(F, I_X) + (size_t)m * DM) + F.lane;
        v2u* o8 = (v2u*)(xb + (size_t)m * DM) + F.lane; float s = 0.f;
#pragma unroll
        for (int j = 0; j < 4; ++j) { const f32x4 v = xr[64 * j]; v2u w; w.x = pk2(v[0], v[1]); w.y = pk2(v[2], v[3]); o8[64 * j] = w; const float a0 = bflo(w.x), a1 = bfhi(w.x), a2 = bflo(w.y), a3 = bfhi(w.y); s += (a0 * a0 + a1 * a1) + (a2 * a2 + a3 * a3); }
        s = wave_sum(s);
        if (F.lane < 16) ssp[(size_t)m * 16 + F.lane] = F.lane == 0 ? s : 0.f;
    }
}
__device__ __forceinline__ void phase_final(Frame& F, const Args& a) {
    relaunder(F);
    const int gw = F.bid * NWAVES + F.wave, NGW = F.G * NWAVES; const f32x4* gnp = (const f32x4*)inp(F, I_FIN) + F.lane;
    const f32x4 gn[4] = {gnp[0], gnp[64], gnp[128], gnp[192]};
    const bf16* xb = (const bf16*)(F.ws + WS_XB);
    for (int m = gw; m < MTOK; m += NGW) {
        const v2u* xr = (const v2u*)(xb + (size_t)m * DM) + F.lane; f32x4* orow = (f32x4*)(a.out + (size_t)m * DM) + F.lane; f32x4 v[4]; float s = 0.f;
#pragma unroll
        for (int j = 0; j < 4; ++j) { const v2u w = xr[64 * j]; v[j] = (f32x4){bflo(w.x), bfhi(w.x), bflo(w.y), bfhi(w.y)}; s += (v[j][0] * v[j][0] + v[j][1] * v[j][1]) + (v[j][2] * v[j][2] + v[j][3] * v[j][3]); }
        const float r = __builtin_amdgcn_rsqf(wave_sum(s) * (1.0f / DM) + EPSN);
#pragma unroll
        for (int j = 0; j < 4; ++j) orow[64 * j] = v[j] * r * gn[j];
    }
}
__device__ __forceinline__ void phase_cmp2(Frame& F, const Args& a, int l) {
    relaunder(F);
    const int gw = F.bid * NWAVES + F.wave, NGW = F.G * NWAVES;
    const bf16* hid = (const bf16*)(F.ws + WS_HID); float* out = (float*)(F.ws + WS_KVCMP);
    for (int row = gw; row < 4096; row += NGW) {
        const int kv = row >> 11; const float* w2 = inp(F, kv ? I_CVW2 : I_CKW2) + (size_t)l * 256 * 64;
        const bf16* hr = hid + (size_t)row * 256; float s = 0.f;
        v4u hw[2][8]; float w[2][64];
#define CMP2_LD(bf_, kb_) do { _Pragma("unroll") for (int j = 0; j < 8; ++j) hw[bf_][j] = *(const v4u*)(hr + (kb_) + 8 * j); \
            _Pragma("unroll") for (int j = 0; j < 64; ++j) w[bf_][j] = w2[((kb_) + j) * 64 + F.lane]; } while (0)
#define CMP2_FMA(bf_) do { _Pragma("unroll") for (int j = 0; j < 8; ++j) \
            s += bflo(hw[bf_][j].x) * w[bf_][8 * j + 0] + bfhi(hw[bf_][j].x) * w[bf_][8 * j + 1] + bflo(hw[bf_][j].y) * w[bf_][8 * j + 2] + bfhi(hw[bf_][j].y) * w[bf_][8 * j + 3] \
               + bflo(hw[bf_][j].z) * w[bf_][8 * j + 4] + bfhi(hw[bf_][j].z) * w[bf_][8 * j + 5] + bflo(hw[bf_][j].w) * w[bf_][8 * j + 6] + bfhi(hw[bf_][j].w) * w[bf_][8 * j + 7]; } while (0)
        CMP2_LD(0, 0);
        CMP2_LD(1, 64);  __builtin_amdgcn_sched_barrier(0); CMP2_FMA(0); __builtin_amdgcn_sched_barrier(0);
        CMP2_LD(0, 128); __builtin_amdgcn_sched_barrier(0); CMP2_FMA(1); __builtin_amdgcn_sched_barrier(0);
        CMP2_LD(1, 192); __builtin_amdgcn_sched_barrier(0); CMP2_FMA(0); __builtin_amdgcn_sched_barrier(0);
        CMP2_FMA(1);
#undef CMP2_LD
#undef CMP2_FMA
        out[(size_t)row * 64 + F.lane] = s; ((bf16*)(F.ws + WS_KVCMPB))[(size_t)row * 64 + F.lane] = (bf16)f2bf(s);
    }
}

__device__ __forceinline__ void dot4_bf16(const bf16* kp, const LAS float* qs, float (&s)[4]) {
    s[0] = s[1] = s[2] = s[3] = 0.f;
#pragma unroll 2
    for (int c = 0; c < 8; ++c) { const v4u kw = *(const v4u*)(kp + c * 8);
        const float kf[8] = {bflo(kw.x), bfhi(kw.x), bflo(kw.y), bfhi(kw.y), bflo(kw.z), bfhi(kw.z), bflo(kw.w), bfhi(kw.w)};
#pragma unroll
        for (int h = 0; h < 4; ++h) { const f32x4 q0 = *(const LAS f32x4*)(qs + h * 64 + c * 8), q1 = *(const LAS f32x4*)(qs + h * 64 + c * 8 + 4);
            s[h] += (kf[0] * q0[0] + kf[1] * q0[1]) + (kf[2] * q0[2] + kf[3] * q0[3]) + (kf[4] * q1[0] + kf[5] * q1[1]) + (kf[6] * q1[2] + kf[7] * q1[3]); } }
}
__device__ __forceinline__ void dot4_f32(const float* kp, const LAS float* qs, float (&s)[4]) {
    s[0] = s[1] = s[2] = s[3] = 0.f;
#pragma unroll 4
    for (int c = 0; c < 16; ++c) { const f32x4 kf = *(const f32x4*)(kp + c * 4);
#pragma unroll
        for (int h = 0; h < 4; ++h) { const f32x4 q0 = *(const LAS f32x4*)(qs + h * 64 + c * 4); s[h] += (kf[0] * q0[0] + kf[1] * q0[1]) + (kf[2] * q0[2] + kf[3] * q0[3]); } }
}
__device__ __forceinline__ void online_block(const float (&s)[4], bool kvalid, const bf16* vp, int vld, LAS float* ps, int lane, float (&m)[4], float (&lsum)[4], float (&o)[4]) {
    float p[4];
#pragma unroll
    for (int h = 0; h < 4; ++h) {
        const float sm = wave_max(kvalid ? s[h] : -INFINITY), mn = fmaxf(m[h], sm);
        const float sc = (m[h] == -INFINITY) ? 0.f : __expf(m[h] - mn);
        p[h] = (kvalid && mn > -INFINITY) ? __expf(s[h] - mn) : 0.f;
        lsum[h] = lsum[h] * sc + wave_sum(p[h]); o[h] *= sc; m[h] = mn;
    }
    *(LAS f32x4*)(ps + lane * 4) = (f32x4){p[0], p[1], p[2], p[3]};
    LDS_WAIT();
#pragma unroll 8
    for (int k = 0; k < 64; ++k) { const f32x4 pv = *(const LAS f32x4*)(ps + k * 4); const float v = bf2f(vp[(size_t)k * vld + lane]);
        o[0] += pv[0] * v; o[1] += pv[1] * v; o[2] += pv[2] * v; o[3] += pv[3] * v; }
    LDS_WAIT();
}
__device__ __forceinline__ void phase_nsa_naive(Frame& F) {
    relaunder(F);
    LAS float* wl = (LAS float*)(F.lds + RING_OFF + F.wave * 16384);
    LAS float* qs = wl; LAS float* ps = wl + 256; LAS float* psum = wl + 512; LAS float* scl = wl + 1024;
    const bf16* qa = (const bf16*)(F.ws + WS_QA); const bf16* kvs = (const bf16*)(F.ws + WS_KVS); const float* ga = (const float*)(F.ws + WS_GA);
    const float* kvcmp = (const float*)(F.ws + WS_KVCMP); const float* lut = (const float*)(F.ws + WS_LUT); bf16* oa = (bf16*)(F.ws + WS_OA);
    const int lane = F.lane;
    for (int wt = F.bid; wt < 4096; wt += F.G) {
        const int bg = wt & 7, tb = wt >> 3, b = bg >> 1, g = bg & 1, t = tb * 8 + F.wave, row = b * SEQ + t, jcur = t >> 6;
        const float* lutg = lut + (size_t)(g * 4) * 4096;
#pragma unroll
        for (int h = 0; h < 4; ++h) qs[h * 64 + lane] = bf2f(qa[(size_t)row * 512 + (g * 4 + h) * 64 + lane]);
        LDS_WAIT();
        float gate[4][3];
#pragma unroll
        for (int h = 0; h < 4; ++h)
#pragma unroll
            for (int br = 0; br < 3; ++br) gate[h][br] = ga[(size_t)row * 24 + (g * 4 + h) * 3 + br];
        float oacc[4] = {0.f, 0.f, 0.f, 0.f};
        const int ncv = t >= 31 ? ((t - 31) >> 4) + 1 : 0;
        float imp = 0.f;
        if (ncv > 0) {
            const float* kc = kvcmp + (size_t)(0 * 8 + bg) * 256 * 64; const float* vc = kvcmp + (size_t)(1 * 8 + bg) * 256 * 64;
            float mx[4] = {-INFINITY, -INFINITY, -INFINITY, -INFINITY};
            const int nblk = (ncv + 63) >> 6;
#pragma unroll 1
            for (int blk = 0; blk < nblk; ++blk) {
                const int c = blk * 64 + lane; const bool valid = c < ncv;
                float s[4]; dot4_f32(kc + (size_t)(c < 255 ? c : 255) * 64, qs, s);
                const int dist = valid ? t - (16 * c + 31) : 0;
#pragma unroll
                for (int h = 0; h < 4; ++h) { const float v = valid ? s[h] + lutg[h * 4096 + dist] : -INFINITY; scl[h * 256 + c] = v; mx[h] = fmaxf(mx[h], v); }
            }
            float ls[4] = {0.f, 0.f, 0.f, 0.f};
#pragma unroll
            for (int h = 0; h < 4; ++h) mx[h] = wave_max(mx[h]);
            LDS_WAIT();
#pragma unroll 1
            for (int blk = 0; blk < nblk; ++blk) {
                const int c = blk * 64 + lane;
#pragma unroll
                for (int h = 0; h < 4; ++h) { const float v = scl[h * 256 + c]; const float p = v > -INFINITY ? __expf(v - mx[h]) : 0.f; scl[h * 256 + c] = p; ls[h] += p; }
            }
#pragma unroll
            for (int h = 0; h < 4; ++h) ls[h] = 1.0f / wave_sum(ls[h]);
            LDS_WAIT();
            float oc[4] = {0.f, 0.f, 0.f, 0.f};
#pragma unroll 1
            for (int blk = 0; blk < 4; ++blk) {
                const int c = blk * 64 + lane; float pt = 0.f;
                if (blk < nblk) {
#pragma unroll
                    for (int h = 0; h < 4; ++h) { const float p = scl[h * 256 + c] * ls[h]; scl[h * 256 + c] = p; pt += p; }
                }
                psum[c] = pt;
            }
            LDS_WAIT();
#pragma unroll 2
            for (int k = 0; k < ncv; ++k) { const float v = vc[(size_t)k * 64 + lane];
                oc[0] += scl[k] * v; oc[1] += scl[256 + k] * v; oc[2] += scl[512 + k] * v; oc[3] += scl[768 + k] * v; }
#pragma unroll
            for (int i = -1; i <= 3; ++i) { const int c = 4 * lane + i; if (c >= 0 && c < 255) imp += psum[c]; }
#pragma unroll
            for (int h = 0; h < 4; ++h) oacc[h] += gate[h][0] * oc[h];
            LDS_WAIT();
        }
        const bool forced = (lane == 0) || (lane == jcur) || (lane == jcur - 1);
        const float score = forced ? 1e6f : (lane <= jcur ? imp : -1e6f);
        int rank = 0;
#pragma unroll 4
        for (int s2 = 0; s2 < 64; ++s2) { const float v2 = __shfl(score, s2); rank += (v2 > score || (v2 == score && s2 < lane)) ? 1 : 0; }
        unsigned long long selmask = __ballot(rank < 16);
        selmask &= (jcur == 63) ? ~0ull : ((1ull << (jcur + 1)) - 1ull);
        {
            float m[4] = {-INFINITY, -INFINITY, -INFINITY, -INFINITY}, lsum[4] = {0.f, 0.f, 0.f, 0.f}, o[4] = {0.f, 0.f, 0.f, 0.f};
#pragma unroll 1
            while (selmask) {
                const int j = __builtin_ctzll(selmask); selmask &= selmask - 1ull;
                const int pos = j * 64 + lane; const bool kvalid = pos <= t;
                float s[4]; dot4_bf16(kvs + (size_t)(b * SEQ + pos) * 512 + 0 * 128 + g * 64, qs, s);
                if (kvalid) {
#pragma unroll
                    for (int h = 0; h < 4; ++h) s[h] += lutg[h * 4096 + (t - pos)];
                }
                online_block(s, kvalid, kvs + (size_t)(b * SEQ + j * 64) * 512 + 1 * 128 + g * 64, 512, ps, lane, m, lsum, o);
            }
#pragma unroll
            for (int h = 0; h < 4; ++h) oacc[h] += gate[h][1] * o[h] / lsum[h];
        }
        {
            float m[4] = {-INFINITY, -INFINITY, -INFINITY, -INFINITY}, lsum[4] = {0.f, 0.f, 0.f, 0.f}, o[4] = {0.f, 0.f, 0.f, 0.f};
            const int lo = t - 511 > 0 ? t - 511 : 0;
#pragma unroll 1
            for (int j = lo >> 6; j <= jcur; ++j) {
                const int pos = j * 64 + lane; const bool kvalid = pos <= t && pos >= lo;
                float s[4]; dot4_bf16(kvs + (size_t)(b * SEQ + pos) * 512 + 2 * 128 + g * 64, qs, s);
                if (kvalid) {
#pragma unroll
                    for (int h = 0; h < 4; ++h) s[h] += lutg[h * 4096 + (t - pos)];
                }
                online_block(s, kvalid, kvs + (size_t)(b * SEQ + j * 64) * 512 + 3 * 128 + g * 64, 512, ps, lane, m, lsum, o);
            }
#pragma unroll
            for (int h = 0; h < 4; ++h) oacc[h] += gate[h][2] * o[h] / lsum[h];
        }
#pragma unroll
        for (int h = 0; h < 4; ++h) oa[(size_t)row * 512 + (g * 4 + h) * 64 + lane] = (bf16)f2bf(oacc[h]);
        LDS_WAIT();
    }
}


typedef float f32x16 __attribute__((ext_vector_type(16)));
typedef short v4i16_t __attribute__((ext_vector_type(4)));
constexpr int NSA_TS = 144;
constexpr int NSA_VS = 192;
constexpr int NL_K = 0, NL_V = 9216, NL_K1 = 9216 + 64 * 192, NL_V1 = NL_K1 + 9216, NL_LUT = NL_V1 + 64 * 192, NL_IMP = NL_LUT + 16384, NL_SEL = NL_IMP + 4 * 64 * 65 * 4, NL_ZERO = NL_SEL + 512, NL_INVL = NL_ZERO + 256, NL_END = NL_INVL + 1024;
static_assert(NL_END <= RING_BYTES, "nsa lds");
#define KLOC(i) (((i) & 3) + 8 * ((i) >> 2) + 4 * hf)

__device__ __forceinline__ void nsa_qk(const LAS unsigned char* Kt, const bf16x8 (&qf)[4], int r32, int hf, f32x16& p0, f32x16& p1) {
#pragma unroll
    for (int i = 0; i < 16; ++i) { p0[i] = 0.f; p1[i] = 0.f; }
    bf16x8 a0[4], a1[4];
#pragma unroll
    for (int ks = 0; ks < 4; ++ks) { a0[ks] = *(const LAS bf16x8*)(Kt + r32 * NSA_TS + ks * 32 + hf * 16); a1[ks] = *(const LAS bf16x8*)(Kt + (32 + r32) * NSA_TS + ks * 32 + hf * 16); }
    __builtin_amdgcn_sched_barrier(0);
#pragma unroll
    for (int ks = 0; ks < 4; ++ks) {
        p0 = __builtin_amdgcn_mfma_f32_32x32x16_bf16(a0[ks], qf[ks], p0, 0, 0, 0);
        p1 = __builtin_amdgcn_mfma_f32_32x32x16_bf16(a1[ks], qf[ks], p1, 0, 0, 0);
    }
}
__device__ __forceinline__ bf16x8 nsa_pack(const f32x16& p, const int s) {
    v4u w; w.x = pk2(p[8 * s + 0], p[8 * s + 1]); w.y = pk2(p[8 * s + 2], p[8 * s + 3]); w.z = pk2(p[8 * s + 4], p[8 * s + 5]); w.w = pk2(p[8 * s + 6], p[8 * s + 7]);
    return __builtin_bit_cast(bf16x8, w);
}
__device__ __forceinline__ void nsa_pv(const LAS unsigned char* Vt, const f32x16& p0, const f32x16& p1, int lane, int hf, f32x16 (&o)[2]) {
    __builtin_amdgcn_sched_barrier(0);
    bf16x8 pb[4]; pb[0] = nsa_pack(p0, 0); pb[1] = nsa_pack(p0, 1); pb[2] = nsa_pack(p1, 0); pb[3] = nsa_pack(p1, 1);
    const LAS unsigned char* base = Vt + (4 * hf + ((lane & 15) >> 2)) * NSA_VS + (16 * ((lane >> 4) & 1) + 4 * (lane & 3)) * 2;
    v4i16_t lo[2][4], hi[2][4];
#pragma unroll
    for (int dt = 0; dt < 2; ++dt)
#pragma unroll
        for (int ks = 0; ks < 4; ++ks) {
            const LAS unsigned char* ap = base + (16 * ks) * NSA_VS + dt * 64;
            lo[dt][ks] = __builtin_amdgcn_ds_read_tr16_b64_v4i16((LAS v4i16_t*)ap);
            hi[dt][ks] = __builtin_amdgcn_ds_read_tr16_b64_v4i16((LAS v4i16_t*)(ap + 8 * NSA_VS));
        }
    __builtin_amdgcn_sched_barrier(0);
#pragma unroll
    for (int ks = 0; ks < 4; ++ks)
#pragma unroll
        for (int dt = 0; dt < 2; ++dt) {
            const bf16x8 a = {lo[dt][ks][0], lo[dt][ks][1], lo[dt][ks][2], lo[dt][ks][3], hi[dt][ks][0], hi[dt][ks][1], hi[dt][ks][2], hi[dt][ks][3]};
            o[dt] = __builtin_amdgcn_mfma_f32_32x32x16_bf16(a, pb[ks], o[dt], 0, 0, 0);
        }
}
__device__ __forceinline__ void nsa_online(f32x16& p0, f32x16& p1, float& m, float& l, f32x16 (&o)[2]) {
    float bm = -INFINITY;
#pragma unroll
    for (int i = 0; i < 16; ++i) bm = fmaxf(bm, fmaxf(p0[i], p1[i]));
    bm = fmaxf(bm, __shfl_xor(bm, 32));
    const float mn = fmaxf(m, bm), mref = (mn == -INFINITY) ? 0.f : mn, sc = __expf(m - mref);
    float ps = 0.f;
#pragma unroll
    for (int i = 0; i < 16; ++i) { p0[i] = __expf(p0[i] - mref); p1[i] = __expf(p1[i] - mref); ps += p0[i] + p1[i]; }
    l = l * sc + ps; m = mn;
#pragma unroll
    for (int i = 0; i < 16; ++i) { o[0][i] *= sc; o[1][i] *= sc; }
}
__device__ __forceinline__ void nsa_qk_init(const LAS unsigned char* Kt, const bf16x8 (&qf)[4], int r32, int hf, float init, f32x16& p0, f32x16& p1) {
#pragma unroll
    for (int i = 0; i < 16; ++i) { p0[i] = init; p1[i] = init; }
    bf16x8 a0[4], a1[4];
#pragma unroll
    for (int ks = 0; ks < 4; ++ks) { a0[ks] = *(const LAS bf16x8*)(Kt + r32 * NSA_TS + ks * 32 + hf * 16); a1[ks] = *(const LAS bf16x8*)(Kt + (32 + r32) * NSA_TS + ks * 32 + hf * 16); }
    __builtin_amdgcn_sched_barrier(0);
#pragma unroll
    for (int ks = 0; ks < 4; ++ks) {
        p0 = __builtin_amdgcn_mfma_f32_32x32x16_bf16(a0[ks], qf[ks], p0, 0, 0, 0);
        p1 = __builtin_amdgcn_mfma_f32_32x32x16_bf16(a1[ks], qf[ks], p1, 0, 0, 0);
    }
}
constexpr float NSA_THR = 8.0f;
constexpr int NSA_GATE_OFF = RS_OFF + 1024;
static_assert(NSA_GATE_OFF + 4096 <= LDS_BYTES, "gate slots");
__device__ __forceinline__ void nsa_step(f32x16& p0, f32x16& p1, float& mr, bool& has, float& l, f32x16 (&o)[2]) {
    __builtin_amdgcn_sched_barrier(0);
    float bm = fmaxf(fmaxf(p0[0], p1[0]), fmaxf(p0[1], p1[1]));
#pragma unroll
    for (int i = 2; i < 16; i += 2) bm = fmaxf(bm, fmaxf(fmaxf(p0[i], p1[i]), fmaxf(p0[i + 1], p1[i + 1])));
    bm = fmaxf(bm, __shfl_xor(bm, 32));
    const bool valid = bm > -INFINITY, need = valid && (bm > NSA_THR || !has);
    if (__any(need)) {
        const float delta = need ? bm : 0.f, sc = (need && has) ? __builtin_amdgcn_exp2f(-delta) : 1.0f;
        mr += delta;
#pragma unroll
        for (int i = 0; i < 16; ++i) { p0[i] -= delta; p1[i] -= delta; o[0][i] *= sc; o[1][i] *= sc; }
        l *= sc;
    }
    has = has || valid;
    float ps = 0.f;
#pragma unroll
    for (int i = 0; i < 16; ++i) { p0[i] = __builtin_amdgcn_exp2f(p0[i]); p1[i] = __builtin_amdgcn_exp2f(p1[i]); ps += p0[i] + p1[i]; }
    l += ps;
}
template <bool MASKED> __device__ __forceinline__ void nsa_bias(f32x16& p0, f32x16& p1, const LAS float* lutH, int dbase, int hf, unsigned dhi) {
    int db = dbase - 4 * hf;
    __builtin_amdgcn_sched_barrier(0);
    asm volatile("" : "+v"(db));
    { float b0[16];
#pragma unroll
      for (int i = 0; i < 16; ++i) { const int d0 = db - ((i & 3) + 8 * (i >> 2)); b0[i] = lutH[MASKED ? min(max(d0, 0), 1023) : d0]; }
#pragma unroll
      for (int i = 0; i < 16; ++i) { const int d0 = db - ((i & 3) + 8 * (i >> 2)); p0[i] = (!MASKED || (unsigned)d0 < dhi) ? p0[i] + b0[i] : -INFINITY; } }
    __builtin_amdgcn_sched_barrier(0);
    { float b1[16];
#pragma unroll
      for (int i = 0; i < 16; ++i) { const int d1 = db - 32 - ((i & 3) + 8 * (i >> 2)); b1[i] = lutH[MASKED ? min(max(d1, 0), 1023) : d1]; }
#pragma unroll
      for (int i = 0; i < 16; ++i) { const int d1 = db - 32 - ((i & 3) + 8 * (i >> 2)); p1[i] = (!MASKED || (unsigned)d1 < dhi) ? p1[i] + b1[i] : -INFINITY; } }
    __builtin_amdgcn_sched_barrier(0);
}
__device__ __forceinline__ v4u nsa_ld16(const bf16* p) { return *(const v4u*)p; }
#define LDS_BARRIER() asm volatile("s_waitcnt lgkmcnt(0)\n\ts_barrier" ::: "memory")

#define NS_SBAR() __builtin_amdgcn_sched_barrier(0)
#define NS_PIN(x) asm volatile("" : "+v"(x))
#define NS_MFMA(a, b, c) __builtin_amdgcn_mfma_f32_32x32x16_bf16(a, b, c, 0, 0, 0)
#define NS_MX3(a, b, c) __builtin_fmaxf(__builtin_fmaxf((a), (b)), (c))
__device__ __forceinline__ float nsa_rowmax(const f32x16& p0, const f32x16& p1) {
    float a = NS_MX3(p0[0], p0[1], p1[0]), b = NS_MX3(p0[2], p0[3], p1[1]); a = NS_MX3(a, p1[2], p1[3]);
#pragma unroll
    for (int r = 4; r < 16; r += 4) { a = NS_MX3(a, p0[r], p0[r + 1]); b = NS_MX3(b, p0[r + 2], p0[r + 3]); a = NS_MX3(a, p1[r], p1[r + 1]); b = NS_MX3(b, p1[r + 2], p1[r + 3]); }
    const float m = __builtin_fmaxf(a, b); auto rr = __builtin_amdgcn_permlane32_swap(__float_as_uint(m), __float_as_uint(m), false, false);
    return __builtin_fmaxf(__uint_as_float(rr[0]), __uint_as_float(rr[1]));
}
template <bool SLC>
__device__ __forceinline__ void nsa_stream(LAS unsigned char* L, const bf16* kvs, const LAS float* lutH, const bf16x8 (&qf)[4], int b, int g, int cq, int tq, int lane, int r32, int hf,
                                           int srow, int schunk, unsigned long long U, const LAS unsigned* selq, float& l_out, f32x16 (&o)[2]) {
    constexpr int KC = SLC ? 0 : 2, VC = SLC ? 1 : 3;
    const int soff = srow * NSA_TS + schunk * 16, svoff = srow * NSA_VS + schunk * 16;
    LAS unsigned char* const K0 = L + NL_K; LAS unsigned char* const K1 = L + NL_K1; LAS unsigned char* const V0 = L + NL_V; LAS unsigned char* const V1 = L + NL_V1;
    const int kfo = r32 * NSA_TS + hf * 16;
    const int vfo = (4 * hf + ((lane & 15) >> 2)) * NSA_VS + (16 * ((lane >> 4) & 1) + 4 * (lane & 3)) * 2;
    const float bias_far = lutH[1023];
    const int jlo = cq - 8 > 0 ? cq - 8 : 0;
    const int n = SLC ? __builtin_popcountll(U) : cq - jlo + 1;
    unsigned long long rem = U; int nj = cq, jlast = 0;
#define NS_NEXT(dst) do { if (SLC) { if (rem != 0ull) { jlast = __builtin_ctzll(rem); rem &= rem - 1ull; } } else { if (nj >= jlo) { jlast = nj; --nj; } } dst = jlast; } while (0)
#define NS_LD(j_, kv_) nsa_ld16(kvs + ((size_t)b * SEQ + (j_) * 64 + srow) * 512 + (kv_) * 128 + g * 64 + schunk * 8)
#define NS_KRD(KS, d0) do { kf[2 * (d0)] = *(const LAS bf16x8*)((KS) + kfo + (d0) * 32); kf[2 * (d0) + 1] = *(const LAS bf16x8*)((KS) + kfo + 32 * NSA_TS + (d0) * 32); } while (0)
#define NS_VRD(VS, i) do { const LAS unsigned char* ap_ = (VS) + vfo + (16 * ((i) >> 1)) * NSA_VS + ((i) & 1) * 64; \
        vlo[i] = __builtin_amdgcn_ds_read_tr16_b64_v4i16((LAS v4i16_t*)ap_); vhi[i] = __builtin_amdgcn_ds_read_tr16_b64_v4i16((LAS v4i16_t*)(ap_ + 8 * NSA_VS)); } while (0)
#define NS_VFR(i) (bf16x8){vlo[i][0], vlo[i][1], vlo[i][2], vlo[i][3], vhi[i][0], vhi[i][1], vhi[i][2], vhi[i][3]}
#define NS_PB(k) __builtin_bit_cast(bf16x8, pw##k)
#define NS_PK(P, i) pk2(P[i], P[i + 1])
#define NS_EX(v) __builtin_amdgcn_exp2f((v) + nmh)
#define NS_INITV(j_) (SLC ? ((((selq[(j_) >> 5] >> ((j_) & 31)) & 1u) != 0u) ? ((cq - (j_) >= 14) ? bias_far : 0.f) : -INFINITY) : 0.f)
#define NS_NEAR(j_) (SLC ? (cq - (j_) < 14) : true)
#define NS_MASKED(j_) (SLC ? ((j_) == cq) : ((j_) == cq || (j_) == cq - 8))
#define NS_DHI(j_) ((j_) == cq ? 0x7fffffffu : 512u)
#define NS_BP(j_) (NS_NEAR(j_) ? lutH + (tq - (j_) * 64 - 4 * hf - 63) : (const LAS float*)(L + NL_ZERO))
#define NS_BL(P, r, h_) P[r] = bpn[63 - ((h_) * 32 + ((r) & 3) + 8 * ((r) >> 2))]
#define NS_BLD4(P0, P1, g) do { { if ((g) < 4) { NS_BL(P0, 4 * (g), 0); NS_BL(P0, 4 * (g) + 1, 0); NS_BL(P0, 4 * (g) + 2, 0); NS_BL(P0, 4 * (g) + 3, 0); } \
        else { NS_BL(P1, 4 * ((g) - 4), 1); NS_BL(P1, 4 * ((g) - 4) + 1, 1); NS_BL(P1, 4 * ((g) - 4) + 2, 1); NS_BL(P1, 4 * ((g) - 4) + 3, 1); } } } while (0)
#define NS_MASK(C0, C1, j_) do { const int dbc_ = tq - (j_) * 64 - 4 * hf; const unsigned dhi_ = NS_DHI(j_); \
        _Pragma("unroll") for (int r = 0; r < 16; ++r) { const int d0_ = dbc_ - ((r & 3) + 8 * (r >> 2)); C0[r] = ((unsigned)d0_ < dhi_) ? C0[r] : -INFINITY; C1[r] = ((unsigned)(d0_ - 32) < dhi_) ? C1[r] : -INFINITY; } } while (0)
#define NS_GAPA(MF, a0, a1, a2, a3, W0, W1, PW) do { MF; sacc += a0; sacc += a1; sacc += a2; sacc += a3; W0; W1; NS_PIN(PW); NS_PIN(sacc); NS_SBAR(); } while (0)
#define NS_GAPB(MF, X, i) do { MF; X[i] = NS_EX(X[i]); X[i + 1] = NS_EX(X[i + 1]); X[i + 2] = NS_EX(X[i + 2]); X[i + 3] = NS_EX(X[i + 3]); NS_PIN(X); NS_SBAR(); } while (0)
    const f32x16 z16 = {0.f, 0.f, 0.f, 0.f, 0.f, 0.f, 0.f, 0.f, 0.f, 0.f, 0.f, 0.f, 0.f, 0.f, 0.f, 0.f};
    f32x16 pA0, pA1, pB0, pB1; bf16x8 kf[8]; v4i16_t vlo[8], vhi[8]; v4u pw0, pw1, pw2, pw3;
    float mhat = 0.f, l = 0.f, fsc = 1.f; bool resc = false;
    int ja, jb, jc, jd; NS_NEXT(ja); NS_NEXT(jb); NS_NEXT(jc); NS_NEXT(jd);
    v4u kreg, vreg;
    {
        const v4u k0 = NS_LD(ja, KC), k1 = NS_LD(jb, KC); kreg = NS_LD(jc, KC); vreg = NS_LD(ja, VC);
        LDS_BARRIER();
        *(LAS v4u*)(K0 + soff) = k0; *(LAS v4u*)(K1 + soff) = k1;
    }
    LDS_BARRIER();
#pragma unroll
    for (int d0 = 0; d0 < 4; ++d0) NS_KRD(K0, d0);
    LDS_BARRIER();
    {
        const LAS float* bpn = NS_BP(ja);
        NS_BLD4(pA0, pA1, 0); NS_BLD4(pA0, pA1, 1); NS_BLD4(pA0, pA1, 2); NS_BLD4(pA0, pA1, 3); NS_BLD4(pA0, pA1, 4); NS_BLD4(pA0, pA1, 5); NS_BLD4(pA0, pA1, 6); NS_BLD4(pA0, pA1, 7);
        if (NS_MASKED(ja)) NS_MASK(pA0, pA1, ja);
        pA0 = NS_MFMA(kf[0], qf[0], pA0); pA1 = NS_MFMA(kf[1], qf[0], pA1);
    }
    pA0 = NS_MFMA(kf[2], qf[1], pA0); pA1 = NS_MFMA(kf[3], qf[1], pA1);
    pA0 = NS_MFMA(kf[4], qf[2], pA0); pA1 = NS_MFMA(kf[5], qf[2], pA1); pA0 = NS_MFMA(kf[6], qf[3], pA0); pA1 = NS_MFMA(kf[7], qf[3], pA1);
    *(LAS v4u*)(K0 + soff) = kreg; *(LAS v4u*)(V0 + svoff) = vreg;
    kreg = NS_LD(jd, KC); vreg = NS_LD(jb, VC);
    { const float iv = NS_INITV(ja); mhat = nsa_rowmax(pA0, pA1) + iv; const float nmh = iv - mhat;
#pragma unroll
      for (int r = 0; r < 16; ++r) { pA0[r] = NS_EX(pA0[r]); pA1[r] = NS_EX(pA1[r]); } }
#pragma unroll
    for (int d0 = 0; d0 < 4; ++d0) NS_KRD(K1, d0);
    { const LAS float* bpn = NS_BP(jb);
      NS_BLD4(pB0, pB1, 0); NS_BLD4(pB0, pB1, 1); NS_BLD4(pB0, pB1, 2); NS_BLD4(pB0, pB1, 3); NS_BLD4(pB0, pB1, 4); NS_BLD4(pB0, pB1, 5); NS_BLD4(pB0, pB1, 6); NS_BLD4(pB0, pB1, 7); }
    LDS_BARRIER();
    ja = jb; jb = jc; jc = jd; NS_NEXT(jd);
#define NS_STEP(C0, C1, P0, P1, KW, VW, VR, KR) do { NS_SBAR(); \
    if (NS_NEAR(ja) && NS_MASKED(ja)) { NS_MASK(C0, C1, ja); NS_SBAR(); } \
    NS_VRD(VR, 0); NS_SBAR(); float sacc = P0[0] + P0[1]; \
                           NS_GAPA(C0 = NS_MFMA(kf[0], qf[0], C0), P0[2], P0[3], P0[4], P0[5],     pw0[0] = NS_PK(P0, 0),  pw0[1] = NS_PK(P0, 2),  pw0); \
    NS_VRD(VR, 1); NS_SBAR(); NS_GAPA(C1 = NS_MFMA(kf[1], qf[0], C1), P0[6], P0[7], P0[8], P0[9],     pw0[2] = NS_PK(P0, 4),  pw0[3] = NS_PK(P0, 6),  pw0); \
    NS_VRD(VR, 2); NS_SBAR(); NS_GAPA(C0 = NS_MFMA(kf[2], qf[1], C0),  P0[10], P0[11], P0[12], P0[13], pw1[0] = NS_PK(P0, 8),  pw1[1] = NS_PK(P0, 10), pw1); \
    NS_VRD(VR, 3); NS_SBAR(); NS_GAPA(C1 = NS_MFMA(kf[3], qf[1], C1),  P0[14], P0[15], P1[0], P1[1],   pw1[2] = NS_PK(P0, 12), pw1[3] = NS_PK(P0, 14), pw1); \
    NS_VRD(VR, 4); NS_SBAR(); NS_GAPA(C0 = NS_MFMA(kf[4], qf[2], C0),  P1[2], P1[3], P1[4], P1[5],     pw2[0] = NS_PK(P1, 0),  pw2[1] = NS_PK(P1, 2),  pw2); \
    NS_VRD(VR, 5); NS_SBAR(); NS_GAPA(C1 = NS_MFMA(kf[5], qf[2], C1),  P1[6], P1[7], P1[8], P1[9],     pw2[2] = NS_PK(P1, 4),  pw2[3] = NS_PK(P1, 6),  pw2); \
    NS_VRD(VR, 6); NS_SBAR(); NS_GAPA(C0 = NS_MFMA(kf[6], qf[3], C0),  P1[10], P1[11], P1[12], P1[13], pw3[0] = NS_PK(P1, 8),  pw3[1] = NS_PK(P1, 10), pw3); \
    NS_VRD(VR, 7); NS_SBAR(); NS_GAPA(C1 = NS_MFMA(kf[7], qf[3], C1),  P1[14], P1[15], 0.f, 0.f,       pw3[2] = NS_PK(P1, 12), pw3[3] = NS_PK(P1, 14), pw3); \
    l += sacc; \
    *(LAS v4u*)((KW) + soff) = kreg; *(LAS v4u*)((VW) + svoff) = vreg; \
    kreg = NS_LD(jd, KC); vreg = NS_LD(jb, VC); \
    const LAS float* bpn = NS_BP(jb); \
    const float iv_ = NS_INITV(ja); \
    { const float rm = (nsa_rowmax(C0, C1) + iv_) - mhat; resc = false; \
      if (__builtin_expect(__any(rm > NSA_THR), 0)) { const float dl = __builtin_fmaxf(rm, 0.f); mhat += dl; fsc = __builtin_amdgcn_exp2f(-dl); l *= fsc; resc = true; } } \
    const float nmh = iv_ - mhat; NS_SBAR(); \
    NS_BLD4(P0, P1, 0); NS_SBAR(); NS_GAPB(o[0] = NS_MFMA(NS_VFR(0), NS_PB(0), o[0]), C0, 0);  NS_BLD4(P0, P1, 1); NS_SBAR(); NS_GAPB(o[1] = NS_MFMA(NS_VFR(1), NS_PB(0), o[1]), C0, 4); \
    NS_KRD(KR, 0); NS_BLD4(P0, P1, 2); NS_SBAR(); NS_GAPB(o[0] = NS_MFMA(NS_VFR(2), NS_PB(1), o[0]), C0, 8);  NS_KRD(KR, 1); NS_BLD4(P0, P1, 3); NS_SBAR(); NS_GAPB(o[1] = NS_MFMA(NS_VFR(3), NS_PB(1), o[1]), C0, 12); \
    NS_KRD(KR, 2); NS_BLD4(P0, P1, 4); NS_SBAR(); NS_GAPB(o[0] = NS_MFMA(NS_VFR(4), NS_PB(2), o[0]), C1, 0);  NS_KRD(KR, 3); NS_BLD4(P0, P1, 5); NS_SBAR(); NS_GAPB(o[1] = NS_MFMA(NS_VFR(5), NS_PB(2), o[1]), C1, 4); \
    NS_BLD4(P0, P1, 6); NS_SBAR(); NS_GAPB(o[0] = NS_MFMA(NS_VFR(6), NS_PB(3), o[0]), C1, 8);  NS_BLD4(P0, P1, 7); NS_SBAR(); NS_GAPB(o[1] = NS_MFMA(NS_VFR(7), NS_PB(3), o[1]), C1, 12); \
    LDS_BARRIER(); \
    if (resc) { _Pragma("unroll") for (int r = 0; r < 16; ++r) { o[0][r] *= fsc; o[1][r] *= fsc; } }        \
    ja = jb; jb = jc; jc = jd; NS_NEXT(jd); \
    } while (0)
    int t = 1;
    for (; t + 1 < n; t += 2) {
        NS_STEP(pB0, pB1, pA0, pA1, K1, V1, V0, K0);
        NS_STEP(pA0, pA1, pB0, pB1, K0, V0, V1, K1);
    }
    if (t < n) NS_STEP(pB0, pB1, pA0, pA1, K1, V1, V0, K0);
#define NS_DRAIN(P0, P1, VR) do { float sacc = P0[0] + P0[1]; \
      _Pragma("unroll") for (int r = 2; r < 16; ++r) sacc += P0[r]; \
      _Pragma("unroll") for (int r = 0; r < 16; ++r) sacc += P1[r]; \
      l += sacc; \
      pw0 = (v4u){NS_PK(P0, 0), NS_PK(P0, 2), NS_PK(P0, 4), NS_PK(P0, 6)}; pw1 = (v4u){NS_PK(P0, 8), NS_PK(P0, 10), NS_PK(P0, 12), NS_PK(P0, 14)}; \
      pw2 = (v4u){NS_PK(P1, 0), NS_PK(P1, 2), NS_PK(P1, 4), NS_PK(P1, 6)}; pw3 = (v4u){NS_PK(P1, 8), NS_PK(P1, 10), NS_PK(P1, 12), NS_PK(P1, 14)}; \
      _Pragma("unroll") for (int i = 0; i < 8; ++i) NS_VRD(VR, i); \
      NS_SBAR(); \
      o[0] = NS_MFMA(NS_VFR(0), NS_PB(0), o[0]); o[1] = NS_MFMA(NS_VFR(1), NS_PB(0), o[1]); o[0] = NS_MFMA(NS_VFR(2), NS_PB(1), o[0]); o[1] = NS_MFMA(NS_VFR(3), NS_PB(1), o[1]); \
      o[0] = NS_MFMA(NS_VFR(4), NS_PB(2), o[0]); o[1] = NS_MFMA(NS_VFR(5), NS_PB(2), o[1]); o[0] = NS_MFMA(NS_VFR(6), NS_PB(3), o[0]); o[1] = NS_MFMA(NS_VFR(7), NS_PB(3), o[1]); } while (0)
    if (n & 1) NS_DRAIN(pA0, pA1, V0); else NS_DRAIN(pB0, pB1, V1);
    l_out = l;
    (void)kreg; (void)vreg;
#undef NS_NEXT
#undef NS_LD
#undef NS_KRD
#undef NS_VRD
#undef NS_VFR
#undef NS_PB
#undef NS_PK
#undef NS_EX
#undef NS_INITV
#undef NS_NEAR
#undef NS_MASKED
#undef NS_DHI
#undef NS_BP
#undef NS_BL
#undef NS_BLD4
#undef NS_MASK
#undef NS_GAPA
#undef NS_GAPB
#undef NS_STEP
#undef NS_DRAIN
}

__device__ __forceinline__ void phase_nsa(Frame& F) {
    relaunder(F);
    LAS unsigned char* L = F.lds + RING_OFF;
    LAS unsigned char* Kt = L + NL_K; LAS unsigned char* Vt = L + NL_V;
    LAS float* lutL = (LAS float*)(L + NL_LUT); LAS float* impL = (LAS float*)(L + NL_IMP); LAS unsigned long long* selL = (LAS unsigned long long*)(L + NL_SEL);
    const bf16* qa = (const bf16*)(F.ws + WS_QA); const bf16* kvs = (const bf16*)(F.ws + WS_KVS); const float* ga = (const float*)(F.ws + WS_GA);
    const bf16* kvcb = (const bf16*)(F.ws + WS_KVCMPB); const float* lut = (const float*)(F.ws + WS_LUT); bf16* oa = (bf16*)(F.ws + WS_OAB);
    const int wave = F.wave, hh = wave >> 1, qh = wave & 1;
    if (F.tid < 64) ((LAS float*)(L + NL_ZERO))[F.tid] = 0.f;
    for (int i = F.tid; i < 4 * 1024; i += 512) lutL[i] = lut[((F.bid & 1) * 4 + (i >> 10)) * 4096 + (i & 1023)] * 1.4426950408889634f;
    __syncthreads();
#pragma unroll 1
    for (int ui = 0; ui < 2; ++ui) {
        int tid = (F.wave0 << 6) | lane_id_here_(); asm volatile("" : "+v"(tid));
        const int lane = tid & 63, r32 = lane & 31, hf = lane >> 5;
        const int srow = tid >> 3, schunk = tid & 7;
        const int soff = srow * NSA_TS + schunk * 16, svoff = srow * NSA_VS + schunk * 16;
        const int w = F.bid, bg = w & 7, a_ = (w >> 3) & 31, cq = ui == 0 ? 63 - a_ : a_;
        if (w >= 256) break;
        const int b = bg >> 1, g = bg & 1, head = g * 4 + hh, tq = cq * 64 + qh * 32 + r32;
        const unsigned qrow = (unsigned)(b * SEQ + tq);
#define QROW_LATE() ({ int tq_ = tq; asm volatile("" : "+v"(tq_)); (unsigned)(b * SEQ + tq_); })
        const float g_cmp0 = ga[qrow * 24u + head * 3 + 0], g_slc0 = ga[qrow * 24u + head * 3 + 1], g_win0 = ga[qrow * 24u + head * 3 + 2];
        LAS float* const gpark = (LAS float*)(F.lds + NSA_GATE_OFF) + tid;
        const LAS float* lutH = lutL + hh * 1024;
        bf16x8 qf[4];
#pragma unroll
        for (int ks = 0; ks < 4; ++ks) qf[ks] = *(const bf16x8*)(qa + (size_t)qrow * 512 + head * 64 + ks * 16 + hf * 8);
        f32x16 oc[2];
#pragma unroll
        for (int i = 0; i < 16; ++i) { oc[0][i] = 0.f; oc[1][i] = 0.f; }
        for (int i = tid; i < 4 * 64 * 65; i += 512) impL[i] = 0.f;
        const bf16* kc = kvcb + (size_t)(0 * 8 + bg) * 256 * 64; const bf16* vc = kvcb + (size_t)(1 * 8 + bg) * 256 * 64;
        const int ncb = (4 * cq + 2) / 64 + 1;
        float l = 0.f;
        f32x16 p0, p1, o[2];
        {
            float mr = 0.f; bool has = false;
#pragma unroll
            for (int i = 0; i < 16; ++i) { o[0][i] = 0.f; o[1][i] = 0.f; }
            LAS float* impH = impL + hh * (64 * 65) + (qh * 32 + r32) * 65;
            v4u ckreg = nsa_ld16(kc + (size_t)srow * 64 + schunk * 8), cvreg = nsa_ld16(vc + (size_t)srow * 64 + schunk * 8);
            for (int cb = 0; cb < ncb; ++cb) {
                __syncthreads();
                *(LAS v4u*)(Kt + soff) = ckreg; *(LAS v4u*)(Vt + svoff) = cvreg;
                __syncthreads();
                if (cb + 1 < ncb) { ckreg = nsa_ld16(kc + (size_t)((cb + 1) * 64 + srow) * 64 + schunk * 8); cvreg = nsa_ld16(vc + (size_t)((cb + 1) * 64 + srow) * 64 + schunk * 8); }
                nsa_qk(Kt, qf, r32, hf, p0, p1);
                {
                    __builtin_amdgcn_sched_barrier(0);
                    { float b0[16];
#pragma unroll
                      for (int i = 0; i < 16; ++i) b0[i] = lutH[min(max(tq - 31 - 16 * (cb * 64 + KLOC(i)), 0), 1023)];
#pragma unroll
                      for (int i = 0; i < 16; ++i) p0[i] = (tq - 31 - 16 * (cb * 64 + KLOC(i))) >= 0 ? p0[i] + b0[i] : -INFINITY; }
                    __builtin_amdgcn_sched_barrier(0);
                    { float b1[16];
#pragma unroll
                      for (int i = 0; i < 16; ++i) b1[i] = lutH[min(max(tq - 543 - 16 * (cb * 64 + KLOC(i)), 0), 1023)];
#pragma unroll
                      for (int i = 0; i < 16; ++i) p1[i] = (tq - 543 - 16 * (cb * 64 + KLOC(i))) >= 0 ? p1[i] + b1[i] : -INFINITY; }
                    __builtin_amdgcn_sched_barrier(0);
                }
                float bm = -INFINITY;
#pragma unroll
                for (int i = 0; i < 16; ++i) bm = fmaxf(bm, fmaxf(p0[i], p1[i]));
                bm = fmaxf(bm, __shfl_xor(bm, 32));
                const bool valid = bm > -INFINITY, need = valid && (!has || bm - mr > NSA_THR);
                if (__any(need)) {
                    const float delta = need ? bm - mr : 0.f, sc = (need && has) ? __builtin_amdgcn_exp2f(-delta) : 1.0f;
                    mr += delta; l *= sc;
#pragma unroll
                    for (int i = 0; i < 16; ++i) { o[0][i] *= sc; o[1][i] *= sc; }
                    if (__any(need && has)) {
#pragma unroll 8
                        for (int k = 0; k < 32; ++k) impH[2 * k + hf] *= sc;
                        LDS_WAIT();
                    }
                }
                has = has || valid;
                float ps = 0.f;
#pragma unroll
                for (int i = 0; i < 16; ++i) { p0[i] = __builtin_amdgcn_exp2f(p0[i] - mr); p1[i] = __builtin_amdgcn_exp2f(p1[i] - mr); ps += p0[i] + p1[i]; }
                l += ps;
#pragma unroll
                for (int g4 = 0; g4 < 4; ++g4) {
                    const int u0 = cb * 16 + 2 * g4 + hf, u1 = u0 + 8;
                    impH[u0] += (p0[4 * g4] + p0[4 * g4 + 1]) + (p0[4 * g4 + 2] + p0[4 * g4 + 3]);
                    impH[u1] += (p1[4 * g4] + p1[4 * g4 + 1]) + (p1[4 * g4 + 2] + p1[4 * g4 + 3]);
                }
                LDS_WAIT();
#pragma unroll
                for (int g4 = 0; g4 < 4; ++g4) {
                    const int u0 = cb * 16 + 2 * g4 + hf + 1, u1 = u0 + 8;
                    if (u0 < 64) impH[u0] += p0[4 * g4 + 3];
                    if (u1 < 64) impH[u1] += p1[4 * g4 + 3];
                }
                nsa_pv(Vt, p0, p1, lane, hf, o);
            }
            const float lt = l + __shfl_xor(l, 32), invl = lt > 0.f ? 1.0f / lt : 0.f;
            gpark[0] = g_slc0; gpark[512] = g_win0;
            if (hf == 0) ((LAS float*)(L + NL_INVL))[hh * 64 + qh * 32 + r32] = invl;
#pragma unroll
            for (int i = 0; i < 16; ++i) { const float g_cmp = g_cmp0 * invl; oc[0][i] += g_cmp * o[0][i]; oc[1][i] += g_cmp * o[1][i]; }
        }
        __syncthreads();
        {
            const int q = tid >> 3, sub = tid & 7; unsigned v[8];
#pragma unroll
            for (int k = 0; k < 8; ++k) { const int s = sub * 8 + k; const int idx = q * 65 + s;
                const LAS float* ivl = (const LAS float*)(L + NL_INVL) + q;
                const float im = ((impL[idx] * ivl[0] + impL[64 * 65 + idx] * ivl[64]) + impL[2 * 64 * 65 + idx] * ivl[128]) + impL[3 * 64 * 65 + idx] * ivl[192];
                const float vf = (s == 0 || s == cq || s == cq - 1) ? 1e6f : (s <= cq ? im : -1e6f);
                const unsigned bits = __float_as_uint(vf), mono = bits ^ ((bits >> 31) ? 0xFFFFFFFFu : 0x80000000u);
                v[k] = (mono & ~63u) | (unsigned)(63 - s); }
            __syncthreads();
            LAS unsigned* keyL = (LAS unsigned*)impL;
#pragma unroll
            for (int k = 0; k < 8; ++k) keyL[q * 65 + sub * 8 + k] = v[k];
            __syncthreads();
            int cnt[8];
#pragma unroll
            for (int k = 0; k < 8; ++k) cnt[k] = 0;
#pragma unroll 1
            for (int s0 = 0; s0 < 64; s0 += 32) {
                unsigned xk[32];
#pragma unroll
                for (int j = 0; j < 32; ++j) xk[j] = keyL[q * 65 + s0 + j];
                __builtin_amdgcn_sched_barrier(0);
#pragma unroll
                for (int j = 0; j < 32; ++j)
#pragma unroll
                    for (int k = 0; k < 8; ++k) cnt[k] += (xk[j] > v[k]) ? 1 : 0;
            }
            unsigned byte = 0;
#pragma unroll
            for (int k = 0; k < 8; ++k) byte |= (cnt[k] < 16 ? 1u : 0u) << k;
            ((LAS unsigned char*)selL)[q * 8 + sub] = (unsigned char)byte;
        }
        __syncthreads();
        const unsigned long long vmask = (cq == 63) ? ~0ull : ((1ull << (cq + 1)) - 1ull);
        const unsigned long long mysel = selL[qh * 32 + r32] & vmask;
        unsigned long long U = selL[lane] & vmask;
#pragma unroll
        for (int off = 1; off < 64; off <<= 1) { const unsigned lo_ = __shfl_xor((unsigned)U, off), hi_ = __shfl_xor((unsigned)(U >> 32), off); U |= ((unsigned long long)hi_ << 32) | lo_; }
        U = ((unsigned long long)(unsigned)__builtin_amdgcn_readfirstlane((unsigned)(U >> 32)) << 32) | (unsigned)__builtin_amdgcn_readfirstlane((unsigned)U);
        LAS float* ocL = impL + wave * 2048 + lane;
#pragma unroll
        for (int i = 0; i < 16; ++i) { ocL[i * 64] = oc[0][i]; ocL[(16 + i) * 64] = oc[1][i]; }
        {
            l = 0.f;
#pragma unroll
            for (int i = 0; i < 16; ++i) { o[0][i] = 0.f; o[1][i] = 0.f; }
            nsa_stream<true>(L, kvs, lutH, qf, b, g, cq, tq, lane, r32, hf, srow, schunk, U, (const LAS unsigned*)(selL + qh * 32 + r32), l, o);
            const float lt = l + __shfl_xor(l, 32), sc = gpark[0] / lt;
#pragma unroll
            for (int i = 0; i < 16; ++i) { ocL[i * 64] += sc * o[0][i]; ocL[(16 + i) * 64] += sc * o[1][i]; }
        }
        {
            l = 0.f;
#pragma unroll
            for (int i = 0; i < 16; ++i) { o[0][i] = 0.f; o[1][i] = 0.f; }
            nsa_stream<false>(L, kvs, lutH, qf, b, g, cq, tq, lane, r32, hf, srow, schunk, U, (const LAS unsigned*)(selL + qh * 32 + r32), l, o);
            const float lt = l + __shfl_xor(l, 32), sc = gpark[512] / lt;
#pragma unroll
            for (int i = 0; i < 16; ++i) { oc[0][i] = ocL[i * 64] + sc * o[0][i]; oc[1][i] = ocL[(16 + i) * 64] + sc * o[1][i]; }
        }
#pragma unroll
        for (int dt = 0; dt < 2; ++dt)
#pragma unroll
            for (int g4 = 0; g4 < 4; ++g4) { v2u wv; wv.x = pk2(oc[dt][4 * g4], oc[dt][4 * g4 + 1]); wv.y = pk2(oc[dt][4 * g4 + 2], oc[dt][4 * g4 + 3]);
                *(v2u*)(oa + (size_t)QROW_LATE() * 1536 + head * 64 + dt * 32 + 8 * g4 + 4 * hf) = wv; }
        __syncthreads();
    }
}
#undef KLOC


constexpr int GV_TS = 576;
constexpr int GL_V = 0, GL_KST = GL_V + 64 * GV_TS, GL_GS = GL_KST + 128 * 144, GL_ST = GL_GS + 2048, GL_END1 = GL_ST + 256 * 264;
static_assert(GL_END1 <= RING_BYTES, "gla lds");
__device__ __forceinline__ float log_sigmoid_(float z) { return fminf(z, 0.f) - __logf(1.0f + __expf(-fabsf(z))); }

__device__ __forceinline__ void gla_stage_v(Frame& F, LAS unsigned char* L, const bf16* vb, size_t row0, int h) {
#pragma unroll
    for (int i = 0; i < 4; ++i) { const int idx = F.tid + 512 * i, r = idx >> 5, c = idx & 31;
        *(LAS v4u*)(L + GL_V + r * GV_TS + c * 16) = *(const v4u*)(vb + (row0 + r) * 1024 + h * 256 + c * 8); }
}
constexpr int GL_ALR = GL_END1;
static_assert(GL_ALR + 4096 <= RING_BYTES, "gla lds 2");
__device__ __forceinline__ void phase_gla1(Frame& F, int l, size_t o_qb = WS_QB, size_t o_kb = WS_KB, size_t o_gst = WS_GST, size_t o_dec = WS_DECAY) {
    relaunder(F);
    LAS unsigned char* L = F.lds + RING_OFF;
    bf16* qb = (bf16*)(F.ws + o_qb); bf16* kb = (bf16*)(F.ws + o_kb); const bf16* vb = (const bf16*)(F.ws + WS_VB);
    const float* alr = (const float*)(F.ws + WS_ALR); bf16* gst = (bf16*)(F.ws + o_gst); float* decay = (float*)(F.ws + o_dec);
    const float* aw2 = inp(F, I_AW2) + (size_t)l * 16 * 512; const float* abp = inp(F, I_AB) + l * 512;
    const int tid = F.tid, lane = F.lane, wave = F.wave, r32 = lane & 31, hf = lane >> 5;
    const int d = tid & 127, tg = tid >> 7;
    const int et = tid >> 3, ec = tid & 7;
    LAS float* gs = (LAS float*)(L + GL_GS); LAS float* bL = (LAS float*)(L + GL_ST); LAS float* alrL = (LAS float*)(L + GL_ALR);
    v4u q0, q1, k0, k1, vr[4]; f32x4 ar = {0.f, 0.f, 0.f, 0.f}; float w2r[16], ab;
#define GLA1_LOAD(u_) do { const int bh_ = (u_) >> 6, n_ = (u_) & 63, b_ = bh_ >> 2, h_ = bh_ & 3; const size_t row0_ = (size_t)b_ * SEQ + n_ * 64; \
        const size_t ea_ = (row0_ + et) * 512 + h_ * 128 + ec * 16; \
        q0 = *(const v4u*)(qb + ea_); q1 = *(const v4u*)(qb + ea_ + 8); k0 = *(const v4u*)(kb + ea_); k1 = *(const v4u*)(kb + ea_ + 8); \
        _Pragma("unroll") for (int i_ = 0; i_ < 4; ++i_) { const int idx_ = tid + 512 * i_; vr[i_] = *(const v4u*)(vb + (row0_ + (idx_ >> 5)) * 1024 + h_ * 256 + (idx_ & 31) * 8); } \
        if (tid < 256) ar = *(const f32x4*)(alr + row0_ * 16 + tid * 4); \
        _Pragma("unroll") for (int r_ = 0; r_ < 16; ++r_) w2r[r_] = aw2[r_ * 512 + h_ * 128 + d]; \
        ab = abp[h_ * 128 + d]; } while (0)
    const int ustep = F.G - 16;
    int u = __builtin_amdgcn_readfirstlane(F.bid - 16);
    asm volatile("" : "+s"(u));
    if (u < 1024) GLA1_LOAD(u);
    for (; u < 1024; u += ustep) {
        const int bh = u >> 6, n = u & 63, b = bh >> 2, h = bh & 3; const size_t row0 = (size_t)b * SEQ + n * 64;
        const size_t ea = (row0 + et) * 512 + h * 128 + ec * 16;
#pragma unroll
        for (int i = 0; i < 4; ++i) { const int idx = tid + 512 * i; *(LAS v4u*)(L + GL_V + (idx >> 5) * GV_TS + (idx & 31) * 16) = vr[i]; }
        if (tid < 256) *(LAS f32x4*)(alrL + tid * 4) = ar;
        LDS_BARRIER();
        float bl[16]; float cum = 0.f;
#pragma unroll
        for (int i = 0; i < 16; ++i) { const LAS f32x4* arow = (const LAS f32x4*)(alrL + (tg * 16 + i) * 16); float z = ab;
#pragma unroll
            for (int q = 0; q < 4; ++q) { const f32x4 av = arow[q]; z += av[0] * w2r[4 * q] + av[1] * w2r[4 * q + 1] + av[2] * w2r[4 * q + 2] + av[3] * w2r[4 * q + 3]; }
            cum += log_sigmoid_(z) * (1.0f / 16.0f); bl[i] = cum; }
        gs[tg * 128 + d] = cum;
        LDS_BARRIER();
        float pre = 0.f, tot = 0.f;
#pragma unroll
        for (int g2 = 0; g2 < 4; ++g2) { const float x = gs[g2 * 128 + d]; tot += x; if (g2 < tg) pre += x; }
        if (tg == 0) decay[(size_t)u * 128 + d] = __expf(tot);
#pragma unroll
        for (int i = 0; i < 16; ++i) bL[(tg * 16 + i) * 128 + d] = bl[i] + pre;
        LDS_BARRIER();
        {
            const unsigned qw[8] = {q0.x, q0.y, q0.z, q0.w, q1.x, q1.y, q1.z, q1.w}, kw[8] = {k0.x, k0.y, k0.z, k0.w, k1.x, k1.y, k1.z, k1.w};
            unsigned qo[8], ko[8];
#pragma unroll
            for (int j = 0; j < 8; ++j) {
                const int dd = ec * 16 + 2 * j;
                const float b0 = bL[et * 128 + dd], b1 = bL[et * 128 + dd + 1], t0 = bL[63 * 128 + dd], t1 = bL[63 * 128 + dd + 1];
                const float e0 = __expf(b0), e1 = __expf(b1);
                qo[j] = pk2(bflo(qw[j]) * e0, bfhi(qw[j]) * e1);
                ko[j] = pk2(bflo(kw[j]) * __builtin_amdgcn_rcpf(e0), bfhi(kw[j]) * __builtin_amdgcn_rcpf(e1));
                *(LAS unsigned short*)(L + GL_KST + dd * 144 + et * 2) = (unsigned short)f2bf(bflo(kw[j]) * __expf(t0 - b0));
                *(LAS unsigned short*)(L + GL_KST + (dd + 1) * 144 + et * 2) = (unsigned short)f2bf(bfhi(kw[j]) * __expf(t1 - b1));
            }
            *(v4u*)(qb + ea) = (v4u){qo[0], qo[1], qo[2], qo[3]}; *(v4u*)(qb + ea + 8) = (v4u){qo[4], qo[5], qo[6], qo[7]};
            *(v4u*)(kb + ea) = (v4u){ko[0], ko[1], ko[2], ko[3]}; *(v4u*)(kb + ea + 8) = (v4u){ko[4], ko[5], ko[6], ko[7]};
        }
        if (u + ustep < 1024) GLA1_LOAD(u + ustep);
        LDS_BARRIER();
        {
            const int dkb = wave & 3, dvh = wave >> 2;
            f32x16 acc[4];
#pragma unroll
            for (int t4 = 0; t4 < 4; ++t4)
#pragma unroll
                for (int i = 0; i < 16; ++i) acc[t4][i] = 0.f;
            const LAS unsigned char* vbase = L + GL_V + (8 * hf + ((lane & 15) >> 2)) * GV_TS + (dvh * 128 + 16 * ((lane >> 4) & 1) + 4 * (lane & 3)) * 2;
#pragma unroll
            for (int kp = 0; kp < 2; ++kp) {
                bf16x8 af[2]; v4i16_t blo[2][4], bhi[2][4];
#pragma unroll
                for (int k2 = 0; k2 < 2; ++k2) { const int kk = kp * 2 + k2;
                    af[k2] = *(const LAS bf16x8*)(L + GL_KST + (dkb * 32 + r32) * 144 + kk * 32 + hf * 16);
#pragma unroll
                    for (int t4 = 0; t4 < 4; ++t4) { const LAS unsigned char* bp = vbase + (16 * kk) * GV_TS + t4 * 64;
                        blo[k2][t4] = __builtin_amdgcn_ds_read_tr16_b64_v4i16((LAS v4i16_t*)bp);
                        bhi[k2][t4] = __builtin_amdgcn_ds_read_tr16_b64_v4i16((LAS v4i16_t*)(bp + 4 * GV_TS)); } }
                __builtin_amdgcn_sched_barrier(0);
#pragma unroll
                for (int k2 = 0; k2 < 2; ++k2)
#pragma unroll
                    for (int t4 = 0; t4 < 4; ++t4) { const v4i16_t lo = blo[k2][t4], hi = bhi[k2][t4];
                        const bf16x8 bv = {lo[0], lo[1], lo[2], lo[3], hi[0], hi[1], hi[2], hi[3]};
                        acc[t4] = __builtin_amdgcn_mfma_f32_32x32x16_bf16(af[k2], bv, acc[t4], 0, 0, 0); }
                __builtin_amdgcn_sched_barrier(0);
            }
#pragma unroll
            for (int t4 = 0; t4 < 4; ++t4)
#pragma unroll
                for (int g4 = 0; g4 < 4; ++g4) { v2u wv; wv.x = pk2(acc[t4][4 * g4], acc[t4][4 * g4 + 1]); wv.y = pk2(acc[t4][4 * g4 + 2], acc[t4][4 * g4 + 3]);
                    *(LAS v2u*)(L + GL_ST + (dvh * 128 + t4 * 32 + r32) * 264 + (dkb * 32 + 8 * g4 + 4 * hf) * 2) = wv; }
        }
        LDS_BARRIER();
        {
            bf16* dst = gst + (size_t)u * 32768;
#pragma unroll
            for (int i = 0; i < 8; ++i) { const int idx = tid + 512 * i, r = idx >> 4, c = idx & 15;
                const v2u x0 = *(const LAS v2u*)(L + GL_ST + r * 264 + c * 16), x1 = *(const LAS v2u*)(L + GL_ST + r * 264 + c * 16 + 8);
                *(v4u*)(dst + (size_t)r * 128 + c * 8) = (v4u){x0.x, x0.y, x1.x, x1.y}; }
        }
        LDS_BARRIER();
    }
#undef GLA1_LOAD
}
__device__ __forceinline__ void phase_gla2(Frame& F, size_t o_gst = WS_GST) {
    relaunder(F);
    bf16* gst = (bf16*)(F.ws + o_gst); const float* decay = (const float*)(F.ws + WS_DECAY);
    for (int e = F.bid * 512 + F.tid; e < 16 * 8192; e += F.G * 512) {
        const int bh = e >> 13, off = (e & 8191) * 4, dk0 = off & 127;
        f32x4 S = {0.f, 0.f, 0.f, 0.f};
#pragma unroll 1
        for (int n0 = 0; n0 < 64; n0 += 16) {
            v2u dv[16]; f32x4 dec[16];
#pragma unroll
            for (int j = 0; j < 16; ++j) {
                dv[j] = *(const v2u*)(gst + (size_t)(bh * 64 + n0 + j) * 32768 + off);
                dec[j] = *(const f32x4*)(decay + (size_t)(bh * 64 + n0 + j) * 128 + dk0); }
#pragma unroll
            for (int j = 0; j < 16; ++j) {
                v2u sv; sv.x = pk2(S[0], S[1]); sv.y = pk2(S[2], S[3]); *(v2u*)(gst + (size_t)(bh * 64 + n0 + j) * 32768 + off) = sv;
                S[0] = dec[j][0] * S[0] + bflo(dv[j].x); S[1] = dec[j][1] * S[1] + bfhi(dv[j].x); S[2] = dec[j][2] * S[2] + bflo(dv[j].y); S[3] = dec[j][3] * S[3] + bfhi(dv[j].y); }
        }
    }
}
__device__ __forceinline__ void phase_gla3(Frame& F) {
    relaunder(F);
    LAS unsigned char* L = F.lds + RING_OFF;
    const bf16* qb = (const bf16*)(F.ws + WS_QB); const bf16* kb = (const bf16*)(F.ws + WS_KB); const bf16* vb = (const bf16*)(F.ws + WS_VB);
    const bf16* gst = (const bf16*)(F.ws + WS_GST); const bf16* rb = (const bf16*)(F.ws + WS_RB); bf16* ob = (bf16*)(F.ws + WS_OAB) + 512;
    const int wave = F.wave, ti = wave & 1, dvp = wave >> 1;
    int tid = F.tid, lane = tid & 63, r32 = lane & 31, hf = lane >> 5;
    LAS float* ssq = (LAS float*)(L + GL_GS);
    constexpr int GK_TS = 272;
    static_assert(64 * GK_TS <= 128 * 144, "k tile fits the ksT slot");
    v4u vr[4], kr[2]; bf16x8 qf[8], sf[8];
#define GLA3_LOAD(u_) do { const int bh_ = (u_) >> 6, n_ = (u_) & 63, b_ = bh_ >> 2, h_ = bh_ & 3; const size_t row0_ = (size_t)b_ * SEQ + n_ * 64; \
        _Pragma("unroll") for (int i_ = 0; i_ < 4; ++i_) { const int idx_ = tid + 512 * i_; vr[i_] = *(const v4u*)(vb + (row0_ + (idx_ >> 5)) * 1024 + h_ * 256 + (idx_ & 31) * 8); } \
        _Pragma("unroll") for (int i_ = 0; i_ < 2; ++i_) { const int idx_ = tid + 512 * i_; kr[i_] = *(const v4u*)(kb + (row0_ + (idx_ >> 4)) * 512 + h_ * 128 + (idx_ & 15) * 8); } \
        const bf16* qrow_ = qb + (row0_ + ti * 32 + r32) * 512 + h_ * 128 + hf * 8; \
        _Pragma("unroll") for (int kk_ = 0; kk_ < 8; ++kk_) qf[kk_] = *(const bf16x8*)(qrow_ + kk_ * 16); \
        const bf16* sb_ = gst + (size_t)(u_) * 32768 + (size_t)(dvp * 64 + r32) * 128 + hf * 8; \
        _Pragma("unroll") for (int x_ = 0; x_ < 8; ++x_) sf[x_] = *(const bf16x8*)(sb_ + x_ * 16); } while (0)
    int u = __builtin_amdgcn_readfirstlane(F.bid); asm volatile("" : "+s"(u));
    if (u < 1024) GLA3_LOAD(u);
    for (; u < 1024; u += F.G) {
        const int bh = u >> 6, n = u & 63, b = bh >> 2, h = bh & 3; const size_t row0 = (size_t)b * SEQ + n * 64;
        tid = (F.wave0 << 6) | lane_id_here_(); asm volatile("" : "+v"(tid)); lane = tid & 63; r32 = lane & 31; hf = lane >> 5;
#pragma unroll
        for (int i = 0; i < 4; ++i) { const int idx = tid + 512 * i; *(LAS v4u*)(L + GL_V + (idx >> 5) * GV_TS + (idx & 31) * 16) = vr[i]; }
#pragma unroll
        for (int i = 0; i < 2; ++i) { const int idx = tid + 512 * i; *(LAS v4u*)(L + GL_KST + (idx >> 4) * GK_TS + (idx & 15) * 16) = kr[i]; }
        f32x16 o[2];
#pragma unroll
        for (int i = 0; i < 16; ++i) { o[0][i] = 0.f; o[1][i] = 0.f; }
        bf16x8 sg[8];
        { const bf16* sb1 = gst + (size_t)u * 32768 + (size_t)(dvp * 64 + 32 + r32) * 128 + hf * 8;
#pragma unroll
          for (int kk = 0; kk < 8; ++kk) sg[kk] = *(const bf16x8*)(sb1 + kk * 16); }
#pragma unroll
        for (int kk = 0; kk < 8; ++kk) o[0] = __builtin_amdgcn_mfma_f32_32x32x16_bf16(sf[kk], qf[kk], o[0], 0, 0, 0);
        LDS_BARRIER();
        bf16x8 pb[2][2];
#pragma unroll
        for (int jt = 0; jt < 2; ++jt) {
            f32x16 pt;
#pragma unroll
            for (int i = 0; i < 16; ++i) pt[i] = 0.f;
            if (jt <= ti) {
                bf16x8 kfr[8];
#pragma unroll
                for (int kk = 0; kk < 8; ++kk) kfr[kk] = *(const LAS bf16x8*)(L + GL_KST + (jt * 32 + r32) * GK_TS + kk * 32 + hf * 16);
                __builtin_amdgcn_sched_barrier(0);
#pragma unroll
                for (int kk = 0; kk < 8; ++kk) pt = __builtin_amdgcn_mfma_f32_32x32x16_bf16(kfr[kk], qf[kk], pt, 0, 0, 0);
                if (jt == ti) {
#pragma unroll
                    for (int i = 0; i < 16; ++i) if (((i & 3) + 8 * (i >> 2) + 4 * hf) > r32) pt[i] = 0.f;
                }
            }
            pb[jt][0] = nsa_pack(pt, 0); pb[jt][1] = nsa_pack(pt, 1);
        }
#pragma unroll
        for (int kk = 0; kk < 8; ++kk) o[1] = __builtin_amdgcn_mfma_f32_32x32x16_bf16(sg[kk], qf[kk], o[1], 0, 0, 0);
        const size_t orow = (row0 + ti * 32 + r32) * 1024 + h * 256 + dvp * 64;
        v2u rw[8];
#pragma unroll
        for (int x = 0; x < 8; ++x) rw[x] = *(const v2u*)(rb + orow + (x >> 2) * 32 + 8 * (x & 3) + 4 * hf);
        if (u + F.G < 1024) GLA3_LOAD(u + F.G);
        {
            const LAS unsigned char* vbase = L + GL_V + (4 * hf + ((lane & 15) >> 2)) * GV_TS + (dvp * 64 + 16 * ((lane >> 4) & 1) + 4 * (lane & 3)) * 2;
#pragma unroll
            for (int dvt = 0; dvt < 2; ++dvt) {
                v4i16_t vlo[2][2], vhi[2][2];
#pragma unroll
                for (int jt = 0; jt < 2; ++jt)
#pragma unroll
                    for (int s2 = 0; s2 < 2; ++s2) {
                        if (jt <= ti) {
                            const LAS unsigned char* ap = vbase + (jt * 32 + 16 * s2) * GV_TS + dvt * 64;
                            vlo[jt][s2] = __builtin_amdgcn_ds_read_tr16_b64_v4i16((LAS v4i16_t*)ap);
                            vhi[jt][s2] = __builtin_amdgcn_ds_read_tr16_b64_v4i16((LAS v4i16_t*)(ap + 8 * GV_TS));
                        }
                    }
                __builtin_amdgcn_sched_barrier(0);
#pragma unroll
                for (int jt = 0; jt < 2; ++jt)
#pragma unroll
                    for (int s2 = 0; s2 < 2; ++s2) {
                        if (jt <= ti) {
                            const v4i16_t lo = vlo[jt][s2], hi = vhi[jt][s2];
                            const bf16x8 a = {lo[0], lo[1], lo[2], lo[3], hi[0], hi[1], hi[2], hi[3]};
                            o[dvt] = __builtin_amdgcn_mfma_f32_32x32x16_bf16(a, pb[jt][s2], o[dvt], 0, 0, 0);
                        }
                    }
                __builtin_amdgcn_sched_barrier(0);
            }
        }
        float ss = 0.f;
#pragma unroll
        for (int i = 0; i < 16; ++i) ss += o[0][i] * o[0][i] + o[1][i] * o[1][i];
        ss += __shfl_xor(ss, 32);
        if (hf == 0) ssq[dvp * 64 + ti * 32 + r32] = ss;
        LDS_BARRIER();
        const float tot = (ssq[ti * 32 + r32] + ssq[64 + ti * 32 + r32]) + (ssq[128 + ti * 32 + r32] + ssq[192 + ti * 32 + r32]);
        const float rs = __builtin_amdgcn_rsqf(tot * (1.0f / 256.0f) + EPSN);
#pragma unroll
        for (int dvt = 0; dvt < 2; ++dvt)
#pragma unroll
            for (int g4 = 0; g4 < 4; ++g4) { const int c0 = dvt * 32 + 8 * g4 + 4 * hf; const v2u rwv = rw[dvt * 4 + g4];
                v2u wv; wv.x = pk2(o[dvt][4 * g4] * rs * bflo(rwv.x), o[dvt][4 * g4 + 1] * rs * bfhi(rwv.x)); wv.y = pk2(o[dvt][4 * g4 + 2] * rs * bflo(rwv.y), o[dvt][4 * g4 + 3] * rs * bfhi(rwv.y));
                *(v2u*)(ob + (row0 + ti * 32 + r32) * 1536 + h * 256 + dvp * 64 + c0) = wv; }
        LDS_BARRIER();
    }
#undef GLA3_LOAD
}

__device__ __forceinline__ void phase_gla_naive(Frame& F, const Args& a, int l) {
    relaunder(F);
    if (F.bid >= 64) return;
    const int bh = F.bid >> 2, cb = F.bid & 3, b = bh >> 2, h = bh & 3;
    LAS float* qL = (LAS float*)(F.lds + RING_OFF); LAS float* kL = qL + 32 * 128; LAS float* aL = kL + 32 * 128; LAS float* vL = aL + 32 * 128;
    const bf16* qb = (const bf16*)(F.ws + WS_QB); const bf16* kb = (const bf16*)(F.ws + WS_KB); const bf16* vb = (const bf16*)(F.ws + WS_VB);
    const float* alr = (const float*)(F.ws + WS_ALR); float* oraw = (float*)(F.ws + WS_ORAW);
    const int tid = F.tid, split = tid & 7, ci = tid >> 3, d_st = tid & 127;
    float w2r[16];
#pragma unroll
    for (int r = 0; r < 16; ++r) w2r[r] = inp(F, I_AW2)[(size_t)l * 16 * 512 + r * 512 + h * 128 + d_st];
    const float ab = inp(F, I_AB)[l * 512 + h * 128 + d_st];
    float S[16];
#pragma unroll
    for (int i = 0; i < 16; ++i) S[i] = 0.f;
    for (int tc = 0; tc < SEQ / 32; ++tc) {
        const int t0 = tc * 32;
        __syncthreads();
#pragma unroll
        for (int i = 0; i < 8; ++i) { const int idx = tid + 512 * i, tt = idx >> 7; const size_t row = (size_t)b * SEQ + t0 + tt;
            qL[idx] = bf2f(qb[row * 512 + h * 128 + d_st]); kL[idx] = bf2f(kb[row * 512 + h * 128 + d_st]);
            const f32x4* ar = (const f32x4*)(alr + row * 16); float z = ab;
#pragma unroll
            for (int q = 0; q < 4; ++q) { const f32x4 av = ar[q]; z += av[0] * w2r[4 * q] + av[1] * w2r[4 * q + 1] + av[2] * w2r[4 * q + 2] + av[3] * w2r[4 * q + 3]; }
            const float ls = fminf(z, 0.f) - log1pf(__expf(-fabsf(z)));
            aL[idx] = __expf(ls * (1.0f / 16.0f)); }
#pragma unroll
        for (int i = 0; i < 4; ++i) { const int idx = tid + 512 * i, tt = idx >> 6, c = idx & 63; vL[idx] = bf2f(vb[((size_t)b * SEQ + t0 + tt) * 1024 + h * 256 + cb * 64 + c]); }
        __syncthreads();
        for (int tt = 0; tt < 32; ++tt) {
            const float vt = vL[tt * 64 + ci]; float o = 0.f;
#pragma unroll
            for (int q = 0; q < 4; ++q) { const f32x4 av = *(const LAS f32x4*)(aL + tt * 128 + split * 16 + 4 * q), kv = *(const LAS f32x4*)(kL + tt * 128 + split * 16 + 4 * q), qv = *(const LAS f32x4*)(qL + tt * 128 + split * 16 + 4 * q);
#pragma unroll
                for (int j = 0; j < 4; ++j) { S[4 * q + j] = av[j] * S[4 * q + j] + kv[j] * vt; o += qv[j] * S[4 * q + j]; } }
            o += __shfl_xor(o, 1); o += __shfl_xor(o, 2); o += __shfl_xor(o, 4);
            if (split == 0) oraw[((size_t)b * SEQ + t0 + tt) * 1024 + h * 256 + cb * 64 + ci] = o;
        }
    }
    __syncthreads();
}
__device__ __forceinline__ void phase_gla_norm(Frame& F) {
    relaunder(F);
    const int gw = F.bid * NWAVES + F.wave, NGW = F.G * NWAVES;
    const float* oraw = (const float*)(F.ws + WS_ORAW); const bf16* rb = (const bf16*)(F.ws + WS_RB); bf16* ob = (bf16*)(F.ws + WS_OB);
    for (int i = gw; i < MTOK * 4; i += NGW) {
        const f32x4 v = *((const f32x4*)(oraw + (size_t)i * 256) + F.lane);
        const float s = wave_sum((v[0] * v[0] + v[1] * v[1]) + (v[2] * v[2] + v[3] * v[3]));
        const float r = 1.0f / sqrtf(s * (1.0f / 256.0f) + EPSN);
        const v2u rw = *((const v2u*)(rb + (size_t)i * 256) + F.lane);
        v2u w; w.x = pk2(v[0] * r * bflo(rw.x), v[1] * r * bfhi(rw.x)); w.y = pk2(v[2] * r * bflo(rw.y), v[3] * r * bfhi(rw.y));
        *((v2u*)(ob + (size_t)i * 256) + F.lane) = w;
    }
}

__device__ __forceinline__ void stagger_wait(unsigned ticks  ) {
    const unsigned long long t0 = __builtin_amdgcn_s_memrealtime();
    while (__builtin_amdgcn_s_memrealtime() - t0 < (unsigned long long)ticks) __builtin_amdgcn_s_sleep(32);
}
#ifndef STAGGER_GU
#define STAGGER_GU 0
#endif
#ifndef STAGGER_WIN
#define STAGGER_WIN 0
#endif
#ifndef GLA_NAIVE
#define GLA_NAIVE 0
#endif
#ifndef MK_PER_PHASE
#define MK_PER_PHASE 0
#endif
#ifndef PG8_SP2
#define PG8_SP2 true
#endif
constexpr int NPH_L = 11, NPHASES = NL * NPH_L + 1;

__global__ void __launch_bounds__(NWAVES * 64, 2) fwd(Args args) {
    extern __shared__ __attribute__((aligned(16))) unsigned char lds[];
    Frame F;
    F.lds = (LAS unsigned char*)lds;
    F.tid = threadIdx.x; F.lane = F.tid & 63; F.wave = __builtin_amdgcn_readfirstlane(F.tid >> 6); F.wave0 = F.wave;
    F.G = gridDim.x; F.bid = blockIdx.x; F.ws = args.ws;
    unsigned char* ws = args.ws;
    for (int u = F.tid; u < (LDS_BYTES - LDSCTL_OFF) / 4; u += NWAVES * 64) ((LAS unsigned*)(F.lds + LDSCTL_OFF))[u] = 0u;
    if (F.tid < 50) ((LAS unsigned*)(F.lds + LDSCTL_OFF))[F.tid] = ((const __attribute__((address_space(4))) unsigned*)__builtin_amdgcn_kernarg_segment_ptr())[F.tid];
    __syncthreads();
    XcdBarrier bar; bar.bar = (unsigned*)(ws + WS_CTL) + CW_BAR; bar.x = 0; bar.st = nullptr; bar.w0 = F.wave0;
    if (!MK_PER_PHASE) bar = xcd_barrier_post((unsigned*)(ws + WS_CTL) + CW_BAR, (volatile LAS unsigned*)(F.lds + MISC_OFF) + 8, F.wave0);
    const int lo = args.ph_lo, hi = args.ph_hi;
#ifndef PH_MASK
#define PH_MASK 0xFFFF
#endif
#ifndef DBL_MASK
#define DBL_MASK 0
#endif
#define DBL(j) ((DBL_MASK >> (j)) & 1)
#define INL(j) (((PH_MASK >> (j)) & 1) && lo <= (pb + (j)) && (pb + (j)) < hi)
#define IN(k) (lo <= (k) && (k) < hi)
#define SEAM(k) do { if (IN((k) + 1)) { if (MK_PER_PHASE) { } else { XcdBarrier b_ = bar; GAS unsigned* bp_ = (GAS unsigned*)b_.bar; asm volatile("" : "+s"(bp_)); b_.bar = (unsigned*)bp_; xcd_barrier(b_); } } } while (0)
#define PH_PTRS relaunder(F); unsigned char* const ws = F.ws; bf16* const xb = (bf16*)(ws + WS_XB); float* const ssp = (float*)(ws + WS_SSP); bf16* const act = (bf16*)(ws + WS_ACT); (void)xb; (void)ssp; (void)act

    for (int l = 0; l < NL; ++l) {
        const int pb = l * NPH_L;
        if (INL(0)) { phase_conv(F, args, l); if (DBL(0)) { __syncthreads(); phase_conv(F, args, l); } if (l == 0) { phase_lut(F, args); phase_x0(F, args); } SEAM(pb + 0); }
        if (INL(1)) {
            PH_PTRS;
            pg8::Gemm g{xb, (const bf16*)(ws + W_GU1), MTOK, NGU, DM, DM}; g.w0 = F.wave; pg8::StaticOrder S; S.init(MTOK, NGU, F.G, F.bid);
            LAS float* rsL = (LAS float*)(F.lds + RS_OFF); pg8::Unit u0; int pm0 = -1; if (S.next(0, u0)) pm0 = u0.pm;
            EpiGU E{act, ssp, rsL, pm0};
            { pg8::Unit ul; if (STAGGER_GU && !S.next(5, ul)) stagger_wait(STAGGER_GU); }
            pg8::gemm_phase<EpiGU, pg8::StaticOrder, true, PG8_SP2>(F.lds + RING_OFF, g, S, E);
            SEAM(pb + 1);
        }
        if (INL(2)) {
            PH_PTRS;
            pg8::Gemm g{act, (const bf16*)(ws + W_D1), MTOK, DM, FF, FF}; g.w0 = F.wave; pg8::StaticOrder S; S.init(MTOK, DM, F.G, F.bid);
            EpiResid E{xb, ssp, 0.5f};
            pg8::gemm_phase<EpiResid, pg8::StaticOrder, true, PG8_SP2>(F.lds + RING_OFF, g, S, E);
            SEAM(pb + 2);
        }
        if (INL(3)) {
            PH_PTRS;
            pg8::Gemm g{xb, (const bf16*)(ws + W_IN), MTOK, NIN, DM, DM}; g.w0 = F.wave; pg8::StaticOrder S; S.init(MTOK, NIN, F.G, F.bid);
            LAS float* rsL = (LAS float*)(F.lds + RS_OFF); pg8::Unit u0; int pm0 = -1; if (S.next(0, u0)) pm0 = u0.pm;
            EpiWin E{ws, ssp, rsL, pm0};
            { pg8::Unit ul; if (STAGGER_WIN && !S.next(6, ul)) stagger_wait(STAGGER_WIN); }
            pg8::gemm_phase<EpiWin, pg8::StaticOrder, true, PG8_SP2>(F.lds + RING_OFF, g, S, E);
            SEAM(pb + 3);
        }
        if (INL(4)) {
            PH_PTRS;
            const bf16* kvc = (const bf16*)(ws + WS_KVC); bf16* hid = (bf16*)(ws + WS_HID); const float* posb = (const float*)(ws + WS_POSB) + l * 512;
            if (F.bid < 16) {
            { pg8::Gemm g{kvc, (const bf16*)(ws + W_C1K), 2048, 256, 2048, 1024}; g.w0 = F.wave; pg8::StaticOrder S; S.init(2048, 256, F.G, F.bid);
              EpiCmp1 E{hid, posb};
              pg8::gemm_phase<EpiCmp1, pg8::StaticOrder, true, PG8_SP2>(F.lds + RING_OFF, g, S, E); }
            { pg8::Gemm g{kvc + (size_t)8 * SEQ * 64, (const bf16*)(ws + W_C1V), 2048, 256, 2048, 1024}; g.w0 = F.wave; pg8::StaticOrder S; S.init(2048, 256, F.G, (F.bid + F.G - 8) % F.G);
              EpiCmp1 E{hid + (size_t)2048 * 256, posb + 256};
              pg8::gemm_phase<EpiCmp1, pg8::StaticOrder, true, PG8_SP2>(F.lds + RING_OFF, g, S, E); }
            } else phase_gla1(F, l);
            SEAM(pb + 4);
        }
        if (INL(5)) { phase_cmp2(F, args, l); phase_gla2(F); SEAM(pb + 5); }
        if (INL(6)) { phase_nsa(F); if (DBL(6)) { __syncthreads(); phase_nsa(F); } phase_gla3(F); SEAM(pb + 6); }
        if (INL(7)) {
            PH_PTRS;
            pg8::Gemm g{(const bf16*)(ws + WS_OAB), (const bf16*)(ws + W_CAT), MTOK, DM, 1536, 1536}; g.w0 = F.wave; pg8::StaticOrder S; S.init(MTOK, DM, F.G, F.bid);
            EpiMergeF E{(const bf16*)(ws + WS_GM), (const bf16*)(ws + WS_GM + 32 * MiB), (bf16*)(ws + WS_Y2)};
            pg8::gemm_phase<EpiMergeF, pg8::StaticOrder, true, PG8_SP2>(F.lds + RING_OFF, g, S, E);
            SEAM(pb + 7);
        }
        if (INL(8)) {
            PH_PTRS;
            pg8::Gemm g{(const bf16*)(ws + WS_Y2), (const bf16*)(ws + W_O), MTOK, DM, DM, DM}; g.w0 = F.wave; pg8::StaticOrder S; S.init(MTOK, DM, F.G, F.bid);
            EpiResid E{xb, ssp, 1.0f};
            pg8::gemm_phase<EpiResid, pg8::StaticOrder, true, PG8_SP2>(F.lds + RING_OFF, g, S, E);
            SEAM(pb + 8);
        }
        if (INL(9)) {
            PH_PTRS;
            pg8::Gemm g{xb, (const bf16*)(ws + W_GU2), MTOK, NGU, DM, DM}; g.w0 = F.wave; pg8::StaticOrder S; S.init(MTOK, NGU, F.G, F.bid);
            LAS float* rsL = (LAS float*)(F.lds + RS_OFF); pg8::Unit u0; int pm0 = -1; if (S.next(0, u0)) pm0 = u0.pm;
            EpiGU E{act, ssp, rsL, pm0};
            { pg8::Unit ul; if (STAGGER_GU && !S.next(5, ul)) stagger_wait(STAGGER_GU); }
            pg8::gemm_phase<EpiGU, pg8::StaticOrder, true, PG8_SP2>(F.lds + RING_OFF, g, S, E);
            SEAM(pb + 9);
        }
        if (INL(10)) {
            PH_PTRS;
            pg8::Gemm g{act, (const bf16*)(ws + W_D2), MTOK, DM, FF, FF}; g.w0 = F.wave; pg8::StaticOrder S; S.init(MTOK, DM, F.G, F.bid);
            EpiResid E{xb, ssp, 0.5f};
            pg8::gemm_phase<EpiResid, pg8::StaticOrder, true, PG8_SP2>(F.lds + RING_OFF, g, S, E);
            SEAM(pb + 10);
        }
    }
    if (IN(NL * NPH_L)) phase_final(F, args);
#undef IN
#undef SEAM
}

extern "C" void kernel_launch(void* const* d_in, const int* in_sizes, int n_in, void* d_out, int out_size, void* d_ws, size_t ws_size, hipStream_t stream) {
    static int grid = 0;
    if (grid == 0) {
        if (n_in != 25 || out_size != MTOK * DM || ws_size < WS_END) { fprintf(stderr, "kernel_launch: unexpected shapes (n_in %d, out %d, ws %zu, need %zu)\n", n_in, out_size, ws_size, (size_t)WS_END); grid = -1; return; }
        int dev = 0, cus = 0, per_cu = 0;
        if (hipGetDevice(&dev) != hipSuccess || hipDeviceGetAttribute(&cus, hipDeviceAttributeMultiprocessorCount, dev) != hipSuccess) { grid = -1; return; }
        if (hipFuncSetAttribute((const void*)fwd, hipFuncAttributeMaxDynamicSharedMemorySize, LDS_BYTES) != hipSuccess) { fprintf(stderr, "kernel_launch: hipFuncSetAttribute failed\n"); grid = -1; return; }
        if (hipOccupancyMaxActiveBlocksPerMultiprocessor(&per_cu, (const void*)fwd, NWAVES * 64, LDS_BYTES) != hipSuccess || per_cu < 1) { fprintf(stderr, "kernel_launch: occupancy query reports %d\n", per_cu); }
        (void)hipGetLastError();
        grid = cus;
    }
    if (grid < 0) return;
    (void)hipMemsetAsync((char*)d_ws + WS_CTL, 0, CTL_ZERO_BYTES, stream);
    Args a{};
    for (int i = 0; i < 25; ++i) a.in[i] = (const float*)d_in[i];
    a.out = (float*)d_out; a.ws = (unsigned char*)d_ws;
#if MK_PER_PHASE
    for (int p = 0; p < NPHASES; ++p) { a.ph_lo = p; a.ph_hi = p + 1; hipLaunchKernelGGL(fwd, dim3(grid), dim3(NWAVES * 64), LDS_BYTES, stream, a); }
#else
    a.ph_lo = 0; a.ph_hi = NPHASES;
    hipLaunchKernelGGL(fwd, dim3(grid), dim3(NWAVES * 64), LDS_BYTES, stream, a);
#endif
    const hipError_t le = hipPeekAtLastError();
    if (le != hipSuccess) fprintf(stderr, "kernel_launch: launch failed: %s\n", hipGetErrorName(le));
}
```
